# Optimizing an MI355X kernel written in HIP

```python
import jax, jax.numpy as jnp
from jax import lax
import numpy as np

D_MODEL = 1024
BATCH = 4
SEQ = 8192
DEPTH = 2

GRID_W = 64
HEAD_DIM = 64
Q_BLOCK = 128
ROPE_THETA = 10000.0
EPS = 1e-6
A_HEADS = 8
A_KV_HEADS = 2
B_HEADS = 8
B_Q_RANK = 384
B_KV_RANK = 256
B_NOPE = 64
B_ROPE = 32
B_V = 64
C_HEADS = 16
C_WIN_ROWS = 8
C_WIN_COLS = 16
D_FF = 4 * D_MODEL

A_Q = A_HEADS * HEAD_DIM
A_KV = A_KV_HEADS * HEAD_DIM
EVEN_SPLITS = (A_Q, A_Q + A_KV, A_Q + 2 * A_KV, A_Q + 2 * A_KV + B_Q_RANK,
               A_Q + 2 * A_KV + B_Q_RANK + B_KV_RANK)
EVEN_IN = A_Q + 2 * A_KV + B_Q_RANK + B_KV_RANK + B_ROPE
MIX_WIDTH = A_HEADS * HEAD_DIM + B_HEADS * B_V
C_WIDTH = C_HEADS * HEAD_DIM
N_EVEN = (DEPTH + 1) // 2
N_ODD = DEPTH // 2

kernel_name = "hybrid_gqa_mla_natten_encoder"


def rmsnorm(x, g):
    xf = x.astype(jnp.float32)
    y = xf * lax.rsqrt(jnp.mean(xf * xf, axis=-1, keepdims=True) + EPS)
    return (y * g.astype(jnp.float32)).astype(x.dtype)


def rope_1d(x, pos):
    d = x.shape[-1]
    inv = ROPE_THETA ** (-jnp.arange(0, d, 2, dtype=jnp.float32) / d)
    ang = pos[:, None] * inv[None, :]
    cos = jnp.cos(ang)[:, None, :].astype(x.dtype)
    sin = jnp.sin(ang)[:, None, :].astype(x.dtype)
    x1, x2 = jnp.split(x, 2, axis=-1)
    return jnp.concatenate([x1 * cos - x2 * sin, x2 * cos + x1 * sin], axis=-1)


def axial_rope(x, row, col):
    xr, xc = jnp.split(x, 2, axis=-1)
    return jnp.concatenate([rope_1d(xr, row), rope_1d(xc, col)], axis=-1)


def block_attention(q, k, v, scale):
    b, s, hq, d = q.shape
    hkv = k.shape[2]
    g = hq // hkv
    nblk = s // Q_BLOCK
    qb = q.reshape(b, nblk, Q_BLOCK, hkv, g, d).transpose(1, 0, 3, 4, 2, 5)
    kt = k.transpose(0, 2, 1, 3)
    vt = v.transpose(0, 2, 1, 3)

    def one(qblk):
        sc = jnp.einsum('bkgqd,bksd->bkgqs', qblk, kt).astype(jnp.float32) * scale
        p = jax.nn.softmax(sc, axis=-1).astype(vt.dtype)
        return jnp.einsum('bkgqs,bksd->bkgqd', p, vt)

    o = lax.map(one, qb)
    return o.transpose(1, 0, 4, 2, 3, 5).reshape(b, s, hq, -1)


def hybrid_attention(h, w_in, a_q_norm, a_k_norm, b_q_norm, b_w_uq, b_kv_norm, b_w_ukv,
                     w_out, row, col):
    b, s, _ = h.shape
    z = h @ w_in
    qa, ka, va, cq, ckv, kr = jnp.split(z, EVEN_SPLITS, axis=-1)
    qa = axial_rope(rmsnorm(qa.reshape(b, s, A_HEADS, HEAD_DIM), a_q_norm), row, col)
    ka = axial_rope(rmsnorm(ka.reshape(b, s, A_KV_HEADS, HEAD_DIM), a_k_norm), row, col)
    va = va.reshape(b, s, A_KV_HEADS, HEAD_DIM)
    oa = block_attention(qa, ka, va, HEAD_DIM ** -0.5)
    qb = (rmsnorm(cq, b_q_norm) @ b_w_uq).reshape(b, s, B_HEADS, B_NOPE + B_ROPE)
    q_nope, q_rope = jnp.split(qb, (B_NOPE,), axis=-1)
    q_rope = axial_rope(q_rope, row, col)
    kvb = (rmsnorm(ckv, b_kv_norm) @ b_w_ukv).reshape(b, s, B_HEADS, B_NOPE + B_V)
    k_nope, vb = jnp.split(kvb, (B_NOPE,), axis=-1)
    k_rope = axial_rope(kr[:, :, None, :], row, col)
    q_full = jnp.concatenate([q_nope, q_rope], axis=-1)
    k_full = jnp.concatenate([k_nope, jnp.broadcast_to(k_rope, (b, s, B_HEADS, B_ROPE))], axis=-1)
    ob = block_attention(q_full, k_full, vb, (B_NOPE + B_ROPE) ** -0.5)
    mixed = jnp.concatenate([oa.reshape(b, s, -1), ob.reshape(b, s, -1)], axis=-1)
    return mixed @ w_out


def neighbourhood_attention(h, w_qkv, rpb, w_out):
    b, s, _ = h.shape
    rows = s // GRID_W
    wr = min(C_WIN_ROWS, rows)
    wc = C_WIN_COLS
    nblk = s // Q_BLOCK
    q, k, v = jnp.split(h @ w_qkv, 3, axis=-1)
    q = q.reshape(b, s, C_HEADS, HEAD_DIM).transpose(0, 2, 1, 3)
    k = k.reshape(b, s, C_HEADS, HEAD_DIM).transpose(0, 2, 1, 3)
    v = v.reshape(b, s, C_HEADS, HEAD_DIM).transpose(0, 2, 1, 3)
    t = jnp.arange(s, dtype=jnp.int32)
    qr, qc = t // GRID_W, t % GRID_W
    rs = jnp.clip(qr - wr // 2, 0, rows - wr)
    cs = jnp.clip(qc - wc // 2, 0, GRID_W - wc)
    kr = rs[:, None, None] + jnp.arange(wr, dtype=jnp.int32)[None, :, None]
    kc = cs[:, None, None] + jnp.arange(wc, dtype=jnp.int32)[None, None, :]
    idx = (kr * GRID_W + kc).reshape(s, wr * wc)
    ridx = jnp.broadcast_to(kr - qr[:, None, None] + (C_WIN_ROWS - 1), (s, wr, wc)).reshape(s, -1)
    cidx = jnp.broadcast_to(kc - qc[:, None, None] + (C_WIN_COLS - 1), (s, wr, wc)).reshape(s, -1)
    qbk = q.reshape(b, C_HEADS, nblk, Q_BLOCK, HEAD_DIM).transpose(2, 0, 1, 3, 4)
    blk = lambda a: a.reshape(nblk, Q_BLOCK, -1)
    scale = HEAD_DIM ** -0.5

    def one(args):
        qblk, iblk, rblk, cblk = args
        kg = jnp.take(k, iblk, axis=2)
        vg = jnp.take(v, iblk, axis=2)
        bias = rpb[:, rblk, cblk].astype(jnp.float32)
        sc = jnp.einsum('bhqd,bhqkd->bhqk', qblk, kg).astype(jnp.float32) * scale + bias[None]
        p = jax.nn.softmax(sc, axis=-1).astype(vg.dtype)
        return jnp.einsum('bhqk,bhqkd->bhqd', p, vg)

    o = lax.map(one, (qbk, blk(idx), blk(ridx), blk(cidx)))
    o = o.transpose(1, 0, 3, 2, 4).reshape(b, s, C_WIDTH)
    return o @ w_out


def sq_relu_mlp(h, w_up, w_down):
    u = jax.nn.relu(h @ w_up)
    return (u * u) @ w_down


def setup_inputs(seed: int = 0) -> dict:
    key = jax.random.key(seed)
    ks = jax.random.split(key, 20)

    def w(k, shape, fan_in):
        return jax.random.normal(k, shape, jnp.float32) * (fan_in ** -0.5)

    def gain(k, shape):
        return 1.0 + 0.05 * jax.random.normal(k, shape, jnp.float32)

    return {
        "x": jax.random.normal(ks[0], (BATCH, SEQ, D_MODEL), jnp.float32),
        "norm_mix": gain(ks[1], (DEPTH, D_MODEL)),
        "ev_w_in": w(ks[2], (N_EVEN, D_MODEL, EVEN_IN), D_MODEL),
        "ev_a_q_norm": gain(ks[3], (N_EVEN, HEAD_DIM)),
        "ev_a_k_norm": gain(ks[4], (N_EVEN, HEAD_DIM)),
        "ev_b_q_norm": gain(ks[5], (N_EVEN, B_Q_RANK)),
        "ev_b_w_uq": w(ks[6], (N_EVEN, B_Q_RANK, B_HEADS * (B_NOPE + B_ROPE)), B_Q_RANK),
        "ev_b_kv_norm": gain(ks[7], (N_EVEN, B_KV_RANK)),
        "ev_b_w_ukv": w(ks[8], (N_EVEN, B_KV_RANK, B_HEADS * (B_NOPE + B_V)), B_KV_RANK),
        "ev_w_out": w(ks[9], (N_EVEN, MIX_WIDTH, D_MODEL), MIX_WIDTH),
        "od_w_qkv": w(ks[10], (N_ODD, D_MODEL, 3 * C_WIDTH), D_MODEL),
        "od_rpb": 0.1 * jax.random.normal(ks[11], (N_ODD, C_HEADS, 2 * C_WIN_ROWS - 1, 2 * C_WIN_COLS - 1), jnp.float32),
        "od_w_out": w(ks[12], (N_ODD, C_WIDTH, D_MODEL), C_WIDTH),
        "norm_ffn": gain(ks[13], (DEPTH, D_MODEL)),
        "ffn_w_up": w(ks[14], (DEPTH, D_MODEL, D_FF), D_MODEL),
        "ffn_w_down": w(ks[15], (DEPTH, D_FF, D_MODEL), D_FF),
        "final_norm": gain(ks[16], (D_MODEL,)),
    }


def reference(x, norm_mix, ev_w_in, ev_a_q_norm, ev_a_k_norm, ev_b_q_norm, ev_b_w_uq,
              ev_b_kv_norm, ev_b_w_ukv, ev_w_out, od_w_qkv, od_rpb, od_w_out,
              norm_ffn, ffn_w_up, ffn_w_down, final_norm):
    s = x.shape[1]
    t = jnp.arange(s, dtype=jnp.int32)
    row = (t // GRID_W).astype(jnp.float32)
    col = (t % GRID_W).astype(jnp.float32)
    h = x
    for layer in range(DEPTH):
        i = layer // 2
        hn = rmsnorm(h, norm_mix[layer])
        if layer % 2 == 0:
            h = h + hybrid_attention(hn, ev_w_in[i], ev_a_q_norm[i], ev_a_k_norm[i],
                                     ev_b_q_norm[i], ev_b_w_uq[i], ev_b_kv_norm[i],
                                     ev_b_w_ukv[i], ev_w_out[i], row, col)
        else:
            h = h + neighbourhood_attention(hn, od_w_qkv[i], od_rpb[i], od_w_out[i])
        h = h + sq_relu_mlp(rmsnorm(h, norm_ffn[layer]), ffn_w_up[layer], ffn_w_down[layer])
    return rmsnorm(h, final_norm)
```

```cpp
#include <hip/hip_runtime.h>
#include <hip/hip_cooperative_groups.h>
#include <cstdio>
#include <cstdint>
#include <cmath>
namespace cg = cooperative_groups;
namespace pg8 {
#define PG8_LAS __attribute__((address_space(3)))
typedef unsigned short bf16_t;
typedef short bf16x8 __attribute__((ext_vector_type(8)));
typedef float f32x4 __attribute__((ext_vector_type(4)));
typedef unsigned u32x4 __attribute__((ext_vector_type(4)));
constexpr int BM = 256, BK = 64, HALF = 128, HTB = HALF * BK * 2  , STAGE_BYTES = 8 * HTB, NXCD = 8, WGM = 8;

__host__ __device__ __forceinline__ int lds_byte(int r, int c) { const int st = (r >> 4) * 2 + (c >> 5), rr = r & 15, cc = c & 31, ob = rr * 64 + cc * 2; return st * 1024 + (ob ^ (((ob >> 9) & 1) << 5)); }
__host__ __device__ __forceinline__ void stage_rc(int b, int& R, int& C) { const int st = b / 1024, sb = b % 1024, swz = sb ^ (((sb >> 9) & 1) << 5); R = (st >> 1) * 16 + swz / 64; C = (st & 1) * 32 + (swz % 64) / 2; }
__host__ __device__ __forceinline__ int perm32(int rho) { const int n = rho >> 4, i = rho & 15; return 8 * (i >> 2) + 4 * n + (i & 3); }

struct Unit { int pm, pn; };
struct Gemm { const bf16_t* A; const bf16_t* Bt; int M, N, K; };

struct StaticOrder {
    int nM, nN, nwg, G, c;
    __host__ __device__ void init(int M, int N, int G_, int c_) { nM = M / BM; nN = N / BM; nwg = nM * nN; G = G_; c = c_; }
    __host__ __device__ bool next(int i, Unit& u) const {
        const long L = (long)i * G + c; if (L >= nwg) return false;
        int wgid = (int)L; { const int q = nwg / NXCD, r = nwg % NXCD, xcd = wgid % NXCD, off = wgid / NXCD; wgid = (xcd < r ? xcd * (q + 1) : r * (q + 1) + (xcd - r) * q) + off; }
        const int nig = WGM * nN, gid = wgid / nig, fm = gid * WGM, gsz = (nM - fm) < WGM ? (nM - fm) : WGM;
        u.pm = fm + ((wgid % nig) % gsz); u.pn = (wgid % nig) / gsz; return true;
    }
    __device__ __forceinline__ void a_ready(const Unit&) const {}
    __device__ __forceinline__ void done(const Unit&) const {}
};
__device__ __forceinline__ unsigned cvt_pk_bf16(float lo, float hi) { unsigned r; asm volatile("v_cvt_pk_bf16_f32 %0, %1, %2" : "=v"(r) : "v"(lo), "v"(hi)); return r; }
constexpr float NORM_EPS = 1e-6f;
template <int ACT> struct EpiScale {
    static constexpr bool PERM = true, AFTER_DRAIN = false;
    bf16_t* O; int ldc; const float* part; float inv_dim; int nq_tiles; float qscale;
    __device__ __forceinline__ void operator()(const f32x4 (&acc)[2][2][4][2], const Unit& u, int wr, int wc, int fr, int fq) const {
        const int row0 = u.pm * BM + wr * 64 + fr; const int col0 = u.pn * BM + wc * 32 + 8 * fq;
        const float sc = (u.pn < nq_tiles) ? qscale : 1.f;
#pragma unroll
        for (int ai = 0; ai < 2; ++ai)
#pragma unroll
            for (int m = 0; m < 4; ++m) { const int row = row0 + ai * HALF + m * 16; float rs = 1.f;
                if (part) { const f32x4* pp = (const f32x4*)(part + (size_t)row * 16); const f32x4 a = pp[0], b = pp[1], c = pp[2], d = pp[3];
                    const float s = ((a[0] + a[1]) + (a[2] + a[3])) + ((b[0] + b[1]) + (b[2] + b[3])) + ((c[0] + c[1]) + (c[2] + c[3])) + ((d[0] + d[1]) + (d[2] + d[3]));
                    rs = 1.0f / sqrtf(s * inv_dim + NORM_EPS); }
                if (ACT == 0) rs *= sc;
                bf16_t* rowp = O + (size_t)row * ldc + col0;
#pragma unroll
                for (int bj = 0; bj < 2; ++bj) { f32x4 v0 = acc[ai][bj][m][0] * rs, v1 = acc[ai][bj][m][1] * rs;
                    if (ACT == 1) {
#pragma unroll
                        for (int e = 0; e < 4; ++e) { float a = fmaxf(v0[e], 0.f), b = fmaxf(v1[e], 0.f); v0[e] = a * a; v1[e] = b * b; } }
                    u32x4 w; w.x = cvt_pk_bf16(v0[0], v0[1]); w.y = cvt_pk_bf16(v0[2], v0[3]); w.z = cvt_pk_bf16(v1[0], v1[1]); w.w = cvt_pk_bf16(v1[2], v1[3]);
                    *(u32x4*)(rowp + bj * HALF) = w; } }
    }
};
struct EpiRes {
    static constexpr bool PERM = true, AFTER_DRAIN = false;
    const float* base; float* out; bf16_t* ob; float* part; int ldc;
    __device__ __forceinline__ void operator()(const f32x4 (&acc)[2][2][4][2], const Unit& u, int wr, int wc, int fr, int fq) const {
        const int row0 = u.pm * BM + wr * 64 + fr; const int col0 = u.pn * BM + wc * 32 + 8 * fq;
#pragma unroll
        for (int ai = 0; ai < 2; ++ai)
#pragma unroll
            for (int m = 0; m < 4; ++m) { const int row = row0 + ai * HALF + m * 16; const size_t off = (size_t)row * ldc + col0; float ss = 0.f;
#pragma unroll
                for (int bj = 0; bj < 2; ++bj) { const f32x4 b0 = *(const f32x4*)(base + off + bj * HALF), b1 = *(const f32x4*)(base + off + bj * HALF + 4);
                    const f32x4 v0 = acc[ai][bj][m][0] + b0, v1 = acc[ai][bj][m][1] + b1;
                    *(f32x4*)(out + off + bj * HALF) = v0; *(f32x4*)(out + off + bj * HALF + 4) = v1;
                    u32x4 w; w.x = cvt_pk_bf16(v0[0], v0[1]); w.y = cvt_pk_bf16(v0[2], v0[3]); w.z = cvt_pk_bf16(v1[0], v1[1]); w.w = cvt_pk_bf16(v1[2], v1[3]);
                    *(u32x4*)(ob + off + bj * HALF) = w;
                    ss += (v0[0] * v0[0] + v0[1] * v0[1]) + (v0[2] * v0[2] + v0[3] * v0[3]) + (v1[0] * v1[0] + v1[1] * v1[1]) + (v1[2] * v1[2] + v1[3] * v1[3]); }
                ss += __shfl_xor(ss, 16); ss += __shfl_xor(ss, 32);
                if (fq == 0) part[(size_t)row * 16 + u.pn * 4 + wc] = ss; }
    }
};

template <class Epi, class Sched, bool ALIGN_EPI = false, bool SP2 = false>
__device__ __forceinline__ void gemm_phase(PG8_LAS unsigned char* lds, const Gemm g, const Sched& S, const Epi& E) {
    const int tid = threadIdx.x, wid = __builtin_amdgcn_readfirstlane(tid >> 6), lane = tid & 63, wr = wid >> 2, wc = wid & 3, fr = lane & 15, fq = lane >> 4;
    const int K = g.K, nt = K / BK;
    unsigned voffA[2], voffB[2];
#pragma unroll
    for (int i = 0; i < 2; ++i) { int R, C; stage_rc(tid * 16 + i * 8192, R, C); const int Rb = Epi::PERM ? ((R & ~31) + perm32(R & 31)) : R;
        voffA[i] = (unsigned)(R * K + C) * 2u; voffB[i] = (unsigned)(Rb * K + C) * 2u; }
    const size_t kstep = (size_t)(BK * 2);
    const size_t hstep = (size_t)HALF * K * 2;
    const size_t tstep = 2 * hstep;
    const unsigned ldsw = (unsigned)wid * 1024u;
    const int aoff = lds_byte(wr * 64 + fr, fq * 8), boff = lds_byte(wc * 32 + fr, fq * 8);
#define PG8_SA(b, h) (((b) * 2 + (h)) * HTB)
#define PG8_SB(b, h) ((4 + (b) * 2 + (h)) * HTB)
#define PG8_STAGE(bufoff, gbase, voff) do { _Pragma("unroll") for (int _i = 0; _i < 2; ++_i) \
        __builtin_amdgcn_global_load_lds((const unsigned*)((const char*)(gbase) + (voff)[_i]), (PG8_LAS unsigned*)(lds + (bufoff) + ldsw + _i * 8192), 16, 0, 0); } while (0)
#define PG8_LDA(dst, b, h) do { _Pragma("unroll") for (int m = 0; m < 4; ++m) _Pragma("unroll") for (int k = 0; k < 2; ++k) dst[m][k] = *(const PG8_LAS bf16x8*)(lds + PG8_SA(b, h) + aoff + m * 2048 + k * 1024); } while (0)
#define PG8_LDB(dst, b, h) do { _Pragma("unroll") for (int n = 0; n < 2; ++n) _Pragma("unroll") for (int k = 0; k < 2; ++k) dst[n][k] = *(const PG8_LAS bf16x8*)(lds + PG8_SB(b, h) + boff + n * 2048 + k * 1024); } while (0)
#define PG8_MMA(ai, bj, At, Bt) do { __builtin_amdgcn_s_setprio(1); _Pragma("unroll") for (int m = 0; m < 4; ++m) _Pragma("unroll") for (int n = 0; n < 2; ++n) _Pragma("unroll") for (int k = 0; k < 2; ++k) \
        acc[ai][bj][m][n] = __builtin_amdgcn_mfma_f32_16x16x32_bf16(Bt[n][k], At[m][k], acc[ai][bj][m][n], 0, 0, 0); __builtin_amdgcn_s_setprio(0); } while (0)
#define PG8_WAIT_V(n) asm volatile("s_waitcnt vmcnt(" #n ")" ::: "memory")
#define PG8_WAIT_L(n) asm volatile("s_waitcnt lgkmcnt(" #n ")" ::: "memory")
#define PG8_BAR __builtin_amdgcn_s_barrier()
#define PG8_SCHED __builtin_amdgcn_sched_barrier(0)
    Unit cur, nxt; int ui = 0;
    if (!S.next(0, cur)) return;
    f32x4 acc[2][2][4][2];
#pragma unroll
    for (int a = 0; a < 2; ++a)
#pragma unroll
        for (int b = 0; b < 2; ++b)
#pragma unroll
            for (int m = 0; m < 4; ++m)
#pragma unroll
                for (int n = 0; n < 2; ++n) acc[a][b][m][n] = (f32x4){0.f, 0.f, 0.f, 0.f};
    bf16x8 At[4][2], B0[2][2], B1[2][2];
    const char* cA = (const char*)g.A + (size_t)cur.pm * tstep; const char* cB = (const char*)g.Bt + (size_t)cur.pn * tstep;
    S.a_ready(cur);
    if constexpr (SP2) {
        PG8_STAGE(PG8_SB(0, 0), cB, voffB); PG8_STAGE(PG8_SB(0, 1), cB + hstep, voffB); PG8_STAGE(PG8_SA(0, 0), cA, voffA); PG8_STAGE(PG8_SA(0, 1), cA + hstep, voffA);
        if (wr == 1) PG8_BAR;
        PG8_WAIT_V(2); PG8_BAR;
        PG8_STAGE(PG8_SB(1, 0), cB + kstep, voffB); PG8_STAGE(PG8_SA(1, 0), cA + kstep, voffA); PG8_STAGE(PG8_SB(1, 1), cB + hstep + kstep, voffB);
        PG8_WAIT_V(6); PG8_BAR;
    } else {
        PG8_STAGE(PG8_SB(0, 0), cB, voffB); PG8_STAGE(PG8_SA(0, 0), cA, voffA); PG8_STAGE(PG8_SB(0, 1), cB + hstep, voffB); PG8_STAGE(PG8_SA(0, 1), cA + hstep, voffA);
        if (wr == 1) PG8_BAR;
        PG8_WAIT_V(4); PG8_BAR;
        PG8_STAGE(PG8_SB(1, 0), cB + kstep, voffB); PG8_STAGE(PG8_SA(1, 0), cA + kstep, voffA); PG8_STAGE(PG8_SB(1, 1), cB + hstep + kstep, voffB);
        PG8_WAIT_V(6); PG8_BAR;
    }
    for (;;) {
        const bool has_next = S.next(ui + 1, nxt);
        const char* nA = has_next ? (const char*)g.A + (size_t)nxt.pm * tstep : cA; const char* nB = has_next ? (const char*)g.Bt + (size_t)nxt.pn * tstep : cB;
        for (int t = 0; t < nt; t += 2) {
            const bool last = (t == nt - 2);
            const char* a1 = cA + (size_t)(t + 1) * kstep;
            const char* a2 = last ? nA : cA + (size_t)(t + 2) * kstep; const char* b2 = last ? nB : cB + (size_t)(t + 2) * kstep;
            const char* a3 = a2 + kstep; const char* b3 = b2 + kstep;
            if (last && has_next) S.a_ready(nxt);
            if constexpr (SP2) {
            PG8_LDB(B0, 0, 0); PG8_LDB(B1, 0, 1); PG8_SCHED; PG8_LDA(At, 0, 0); PG8_STAGE(PG8_SA(1, 1), a1 + hstep, voffA);
            PG8_WAIT_V(8); PG8_WAIT_L(0); PG8_BAR; PG8_MMA(0, 0, At, B0); PG8_MMA(0, 1, At, B1); PG8_BAR; PG8_SCHED;
            PG8_LDA(At, 0, 1); PG8_STAGE(PG8_SB(0, 0), b2, voffB); PG8_STAGE(PG8_SB(0, 1), b2 + hstep, voffB); PG8_STAGE(PG8_SA(0, 0), a2, voffA);
            PG8_WAIT_V(8); PG8_WAIT_L(0); PG8_BAR; PG8_MMA(1, 0, At, B0); PG8_MMA(1, 1, At, B1); PG8_BAR; PG8_SCHED;
            PG8_LDB(B0, 1, 0); PG8_LDB(B1, 1, 1); PG8_SCHED; PG8_LDA(At, 1, 0); PG8_STAGE(PG8_SA(0, 1), a2 + hstep, voffA);
            PG8_WAIT_V(8); PG8_WAIT_L(0); PG8_BAR; PG8_MMA(0, 0, At, B0); PG8_MMA(0, 1, At, B1); PG8_BAR; PG8_SCHED;
            PG8_LDA(At, 1, 1); PG8_STAGE(PG8_SB(1, 0), b3, voffB); PG8_STAGE(PG8_SB(1, 1), b3 + hstep, voffB); PG8_STAGE(PG8_SA(1, 0), a3, voffA);
            PG8_WAIT_V(8); PG8_WAIT_L(0); PG8_BAR; PG8_MMA(1, 0, At, B0); PG8_MMA(1, 1, At, B1); PG8_BAR; PG8_SCHED;
            } else {
            PG8_LDB(B0, 0, 0); PG8_SCHED; PG8_LDA(At, 0, 0); PG8_STAGE(PG8_SA(1, 1), a1 + hstep, voffA);
            PG8_WAIT_L(8); PG8_BAR; PG8_WAIT_L(0); PG8_MMA(0, 0, At, B0); PG8_BAR; PG8_SCHED;
            PG8_LDB(B1, 0, 1); PG8_STAGE(PG8_SB(0, 0), b2, voffB);
            PG8_BAR; PG8_WAIT_L(0); PG8_MMA(0, 1, At, B1); PG8_BAR;
            PG8_LDA(At, 0, 1); PG8_STAGE(PG8_SA(0, 0), a2, voffA);
            PG8_BAR; PG8_WAIT_L(0); PG8_MMA(1, 0, At, B0); PG8_BAR; PG8_SCHED;
            PG8_STAGE(PG8_SB(0, 1), b2 + hstep, voffB);
            PG8_WAIT_V(6); PG8_BAR; PG8_MMA(1, 1, At, B1); PG8_BAR;
            PG8_LDB(B0, 1, 0); PG8_SCHED; PG8_LDA(At, 1, 0); PG8_STAGE(PG8_SA(0, 1), a2 + hstep, voffA);
            PG8_WAIT_L(8); PG8_BAR; PG8_WAIT_L(0); PG8_MMA(0, 0, At, B0); PG8_BAR; PG8_SCHED;
            PG8_LDB(B1, 1, 1); PG8_STAGE(PG8_SB(1, 0), b3, voffB);
            PG8_BAR; PG8_WAIT_L(0); PG8_MMA(0, 1, At, B1); PG8_BAR;
            PG8_LDA(At, 1, 1); PG8_STAGE(PG8_SA(1, 0), a3, voffA);
            PG8_BAR; PG8_WAIT_L(0); PG8_MMA(1, 0, At, B0); PG8_BAR; PG8_SCHED;
            PG8_STAGE(PG8_SB(1, 1), b3 + hstep, voffB);
            PG8_WAIT_V(6); PG8_BAR; PG8_MMA(1, 1, At, B1); PG8_BAR;
            }
        }
        if constexpr (ALIGN_EPI) { if (wr == 0) PG8_BAR; }
        if constexpr (!Epi::AFTER_DRAIN) { E(acc, cur, wr, wc, fr, fq); S.done(cur); }
        if (!has_next) break;
#pragma unroll
        for (int a = 0; a < 2; ++a)
#pragma unroll
            for (int b = 0; b < 2; ++b)
#pragma unroll
                for (int m = 0; m < 4; ++m)
#pragma unroll
                    for (int n = 0; n < 2; ++n) acc[a][b][m][n] = (f32x4){0.f, 0.f, 0.f, 0.f};
        cur = nxt; cA = nA; cB = nB; ++ui;
        if constexpr (ALIGN_EPI) { if (wr == 1) PG8_BAR; }
    }
    PG8_WAIT_V(0);
    if constexpr (!ALIGN_EPI) { if (wr == 0) PG8_BAR; }
    PG8_BAR;
    if constexpr (Epi::AFTER_DRAIN) { E.fused(acc, cur, wr, wc, fr, fq, lds, wid, lane); S.done(cur); }
#undef PG8_SA
#undef PG8_SB
#undef PG8_STAGE
#undef PG8_LDA
#undef PG8_LDB
#undef PG8_MMA
#undef PG8_WAIT_V
#undef PG8_WAIT_L
#undef PG8_BAR
#undef PG8_SCHED
}
}
namespace att {
using bf16x8 = __attribute__((ext_vector_type(8))) short;
using s16x4 = __attribute__((ext_vector_type(4))) short;
using f32x16 = __attribute__((ext_vector_type(16))) float;
using u32x4 = __attribute__((ext_vector_type(4))) unsigned;
typedef unsigned short bf16_t;
#define ALAS __attribute__((address_space(3)))
constexpr int KSLOT = 12288, VSLOT = 8192;
constexpr int L_K = 0, L_V = 2 * KSLOT, L_WS = L_V + 2 * VSLOT, L_OST = L_WS + 8 * 64 * 4, L_RPB = L_OST + 8 * 4096, L_END = L_RPB + 2048;
constexpr float THR = 8.f;
constexpr float LOG2E = 1.4426950408889634f;
struct Desc { const bf16_t *Q0, *Q1, *K0, *K1, *V; bf16_t* O; int q0p, q1p, k0p, k1p, vp, op; };

__device__ __forceinline__ int crow(int r, int hi) { return (r & 3) + 8 * (r >> 2) + 4 * hi; }
typedef float f32x2_t __attribute__((ext_vector_type(2))); typedef __bf16 bf16x2_t __attribute__((ext_vector_type(2)));
__device__ __forceinline__ unsigned cvtpk_s(float lo, float hi) { f32x2_t v = {lo, hi}; bf16x2_t b = __builtin_convertvector(v, bf16x2_t); return __builtin_bit_cast(unsigned, b); }
__device__ __forceinline__ float bf2f(short s) { return __uint_as_float(((unsigned)(unsigned short)s) << 16); }
typedef short v4i16_t __attribute__((ext_vector_type(4)));
__device__ __forceinline__ s16x4 vtr(const ALAS unsigned char* p) { return __builtin_bit_cast(s16x4, __builtin_amdgcn_ds_read_tr16_b64_v4i16((ALAS v4i16_t*)p)); }
__device__ __forceinline__ void dma16(const void* g, ALAS unsigned char* l) { __builtin_amdgcn_global_load_lds((const unsigned*)g, (ALAS unsigned*)l, 16, 0, 0); }
__device__ __forceinline__ float xhalf_max(float m) { auto rr = __builtin_amdgcn_permlane32_swap(__float_as_uint(m), __float_as_uint(m), false, false); return fmaxf(__uint_as_float(rr[0]), __uint_as_float(rr[1])); }
__device__ __forceinline__ float xhalf_sum(float m) { auto rr = __builtin_amdgcn_permlane32_swap(__float_as_uint(m), __float_as_uint(m), false, false); return __uint_as_float(rr[0]) + __uint_as_float(rr[1]); }
__device__ __forceinline__ void sincos_acc(float x, float& s, float& c) {
    const float k = rintf(x * 0.6366197723675814f);
    float r = fmaf(-k, 1.5707962513e+00f, x); r = fmaf(-k, 7.5497894159e-08f, r); r = fmaf(-k, 5.3903029534e-15f, r);
    const int q = ((int)k) & 3; const float r2 = r * r;
    const float sp = r + r * r2 * (-1.6666654611e-1f + r2 * (8.3321608736e-3f + r2 * (-1.9515295891e-4f)));
    const float cp = 1.f + r2 * (-0.5f + r2 * (4.166664568298827e-2f + r2 * (-1.388731625493765e-3f + r2 * 2.443315711809948e-5f)));
    const float s0 = (q & 1) ? cp : sp, c0 = (q & 1) ? sp : cp;
    s = (q & 2) ? -s0 : s0; c = ((q + 1) & 2) ? -c0 : c0;
}

template <int DQK, int MODE>
__device__ __forceinline__ void unit(const Desc& d, long rowbase, int q0, int tlo, int thi, const float* rpb_h, ALAS unsigned char* shm) {
    constexpr int ND = DQK / 16;
    const int tid = threadIdx.x, lane = tid & 63, r32 = lane & 31, hi = lane >> 5;
    const int wid = __builtin_amdgcn_readfirstlane(tid >> 6);
    ALAS float* wsf = (ALAS float*)(shm + L_WS) + wid * 64;
    ALAS float* rpbs = (ALAS float*)(shm + L_RPB);
    const bf16_t* ksrc0 = d.K0 + (rowbase + lane) * (long)d.k0p + wid * 8;
    const bf16_t* ksrc1 = d.K1 + (rowbase + lane) * (long)d.k1p + (wid & 3) * 8;
    const bf16_t* vsrc = d.V + (rowbase + 16 * (wid & 3) + (lane >> 2)) * (long)d.vp + (wid >> 2) * 32 + (lane & 3) * 8;
#define ATT_ISSUE(t, buf) do { \
        dma16(ksrc0 + (long)(t) * 64 * d.k0p, shm + L_K + (buf) * KSLOT + wid * 1024); \
        if (DQK == 96) { if (wid < 4) dma16(ksrc1 + (long)(t) * 64 * d.k1p, shm + L_K + (buf) * KSLOT + (8 + wid) * 1024); } \
        dma16(vsrc + (long)(t) * 64 * d.vp, shm + L_V + (buf) * VSLOT + wid * 1024); } while (0)
#define ATT_WAITBAR() asm volatile("s_waitcnt vmcnt(0) lgkmcnt(0)\n\ts_barrier" ::: "memory")
    ATT_ISSUE(tlo, 0);
    const int tq = q0 + wid * 32 + r32;
    if (MODE == 1) { for (int i = tid; i < 465; i += 512) rpbs[i] = rpb_h[i] * LOG2E; }
    bf16x8 qr[ND];
    { const bf16_t* qp = d.Q0 + (rowbase + tq) * (long)d.q0p + hi * 8;
#pragma unroll
      for (int d0 = 0; d0 < 4; ++d0) qr[d0] = *(const bf16x8*)(qp + d0 * 16); }
    if constexpr (DQK == 96) {
        const bf16_t* qp = d.Q1 + (rowbase + tq) * (long)d.q1p + hi * 8;
#pragma unroll
        for (int dd = 0; dd < 2; ++dd) {
            const bf16x8 raw = *(const bf16x8*)(qp + dd * 16); const u32x4 w = __builtin_bit_cast(u32x4, raw); u32x4 pw;
#pragma unroll
            for (int j = 0; j < 4; ++j) pw[j] = (unsigned)__shfl_xor((int)w[j], 32);
            const bf16x8 par = __builtin_bit_cast(bf16x8, pw);
            const float pos = (dd == 0) ? (float)(tq >> 6) : (float)(tq & 63);
            float ov[8];
#pragma unroll
            for (int e = 0; e < 8; ++e) { const float inv = exp2f(-(float)e * (13.287712379549449f / 8.0f)); float s, c; sincos_acc(pos * inv, s, c);
                const float x = bf2f(raw[e]), y = bf2f(par[e]); ov[e] = hi == 0 ? x * c - y * s : x * c + y * s; }
            u32x4 o4; o4.x = cvtpk_s(ov[0], ov[1]); o4.y = cvtpk_s(ov[2], ov[3]); o4.z = cvtpk_s(ov[4], ov[5]); o4.w = cvtpk_s(ov[6], ov[7]);
            qr[4 + dd] = __builtin_bit_cast(bf16x8, o4);
        }
    }
    float mhat = 0.f, l_reg = 0.f; f32x16 o[2]; o[0] = f32x16{}; o[1] = f32x16{}; f32x16 negm = f32x16{};
    bool first = true;
    const int qrow = tq >> 6, qc = tq & 63;
    const int wrow = __builtin_amdgcn_readfirstlane(qrow);
    const int rs = min(max(wrow - 4, 0), 120);
    const int cs = min(max(qc - 8, 0), 48);
    const ALAS unsigned char* vp0 = shm + L_V + ((lane >> 4) & 1) * 32 + (lane & 3) * 8 + (4 * hi + ((lane & 15) >> 2)) * 64;
    ATT_WAITBAR();
    for (int t = tlo; t <= thi; ++t) {
        const int buf = (t - tlo) & 1;
        if (t < thi) ATT_ISSUE(t + 1, buf ^ 1);
        const bool active = (MODE == 0) || (t >= rs && t <= rs + 7);
        if (active) {
            f32x16 p0, p1;
            const ALAS unsigned char* kb = shm + L_K + buf * KSLOT + hi * 1024 + r32 * 16;
#pragma unroll
            for (int d0 = 0; d0 < ND; ++d0) {
                const bf16x8 b0 = *(const ALAS bf16x8*)(kb + d0 * 2048), b1 = *(const ALAS bf16x8*)(kb + d0 * 2048 + 512);
                if (d0 == 0) { p0 = __builtin_amdgcn_mfma_f32_32x32x16_bf16(b0, qr[0], negm, 0, 0, 0); p1 = __builtin_amdgcn_mfma_f32_32x32x16_bf16(b1, qr[0], negm, 0, 0, 0); }
                else { p0 = __builtin_amdgcn_mfma_f32_32x32x16_bf16(b0, qr[d0], p0, 0, 0, 0); p1 = __builtin_amdgcn_mfma_f32_32x32x16_bf16(b1, qr[d0], p1, 0, 0, 0); }
            }
            if (MODE == 1) {
                const ALAS float* tb = rpbs + (t - wrow + 7) * 31;
#pragma unroll
                for (int r = 0; r < 16; ++r) { const int kc = crow(r, hi), kc1 = kc + 32;
                    const int i0 = min(max(kc - qc + 15, 0), 30), i1 = min(max(kc1 - qc + 15, 0), 30);
                    const float b0 = tb[i0], b1 = tb[i1];
                    p0[r] = ((unsigned)(kc - cs) < 16u) ? p0[r] + b0 : -INFINITY;
                    p1[r] = ((unsigned)(kc1 - cs) < 16u) ? p1[r] + b1 : -INFINITY; }
            }
            float rm = fmaxf(p0[0], p1[0]);
#pragma unroll
            for (int r = 1; r < 16; ++r) rm = fmaxf(rm, fmaxf(p0[r], p1[r]));
            rm = xhalf_max(rm);
            if (first || __any(rm > THR)) {
                const float dl = first ? rm : fmaxf(rm, 0.f);
                mhat += dl;
#pragma unroll
                for (int r = 0; r < 16; ++r) { p0[r] -= dl; p1[r] -= dl; negm[r] = -mhat; }
                if (!first) { const float f = exp2f(-dl); l_reg *= f; if (hi == 0) wsf[r32] = f;
#pragma unroll
                    for (int r = 0; r < 16; ++r) { const float fr_ = wsf[crow(r, hi)]; o[0][r] *= fr_; o[1][r] *= fr_; } }
                first = false;
            }
            float sacc = 0.f;
#pragma unroll
            for (int r = 0; r < 16; ++r) { p0[r] = __builtin_amdgcn_exp2f(p0[r]); p1[r] = __builtin_amdgcn_exp2f(p1[r]); sacc += p0[r] + p1[r]; }
            l_reg += sacc;
            u32x4 pw[4];
#pragma unroll
            for (int j = 0; j < 4; ++j) { pw[0][j] = cvtpk_s(p0[2 * j], p0[2 * j + 1]); pw[1][j] = cvtpk_s(p0[8 + 2 * j], p0[8 + 2 * j + 1]);
                                          pw[2][j] = cvtpk_s(p1[2 * j], p1[2 * j + 1]); pw[3][j] = cvtpk_s(p1[8 + 2 * j], p1[8 + 2 * j + 1]); }
            const ALAS unsigned char* vp_ = vp0 + buf * VSLOT;
#pragma unroll
            for (int dh = 0; dh < 2; ++dh)
#pragma unroll
                for (int kg = 0; kg < 4; ++kg) {
                    const s16x4 lo = vtr(vp_ + dh * 4096 + kg * 1024), hh = vtr(vp_ + dh * 4096 + kg * 1024 + 512);
                    const bf16x8 vf = (bf16x8){lo[0], lo[1], lo[2], lo[3], hh[0], hh[1], hh[2], hh[3]};
                    o[dh] = __builtin_amdgcn_mfma_f32_32x32x16_bf16(__builtin_bit_cast(bf16x8, pw[kg]), vf, o[dh], 0, 0, 0);
                }
        }
        ATT_WAITBAR();
    }
    l_reg = xhalf_sum(l_reg);
    if (hi == 0) wsf[32 + r32] = l_reg;
    float rli[16];
#pragma unroll
    for (int r = 0; r < 16; ++r) rli[r] = 1.0f / wsf[32 + crow(r, hi)];
    bf16_t* Ow = d.O + (rowbase + q0 + wid * 32) * (long)d.op;
    { ALAS bf16_t* stg = (ALAS bf16_t*)(shm + L_OST) + wid * 2048;
#pragma unroll
      for (int r = 0; r < 16; ++r) { const int orow = crow(r, hi);
#pragma unroll
          for (int dh = 0; dh < 2; ++dh) stg[orow * 64 + dh * 32 + r32] = (bf16_t)(cvtpk_s(o[dh][r] * rli[r], 0.f) & 0xffffu); }
      asm volatile("s_waitcnt lgkmcnt(0)" ::: "memory");
#pragma unroll
      for (int i = 0; i < 4; ++i) { const int row = i * 8 + (lane >> 3), ch = lane & 7; const u32x4 v = *(const ALAS u32x4*)(stg + row * 64 + ch * 8); *(u32x4*)(Ow + (long)row * d.op + ch * 8) = v; } }
    asm volatile("s_waitcnt lgkmcnt(0)\n\ts_barrier" ::: "memory");
#undef ATT_ISSUE
#undef ATT_WAITBAR
}
}

constexpr int NWAVES = 8;
constexpr int M = 32768, D = 1024, SEQ = 8192, NB = 4, FF = 4096, NIN = 1440, NINP = 1536;
constexpr size_t MiB = 1u << 20;
constexpr size_t WS_PART = 2 * MiB;
constexpr size_t WS_WIN = 18 * MiB, WS_WUQ = 21 * MiB, WS_WUKV = 22 * MiB, WS_WO0 = 23 * MiB, WS_WUP0 = 25 * MiB, WS_WDN0 = 33 * MiB;
constexpr size_t WS_WQKV = 41 * MiB, WS_WO1 = 47 * MiB, WS_WUP1 = 49 * MiB, WS_WDN1 = 57 * MiB;
constexpr size_t WS_HB = 66 * MiB;
constexpr size_t WS_U = 130 * MiB;
constexpr size_t WS_Z = 130 * MiB, WS_MIX = 130 * MiB, WS_QA = 226 * MiB, WS_KA = 258 * MiB, WS_VA = 266 * MiB, WS_CQ = 274 * MiB, WS_CKV = 298 * MiB, WS_KR = 314 * MiB, WS_QB = 316 * MiB, WS_KVB = 386 * MiB;
constexpr size_t WS_QKV = 130 * MiB, WS_O1 = 322 * MiB;
constexpr size_t WS_END = 450 * MiB;
constexpr int LDS_BYTES = 135168;
static_assert(att::L_END <= 131072, "attention LDS");

#define LAS __attribute__((address_space(3)))
typedef unsigned short bf16;
typedef unsigned v4u __attribute__((ext_vector_type(4)));
typedef float f32x4 __attribute__((ext_vector_type(4)));
#define LDS_WAIT() asm volatile("s_waitcnt lgkmcnt(0)" ::: "memory")

__device__ __forceinline__ float wave_sum(float v) {
#pragma unroll
    for (int o = 1; o < 64; o <<= 1) v += __shfl_xor(v, o);
    return v;
}
__device__ __forceinline__ unsigned pk2(float lo, float hi) { return pg8::cvt_pk_bf16(lo, hi); }
__device__ __forceinline__ void transpose_item(const float* W, const float* gain, int K, int N, bf16* WT, LAS float* scr, int item, int lane) {
    const int nblk = N / 32, kb = item / nblk, nb = item % nblk, k0 = 64 * kb, n0 = 32 * nb;
#pragma unroll 8
    for (int i = 0; i < 32; ++i) { const int kk = 2 * i + (lane >> 5); const float g = gain ? gain[k0 + kk] : 1.f; scr[kk * 33 + (lane & 31)] = W[(size_t)(k0 + kk) * N + n0 + (lane & 31)] * g; }
    LDS_WAIT(); asm volatile("" ::: "memory");
    const int c = lane & 7;
#pragma unroll
    for (int j = 0; j < 4; ++j) { const int n = (lane >> 3) + 8 * j; const LAS float* s = scr + (8 * c) * 33 + n;
        v4u o; o.x = pk2(s[0 * 33], s[1 * 33]); o.y = pk2(s[2 * 33], s[3 * 33]); o.z = pk2(s[4 * 33], s[5 * 33]); o.w = pk2(s[6 * 33], s[7 * 33]);
        *(v4u*)(WT + (size_t)(n0 + n) * K + k0 + 8 * c) = o; }
    LDS_WAIT(); asm volatile("" ::: "memory");
}

struct Args { const float* in[17]; float* out; unsigned char* ws; int ph_lo, ph_hi; };

__device__ __forceinline__ void ld8(const bf16* p, float (&v)[8]) { const v4u w = *(const v4u*)p;
#pragma unroll
    for (int j = 0; j < 4; ++j) { v[2 * j] = __uint_as_float(w[j] << 16); v[2 * j + 1] = __uint_as_float(w[j] & 0xffff0000u); } }
__device__ __forceinline__ void st8(bf16* p, const float (&v)[8]) { v4u o; o.x = pk2(v[0], v[1]); o.y = pk2(v[2], v[3]); o.z = pk2(v[4], v[5]); o.w = pk2(v[6], v[7]); *(v4u*)p = o; }

__device__ __forceinline__ void head_norm_rope(float (&v)[8], const float* gain, int j, float prow, float pcol, float scale) {
    float ss = 0.f;
#pragma unroll
    for (int e = 0; e < 8; ++e) ss += v[e] * v[e];
    ss += __shfl_xor(ss, 1); ss += __shfl_xor(ss, 2); ss += __shfl_xor(ss, 4);
    const float rstd = 1.0f / sqrtf(ss * (1.0f / 64.0f) + pg8::NORM_EPS);
    const float pos = (j < 4) ? prow : pcol;
#pragma unroll
    for (int e = 0; e < 8; ++e) {
        const float y = v[e] * rstd * gain[j * 8 + e]; const float py = __shfl_xor(y, 2);
        const int i = (j & 1) * 8 + e; const float inv = exp2f(-(float)i * (13.287712379549449f / 16.0f)); float s, c; att::sincos_acc(pos * inv, s, c);
        v[e] = (((j & 2) == 0) ? y * c - py * s : y * c + py * s) * scale;
    }
}

__global__ void __launch_bounds__(NWAVES * 64, 2) fwd_kernel(Args args) {
    extern __shared__ __attribute__((aligned(16))) unsigned char lds[];
    cg::grid_group grid = cg::this_grid();
    LAS unsigned char* L = (LAS unsigned char*)lds;
    const int tid = threadIdx.x, lane = tid & 63, wave = __builtin_amdgcn_readfirstlane(tid >> 6);
    const int G = gridDim.x; const int bx = blockIdx.x;
    const int vcu = (G % 8 == 0) ? (bx % 8) * (G / 8) + bx / 8 : bx;
    const int gw = vcu * NWAVES + wave, NGW = G * NWAVES;
    unsigned char* ws = args.ws;
    const float* x = args.in[0]; float* out = args.out;
    float* PART = (float*)(ws + WS_PART);
#define PARTN(k) (PART + (size_t)(k) * M * 16)
    bf16 *HB = (bf16*)(ws + WS_HB), *U = (bf16*)(ws + WS_U), *Z = (bf16*)(ws + WS_Z), *MIX = (bf16*)(ws + WS_MIX);
    bf16 *QA = (bf16*)(ws + WS_QA), *KA = (bf16*)(ws + WS_KA), *VA = (bf16*)(ws + WS_VA), *CQ = (bf16*)(ws + WS_CQ), *CKV = (bf16*)(ws + WS_CKV), *KR = (bf16*)(ws + WS_KR);
    bf16 *QB = (bf16*)(ws + WS_QB), *KVB = (bf16*)(ws + WS_KVB), *QKV = (bf16*)(ws + WS_QKV), *O1 = (bf16*)(ws + WS_O1);
    bf16 *WIN = (bf16*)(ws + WS_WIN), *WUQ = (bf16*)(ws + WS_WUQ), *WUKV = (bf16*)(ws + WS_WUKV), *WO0 = (bf16*)(ws + WS_WO0), *WUP0 = (bf16*)(ws + WS_WUP0), *WDN0 = (bf16*)(ws + WS_WDN0);
    bf16 *WQKV = (bf16*)(ws + WS_WQKV), *WO1 = (bf16*)(ws + WS_WO1), *WUP1 = (bf16*)(ws + WS_WUP1), *WDN1 = (bf16*)(ws + WS_WDN1);
    const int lo = args.ph_lo, hi = args.ph_hi;
#define IN(k) (lo <= (k) && (k) < hi)
#define SEAM(k) do { if (IN(k) && IN((k) + 1)) grid.sync(); } while (0)
    constexpr float C2A = 0.125f * att::LOG2E;
    constexpr float C2B = 0.10206207261596577f * att::LOG2E;

    if (IN(0)) {
        LAS float* scr = (LAS float*)(L + wave * 16384);
        constexpr int I0 = 16 * 45, I1 = 6 * 24, I2 = 4 * 32, I3 = 16 * 32, I4 = 16 * 128, I5 = 64 * 32, I6 = 16 * 96, I7 = 16 * 32, I8 = I4, I9 = I5;
        constexpr int NITEMS = I0 + I1 + I2 + I3 + I4 + I5 + I6 + I7 + I8 + I9;
        for (int it = gw; it < NITEMS; it += NGW) {
            int r = it;
            if (r < I0) { transpose_item(args.in[2], args.in[1], D, NIN, WIN, scr, r, lane); continue; } r -= I0;
            if (r < I1) { transpose_item(args.in[6], args.in[5], 384, 768, WUQ, scr, r, lane); continue; } r -= I1;
            if (r < I2) { transpose_item(args.in[8], args.in[7], 256, 1024, WUKV, scr, r, lane); continue; } r -= I2;
            if (r < I3) { transpose_item(args.in[9], nullptr, D, D, WO0, scr, r, lane); continue; } r -= I3;
            if (r < I4) { transpose_item(args.in[14], args.in[13], D, FF, WUP0, scr, r, lane); continue; } r -= I4;
            if (r < I5) { transpose_item(args.in[15], nullptr, FF, D, WDN0, scr, r, lane); continue; } r -= I5;
            if (r < I6) { transpose_item(args.in[10], args.in[1] + D, D, 3 * D, WQKV, scr, r, lane); continue; } r -= I6;
            if (r < I7) { transpose_item(args.in[12], nullptr, D, D, WO1, scr, r, lane); continue; } r -= I7;
            if (r < I8) { transpose_item(args.in[14] + (size_t)D * FF, args.in[13] + D, D, FF, WUP1, scr, r, lane); continue; } r -= I8;
            transpose_item(args.in[15] + (size_t)FF * D, nullptr, FF, D, WDN1, scr, r, lane);
        }
        { v4u* p = (v4u*)(WIN + (size_t)NIN * D); const int n16 = (NINP - NIN) * D * 2 / 16; for (int i = bx * 512 + tid; i < n16; i += G * 512) p[i] = (v4u){0u, 0u, 0u, 0u}; }
        for (int m = gw; m < M; m += NGW) {
            const f32x4* xr = (const f32x4*)(x + (size_t)m * D) + lane; f32x4 v[4]; float s = 0.f;
#pragma unroll
            for (int j = 0; j < 4; ++j) { v[j] = xr[64 * j]; s += (v[j].x * v[j].x + v[j].y * v[j].y) + (v[j].z * v[j].z + v[j].w * v[j].w); }
            s = wave_sum(s);
            unsigned long long* o8 = (unsigned long long*)(HB + (size_t)m * D) + lane;
#pragma unroll
            for (int j = 0; j < 4; ++j) o8[64 * j] = (unsigned long long)pk2(v[j].x, v[j].y) | ((unsigned long long)pk2(v[j].z, v[j].w) << 32);
            if (lane < 16) PARTN(0)[(size_t)m * 16 + lane] = (lane == 0) ? s : 0.f;
        }
    }
    SEAM(0);
    if (IN(1)) {
        pg8::Gemm g{HB, WIN, M, NINP, D}; pg8::StaticOrder S; S.init(M, NINP, G, bx);
        pg8::EpiScale<0> E{Z, NINP, PARTN(0), 1.0f / D, 0, 1.f};
        pg8::gemm_phase<pg8::EpiScale<0>, pg8::StaticOrder, true, true>(L, g, S, E);
    }
    SEAM(1);
    if (IN(2)) {
        const float* gq = args.in[3]; const float* gk = args.in[4];
        for (int m = gw; m < M; m += NGW) {
            const bf16* zr = Z + (size_t)m * NINP; const int t = m & (SEQ - 1); const float prow = (float)(t >> 6), pcol = (float)(t & 63); const int j = lane & 7;
            float v1[8], v2[8], v3[8];
            ld8(zr + lane * 8, v1); ld8(zr + 512 + lane * 8, v2); ld8(zr + 1024 + lane * 8, v3);
            float ss2 = 0.f, ss3 = 0.f;
#pragma unroll
            for (int e = 0; e < 8; ++e) { ss2 += v2[e] * v2[e]; ss3 += v3[e] * v3[e]; }
            const float s_cq = wave_sum((lane >= 32 ? ss2 : 0.f) + (lane < 16 ? ss3 : 0.f));
            const float s_ckv = wave_sum((lane >= 16 && lane < 48) ? ss3 : 0.f);
            const float r_cq = 1.0f / sqrtf(s_cq * (1.0f / 384.0f) + pg8::NORM_EPS), r_ckv = 1.0f / sqrtf(s_ckv * (1.0f / 256.0f) + pg8::NORM_EPS);
            head_norm_rope(v1, gq, j, prow, pcol, C2A);
            st8(QA + (size_t)m * 512 + lane * 8, v1);
            float k2[8];
#pragma unroll
            for (int e = 0; e < 8; ++e) k2[e] = v2[e];
            head_norm_rope(k2, gk, j, prow, pcol, 1.f);
            float kr8[8];
            { const int jj = lane & 3; const float pos = (jj < 2) ? prow : pcol;
#pragma unroll
              for (int e = 0; e < 8; ++e) { const float y = v3[e], py = __shfl_xor(y, 1); const float inv = exp2f(-(float)e * (13.287712379549449f / 8.0f)); float s, c; att::sincos_acc(pos * inv, s, c);
                  kr8[e] = ((jj & 1) == 0) ? y * c - py * s : y * c + py * s; } }
            if (lane < 16) st8(KA + (size_t)m * 128 + lane * 8, k2);
            else if (lane < 32) st8(VA + (size_t)m * 128 + (lane - 16) * 8, v2);
            else { float c8[8];
#pragma unroll
                for (int e = 0; e < 8; ++e) c8[e] = v2[e] * r_cq;
                st8(CQ + (size_t)m * 384 + (lane - 32) * 8, c8); }
            if (lane < 16) { float c8[8];
#pragma unroll
                for (int e = 0; e < 8; ++e) c8[e] = v3[e] * r_cq;
                st8(CQ + (size_t)m * 384 + 256 + lane * 8, c8); }
            else if (lane < 48) { float c8[8];
#pragma unroll
                for (int e = 0; e < 8; ++e) c8[e] = v3[e] * r_ckv;
                st8(CKV + (size_t)m * 256 + (lane - 16) * 8, c8); }
            else if (lane < 52) st8(KR + (size_t)m * 32 + (lane - 48) * 8, kr8);
        }
    }
    SEAM(2);
    if (IN(3)) {
        { pg8::Gemm g{CQ, WUQ, M, 768, 384}; pg8::StaticOrder S; S.init(M, 768, G, bx);
          pg8::EpiScale<0> E{QB, 768, nullptr, 0.f, 3, C2B};
          pg8::gemm_phase<pg8::EpiScale<0>, pg8::StaticOrder, true, true>(L, g, S, E); }
        { pg8::Gemm g{CKV, WUKV, M, 1024, 256}; pg8::StaticOrder S; S.init(M, 1024, G, bx);
          pg8::EpiScale<0> E{KVB, 1024, nullptr, 0.f, 0, 1.f};
          pg8::gemm_phase<pg8::EpiScale<0>, pg8::StaticOrder, true, true>(L, g, S, E); }
    }
    SEAM(3);
    if (IN(4)) {
        for (int u = vcu; u < 2048; u += G) {
            const int pair = u >> 5, qb = u & 31; const int typ = (pair >> 3) & 1; const int idx = (pair >> 4) * 8 + (pair & 7); const int b = idx >> 3, h = idx & 7;
            const long rowbase = (long)b * SEQ;
            if (typ == 0) { att::Desc d{QA + h * 64, nullptr, KA + (h >> 2) * 64, nullptr, VA + (h >> 2) * 64, MIX + h * 64, 512, 0, 128, 0, 128, 1024};
                att::unit<64, 0>(d, rowbase, qb * 256, 0, SEQ / 64 - 1, nullptr, L); }
            else { att::Desc d{QB + h * 96, QB + h * 96 + 64, KVB + h * 128, KR, KVB + h * 128 + 64, MIX + 512 + h * 64, 768, 768, 1024, 32, 1024, 1024};
                att::unit<96, 0>(d, rowbase, qb * 256, 0, SEQ / 64 - 1, nullptr, L); }
        }
    }
    SEAM(4);
    if (IN(5)) {
        pg8::Gemm g{MIX, WO0, M, D, D}; pg8::StaticOrder S; S.init(M, D, G, bx);
        pg8::EpiRes E{x, out, HB, PARTN(1), D};
        pg8::gemm_phase<pg8::EpiRes, pg8::StaticOrder, true, true>(L, g, S, E);
    }
    SEAM(5);
    if (IN(6)) {
        pg8::Gemm g{HB, WUP0, M, FF, D}; pg8::StaticOrder S; S.init(M, FF, G, bx);
        pg8::EpiScale<1> E{U, FF, PARTN(1), 1.0f / D, 0, 1.f};
        pg8::gemm_phase<pg8::EpiScale<1>, pg8::StaticOrder, true, true>(L, g, S, E);
    }
    SEAM(6);
    if (IN(7)) {
        pg8::Gemm g{U, WDN0, M, D, FF}; pg8::StaticOrder S; S.init(M, D, G, bx);
        pg8::EpiRes E{out, out, HB, PARTN(2), D};
        pg8::gemm_phase<pg8::EpiRes, pg8::StaticOrder, true, true>(L, g, S, E);
    }
    SEAM(7);
    if (IN(8)) {
        pg8::Gemm g{HB, WQKV, M, 3 * D, D}; pg8::StaticOrder S; S.init(M, 3 * D, G, bx);
        pg8::EpiScale<0> E{QKV, 3 * D, PARTN(2), 1.0f / D, 4, C2A};
        pg8::gemm_phase<pg8::EpiScale<0>, pg8::StaticOrder, true, true>(L, g, S, E);
    }
    SEAM(8);
    if (IN(9)) {
        for (int u = vcu; u < 2048; u += G) {
            const int pair = u >> 5, qb = u & 31; const int b = pair >> 4, h = pair & 15;
            const int R0 = qb * 4; const int tlo = min(max(R0 - 4, 0), 120), thi = min(max(R0 + 3 - 4, 0), 120) + 7;
            att::Desc d{QKV + h * 64, nullptr, QKV + D + h * 64, nullptr, QKV + 2 * D + h * 64, O1 + h * 64, 3 * D, 0, 3 * D, 0, 3 * D, D};
            att::unit<64, 1>(d, (long)b * SEQ, qb * 256, tlo, thi, args.in[11] + h * 465, L);
        }
    }
    SEAM(9);
    if (IN(10)) {
        pg8::Gemm g{O1, WO1, M, D, D}; pg8::StaticOrder S; S.init(M, D, G, bx);
        pg8::EpiRes E{out, out, HB, PARTN(3), D};
        pg8::gemm_phase<pg8::EpiRes, pg8::StaticOrder, true, true>(L, g, S, E);
    }
    SEAM(10);
    if (IN(11)) {
        pg8::Gemm g{HB, WUP1, M, FF, D}; pg8::StaticOrder S; S.init(M, FF, G, bx);
        pg8::EpiScale<1> E{U, FF, PARTN(3), 1.0f / D, 0, 1.f};
        pg8::gemm_phase<pg8::EpiScale<1>, pg8::StaticOrder, true, true>(L, g, S, E);
    }
    SEAM(11);
    if (IN(12)) {
        pg8::Gemm g{U, WDN1, M, D, FF}; pg8::StaticOrder S; S.init(M, D, G, bx);
        pg8::EpiRes E{out, out, HB, PARTN(4), D};
        pg8::gemm_phase<pg8::EpiRes, pg8::StaticOrder, true, true>(L, g, S, E);
    }
    SEAM(12);
    if (IN(13)) {
        const float* gf = args.in[16];
        for (int m = gw; m < M; m += NGW) {
            f32x4* xr = (f32x4*)(out + (size_t)m * D) + lane; const f32x4* pp = (const f32x4*)(PARTN(4) + (size_t)m * 16);
            const f32x4 a = pp[0], b = pp[1], c = pp[2], d4 = pp[3];
            const float s = ((a[0] + a[1]) + (a[2] + a[3])) + ((b[0] + b[1]) + (b[2] + b[3])) + ((c[0] + c[1]) + (c[2] + c[3])) + ((d4[0] + d4[1]) + (d4[2] + d4[3]));
            const float rstd = 1.0f / sqrtf(s * (1.0f / D) + pg8::NORM_EPS);
#pragma unroll
            for (int j = 0; j < 4; ++j) { const f32x4 v = xr[64 * j]; const f32x4 gg = ((const f32x4*)gf)[lane + 64 * j]; xr[64 * j] = v * rstd * gg; }
        }
    }
#undef IN
#undef SEAM
}

#ifndef MK_PER_PHASE
#define MK_PER_PHASE 0
#endif
extern "C" void kernel_launch(void* const* d_in, const int* in_sizes, int n_in, void* d_out, int out_size, void* d_ws, size_t ws_size, hipStream_t stream) {
    static int grid = 0;
    if (grid == 0) {
        if (n_in != 17 || in_sizes[0] != M * D || out_size != M * D || ws_size < WS_END) { fprintf(stderr, "kernel_launch: unexpected shapes / workspace (n_in %d, in0 %d, out %d, ws %zu)\n", n_in, n_in > 0 ? in_sizes[0] : -1, out_size, ws_size); grid = -1; return; }
        int dev = 0, cus = 0, per_cu = 0;
        if (hipGetDevice(&dev) != hipSuccess || hipDeviceGetAttribute(&cus, hipDeviceAttributeMultiprocessorCount, dev) != hipSuccess) { grid = -1; return; }
        if (hipFuncSetAttribute((const void*)fwd_kernel, hipFuncAttributeMaxDynamicSharedMemorySize, LDS_BYTES) != hipSuccess) { fprintf(stderr, "kernel_launch: hipFuncSetAttribute failed\n"); grid = -1; return; }
        if (hipOccupancyMaxActiveBlocksPerMultiprocessor(&per_cu, (const void*)fwd_kernel, NWAVES * 64, LDS_BYTES) != hipSuccess || per_cu < 1) { fprintf(stderr, "kernel_launch: occupancy query says %d\n", per_cu); per_cu = 1; }
        (void)hipGetLastError();
        grid = cus * per_cu;
        fprintf(stderr, "kernel_launch: grid %d (cus %d x %d)\n", grid, cus, per_cu);
    }
    if (grid < 0) return;
    Args a{};
    for (int i = 0; i < 17; ++i) a.in[i] = (const float*)d_in[i];
    a.out = (float*)d_out; a.ws = (unsigned char*)d_ws;
#if MK_PER_PHASE
    for (int p = 0; p < 14; ++p) { a.ph_lo = p; a.ph_hi = p + 1; hipLaunchKernelGGL(fwd_kernel, dim3(grid), dim3(NWAVES * 64), LDS_BYTES, stream, a); }
#else
    a.ph_lo = 0; a.ph_hi = 14;
    void* kargs[] = {&a};
    hipError_t e = hipLaunchCooperativeKernel((const void*)fwd_kernel, dim3(grid), dim3(NWAVES * 64), kargs, LDS_BYTES, stream);
    if (e != hipSuccess) fprintf(stderr, "cooperative launch failed: %s (grid %d)\n", hipGetErrorString(e), grid);
#endif
}
```

```cpp
#include <hip/hip_runtime.h>
#include <hip/hip_cooperative_groups.h>
#include <cstdio>
#include <cstdint>
#include <cmath>
namespace cg = cooperative_groups;
namespace pg8 {
#define PG8_LAS __attribute__((address_space(3)))
typedef unsigned short bf16_t;
typedef short bf16x8 __attribute__((ext_vector_type(8)));
typedef float f32x4 __attribute__((ext_vector_type(4)));
typedef unsigned u32x4 __attribute__((ext_vector_type(4)));
constexpr int BM = 256, BK = 64, HALF = 128, HTB = HALF * BK * 2  , STAGE_BYTES = 8 * HTB, NXCD = 8, WGM = 8;

__host__ __device__ __forceinline__ int lds_byte(int r, int c) { const int st = (r >> 4) * 2 + (c >> 5), rr = r & 15, cc = c & 31, ob = rr * 64 + cc * 2; return st * 1024 + (ob ^ (((ob >> 9) & 1) << 5)); }
__host__ __device__ __forceinline__ void stage_rc(int b, int& R, int& C) { const int st = b / 1024, sb = b % 1024, swz = sb ^ (((sb >> 9) & 1) << 5); R = (st >> 1) * 16 + swz / 64; C = (st & 1) * 32 + (swz % 64) / 2; }
__host__ __device__ __forceinline__ int perm32(int rho) { const int n = rho >> 4, i = rho & 15; return 8 * (i >> 2) + 4 * n + (i & 3); }

struct Unit { int pm, pn; };
struct Gemm { const bf16_t* A; const bf16_t* Bt; int M, N, K; };

struct StaticOrder {
    int nM, nN, nwg, G, c, rep = 1;
    __host__ __device__ void init(int M, int N, int G_, int c_) { nM = M / BM; nN = N / BM; nwg = nM * nN; G = G_; c = c_; }
    __host__ __device__ bool next(int i, Unit& u) const {
        const long L = (long)i * G + c; if (L >= (long)nwg * rep) return false;
        int wgid = (int)(L % nwg); { const int q = nwg / NXCD, r = nwg % NXCD, xcd = wgid % NXCD, off = wgid / NXCD; wgid = (xcd < r ? xcd * (q + 1) : r * (q + 1) + (xcd - r) * q) + off; }
        const int nig = WGM * nN, gid = wgid / nig, fm = gid * WGM, gsz = (nM - fm) < WGM ? (nM - fm) : WGM;
        u.pm = fm + ((wgid % nig) % gsz); u.pn = (wgid % nig) / gsz; return true;
    }
    __device__ __forceinline__ void a_ready(const Unit&) const {}
    __device__ __forceinline__ void done(const Unit&) const {}
};
__device__ __forceinline__ unsigned cvt_pk_bf16(float lo, float hi) { unsigned r; asm volatile("v_cvt_pk_bf16_f32 %0, %1, %2" : "=v"(r) : "v"(lo), "v"(hi)); return r; }
constexpr float NORM_EPS = 1e-6f;
template <int ACT> struct EpiScale {
    static constexpr bool PERM = true, AFTER_DRAIN = false;
    bf16_t* O; int ldc; const float* part; float inv_dim; int nq_tiles; float qscale; int hm = 0;
    __device__ __forceinline__ void operator()(const f32x4 (&acc)[2][2][4][2], const Unit& u, int wr, int wc, int fr, int fq) const {
        const int row0 = u.pm * BM + wr * 64 + fr; const int col0 = u.pn * BM + wc * 32 + 8 * fq;
        const float sc = (u.pn < nq_tiles) ? qscale : 1.f;
#pragma unroll
        for (int ai = 0; ai < 2; ++ai)
#pragma unroll
            for (int m = 0; m < 4; ++m) { const int row = row0 + ai * HALF + m * 16; float rs = 1.f;
                if (part) { const f32x4* pp = (const f32x4*)(part + (size_t)row * 16); const f32x4 a = pp[0], b = pp[1], c = pp[2], d = pp[3];
                    const float s = ((a[0] + a[1]) + (a[2] + a[3])) + ((b[0] + b[1]) + (b[2] + b[3])) + ((c[0] + c[1]) + (c[2] + c[3])) + ((d[0] + d[1]) + (d[2] + d[3]));
                    rs = 1.0f / sqrtf(s * inv_dim + NORM_EPS); }
                if (ACT == 0) rs *= sc;
                bf16_t* rowp = hm ? O + ((size_t)(col0 >> 6) * hm + row) * 64 + (col0 & 63) : O + (size_t)row * ldc + col0;
#pragma unroll
                for (int bj = 0; bj < 2; ++bj) { f32x4 v0 = acc[ai][bj][m][0] * rs, v1 = acc[ai][bj][m][1] * rs;
                    if (ACT == 1) {
#pragma unroll
                        for (int e = 0; e < 4; ++e) { float a = fmaxf(v0[e], 0.f), b = fmaxf(v1[e], 0.f); v0[e] = a * a; v1[e] = b * b; } }
                    u32x4 w; w.x = cvt_pk_bf16(v0[0], v0[1]); w.y = cvt_pk_bf16(v0[2], v0[3]); w.z = cvt_pk_bf16(v1[0], v1[1]); w.w = cvt_pk_bf16(v1[2], v1[3]);
                    *(u32x4*)(rowp + (hm ? (size_t)bj * 2 * hm * 64 : (size_t)(bj * HALF))) = w; } }
    }
};
struct EpiRes {
    static constexpr bool PERM = true, AFTER_DRAIN = false;
    const float* base; float* out; bf16_t* ob; float* part; int ldc;
    __device__ __forceinline__ void operator()(const f32x4 (&acc)[2][2][4][2], const Unit& u, int wr, int wc, int fr, int fq) const {
        const int row0 = u.pm * BM + wr * 64 + fr; const int col0 = u.pn * BM + wc * 32 + 8 * fq;
#pragma unroll
        for (int ai = 0; ai < 2; ++ai)
#pragma unroll
            for (int m = 0; m < 4; ++m) { const int row = row0 + ai * HALF + m * 16; const size_t off = (size_t)row * ldc + col0; float ss = 0.f;
#pragma unroll
                for (int bj = 0; bj < 2; ++bj) { const f32x4 b0 = *(const f32x4*)(base + off + bj * HALF), b1 = *(const f32x4*)(base + off + bj * HALF + 4);
                    const f32x4 v0 = acc[ai][bj][m][0] + b0, v1 = acc[ai][bj][m][1] + b1;
                    *(f32x4*)(out + off + bj * HALF) = v0; *(f32x4*)(out + off + bj * HALF + 4) = v1;
                    u32x4 w; w.x = cvt_pk_bf16(v0[0], v0[1]); w.y = cvt_pk_bf16(v0[2], v0[3]); w.z = cvt_pk_bf16(v1[0], v1[1]); w.w = cvt_pk_bf16(v1[2], v1[3]);
                    *(u32x4*)(ob + off + bj * HALF) = w;
                    ss += (v0[0] * v0[0] + v0[1] * v0[1]) + (v0[2] * v0[2] + v0[3] * v0[3]) + (v1[0] * v1[0] + v1[1] * v1[1]) + (v1[2] * v1[2] + v1[3] * v1[3]); }
                ss += __shfl_xor(ss, 16); ss += __shfl_xor(ss, 32);
                if (fq == 0) part[(size_t)row * 16 + u.pn * 4 + wc] = ss; }
    }
};

template <class Epi, class Sched, bool ALIGN_EPI = false, bool SP2 = false>
__device__ __forceinline__ void gemm_phase(PG8_LAS unsigned char* lds, const Gemm g, const Sched& S, const Epi& E) {
    const int tid = threadIdx.x, wid = __builtin_amdgcn_readfirstlane(tid >> 6), lane = tid & 63, wr = wid >> 2, wc = wid & 3, fr = lane & 15, fq = lane >> 4;
    const int K = g.K, nt = K / BK;
    unsigned voffA[2], voffB[2];
#pragma unroll
    for (int i = 0; i < 2; ++i) { int R, C; stage_rc(tid * 16 + i * 8192, R, C); const int Rb = Epi::PERM ? ((R & ~31) + perm32(R & 31)) : R;
        voffA[i] = (unsigned)(R * K + C) * 2u; voffB[i] = (unsigned)(Rb * K + C) * 2u; }
    const size_t kstep = (size_t)(BK * 2);
    const size_t hstep = (size_t)HALF * K * 2;
    const size_t tstep = 2 * hstep;
    const unsigned ldsw = (unsigned)wid * 1024u;
    const int aoff = lds_byte(wr * 64 + fr, fq * 8), boff = lds_byte(wc * 32 + fr, fq * 8);
#define PG8_SA(b, h) (((b) * 2 + (h)) * HTB)
#define PG8_SB(b, h) ((4 + (b) * 2 + (h)) * HTB)
#define PG8_STAGE(bufoff, gbase, voff) do { _Pragma("unroll") for (int _i = 0; _i < 2; ++_i) \
        __builtin_amdgcn_global_load_lds((const unsigned*)((const char*)(gbase) + (voff)[_i]), (PG8_LAS unsigned*)(lds + (bufoff) + ldsw + _i * 8192), 16, 0, 0); } while (0)
#define PG8_LDA(dst, b, h) do { _Pragma("unroll") for (int m = 0; m < 4; ++m) _Pragma("unroll") for (int k = 0; k < 2; ++k) dst[m][k] = *(const PG8_LAS bf16x8*)(lds + PG8_SA(b, h) + aoff + m * 2048 + k * 1024); } while (0)
#define PG8_LDB(dst, b, h) do { _Pragma("unroll") for (int n = 0; n < 2; ++n) _Pragma("unroll") for (int k = 0; k < 2; ++k) dst[n][k] = *(const PG8_LAS bf16x8*)(lds + PG8_SB(b, h) + boff + n * 2048 + k * 1024); } while (0)
#define PG8_MMA(ai, bj, At, Bt) do { __builtin_amdgcn_s_setprio(1); _Pragma("unroll") for (int m = 0; m < 4; ++m) _Pragma("unroll") for (int n = 0; n < 2; ++n) _Pragma("unroll") for (int k = 0; k < 2; ++k) \
        acc[ai][bj][m][n] = __builtin_amdgcn_mfma_f32_16x16x32_bf16(Bt[n][k], At[m][k], acc[ai][bj][m][n], 0, 0, 0); __builtin_amdgcn_s_setprio(0); } while (0)
#define PG8_WAIT_V(n) asm volatile("s_waitcnt vmcnt(" #n ")" ::: "memory")
#define PG8_WAIT_L(n) asm volatile("s_waitcnt lgkmcnt(" #n ")" ::: "memory")
#define PG8_BAR __builtin_amdgcn_s_barrier()
#define PG8_SCHED __builtin_amdgcn_sched_barrier(0)
    Unit cur, nxt; int ui = 0;
    if (!S.next(0, cur)) return;
    f32x4 acc[2][2][4][2];
#pragma unroll
    for (int a = 0; a < 2; ++a)
#pragma unroll
        for (int b = 0; b < 2; ++b)
#pragma unroll
            for (int m = 0; m < 4; ++m)
#pragma unroll
                for (int n = 0; n < 2; ++n) acc[a][b][m][n] = (f32x4){0.f, 0.f, 0.f, 0.f};
    bf16x8 At[4][2], B0[2][2], B1[2][2];
    const char* cA = (const char*)g.A + (size_t)cur.pm * tstep; const char* cB = (const char*)g.Bt + (size_t)cur.pn * tstep;
    S.a_ready(cur);
    if constexpr (SP2) {
        PG8_STAGE(PG8_SB(0, 0), cB, voffB); PG8_STAGE(PG8_SB(0, 1), cB + hstep, voffB); PG8_STAGE(PG8_SA(0, 0), cA, voffA); PG8_STAGE(PG8_SA(0, 1), cA + hstep, voffA);
        if (wr == 1) PG8_BAR;
        PG8_WAIT_V(2); PG8_BAR;
        PG8_STAGE(PG8_SB(1, 0), cB + kstep, voffB); PG8_STAGE(PG8_SA(1, 0), cA + kstep, voffA); PG8_STAGE(PG8_SB(1, 1), cB + hstep + kstep, voffB);
        PG8_WAIT_V(6); PG8_BAR;
    } else {
        PG8_STAGE(PG8_SB(0, 0), cB, voffB); PG8_STAGE(PG8_SA(0, 0), cA, voffA); PG8_STAGE(PG8_SB(0, 1), cB + hstep, voffB); PG8_STAGE(PG8_SA(0, 1), cA + hstep, voffA);
        if (wr == 1) PG8_BAR;
        PG8_WAIT_V(4); PG8_BAR;
        PG8_STAGE(PG8_SB(1, 0), cB + kstep, voffB); PG8_STAGE(PG8_SA(1, 0), cA + kstep, voffA); PG8_STAGE(PG8_SB(1, 1), cB + hstep + kstep, voffB);
        PG8_WAIT_V(6); PG8_BAR;
    }
    for (;;) {
        const bool has_next = S.next(ui + 1, nxt);
        const char* nA = has_next ? (const char*)g.A + (size_t)nxt.pm * tstep : cA; const char* nB = has_next ? (const char*)g.Bt + (size_t)nxt.pn * tstep : cB;
        for (int t = 0; t < nt; t += 2) {
            const bool last = (t == nt - 2);
            const char* a1 = cA + (size_t)(t + 1) * kstep;
            const char* a2 = last ? nA : cA + (size_t)(t + 2) * kstep; const char* b2 = last ? nB : cB + (size_t)(t + 2) * kstep;
            const char* a3 = a2 + kstep; const char* b3 = b2 + kstep;
            if (last && has_next) S.a_ready(nxt);
            if constexpr (SP2) {
            PG8_LDB(B0, 0, 0); PG8_LDB(B1, 0, 1); PG8_SCHED; PG8_LDA(At, 0, 0); PG8_STAGE(PG8_SA(1, 1), a1 + hstep, voffA);
            PG8_WAIT_V(8); PG8_WAIT_L(0); PG8_BAR; PG8_MMA(0, 0, At, B0); PG8_MMA(0, 1, At, B1); PG8_BAR; PG8_SCHED;
            PG8_LDA(At, 0, 1); PG8_STAGE(PG8_SB(0, 0), b2, voffB); PG8_STAGE(PG8_SB(0, 1), b2 + hstep, voffB); PG8_STAGE(PG8_SA(0, 0), a2, voffA);
            PG8_WAIT_V(8); PG8_WAIT_L(0); PG8_BAR; PG8_MMA(1, 0, At, B0); PG8_MMA(1, 1, At, B1); PG8_BAR; PG8_SCHED;
            PG8_LDB(B0, 1, 0); PG8_LDB(B1, 1, 1); PG8_SCHED; PG8_LDA(At, 1, 0); PG8_STAGE(PG8_SA(0, 1), a2 + hstep, voffA);
            PG8_WAIT_V(8); PG8_WAIT_L(0); PG8_BAR; PG8_MMA(0, 0, At, B0); PG8_MMA(0, 1, At, B1); PG8_BAR; PG8_SCHED;
            PG8_LDA(At, 1, 1); PG8_STAGE(PG8_SB(1, 0), b3, voffB); PG8_STAGE(PG8_SB(1, 1), b3 + hstep, voffB); PG8_STAGE(PG8_SA(1, 0), a3, voffA);
            PG8_WAIT_V(8); PG8_WAIT_L(0); PG8_BAR; PG8_MMA(1, 0, At, B0); PG8_MMA(1, 1, At, B1); PG8_BAR; PG8_SCHED;
            } else {
            PG8_LDB(B0, 0, 0); PG8_SCHED; PG8_LDA(At, 0, 0); PG8_STAGE(PG8_SA(1, 1), a1 + hstep, voffA);
            PG8_WAIT_L(8); PG8_BAR; PG8_WAIT_L(0); PG8_MMA(0, 0, At, B0); PG8_BAR; PG8_SCHED;
            PG8_LDB(B1, 0, 1); PG8_STAGE(PG8_SB(0, 0), b2, voffB);
            PG8_BAR; PG8_WAIT_L(0); PG8_MMA(0, 1, At, B1); PG8_BAR;
            PG8_LDA(At, 0, 1); PG8_STAGE(PG8_SA(0, 0), a2, voffA);
            PG8_BAR; PG8_WAIT_L(0); PG8_MMA(1, 0, At, B0); PG8_BAR; PG8_SCHED;
            PG8_STAGE(PG8_SB(0, 1), b2 + hstep, voffB);
            PG8_WAIT_V(6); PG8_BAR; PG8_MMA(1, 1, At, B1); PG8_BAR;
            PG8_LDB(B0, 1, 0); PG8_SCHED; PG8_LDA(At, 1, 0); PG8_STAGE(PG8_SA(0, 1), a2 + hstep, voffA);
            PG8_WAIT_L(8); PG8_BAR; PG8_WAIT_L(0); PG8_MMA(0, 0, At, B0); PG8_BAR; PG8_SCHED;
            PG8_LDB(B1, 1, 1); PG8_STAGE(PG8_SB(1, 0), b3, voffB);
            PG8_BAR; PG8_WAIT_L(0); PG8_MMA(0, 1, At, B1); PG8_BAR;
            PG8_LDA(At, 1, 1); PG8_STAGE(PG8_SA(1, 0), a3, voffA);
            PG8_BAR; PG8_WAIT_L(0); PG8_MMA(1, 0, At, B0); PG8_BAR; PG8_SCHED;
            PG8_STAGE(PG8_SB(1, 1), b3 + hstep, voffB);
            PG8_WAIT_V(6); PG8_BAR; PG8_MMA(1, 1, At, B1); PG8_BAR;
            }
        }
        if constexpr (ALIGN_EPI) { if (wr == 0) PG8_BAR; }
        if constexpr (!Epi::AFTER_DRAIN) { E(acc, cur, wr, wc, fr, fq); S.done(cur); }
        if (!has_next) break;
#pragma unroll
        for (int a = 0; a < 2; ++a)
#pragma unroll
            for (int b = 0; b < 2; ++b)
#pragma unroll
                for (int m = 0; m < 4; ++m)
#pragma unroll
                    for (int n = 0; n < 2; ++n) acc[a][b][m][n] = (f32x4){0.f, 0.f, 0.f, 0.f};
        cur = nxt; cA = nA; cB = nB; ++ui;
        if constexpr (ALIGN_EPI) { if (wr == 1) PG8_BAR; }
    }
    PG8_WAIT_V(0);
    if constexpr (!ALIGN_EPI) { if (wr == 0) PG8_BAR; }
    PG8_BAR;
    if constexpr (Epi::AFTER_DRAIN) { E.fused(acc, cur, wr, wc, fr, fq, lds, wid, lane); S.done(cur); }
#undef PG8_SA
#undef PG8_SB
#undef PG8_STAGE
#undef PG8_LDA
#undef PG8_LDB
#undef PG8_MMA
#undef PG8_WAIT_V
#undef PG8_WAIT_L
#undef PG8_BAR
#undef PG8_SCHED
}
}
namespace att {
using bf16x8 = __attribute__((ext_vector_type(8))) short;
using s16x4 = __attribute__((ext_vector_type(4))) short;
using f32x16 = __attribute__((ext_vector_type(16))) float;
using u32x4 = __attribute__((ext_vector_type(4))) unsigned;
typedef unsigned short bf16_t;
#define ALAS __attribute__((address_space(3)))
constexpr int KSLOT = 12288, VSLOT = 8192;
constexpr int NSLOT = 4;
constexpr int L_K = 0, L_V = NSLOT * KSLOT, L_WS = L_V + NSLOT * VSLOT, L_OST = L_WS + 8 * 64 * 4, L_RPB = L_OST + 8 * 4096, L_END = L_RPB + 2048;
constexpr float THR = 8.f;
constexpr float LOG2E = 1.4426950408889634f;
struct Desc { const bf16_t *Q0, *Q1, *K0, *K1, *V; bf16_t* O; int q0p, q1p, k0p, k1p, vp, op; };

__device__ __forceinline__ int crow(int r, int hi) { return (r & 3) + 8 * (r >> 2) + 4 * hi; }
typedef float f32x2_t __attribute__((ext_vector_type(2))); typedef __bf16 bf16x2_t __attribute__((ext_vector_type(2)));
__device__ __forceinline__ unsigned cvtpk_s(float lo, float hi) { f32x2_t v = {lo, hi}; bf16x2_t b = __builtin_convertvector(v, bf16x2_t); return __builtin_bit_cast(unsigned, b); }
__device__ __forceinline__ float bf2f(short s) { return __uint_as_float(((unsigned)(unsigned short)s) << 16); }
typedef short v4i16_t __attribute__((ext_vector_type(4)));
__device__ __forceinline__ s16x4 vtr(const ALAS unsigned char* p) { return __builtin_bit_cast(s16x4, __builtin_amdgcn_ds_read_tr16_b64_v4i16((ALAS v4i16_t*)p)); }
__device__ __forceinline__ void dma16(const void* g, ALAS unsigned char* l) { __builtin_amdgcn_global_load_lds((const unsigned*)g, (ALAS unsigned*)l, 16, 0, 0); }
__device__ __forceinline__ float xhalf_max(float m) { auto rr = __builtin_amdgcn_permlane32_swap(__float_as_uint(m), __float_as_uint(m), false, false); return fmaxf(__uint_as_float(rr[0]), __uint_as_float(rr[1])); }
__device__ __forceinline__ float xhalf_sum(float m) { auto rr = __builtin_amdgcn_permlane32_swap(__float_as_uint(m), __float_as_uint(m), false, false); return __uint_as_float(rr[0]) + __uint_as_float(rr[1]); }
__device__ __forceinline__ void sincos_acc(float x, float& s, float& c) {
    const float k = rintf(x * 0.6366197723675814f);
    float r = fmaf(-k, 1.5707962513e+00f, x); r = fmaf(-k, 7.5497894159e-08f, r); r = fmaf(-k, 5.3903029534e-15f, r);
    const int q = ((int)k) & 3; const float r2 = r * r;
    const float sp = r + r * r2 * (-1.6666654611e-1f + r2 * (8.3321608736e-3f + r2 * (-1.9515295891e-4f)));
    const float cp = 1.f + r2 * (-0.5f + r2 * (4.166664568298827e-2f + r2 * (-1.388731625493765e-3f + r2 * 2.443315711809948e-5f)));
    const float s0 = (q & 1) ? cp : sp, c0 = (q & 1) ? sp : cp;
    s = (q & 2) ? -s0 : s0; c = ((q + 1) & 2) ? -c0 : c0;
}

template <int DQK, int MODE>
__device__ __forceinline__ void unit(const Desc& d, long rowbase, int q0, int tlo, int thi, const float* rpb_h, ALAS unsigned char* shm) {
    constexpr int ND = DQK / 16;
    const int tid = threadIdx.x, lane = tid & 63, r32 = lane & 31, hi = lane >> 5;
    const int wid = __builtin_amdgcn_readfirstlane(tid >> 6);
    ALAS float* wsf = (ALAS float*)(shm + L_WS) + wid * 64;
    ALAS float* rpbs = (ALAS float*)(shm + L_RPB);
    const bf16_t* ksrc0 = d.K0 + (rowbase + lane) * (long)d.k0p + wid * 8;
    const bf16_t* ksrc1 = d.K1 + (rowbase + lane) * (long)d.k1p + (wid & 3) * 8;
    const bf16_t* vsrc = d.V + (rowbase + 16 * (wid & 3) + (lane >> 2)) * (long)d.vp + (wid >> 2) * 32 + (lane & 3) * 8;
#define ATT_ISSUE_K(t, koff) do { \
        dma16(ksrc0 + (long)(t) * 64 * d.k0p, shm + L_K + (koff) + wid * 1024); \
        if (DQK == 96) { dma16(ksrc1 + (long)(t) * 64 * d.k1p, shm + L_K + (koff) + (8 + (wid & 3)) * 1024); } } while (0)
#define ATT_ISSUE_V(t, voff) dma16(vsrc + (long)(t) * 64 * d.vp, shm + L_V + (voff) + wid * 1024)
#define ATT_WAITBAR() asm volatile("s_waitcnt vmcnt(0) lgkmcnt(0)\n\ts_barrier" ::: "memory")
    ATT_ISSUE_K(tlo, 0); ATT_ISSUE_V(tlo, 0);
    if (tlo + 1 <= thi) { ATT_ISSUE_K(tlo + 1, KSLOT); ATT_ISSUE_V(tlo + 1, VSLOT); }
    if (tlo + 2 <= thi) { ATT_ISSUE_K(tlo + 2, 2 * KSLOT); ATT_ISSUE_V(tlo + 2, 2 * VSLOT); }
    const int tq = q0 + wid * 32 + r32;
    if (MODE == 1) { for (int i = tid; i < 15 * 32; i += 512) { const int dr = i >> 5, j = i & 31; rpbs[i] = (j < 31) ? rpb_h[dr * 31 + j] * LOG2E : -INFINITY; } }
    bf16x8 qr[ND];
    { const bf16_t* qp = d.Q0 + (rowbase + tq) * (long)d.q0p + hi * 8;
#pragma unroll
      for (int d0 = 0; d0 < 4; ++d0) qr[d0] = *(const bf16x8*)(qp + d0 * 16); }
    if constexpr (DQK == 96) {
        const bf16_t* qp = d.Q1 + (rowbase + tq) * (long)d.q1p + hi * 8;
#pragma unroll
        for (int dd = 0; dd < 2; ++dd) {
            const bf16x8 raw = *(const bf16x8*)(qp + dd * 16); const u32x4 w = __builtin_bit_cast(u32x4, raw); u32x4 pw;
#pragma unroll
            for (int j = 0; j < 4; ++j) pw[j] = (unsigned)__shfl_xor((int)w[j], 32);
            const bf16x8 par = __builtin_bit_cast(bf16x8, pw);
            const float pos = (dd == 0) ? (float)(tq >> 6) : (float)(tq & 63);
            float ov[8];
#pragma unroll
            for (int e = 0; e < 8; ++e) { const float inv = exp2f(-(float)e * (13.287712379549449f / 8.0f)); float s, c; sincos_acc(pos * inv, s, c);
                const float x = bf2f(raw[e]), y = bf2f(par[e]); ov[e] = hi == 0 ? x * c - y * s : x * c + y * s; }
            u32x4 o4; o4.x = cvtpk_s(ov[0], ov[1]); o4.y = cvtpk_s(ov[2], ov[3]); o4.z = cvtpk_s(ov[4], ov[5]); o4.w = cvtpk_s(ov[6], ov[7]);
            qr[4 + dd] = __builtin_bit_cast(bf16x8, o4);
        }
    }
    float mhat = 0.f, l_reg = 0.f; f32x16 o[2]; o[0] = f32x16{}; o[1] = f32x16{}; f32x16 negm = f32x16{};
    bool first = true;
    const int qrow = tq >> 6, qc = tq & 63;
    const int wrow = __builtin_amdgcn_readfirstlane(qrow);
    const int rs = min(max(wrow - 4, 0), 120);
    const int cs = min(max(qc - 8, 0), 48);
    unsigned co[32];
    if (MODE == 1) {
#pragma unroll
        for (int r = 0; r < 16; ++r) { const int kc = crow(r, hi), kc1 = kc + 32;
            co[r] = (((unsigned)(kc - cs) < 16u) ? (unsigned)(kc - qc + 15) : 31u) * 4u; co[16 + r] = (((unsigned)(kc1 - cs) < 16u) ? (unsigned)(kc1 - qc + 15) : 31u) * 4u; }
    }
    const unsigned tb_addr = (unsigned)(uintptr_t)(shm + L_RPB);
#define LDS_RD128(dst, addr, off) asm volatile("ds_read_b128 %0, %1 offset:%c2" : "=&v"(dst) : "v"(addr), "i"(off) : "memory")
#define LDS_RDTR(dst, addr, off) asm volatile("ds_read_b64_tr_b16 %0, %1 offset:%c2" : "=v"(dst) : "v"(addr), "i"(off) : "memory")
#define ATT_KRD(KOFF) do { const unsigned ka_ = kaddr0 + (unsigned)(KOFF); \
        _Pragma("unroll") for (int d0 = 0; d0 < ND; ++d0) { LDS_RD128(kf[2 * d0], ka_, d0 * 2048); LDS_RD128(kf[2 * d0 + 1], ka_, d0 * 2048 + 512); } } while (0)
#define ATT_KW2(N, A, B) asm volatile("s_waitcnt lgkmcnt(" #N ")" : "+v"(A), "+v"(B) :: "memory")
#define ATT_QK2(P0, P1, d0) do { if ((d0) == 0) { P0 = __builtin_amdgcn_mfma_f32_32x32x16_bf16(kf[0], qr[0], negm, 0, 0, 0); P1 = __builtin_amdgcn_mfma_f32_32x32x16_bf16(kf[1], qr[0], negm, 0, 0, 0); } \
            else { P0 = __builtin_amdgcn_mfma_f32_32x32x16_bf16(kf[2 * (d0)], qr[d0], P0, 0, 0, 0); P1 = __builtin_amdgcn_mfma_f32_32x32x16_bf16(kf[2 * (d0) + 1], qr[d0], P1, 0, 0, 0); } } while (0)
#define ATT_QKM(P0, P1) do { if constexpr (ND == 4) { \
            ATT_KW2(6, kf[0], kf[1]); ATT_QK2(P0, P1, 0); ATT_KW2(4, kf[2], kf[3]); ATT_QK2(P0, P1, 1); ATT_KW2(2, kf[4], kf[5]); ATT_QK2(P0, P1, 2); ATT_KW2(0, kf[6], kf[7]); ATT_QK2(P0, P1, 3); } \
        else { ATT_KW2(10, kf[0], kf[1]); ATT_QK2(P0, P1, 0); ATT_KW2(8, kf[2], kf[3]); ATT_QK2(P0, P1, 1); ATT_KW2(6, kf[4], kf[5]); ATT_QK2(P0, P1, 2); ATT_KW2(4, kf[6], kf[7]); ATT_QK2(P0, P1, 3); \
               ATT_KW2(2, kf[8 % (2 * ND)], kf[9 % (2 * ND)]); ATT_QK2(P0, P1, 4 % ND); ATT_KW2(0, kf[10 % (2 * ND)], kf[11 % (2 * ND)]); ATT_QK2(P0, P1, 5 % ND); } } while (0)
#define ATT_VRD(VOFF) do { const unsigned va_ = vaddr0 + (unsigned)(VOFF); \
        _Pragma("unroll") for (int kg = 0; kg < 4; ++kg) _Pragma("unroll") for (int dh = 0; dh < 2; ++dh) { \
            LDS_RDTR(vf[(kg * 2 + dh) * 2], va_, dh * 4096 + kg * 1024); LDS_RDTR(vf[(kg * 2 + dh) * 2 + 1], va_, dh * 4096 + kg * 1024 + 512); } } while (0)
#define ATT_VWAIT() asm volatile("s_waitcnt lgkmcnt(0)" : "+v"(vf[0]), "+v"(vf[1]), "+v"(vf[2]), "+v"(vf[3]), "+v"(vf[4]), "+v"(vf[5]), "+v"(vf[6]), "+v"(vf[7]), "+v"(vf[8]), "+v"(vf[9]), "+v"(vf[10]), "+v"(vf[11]), "+v"(vf[12]), "+v"(vf[13]), "+v"(vf[14]), "+v"(vf[15]) :: "memory")
#define ATT_VF(kg, dh) ((bf16x8){vf[((kg) * 2 + (dh)) * 2][0], vf[((kg) * 2 + (dh)) * 2][1], vf[((kg) * 2 + (dh)) * 2][2], vf[((kg) * 2 + (dh)) * 2][3], vf[((kg) * 2 + (dh)) * 2 + 1][0], vf[((kg) * 2 + (dh)) * 2 + 1][1], vf[((kg) * 2 + (dh)) * 2 + 1][2], vf[((kg) * 2 + (dh)) * 2 + 1][3]})
#define ATT_ACTIVE(t) ((MODE == 0) || ((t) >= rs && (t) <= rs + 7))
    const unsigned kaddr0 = (unsigned)(uintptr_t)(shm + L_K) + hi * 1024 + r32 * 16;
    const unsigned vaddr0 = (unsigned)(uintptr_t)(shm + L_V) + ((lane >> 4) & 1) * 32 + (lane & 3) * 8 + (4 * hi + ((lane & 15) >> 2)) * 64;
    bf16x8 kf[2 * ND]; s16x4 vf[16];
    f32x16 p0 = f32x16{}, p1 = f32x16{};
    ATT_WAITBAR();
    for (int t = tlo; t <= thi; ++t) {
        const int buf = (t - tlo) & 3;
        if (t + 3 <= thi) { ATT_ISSUE_K(t + 3, ((buf + 3) & 3) * KSLOT); ATT_ISSUE_V(t + 3, ((buf + 3) & 3) * VSLOT); }
        const bool act = ATT_ACTIVE(t);
        if (act) { ATT_KRD(buf * KSLOT); ATT_QKM(p0, p1); if (MODE == 0) ATT_VRD(buf * VSLOT); }
        __builtin_amdgcn_sched_barrier(0);
        if (act) {
            if (MODE == 1) {
                const unsigned ra = tb_addr + (unsigned)(t - wrow + 7) * 128u;
                float bb[32];
#define NA_RD(k) do { _Pragma("unroll") for (int e = 8 * (k); e < 8 * (k) + 8; ++e) asm volatile("ds_read_b32 %0, %1" : "=v"(bb[e]) : "v"(co[e] + ra) : "memory"); } while (0)
#define NA_WAIT(N, k) asm volatile("s_waitcnt lgkmcnt(" #N ")" : "+v"(bb[8 * (k)]), "+v"(bb[8 * (k) + 1]), "+v"(bb[8 * (k) + 2]), "+v"(bb[8 * (k) + 3]), "+v"(bb[8 * (k) + 4]), "+v"(bb[8 * (k) + 5]), "+v"(bb[8 * (k) + 6]), "+v"(bb[8 * (k) + 7]) :: "memory")
                NA_RD(0); NA_RD(1); NA_WAIT(8, 0);
#pragma unroll
                for (int e = 0; e < 8; ++e) p0[e] += bb[e];
                NA_RD(2); NA_WAIT(8, 1);
#pragma unroll
                for (int e = 8; e < 16; ++e) p0[e] += bb[e];
                NA_RD(3); NA_WAIT(8, 2);
#pragma unroll
                for (int e = 0; e < 8; ++e) p1[e] += bb[16 + e];
                NA_WAIT(0, 3);
#pragma unroll
                for (int e = 8; e < 16; ++e) p1[e] += bb[16 + e];
#undef NA_RD
#undef NA_WAIT
                ATT_VRD(buf * VSLOT);
            }
            float rm0 = fmaxf(fmaxf(p0[0], p0[1]), p0[2]), rm1 = fmaxf(fmaxf(p1[0], p1[1]), p1[2]), rm2 = fmaxf(fmaxf(p0[3], p0[4]), p0[5]), rm3 = fmaxf(fmaxf(p1[3], p1[4]), p1[5]);
#pragma unroll
            for (int r = 6; r < 16; r += 2) { rm0 = fmaxf(fmaxf(rm0, p0[r]), p0[r + 1]); rm1 = fmaxf(fmaxf(rm1, p1[r]), p1[r + 1]); }
            float rm = fmaxf(fmaxf(rm0, rm1), fmaxf(rm2, rm3));
            rm = xhalf_max(rm);
            if (first || __any(rm > THR)) {
                const float dl = first ? rm : fmaxf(rm, 0.f);
                mhat += dl;
#pragma unroll
                for (int r = 0; r < 16; ++r) { p0[r] -= dl; p1[r] -= dl; negm[r] = -mhat; }
                if (!first) { const float f = exp2f(-dl); l_reg *= f; if (hi == 0) wsf[r32] = f;
#pragma unroll
                    for (int r = 0; r < 16; ++r) { const float fr_ = wsf[crow(r, hi)]; o[0][r] *= fr_; o[1][r] *= fr_; } }
                first = false;
            }
            u32x4 pw[4];
            float sa0 = 0.f, sa1 = 0.f, sa2 = 0.f, sa3 = 0.f;
#pragma unroll
            for (int r = 0; r < 16; r += 4) { p0[r] = __builtin_amdgcn_exp2f(p0[r]); p0[r + 1] = __builtin_amdgcn_exp2f(p0[r + 1]); p0[r + 2] = __builtin_amdgcn_exp2f(p0[r + 2]); p0[r + 3] = __builtin_amdgcn_exp2f(p0[r + 3]);
                sa0 += p0[r]; sa1 += p0[r + 1]; sa2 += p0[r + 2]; sa3 += p0[r + 3]; }
#pragma unroll
            for (int j = 0; j < 4; ++j) { pw[0][j] = cvtpk_s(p0[2 * j], p0[2 * j + 1]); pw[1][j] = cvtpk_s(p0[8 + 2 * j], p0[8 + 2 * j + 1]); }
            ATT_VWAIT();
#pragma unroll
            for (int kg = 0; kg < 2; ++kg)
#pragma unroll
                for (int dh = 0; dh < 2; ++dh) o[dh] = __builtin_amdgcn_mfma_f32_32x32x16_bf16(__builtin_bit_cast(bf16x8, pw[kg]), ATT_VF(kg, dh), o[dh], 0, 0, 0);
            __builtin_amdgcn_sched_barrier(0);
#pragma unroll
            for (int r = 0; r < 16; r += 4) { p1[r] = __builtin_amdgcn_exp2f(p1[r]); p1[r + 1] = __builtin_amdgcn_exp2f(p1[r + 1]); p1[r + 2] = __builtin_amdgcn_exp2f(p1[r + 2]); p1[r + 3] = __builtin_amdgcn_exp2f(p1[r + 3]);
                sa0 += p1[r]; sa1 += p1[r + 1]; sa2 += p1[r + 2]; sa3 += p1[r + 3]; }
            l_reg += (sa0 + sa1) + (sa2 + sa3);
#pragma unroll
            for (int j = 0; j < 4; ++j) { pw[2][j] = cvtpk_s(p1[2 * j], p1[2 * j + 1]); pw[3][j] = cvtpk_s(p1[8 + 2 * j], p1[8 + 2 * j + 1]); }
#pragma unroll
            for (int kg = 2; kg < 4; ++kg)
#pragma unroll
                for (int dh = 0; dh < 2; ++dh) o[dh] = __builtin_amdgcn_mfma_f32_32x32x16_bf16(__builtin_bit_cast(bf16x8, pw[kg]), ATT_VF(kg, dh), o[dh], 0, 0, 0);
        }
        if (t + 3 <= thi) { if constexpr (DQK == 96) asm volatile("s_waitcnt vmcnt(6) lgkmcnt(0)\n\ts_barrier" ::: "memory"); else asm volatile("s_waitcnt vmcnt(4) lgkmcnt(0)\n\ts_barrier" ::: "memory"); }
        else ATT_WAITBAR();
    }
#undef LDS_RD128
#undef LDS_RDTR
#undef ATT_KRD
#undef ATT_KW2
#undef ATT_QK2
#undef ATT_QKM
#undef ATT_VRD
#undef ATT_VWAIT
#undef ATT_VF
#undef ATT_QK
#undef ATT_ACTIVE
    l_reg = xhalf_sum(l_reg);
    if (hi == 0) wsf[32 + r32] = l_reg;
    float rli[16];
#pragma unroll
    for (int r = 0; r < 16; ++r) rli[r] = 1.0f / wsf[32 + crow(r, hi)];
    bf16_t* Ow = d.O + (rowbase + q0 + wid * 32) * (long)d.op;
    { ALAS bf16_t* stg = (ALAS bf16_t*)(shm + L_OST) + wid * 2048;
#pragma unroll
      for (int r = 0; r < 16; ++r) { const int orow = crow(r, hi);
#pragma unroll
          for (int dh = 0; dh < 2; ++dh) stg[orow * 64 + dh * 32 + r32] = (bf16_t)(cvtpk_s(o[dh][r] * rli[r], 0.f) & 0xffffu); }
      asm volatile("s_waitcnt lgkmcnt(0)" ::: "memory");
#pragma unroll
      for (int i = 0; i < 4; ++i) { const int row = i * 8 + (lane >> 3), ch = lane & 7; const u32x4 v = *(const ALAS u32x4*)(stg + row * 64 + ch * 8); *(u32x4*)(Ow + (long)row * d.op + ch * 8) = v; } }
    asm volatile("s_waitcnt lgkmcnt(0)\n\ts_barrier" ::: "memory");
#undef ATT_ISSUE_K
#undef ATT_ISSUE_V
#undef ATT_WAITBAR
}
}

constexpr int NWAVES = 8;
constexpr int M = 32768, D = 1024, SEQ = 8192, NB = 4, FF = 4096, NIN = 1440, NINP = 1536;
constexpr size_t MiB = 1u << 20;
constexpr size_t WS_PART = 2 * MiB;
constexpr size_t WS_WIN = 18 * MiB, WS_WUQ = 21 * MiB, WS_WUKV = 22 * MiB, WS_WO0 = 23 * MiB, WS_WUP0 = 25 * MiB, WS_WDN0 = 33 * MiB;
constexpr size_t WS_WQKV = 41 * MiB, WS_WO1 = 47 * MiB, WS_WUP1 = 49 * MiB, WS_WDN1 = 57 * MiB;
constexpr size_t WS_HB = 66 * MiB;
constexpr size_t WS_U = 130 * MiB;
constexpr size_t WS_Z = 130 * MiB, WS_MIX = 130 * MiB, WS_QA = 226 * MiB, WS_KA = 258 * MiB, WS_VA = 266 * MiB, WS_CQ = 274 * MiB, WS_CKV = 298 * MiB, WS_KR = 314 * MiB, WS_QB = 316 * MiB, WS_KVB = 386 * MiB;
constexpr size_t WS_QKV = 130 * MiB, WS_O1 = 322 * MiB;
constexpr size_t WS_END = 450 * MiB;
constexpr int LDS_BYTES = 135168;
static_assert(att::L_END <= 131072, "attention LDS");

#define LAS __attribute__((address_space(3)))
typedef unsigned short bf16;
typedef unsigned v4u __attribute__((ext_vector_type(4)));
typedef float f32x4 __attribute__((ext_vector_type(4)));
#define LDS_WAIT() asm volatile("s_waitcnt lgkmcnt(0)" ::: "memory")

__device__ __forceinline__ float wave_sum(float v) {
#pragma unroll
    for (int o = 1; o < 64; o <<= 1) v += __shfl_xor(v, o);
    return v;
}
__device__ __forceinline__ unsigned pk2(float lo, float hi) { return pg8::cvt_pk_bf16(lo, hi); }
__device__ __forceinline__ void transpose_item(const float* W, const float* gain, int K, int N, bf16* WT, LAS float* scr, int item, int lane) {
    const int nblk = N / 32, kb = item / nblk, nb = item % nblk, k0 = 64 * kb, n0 = 32 * nb;
#pragma unroll 8
    for (int i = 0; i < 32; ++i) { const int kk = 2 * i + (lane >> 5); const float g = gain ? gain[k0 + kk] : 1.f; scr[kk * 33 + (lane & 31)] = W[(size_t)(k0 + kk) * N + n0 + (lane & 31)] * g; }
    LDS_WAIT(); asm volatile("" ::: "memory");
    const int c = lane & 7;
#pragma unroll
    for (int j = 0; j < 4; ++j) { const int n = (lane >> 3) + 8 * j; const LAS float* s = scr + (8 * c) * 33 + n;
        v4u o; o.x = pk2(s[0 * 33], s[1 * 33]); o.y = pk2(s[2 * 33], s[3 * 33]); o.z = pk2(s[4 * 33], s[5 * 33]); o.w = pk2(s[6 * 33], s[7 * 33]);
        *(v4u*)(WT + (size_t)(n0 + n) * K + k0 + 8 * c) = o; }
    LDS_WAIT(); asm volatile("" ::: "memory");
}

struct Args { const float* in[17]; float* out; unsigned char* ws; int ph_lo, ph_hi; };

__device__ __forceinline__ void ld8(const bf16* p, float (&v)[8]) { const v4u w = *(const v4u*)p;
#pragma unroll
    for (int j = 0; j < 4; ++j) { v[2 * j] = __uint_as_float(w[j] << 16); v[2 * j + 1] = __uint_as_float(w[j] & 0xffff0000u); } }
__device__ __forceinline__ void st8(bf16* p, const float (&v)[8]) { v4u o; o.x = pk2(v[0], v[1]); o.y = pk2(v[2], v[3]); o.z = pk2(v[4], v[5]); o.w = pk2(v[6], v[7]); *(v4u*)p = o; }

__device__ __forceinline__ void head_norm_rope(float (&v)[8], const float* gain, int j, float prow, float pcol, float scale) {
    float ss = 0.f;
#pragma unroll
    for (int e = 0; e < 8; ++e) ss += v[e] * v[e];
    ss += __shfl_xor(ss, 1); ss += __shfl_xor(ss, 2); ss += __shfl_xor(ss, 4);
    const float rstd = 1.0f / sqrtf(ss * (1.0f / 64.0f) + pg8::NORM_EPS);
    const float pos = (j < 4) ? prow : pcol;
#pragma unroll
    for (int e = 0; e < 8; ++e) {
        const float y = v[e] * rstd * gain[j * 8 + e]; const float py = __shfl_xor(y, 2);
        const int i = (j & 1) * 8 + e; const float inv = exp2f(-(float)i * (13.287712379549449f / 16.0f)); float s, c; att::sincos_acc(pos * inv, s, c);
        v[e] = (((j & 2) == 0) ? y * c - py * s : y * c + py * s) * scale;
    }
}

__global__ void __launch_bounds__(NWAVES * 64, 2) fwd_kernel(Args args) {
    extern __shared__ __attribute__((aligned(16))) unsigned char lds[];
    cg::grid_group grid = cg::this_grid();
    LAS unsigned char* L = (LAS unsigned char*)lds;
    const int tid = threadIdx.x, lane = tid & 63, wave = __builtin_amdgcn_readfirstlane(tid >> 6);
    const int G = gridDim.x; const int bx = blockIdx.x;
    const int vcu = (G % 8 == 0) ? (bx % 8) * (G / 8) + bx / 8 : bx;
    const int gw = vcu * NWAVES + wave, NGW = G * NWAVES;
    unsigned char* ws = args.ws;
    const float* x = args.in[0]; float* out = args.out;
    float* PART = (float*)(ws + WS_PART);
#define PARTN(k) (PART + (size_t)(k) * M * 16)
    bf16 *HB = (bf16*)(ws + WS_HB), *U = (bf16*)(ws + WS_U), *Z = (bf16*)(ws + WS_Z), *MIX = (bf16*)(ws + WS_MIX);
    bf16 *QA = (bf16*)(ws + WS_QA), *KA = (bf16*)(ws + WS_KA), *VA = (bf16*)(ws + WS_VA), *CQ = (bf16*)(ws + WS_CQ), *CKV = (bf16*)(ws + WS_CKV), *KR = (bf16*)(ws + WS_KR);
    bf16 *QB = (bf16*)(ws + WS_QB), *KVB = (bf16*)(ws + WS_KVB), *QKV = (bf16*)(ws + WS_QKV), *O1 = (bf16*)(ws + WS_O1);
    bf16 *WIN = (bf16*)(ws + WS_WIN), *WUQ = (bf16*)(ws + WS_WUQ), *WUKV = (bf16*)(ws + WS_WUKV), *WO0 = (bf16*)(ws + WS_WO0), *WUP0 = (bf16*)(ws + WS_WUP0), *WDN0 = (bf16*)(ws + WS_WDN0);
    bf16 *WQKV = (bf16*)(ws + WS_WQKV), *WO1 = (bf16*)(ws + WS_WO1), *WUP1 = (bf16*)(ws + WS_WUP1), *WDN1 = (bf16*)(ws + WS_WDN1);
    const int lo = args.ph_lo, hi = args.ph_hi;
#ifndef PROBE_PHASE
#define PROBE_PHASE -1
#endif
#define IN(k) (lo <= (k) && (k) < hi)
#define REPS(k) ((PROBE_PHASE == (k)) ? 2 : 1)
#define SEAM(k) do { if (IN(k) && IN((k) + 1)) grid.sync(); } while (0)
    constexpr float C2A = 0.125f * att::LOG2E;
    constexpr float C2B = 0.10206207261596577f * att::LOG2E;

    if (IN(0)) {
        LAS float* scr = (LAS float*)(L + wave * 16384);
        constexpr int I0 = 16 * 45, I1 = 6 * 24, I2 = 4 * 32, I3 = 16 * 32, I4 = 16 * 128, I5 = 64 * 32, I6 = 16 * 96, I7 = 16 * 32, I8 = I4, I9 = I5;
        constexpr int NITEMS = I0 + I1 + I2 + I3 + I4 + I5 + I6 + I7 + I8 + I9;
        for (int it = gw; it < NITEMS; it += NGW) {
            int r = it;
            if (r < I0) { transpose_item(args.in[2], args.in[1], D, NIN, WIN, scr, r, lane); continue; } r -= I0;
            if (r < I1) { transpose_item(args.in[6], args.in[5], 384, 768, WUQ, scr, r, lane); continue; } r -= I1;
            if (r < I2) { transpose_item(args.in[8], args.in[7], 256, 1024, WUKV, scr, r, lane); continue; } r -= I2;
            if (r < I3) { transpose_item(args.in[9], nullptr, D, D, WO0, scr, r, lane); continue; } r -= I3;
            if (r < I4) { transpose_item(args.in[14], args.in[13], D, FF, WUP0, scr, r, lane); continue; } r -= I4;
            if (r < I5) { transpose_item(args.in[15], nullptr, FF, D, WDN0, scr, r, lane); continue; } r -= I5;
            if (r < I6) { transpose_item(args.in[10], args.in[1] + D, D, 3 * D, WQKV, scr, r, lane); continue; } r -= I6;
            if (r < I7) { transpose_item(args.in[12], nullptr, D, D, WO1, scr, r, lane); continue; } r -= I7;
            if (r < I8) { transpose_item(args.in[14] + (size_t)D * FF, args.in[13] + D, D, FF, WUP1, scr, r, lane); continue; } r -= I8;
            transpose_item(args.in[15] + (size_t)FF * D, nullptr, FF, D, WDN1, scr, r, lane);
        }
        { v4u* p = (v4u*)(WIN + (size_t)NIN * D); const int n16 = (NINP - NIN) * D * 2 / 16; for (int i = bx * 512 + tid; i < n16; i += G * 512) p[i] = (v4u){0u, 0u, 0u, 0u}; }
        for (int m = gw; m < M; m += NGW) {
            const f32x4* xr = (const f32x4*)(x + (size_t)m * D) + lane; f32x4 v[4]; float s = 0.f;
#pragma unroll
            for (int j = 0; j < 4; ++j) { v[j] = xr[64 * j]; s += (v[j].x * v[j].x + v[j].y * v[j].y) + (v[j].z * v[j].z + v[j].w * v[j].w); }
            s = wave_sum(s);
            unsigned long long* o8 = (unsigned long long*)(HB + (size_t)m * D) + lane;
#pragma unroll
            for (int j = 0; j < 4; ++j) o8[64 * j] = (unsigned long long)pk2(v[j].x, v[j].y) | ((unsigned long long)pk2(v[j].z, v[j].w) << 32);
            if (lane < 16) PARTN(0)[(size_t)m * 16 + lane] = (lane == 0) ? s : 0.f;
        }
    }
    SEAM(0);
    if (IN(1)) {
        pg8::Gemm g{HB, WIN, M, NINP, D}; pg8::StaticOrder S; S.init(M, NINP, G, bx); S.rep = REPS(1);
        pg8::EpiScale<0> E{Z, NINP, PARTN(0), 1.0f / D, 0, 1.f};
        pg8::gemm_phase<pg8::EpiScale<0>, pg8::StaticOrder, true, true>(L, g, S, E);
    }
    SEAM(1);
    if (IN(2)) {
        const float* gq = args.in[3]; const float* gk = args.in[4];
        for (int m = gw; m < M; m += NGW) {
            const bf16* zr = Z + (size_t)m * NINP; const int t = m & (SEQ - 1); const float prow = (float)(t >> 6), pcol = (float)(t & 63); const int j = lane & 7;
            float v1[8], v2[8], v3[8];
            ld8(zr + lane * 8, v1); ld8(zr + 512 + lane * 8, v2); ld8(zr + 1024 + lane * 8, v3);
            float ss2 = 0.f, ss3 = 0.f;
#pragma unroll
            for (int e = 0; e < 8; ++e) { ss2 += v2[e] * v2[e]; ss3 += v3[e] * v3[e]; }
            const float s_cq = wave_sum((lane >= 32 ? ss2 : 0.f) + (lane < 16 ? ss3 : 0.f));
            const float s_ckv = wave_sum((lane >= 16 && lane < 48) ? ss3 : 0.f);
            const float r_cq = 1.0f / sqrtf(s_cq * (1.0f / 384.0f) + pg8::NORM_EPS), r_ckv = 1.0f / sqrtf(s_ckv * (1.0f / 256.0f) + pg8::NORM_EPS);
            head_norm_rope(v1, gq, j, prow, pcol, C2A);
            st8(QA + (size_t)m * 512 + lane * 8, v1);
            float k2[8];
#pragma unroll
            for (int e = 0; e < 8; ++e) k2[e] = v2[e];
            head_norm_rope(k2, gk, j, prow, pcol, 1.f);
            float kr8[8];
            { const int jj = lane & 3; const float pos = (jj < 2) ? prow : pcol;
#pragma unroll
              for (int e = 0; e < 8; ++e) { const float y = v3[e], py = __shfl_xor(y, 1); const float inv = exp2f(-(float)e * (13.287712379549449f / 8.0f)); float s, c; att::sincos_acc(pos * inv, s, c);
                  kr8[e] = ((jj & 1) == 0) ? y * c - py * s : y * c + py * s; } }
            if (lane < 16) st8(KA + (size_t)m * 128 + lane * 8, k2);
            else if (lane < 32) st8(VA + (size_t)m * 128 + (lane - 16) * 8, v2);
            else { float c8[8];
#pragma unroll
                for (int e = 0; e < 8; ++e) c8[e] = v2[e] * r_cq;
                st8(CQ + (size_t)m * 384 + (lane - 32) * 8, c8); }
            if (lane < 16) { float c8[8];
#pragma unroll
                for (int e = 0; e < 8; ++e) c8[e] = v3[e] * r_cq;
                st8(CQ + (size_t)m * 384 + 256 + lane * 8, c8); }
            else if (lane < 48) { float c8[8];
#pragma unroll
                for (int e = 0; e < 8; ++e) c8[e] = v3[e] * r_ckv;
                st8(CKV + (size_t)m * 256 + (lane - 16) * 8, c8); }
            else if (lane < 52) st8(KR + (size_t)m * 32 + (lane - 48) * 8, kr8);
        }
    }
    SEAM(2);
    if (IN(3)) {
        { pg8::Gemm g{CQ, WUQ, M, 768, 384}; pg8::StaticOrder S; S.init(M, 768, G, bx);
          pg8::EpiScale<0> E{QB, 768, nullptr, 0.f, 3, C2B};
          pg8::gemm_phase<pg8::EpiScale<0>, pg8::StaticOrder, true, true>(L, g, S, E); }
        { pg8::Gemm g{CKV, WUKV, M, 1024, 256}; pg8::StaticOrder S; S.init(M, 1024, G, bx);
          pg8::EpiScale<0> E{KVB, 1024, nullptr, 0.f, 0, 1.f};
          pg8::gemm_phase<pg8::EpiScale<0>, pg8::StaticOrder, true, true>(L, g, S, E); }
    }
    SEAM(3);
    if (IN(4)) {
        for (int uu = vcu; uu < 2048 * REPS(4); uu += G) { const int u = uu & 2047;
            const int pair = u >> 5, qb = u & 31; const int typ = (pair >> 3) & 1; const int idx = (pair >> 4) * 8 + (pair & 7); const int b = idx >> 3, h = idx & 7;
            const long rowbase = (long)b * SEQ;
            if (typ == 0) { att::Desc d{QA + h * 64, nullptr, KA + (h >> 2) * 64, nullptr, VA + (h >> 2) * 64, MIX + h * 64, 512, 0, 128, 0, 128, 1024};
                att::unit<64, 0>(d, rowbase, qb * 256, 0, SEQ / 64 - 1, nullptr, L); }
            else { att::Desc d{QB + h * 96, QB + h * 96 + 64, KVB + h * 128, KR, KVB + h * 128 + 64, MIX + 512 + h * 64, 768, 768, 1024, 32, 1024, 1024};
                att::unit<96, 0>(d, rowbase, qb * 256, 0, SEQ / 64 - 1, nullptr, L); }
        }
    }
    SEAM(4);
    if (IN(5)) {
        pg8::Gemm g{MIX, WO0, M, D, D}; pg8::StaticOrder S; S.init(M, D, G, bx); S.rep = REPS(5);
        pg8::EpiRes E{x, out, HB, PARTN(1), D};
        pg8::gemm_phase<pg8::EpiRes, pg8::StaticOrder, true, true>(L, g, S, E);
    }
    SEAM(5);
    if (IN(6)) {
        pg8::Gemm g{HB, WUP0, M, FF, D}; pg8::StaticOrder S; S.init(M, FF, G, bx); S.rep = REPS(6);
        pg8::EpiScale<1> E{U, FF, PARTN(1), 1.0f / D, 0, 1.f};
        pg8::gemm_phase<pg8::EpiScale<1>, pg8::StaticOrder, true, true>(L, g, S, E);
    }
    SEAM(6);
    if (IN(7)) {
        pg8::Gemm g{U, WDN0, M, D, FF}; pg8::StaticOrder S; S.init(M, D, G, bx);
        pg8::EpiRes E{out, out, HB, PARTN(2), D};
        pg8::gemm_phase<pg8::EpiRes, pg8::StaticOrder, true, true>(L, g, S, E);
    }
    SEAM(7);
    if (IN(8)) {
        pg8::Gemm g{HB, WQKV, M, 3 * D, D}; pg8::StaticOrder S; S.init(M, 3 * D, G, bx); S.rep = REPS(8);
        pg8::EpiScale<0> E{QKV, 3 * D, PARTN(2), 1.0f / D, 4, C2A, M};
        pg8::gemm_phase<pg8::EpiScale<0>, pg8::StaticOrder, true, true>(L, g, S, E);
    }
    SEAM(8);
    if (IN(9)) {
        for (int uu = vcu; uu < 2048 * REPS(9); uu += G) { const int u = uu & 2047;
            const int pair = u >> 5, qb = u & 31; const int b = pair >> 4, h = pair & 15;
            const int R0 = qb * 4; const int tlo = min(max(R0 - 4, 0), 120), thi = min(max(R0 + 3 - 4, 0), 120) + 7;
            att::Desc d{QKV + (size_t)h * M * 64, nullptr, QKV + (size_t)(16 + h) * M * 64, nullptr, QKV + (size_t)(32 + h) * M * 64, O1 + h * 64, 64, 0, 64, 0, 64, D};
            att::unit<64, 1>(d, (long)b * SEQ, qb * 256, tlo, thi, args.in[11] + h * 465, L);
        }
    }
    SEAM(9);
    if (IN(10)) {
        pg8::Gemm g{O1, WO1, M, D, D}; pg8::StaticOrder S; S.init(M, D, G, bx);
        pg8::EpiRes E{out, out, HB, PARTN(3), D};
        pg8::gemm_phase<pg8::EpiRes, pg8::StaticOrder, true, true>(L, g, S, E);
    }
    SEAM(10);
    if (IN(11)) {
        pg8::Gemm g{HB, WUP1, M, FF, D}; pg8::StaticOrder S; S.init(M, FF, G, bx);
        pg8::EpiScale<1> E{U, FF, PARTN(3), 1.0f / D, 0, 1.f};
        pg8::gemm_phase<pg8::EpiScale<1>, pg8::StaticOrder, true, true>(L, g, S, E);
    }
    SEAM(11);
    if (IN(12)) {
        pg8::Gemm g{U, WDN1, M, D, FF}; pg8::StaticOrder S; S.init(M, D, G, bx);
        pg8::EpiRes E{out, out, HB, PARTN(4), D};
        pg8::gemm_phase<pg8::EpiRes, pg8::StaticOrder, true, true>(L, g, S, E);
    }
    SEAM(12);
    if (IN(13)) {
        const float* gf = args.in[16];
        for (int m = gw; m < M; m += NGW) {
            f32x4* xr = (f32x4*)(out + (size_t)m * D) + lane; const f32x4* pp = (const f32x4*)(PARTN(4) + (size_t)m * 16);
            const f32x4 a = pp[0], b = pp[1], c = pp[2], d4 = pp[3];
            const float s = ((a[0] + a[1]) + (a[2] + a[3])) + ((b[0] + b[1]) + (b[2] + b[3])) + ((c[0] + c[1]) + (c[2] + c[3])) + ((d4[0] + d4[1]) + (d4[2] + d4[3]));
            const float rstd = 1.0f / sqrtf(s * (1.0f / D) + pg8::NORM_EPS);
#pragma unroll
            for (int j = 0; j < 4; ++j) { const f32x4 v = xr[64 * j]; const f32x4 gg = ((const f32x4*)gf)[lane + 64 * j]; xr[64 * j] = v * rstd * gg; }
        }
    }
#undef IN
#undef SEAM
}

#ifndef MK_PER_PHASE
#define MK_PER_PHASE 0
#endif
extern "C" void kernel_launch(void* const* d_in, const int* in_sizes, int n_in, void* d_out, int out_size, void* d_ws, size_t ws_size, hipStream_t stream) {
    static int grid = 0;
    if (grid == 0) {
        if (n_in != 17 || in_sizes[0] != M * D || out_size != M * D || ws_size < WS_END) { fprintf(stderr, "kernel_launch: unexpected shapes / workspace (n_in %d, in0 %d, out %d, ws %zu)\n", n_in, n_in > 0 ? in_sizes[0] : -1, out_size, ws_size); grid = -1; return; }
        int dev = 0, cus = 0, per_cu = 0;
        if (hipGetDevice(&dev) != hipSuccess || hipDeviceGetAttribute(&cus, hipDeviceAttributeMultiprocessorCount, dev) != hipSuccess) { grid = -1; return; }
        if (hipFuncSetAttribute((const void*)fwd_kernel, hipFuncAttributeMaxDynamicSharedMemorySize, LDS_BYTES) != hipSuccess) { fprintf(stderr, "kernel_launch: hipFuncSetAttribute failed\n"); grid = -1; return; }
        if (hipOccupancyMaxActiveBlocksPerMultiprocessor(&per_cu, (const void*)fwd_kernel, NWAVES * 64, LDS_BYTES) != hipSuccess || per_cu < 1) { fprintf(stderr, "kernel_launch: occupancy query says %d\n", per_cu); per_cu = 1; }
        (void)hipGetLastError();
        grid = cus * per_cu;
        fprintf(stderr, "kernel_launch: grid %d (cus %d x %d)\n", grid, cus, per_cu);
    }
    if (grid < 0) return;
    Args a{};
    for (int i = 0; i < 17; ++i) a.in[i] = (const float*)d_in[i];
    a.out = (float*)d_out; a.ws = (unsigned char*)d_ws;
#if MK_PER_PHASE
    for (int p = 0; p < 14; ++p) { a.ph_lo = p; a.ph_hi = p + 1; hipLaunchKernelGGL(fwd_kernel, dim3(grid), dim3(NWAVES * 64), LDS_BYTES, stream, a); }
#else
    a.ph_lo = 0; a.ph_hi = 14;
    void* kargs[] = {&a};
    hipError_t e = hipLaunchCooperativeKernel((const void*)fwd_kernel, dim3(grid), dim3(NWAVES * 64), kargs, LDS_BYTES, stream);
    if (e != hipSuccess) fprintf(stderr, "cooperative launch failed: %s (grid %d)\n", hipGetErrorString(e), grid);
#endif
}
```

```cpp
#include <hip/hip_runtime.h>
#include <hip/hip_cooperative_groups.h>
#include <cstdio>
#include <cstdint>
#include <cmath>
namespace cg = cooperative_groups;
namespace pg8 {
#define PG8_LAS __attribute__((address_space(3)))
typedef unsigned short bf16_t;
typedef short bf16x8 __attribute__((ext_vector_type(8)));
typedef float f32x4 __attribute__((ext_vector_type(4)));
typedef unsigned u32x4 __attribute__((ext_vector_type(4)));
constexpr int BM = 256, BK = 64, HALF = 128, HTB = HALF * BK * 2  , STAGE_BYTES = 8 * HTB, NXCD = 8, WGM = 8;

__host__ __device__ __forceinline__ int lds_byte(int r, int c) { const int st = (r >> 4) * 2 + (c >> 5), rr = r & 15, cc = c & 31, ob = rr * 64 + cc * 2; return st * 1024 + (ob ^ (((ob >> 9) & 1) << 5)); }
__host__ __device__ __forceinline__ void stage_rc(int b, int& R, int& C) { const int st = b / 1024, sb = b % 1024, swz = sb ^ (((sb >> 9) & 1) << 5); R = (st >> 1) * 16 + swz / 64; C = (st & 1) * 32 + (swz % 64) / 2; }
__host__ __device__ __forceinline__ int perm32(int rho) { const int n = rho >> 4, i = rho & 15; return 8 * (i >> 2) + 4 * n + (i & 3); }

struct Unit { int pm, pn; };
struct Gemm { const bf16_t* A; const bf16_t* Bt; int M, N, K; };

struct StaticOrder {
    int nM, nN, nwg, G, c, rep = 1;
    __host__ __device__ void init(int M, int N, int G_, int c_) { nM = M / BM; nN = N / BM; nwg = nM * nN; G = G_; c = c_; }
    __host__ __device__ bool next(int i, Unit& u) const {
        const long L = (long)i * G + c; if (L >= (long)nwg * rep) return false;
        int wgid = (int)(L % nwg); { const int q = nwg / NXCD, r = nwg % NXCD, xcd = wgid % NXCD, off = wgid / NXCD; wgid = (xcd < r ? xcd * (q + 1) : r * (q + 1) + (xcd - r) * q) + off; }
        const int nig = WGM * nN, gid = wgid / nig, fm = gid * WGM, gsz = (nM - fm) < WGM ? (nM - fm) : WGM;
        u.pm = fm + ((wgid % nig) % gsz); u.pn = (wgid % nig) / gsz; return true;
    }
    __device__ __forceinline__ void a_ready(const Unit&) const {}
    __device__ __forceinline__ void done(const Unit&) const {}
};
__device__ __forceinline__ unsigned cvt_pk_bf16(float lo, float hi) { unsigned r; asm volatile("v_cvt_pk_bf16_f32 %0, %1, %2" : "=v"(r) : "v"(lo), "v"(hi)); return r; }
constexpr float NORM_EPS = 1e-6f;
template <int ACT> struct EpiScale {
    static constexpr bool PERM = true, AFTER_DRAIN = false;
    bf16_t* O; int ldc; const float* part; float inv_dim; int nq_tiles; float qscale; int hm = 0;
    __device__ __forceinline__ void operator()(const f32x4 (&acc)[2][2][4][2], const Unit& u, int wr, int wc, int fr, int fq) const {
        const int row0 = u.pm * BM + wr * 64 + fr; const int col0 = u.pn * BM + wc * 32 + 8 * fq;
        const float sc = (u.pn < nq_tiles) ? qscale : 1.f;
#pragma unroll
        for (int ai = 0; ai < 2; ++ai)
#pragma unroll
            for (int m = 0; m < 4; ++m) { const int row = row0 + ai * HALF + m * 16; float rs = 1.f;
                if (part) { const f32x4* pp = (const f32x4*)(part + (size_t)row * 16); const f32x4 a = pp[0], b = pp[1], c = pp[2], d = pp[3];
                    const float s = ((a[0] + a[1]) + (a[2] + a[3])) + ((b[0] + b[1]) + (b[2] + b[3])) + ((c[0] + c[1]) + (c[2] + c[3])) + ((d[0] + d[1]) + (d[2] + d[3]));
                    rs = 1.0f / sqrtf(s * inv_dim + NORM_EPS); }
                if (ACT == 0) rs *= sc;
                bf16_t* rowp = hm ? O + ((size_t)(col0 >> 6) * hm + row) * 64 + (col0 & 63) : O + (size_t)row * ldc + col0;
#pragma unroll
                for (int bj = 0; bj < 2; ++bj) { f32x4 v0 = acc[ai][bj][m][0] * rs, v1 = acc[ai][bj][m][1] * rs;
                    if (ACT == 1) {
#pragma unroll
                        for (int e = 0; e < 4; ++e) { float a = fmaxf(v0[e], 0.f), b = fmaxf(v1[e], 0.f); v0[e] = a * a; v1[e] = b * b; } }
                    u32x4 w; w.x = cvt_pk_bf16(v0[0], v0[1]); w.y = cvt_pk_bf16(v0[2], v0[3]); w.z = cvt_pk_bf16(v1[0], v1[1]); w.w = cvt_pk_bf16(v1[2], v1[3]);
                    *(u32x4*)(rowp + (hm ? (size_t)bj * 2 * hm * 64 : (size_t)(bj * HALF))) = w; } }
    }
};
struct EpiRes {
    static constexpr bool PERM = true, AFTER_DRAIN = false;
    const float* base; float* out; bf16_t* ob; float* part; int ldc;
    __device__ __forceinline__ void operator()(const f32x4 (&acc)[2][2][4][2], const Unit& u, int wr, int wc, int fr, int fq) const {
        const int row0 = u.pm * BM + wr * 64 + fr; const int col0 = u.pn * BM + wc * 32 + 8 * fq;
#pragma unroll
        for (int ai = 0; ai < 2; ++ai)
#pragma unroll
            for (int m = 0; m < 4; ++m) { const int row = row0 + ai * HALF + m * 16; const size_t off = (size_t)row * ldc + col0; float ss = 0.f;
#pragma unroll
                for (int bj = 0; bj < 2; ++bj) { const f32x4 b0 = *(const f32x4*)(base + off + bj * HALF), b1 = *(const f32x4*)(base + off + bj * HALF + 4);
                    const f32x4 v0 = acc[ai][bj][m][0] + b0, v1 = acc[ai][bj][m][1] + b1;
                    *(f32x4*)(out + off + bj * HALF) = v0; *(f32x4*)(out + off + bj * HALF + 4) = v1;
                    u32x4 w; w.x = cvt_pk_bf16(v0[0], v0[1]); w.y = cvt_pk_bf16(v0[2], v0[3]); w.z = cvt_pk_bf16(v1[0], v1[1]); w.w = cvt_pk_bf16(v1[2], v1[3]);
                    *(u32x4*)(ob + off + bj * HALF) = w;
                    ss += (v0[0] * v0[0] + v0[1] * v0[1]) + (v0[2] * v0[2] + v0[3] * v0[3]) + (v1[0] * v1[0] + v1[1] * v1[1]) + (v1[2] * v1[2] + v1[3] * v1[3]); }
                ss += __shfl_xor(ss, 16); ss += __shfl_xor(ss, 32);
                if (fq == 0) part[(size_t)row * 16 + u.pn * 4 + wc] = ss; }
    }
};

template <class Epi, class Sched, bool ALIGN_EPI = false, bool SP2 = false>
__device__ __forceinline__ void gemm_phase(PG8_LAS unsigned char* lds, const Gemm g, const Sched& S, const Epi& E) {
    const int tid = threadIdx.x, wid = __builtin_amdgcn_readfirstlane(tid >> 6), lane = tid & 63, wr = wid >> 2, wc = wid & 3, fr = lane & 15, fq = lane >> 4;
    const int K = g.K, nt = K / BK;
    unsigned voffA[2], voffB[2];
#pragma unroll
    for (int i = 0; i < 2; ++i) { int R, C; stage_rc(tid * 16 + i * 8192, R, C); const int Rb = Epi::PERM ? ((R & ~31) + perm32(R & 31)) : R;
        voffA[i] = (unsigned)(R * K + C) * 2u; voffB[i] = (unsigned)(Rb * K + C) * 2u; }
    const size_t kstep = (size_t)(BK * 2);
    const size_t hstep = (size_t)HALF * K * 2;
    const size_t tstep = 2 * hstep;
    const unsigned ldsw = (unsigned)wid * 1024u;
    const int aoff = lds_byte(wr * 64 + fr, fq * 8), boff = lds_byte(wc * 32 + fr, fq * 8);
#define PG8_SA(b, h) (((b) * 2 + (h)) * HTB)
#define PG8_SB(b, h) ((4 + (b) * 2 + (h)) * HTB)
#define PG8_STAGE(bufoff, gbase, voff) do { _Pragma("unroll") for (int _i = 0; _i < 2; ++_i) \
        __builtin_amdgcn_global_load_lds((const unsigned*)((const char*)(gbase) + (voff)[_i]), (PG8_LAS unsigned*)(lds + (bufoff) + ldsw + _i * 8192), 16, 0, 0); } while (0)
#define PG8_LDA(dst, b, h) do { _Pragma("unroll") for (int m = 0; m < 4; ++m) _Pragma("unroll") for (int k = 0; k < 2; ++k) dst[m][k] = *(const PG8_LAS bf16x8*)(lds + PG8_SA(b, h) + aoff + m * 2048 + k * 1024); } while (0)
#define PG8_LDB(dst, b, h) do { _Pragma("unroll") for (int n = 0; n < 2; ++n) _Pragma("unroll") for (int k = 0; k < 2; ++k) dst[n][k] = *(const PG8_LAS bf16x8*)(lds + PG8_SB(b, h) + boff + n * 2048 + k * 1024); } while (0)
#define PG8_MMA(ai, bj, At, Bt) do { __builtin_amdgcn_s_setprio(1); _Pragma("unroll") for (int m = 0; m < 4; ++m) _Pragma("unroll") for (int n = 0; n < 2; ++n) _Pragma("unroll") for (int k = 0; k < 2; ++k) \
        acc[ai][bj][m][n] = __builtin_amdgcn_mfma_f32_16x16x32_bf16(Bt[n][k], At[m][k], acc[ai][bj][m][n], 0, 0, 0); __builtin_amdgcn_s_setprio(0); } while (0)
#define PG8_WAIT_V(n) asm volatile("s_waitcnt vmcnt(" #n ")" ::: "memory")
#define PG8_WAIT_L(n) asm volatile("s_waitcnt lgkmcnt(" #n ")" ::: "memory")
#define PG8_BAR __builtin_amdgcn_s_barrier()
#define PG8_SCHED __builtin_amdgcn_sched_barrier(0)
    Unit cur, nxt; int ui = 0;
    if (!S.next(0, cur)) return;
    f32x4 acc[2][2][4][2];
#pragma unroll
    for (int a = 0; a < 2; ++a)
#pragma unroll
        for (int b = 0; b < 2; ++b)
#pragma unroll
            for (int m = 0; m < 4; ++m)
#pragma unroll
                for (int n = 0; n < 2; ++n) acc[a][b][m][n] = (f32x4){0.f, 0.f, 0.f, 0.f};
    bf16x8 At[4][2], B0[2][2], B1[2][2];
    const char* cA = (const char*)g.A + (size_t)cur.pm * tstep; const char* cB = (const char*)g.Bt + (size_t)cur.pn * tstep;
    S.a_ready(cur);
    if constexpr (SP2) {
        PG8_STAGE(PG8_SB(0, 0), cB, voffB); PG8_STAGE(PG8_SB(0, 1), cB + hstep, voffB); PG8_STAGE(PG8_SA(0, 0), cA, voffA); PG8_STAGE(PG8_SA(0, 1), cA + hstep, voffA);
        if (wr == 1) PG8_BAR;
        PG8_WAIT_V(2); PG8_BAR;
        PG8_STAGE(PG8_SB(1, 0), cB + kstep, voffB); PG8_STAGE(PG8_SA(1, 0), cA + kstep, voffA); PG8_STAGE(PG8_SB(1, 1), cB + hstep + kstep, voffB);
        PG8_WAIT_V(6); PG8_BAR;
    } else {
        PG8_STAGE(PG8_SB(0, 0), cB, voffB); PG8_STAGE(PG8_SA(0, 0), cA, voffA); PG8_STAGE(PG8_SB(0, 1), cB + hstep, voffB); PG8_STAGE(PG8_SA(0, 1), cA + hstep, voffA);
        if (wr == 1) PG8_BAR;
        PG8_WAIT_V(4); PG8_BAR;
        PG8_STAGE(PG8_SB(1, 0), cB + kstep, voffB); PG8_STAGE(PG8_SA(1, 0), cA + kstep, voffA); PG8_STAGE(PG8_SB(1, 1), cB + hstep + kstep, voffB);
        PG8_WAIT_V(6); PG8_BAR;
    }
    for (;;) {
        const bool has_next = S.next(ui + 1, nxt);
        const char* nA = has_next ? (const char*)g.A + (size_t)nxt.pm * tstep : cA; const char* nB = has_next ? (const char*)g.Bt + (size_t)nxt.pn * tstep : cB;
        for (int t = 0; t < nt; t += 2) {
            const bool last = (t == nt - 2);
            const char* a1 = cA + (size_t)(t + 1) * kstep;
            const char* a2 = last ? nA : cA + (size_t)(t + 2) * kstep; const char* b2 = last ? nB : cB + (size_t)(t + 2) * kstep;
            const char* a3 = a2 + kstep; const char* b3 = b2 + kstep;
            if (last && has_next) S.a_ready(nxt);
            if constexpr (SP2) {
            PG8_LDB(B0, 0, 0); PG8_LDB(B1, 0, 1); PG8_SCHED; PG8_LDA(At, 0, 0); PG8_STAGE(PG8_SA(1, 1), a1 + hstep, voffA);
            PG8_WAIT_V(8); PG8_WAIT_L(0); PG8_BAR; PG8_MMA(0, 0, At, B0); PG8_MMA(0, 1, At, B1); PG8_BAR; PG8_SCHED;
            PG8_LDA(At, 0, 1); PG8_STAGE(PG8_SB(0, 0), b2, voffB); PG8_STAGE(PG8_SB(0, 1), b2 + hstep, voffB); PG8_STAGE(PG8_SA(0, 0), a2, voffA);
            PG8_WAIT_V(8); PG8_WAIT_L(0); PG8_BAR; PG8_MMA(1, 0, At, B0); PG8_MMA(1, 1, At, B1); PG8_BAR; PG8_SCHED;
            PG8_LDB(B0, 1, 0); PG8_LDB(B1, 1, 1); PG8_SCHED; PG8_LDA(At, 1, 0); PG8_STAGE(PG8_SA(0, 1), a2 + hstep, voffA);
            PG8_WAIT_V(8); PG8_WAIT_L(0); PG8_BAR; PG8_MMA(0, 0, At, B0); PG8_MMA(0, 1, At, B1); PG8_BAR; PG8_SCHED;
            PG8_LDA(At, 1, 1); PG8_STAGE(PG8_SB(1, 0), b3, voffB); PG8_STAGE(PG8_SB(1, 1), b3 + hstep, voffB); PG8_STAGE(PG8_SA(1, 0), a3, voffA);
            PG8_WAIT_V(8); PG8_WAIT_L(0); PG8_BAR; PG8_MMA(1, 0, At, B0); PG8_MMA(1, 1, At, B1); PG8_BAR; PG8_SCHED;
            } else {
            PG8_LDB(B0, 0, 0); PG8_SCHED; PG8_LDA(At, 0, 0); PG8_STAGE(PG8_SA(1, 1), a1 + hstep, voffA);
            PG8_WAIT_L(8); PG8_BAR; PG8_WAIT_L(0); PG8_MMA(0, 0, At, B0); PG8_BAR; PG8_SCHED;
            PG8_LDB(B1, 0, 1); PG8_STAGE(PG8_SB(0, 0), b2, voffB);
            PG8_BAR; PG8_WAIT_L(0); PG8_MMA(0, 1, At, B1); PG8_BAR;
            PG8_LDA(At, 0, 1); PG8_STAGE(PG8_SA(0, 0), a2, voffA);
            PG8_BAR; PG8_WAIT_L(0); PG8_MMA(1, 0, At, B0); PG8_BAR; PG8_SCHED;
            PG8_STAGE(PG8_SB(0, 1), b2 + hstep, voffB);
            PG8_WAIT_V(6); PG8_BAR; PG8_MMA(1, 1, At, B1); PG8_BAR;
            PG8_LDB(B0, 1, 0); PG8_SCHED; PG8_LDA(At, 1, 0); PG8_STAGE(PG8_SA(0, 1), a2 + hstep, voffA);
            PG8_WAIT_L(8); PG8_BAR; PG8_WAIT_L(0); PG8_MMA(0, 0, At, B0); PG8_BAR; PG8_SCHED;
            PG8_LDB(B1, 1, 1); PG8_STAGE(PG8_SB(1, 0), b3, voffB);
            PG8_BAR; PG8_WAIT_L(0); PG8_MMA(0, 1, At, B1); PG8_BAR;
            PG8_LDA(At, 1, 1); PG8_STAGE(PG8_SA(1, 0), a3, voffA);
            PG8_BAR; PG8_WAIT_L(0); PG8_MMA(1, 0, At, B0); PG8_BAR; PG8_SCHED;
            PG8_STAGE(PG8_SB(1, 1), b3 + hstep, voffB);
            PG8_WAIT_V(6); PG8_BAR; PG8_MMA(1, 1, At, B1); PG8_BAR;
            }
        }
        if constexpr (ALIGN_EPI) { if (wr == 0) PG8_BAR; }
        if constexpr (!Epi::AFTER_DRAIN) { E(acc, cur, wr, wc, fr, fq); S.done(cur); }
        if (!has_next) break;
#pragma unroll
        for (int a = 0; a < 2; ++a)
#pragma unroll
            for (int b = 0; b < 2; ++b)
#pragma unroll
                for (int m = 0; m < 4; ++m)
#pragma unroll
                    for (int n = 0; n < 2; ++n) acc[a][b][m][n] = (f32x4){0.f, 0.f, 0.f, 0.f};
        cur = nxt; cA = nA; cB = nB; ++ui;
        if constexpr (ALIGN_EPI) { if (wr == 1) PG8_BAR; }
    }
    PG8_WAIT_V(0);
    if constexpr (!ALIGN_EPI) { if (wr == 0) PG8_BAR; }
    PG8_BAR;
    if constexpr (Epi::AFTER_DRAIN) { E.fused(acc, cur, wr, wc, fr, fq, lds, wid, lane); S.done(cur); }
#undef PG8_SA
#undef PG8_SB
#undef PG8_STAGE
#undef PG8_LDA
#undef PG8_LDB
#undef PG8_MMA
#undef PG8_WAIT_V
#undef PG8_WAIT_L
#undef PG8_BAR
#undef PG8_SCHED
}
}
namespace att {
using bf16x8 = __attribute__((ext_vector_type(8))) short;
using s16x4 = __attribute__((ext_vector_type(4))) short;
using f32x16 = __attribute__((ext_vector_type(16))) float;
using u32x4 = __attribute__((ext_vector_type(4))) unsigned;
typedef unsigned short bf16_t;
#define ALAS __attribute__((address_space(3)))
constexpr int KSLOT = 12288, VSLOT = 8192;
constexpr int NSLOT = 4;
constexpr int L_K = 0, L_V = NSLOT * KSLOT, L_WS = L_V + NSLOT * VSLOT, L_OST = L_WS + 8 * 64 * 4, L_RPB = L_OST + 8 * 4096, L_END = L_RPB + 2048;
constexpr float THR = 8.f;
constexpr float LOG2E = 1.4426950408889634f;
struct Desc { const bf16_t *Q0, *Q1, *K0, *K1, *V; bf16_t* O; int q0p, q1p, k0p, k1p, vp, op; };

__device__ __forceinline__ int crow(int r, int hi) { return (r & 3) + 8 * (r >> 2) + 4 * hi; }
typedef float f32x2_t __attribute__((ext_vector_type(2))); typedef __bf16 bf16x2_t __attribute__((ext_vector_type(2)));
__device__ __forceinline__ unsigned cvtpk_s(float lo, float hi) { f32x2_t v = {lo, hi}; bf16x2_t b = __builtin_convertvector(v, bf16x2_t); return __builtin_bit_cast(unsigned, b); }
__device__ __forceinline__ float bf2f(short s) { return __uint_as_float(((unsigned)(unsigned short)s) << 16); }
typedef short v4i16_t __attribute__((ext_vector_type(4)));
__device__ __forceinline__ s16x4 vtr(const ALAS unsigned char* p) { return __builtin_bit_cast(s16x4, __builtin_amdgcn_ds_read_tr16_b64_v4i16((ALAS v4i16_t*)p)); }
__device__ __forceinline__ void dma16(const void* g, ALAS unsigned char* l) { __builtin_amdgcn_global_load_lds((const unsigned*)g, (ALAS unsigned*)l, 16, 0, 0); }
__device__ __forceinline__ float xhalf_max(float m) { auto rr = __builtin_amdgcn_permlane32_swap(__float_as_uint(m), __float_as_uint(m), false, false); return fmaxf(__uint_as_float(rr[0]), __uint_as_float(rr[1])); }
__device__ __forceinline__ float xhalf_sum(float m) { auto rr = __builtin_amdgcn_permlane32_swap(__float_as_uint(m), __float_as_uint(m), false, false); return __uint_as_float(rr[0]) + __uint_as_float(rr[1]); }
__device__ __forceinline__ void sincos_acc(float x, float& s, float& c) {
    const float k = rintf(x * 0.6366197723675814f);
    float r = fmaf(-k, 1.5707962513e+00f, x); r = fmaf(-k, 7.5497894159e-08f, r); r = fmaf(-k, 5.3903029534e-15f, r);
    const int q = ((int)k) & 3; const float r2 = r * r;
    const float sp = r + r * r2 * (-1.6666654611e-1f + r2 * (8.3321608736e-3f + r2 * (-1.9515295891e-4f)));
    const float cp = 1.f + r2 * (-0.5f + r2 * (4.166664568298827e-2f + r2 * (-1.388731625493765e-3f + r2 * 2.443315711809948e-5f)));
    const float s0 = (q & 1) ? cp : sp, c0 = (q & 1) ? sp : cp;
    s = (q & 2) ? -s0 : s0; c = ((q + 1) & 2) ? -c0 : c0;
}

template <int DQK, int MODE>
__device__ __forceinline__ void unit(const Desc& d, long rowbase, int q0, int tlo, int thi, const float* rpb_h, ALAS unsigned char* shm) {
    constexpr int ND = DQK / 16;
    const int tid = threadIdx.x, lane = tid & 63, r32 = lane & 31, hi = lane >> 5;
    const int wid = __builtin_amdgcn_readfirstlane(tid >> 6);
    ALAS float* wsf = (ALAS float*)(shm + L_WS) + wid * 64;
    ALAS float* rpbs = (ALAS float*)(shm + L_RPB);
    const bf16_t* ksrc0 = d.K0 + (rowbase + lane) * (long)d.k0p + wid * 8;
    const bf16_t* ksrc1 = d.K1 + (rowbase + lane) * (long)d.k1p + (wid & 3) * 8;
    const bf16_t* vsrc = d.V + (rowbase + 16 * (wid & 3) + (lane >> 2)) * (long)d.vp + (wid >> 2) * 32 + (lane & 3) * 8;
#define ATT_ISSUE_K(t, koff) do { \
        dma16(ksrc0 + (long)(t) * 64 * d.k0p, shm + L_K + (koff) + wid * 1024); \
        if (DQK == 96) { dma16(ksrc1 + (long)(t) * 64 * d.k1p, shm + L_K + (koff) + (8 + (wid & 3)) * 1024); } } while (0)
#define ATT_ISSUE_V(t, voff) dma16(vsrc + (long)(t) * 64 * d.vp, shm + L_V + (voff) + wid * 1024)
#define ATT_WAITBAR() asm volatile("s_waitcnt vmcnt(0) lgkmcnt(0)\n\ts_barrier" ::: "memory")
    ATT_ISSUE_K(tlo, 0); ATT_ISSUE_V(tlo, 0);
    if (tlo + 1 <= thi) { ATT_ISSUE_K(tlo + 1, KSLOT); ATT_ISSUE_V(tlo + 1, VSLOT); }
    if (tlo + 2 <= thi) { ATT_ISSUE_K(tlo + 2, 2 * KSLOT); ATT_ISSUE_V(tlo + 2, 2 * VSLOT); }
    const int tq = q0 + wid * 32 + r32;
    if (MODE == 1) { for (int i = tid; i < 15 * 32; i += 512) { const int dr = i >> 5, j = i & 31; rpbs[i] = (j < 31) ? rpb_h[dr * 31 + j] * LOG2E : -INFINITY; } }
    bf16x8 qr[ND];
    { const bf16_t* qp = d.Q0 + (rowbase + tq) * (long)d.q0p + hi * 8;
#pragma unroll
      for (int d0 = 0; d0 < 4; ++d0) qr[d0] = *(const bf16x8*)(qp + d0 * 16); }
    if constexpr (DQK == 96) {
        const bf16_t* qp = d.Q1 + (rowbase + tq) * (long)d.q1p + hi * 8;
#pragma unroll
        for (int dd = 0; dd < 2; ++dd) {
            const bf16x8 raw = *(const bf16x8*)(qp + dd * 16); const u32x4 w = __builtin_bit_cast(u32x4, raw); u32x4 pw;
#pragma unroll
            for (int j = 0; j < 4; ++j) pw[j] = (unsigned)__shfl_xor((int)w[j], 32);
            const bf16x8 par = __builtin_bit_cast(bf16x8, pw);
            const float pos = (dd == 0) ? (float)(tq >> 6) : (float)(tq & 63);
            float ov[8];
#pragma unroll
            for (int e = 0; e < 8; ++e) { const float inv = exp2f(-(float)e * (13.287712379549449f / 8.0f)); float s, c; sincos_acc(pos * inv, s, c);
                const float x = bf2f(raw[e]), y = bf2f(par[e]); ov[e] = hi == 0 ? x * c - y * s : x * c + y * s; }
            u32x4 o4; o4.x = cvtpk_s(ov[0], ov[1]); o4.y = cvtpk_s(ov[2], ov[3]); o4.z = cvtpk_s(ov[4], ov[5]); o4.w = cvtpk_s(ov[6], ov[7]);
            qr[4 + dd] = __builtin_bit_cast(bf16x8, o4);
        }
    }
    float mhat = 0.f, l_reg = 0.f; f32x16 o[2]; o[0] = f32x16{}; o[1] = f32x16{}; f32x16 negm = f32x16{};
    bool first = true;
    const int qrow = tq >> 6, qc = tq & 63;
    const int wrow = __builtin_amdgcn_readfirstlane(qrow);
    const int rs = min(max(wrow - 4, 0), 120);
    const int cs = min(max(qc - 8, 0), 48);
    unsigned co[32];
    if (MODE == 1) {
#pragma unroll
        for (int r = 0; r < 16; ++r) { const int kc = crow(r, hi), kc1 = kc + 32;
            co[r] = (((unsigned)(kc - cs) < 16u) ? (unsigned)(kc - qc + 15) : 31u) * 4u; co[16 + r] = (((unsigned)(kc1 - cs) < 16u) ? (unsigned)(kc1 - qc + 15) : 31u) * 4u; }
    }
    const unsigned tb_addr = (unsigned)(uintptr_t)(shm + L_RPB);
#define LDS_RD128(dst, addr, off) asm volatile("ds_read_b128 %0, %1 offset:%c2" : "=&v"(dst) : "v"(addr), "i"(off) : "memory")
#define LDS_RDTR(dst, addr, off) asm volatile("ds_read_b64_tr_b16 %0, %1 offset:%c2" : "=v"(dst) : "v"(addr), "i"(off) : "memory")
#define ATT_KRD(KOFF) do { const unsigned ka_ = kaddr0 + (unsigned)(KOFF); \
        _Pragma("unroll") for (int d0 = 0; d0 < ND; ++d0) { LDS_RD128(kf[2 * d0], ka_, d0 * 2048); LDS_RD128(kf[2 * d0 + 1], ka_, d0 * 2048 + 512); } } while (0)
#define ATT_KW2(N, A, B) asm volatile("s_waitcnt lgkmcnt(" #N ")" : "+v"(A), "+v"(B) :: "memory")
#define ATT_QK2(P0, P1, d0) do { if ((d0) == 0) { P0 = __builtin_amdgcn_mfma_f32_32x32x16_bf16(kf[0], qr[0], negm, 0, 0, 0); P1 = __builtin_amdgcn_mfma_f32_32x32x16_bf16(kf[1], qr[0], negm, 0, 0, 0); } \
            else { P0 = __builtin_amdgcn_mfma_f32_32x32x16_bf16(kf[2 * (d0)], qr[d0], P0, 0, 0, 0); P1 = __builtin_amdgcn_mfma_f32_32x32x16_bf16(kf[2 * (d0) + 1], qr[d0], P1, 0, 0, 0); } } while (0)
#define ATT_QKM(P0, P1) do { if constexpr (ND == 4) { \
            ATT_KW2(6, kf[0], kf[1]); ATT_QK2(P0, P1, 0); ATT_KW2(4, kf[2], kf[3]); ATT_QK2(P0, P1, 1); ATT_KW2(2, kf[4], kf[5]); ATT_QK2(P0, P1, 2); ATT_KW2(0, kf[6], kf[7]); ATT_QK2(P0, P1, 3); } \
        else { ATT_KW2(10, kf[0], kf[1]); ATT_QK2(P0, P1, 0); ATT_KW2(8, kf[2], kf[3]); ATT_QK2(P0, P1, 1); ATT_KW2(6, kf[4], kf[5]); ATT_QK2(P0, P1, 2); ATT_KW2(4, kf[6], kf[7]); ATT_QK2(P0, P1, 3); \
               ATT_KW2(2, kf[8 % (2 * ND)], kf[9 % (2 * ND)]); ATT_QK2(P0, P1, 4 % ND); ATT_KW2(0, kf[10 % (2 * ND)], kf[11 % (2 * ND)]); ATT_QK2(P0, P1, 5 % ND); } } while (0)
#define ATT_VRD(VOFF) do { const unsigned va_ = vaddr0 + (unsigned)(VOFF); \
        _Pragma("unroll") for (int kg = 0; kg < 4; ++kg) _Pragma("unroll") for (int dh = 0; dh < 2; ++dh) { \
            LDS_RDTR(vf[(kg * 2 + dh) * 2], va_, dh * 4096 + kg * 1024); LDS_RDTR(vf[(kg * 2 + dh) * 2 + 1], va_, dh * 4096 + kg * 1024 + 512); } } while (0)
#define ATT_VWAIT() asm volatile("s_waitcnt lgkmcnt(0)" : "+v"(vf[0]), "+v"(vf[1]), "+v"(vf[2]), "+v"(vf[3]), "+v"(vf[4]), "+v"(vf[5]), "+v"(vf[6]), "+v"(vf[7]), "+v"(vf[8]), "+v"(vf[9]), "+v"(vf[10]), "+v"(vf[11]), "+v"(vf[12]), "+v"(vf[13]), "+v"(vf[14]), "+v"(vf[15]) :: "memory")
#define ATT_VF(kg, dh) ((bf16x8){vf[((kg) * 2 + (dh)) * 2][0], vf[((kg) * 2 + (dh)) * 2][1], vf[((kg) * 2 + (dh)) * 2][2], vf[((kg) * 2 + (dh)) * 2][3], vf[((kg) * 2 + (dh)) * 2 + 1][0], vf[((kg) * 2 + (dh)) * 2 + 1][1], vf[((kg) * 2 + (dh)) * 2 + 1][2], vf[((kg) * 2 + (dh)) * 2 + 1][3]})
#define ATT_ACTIVE(t) ((MODE == 0) || ((t) >= rs && (t) <= rs + 7))
    const unsigned kaddr0 = (unsigned)(uintptr_t)(shm + L_K) + hi * 1024 + r32 * 16;
    const unsigned vaddr0 = (unsigned)(uintptr_t)(shm + L_V) + ((lane >> 4) & 1) * 32 + (lane & 3) * 8 + (4 * hi + ((lane & 15) >> 2)) * 64;
    bf16x8 kf[2 * ND]; s16x4 vf[16];
    f32x16 p0 = f32x16{}, p1 = f32x16{};
    ATT_WAITBAR();
    for (int t = tlo; t <= thi; ++t) {
        const int buf = (t - tlo) & 3;
        if (t + 3 <= thi) { ATT_ISSUE_K(t + 3, ((buf + 3) & 3) * KSLOT); ATT_ISSUE_V(t + 3, ((buf + 3) & 3) * VSLOT); }
        const bool act = ATT_ACTIVE(t);
        if (act) { ATT_KRD(buf * KSLOT); ATT_QKM(p0, p1); if (MODE == 0) ATT_VRD(buf * VSLOT); }
        __builtin_amdgcn_sched_barrier(0);
        if (act) {
            if (MODE == 1) {
                const unsigned ra = tb_addr + (unsigned)(t - wrow + 7) * 128u;
                float bb[32];
#define NA_RD(k) do { _Pragma("unroll") for (int e = 8 * (k); e < 8 * (k) + 8; ++e) asm volatile("ds_read_b32 %0, %1" : "=v"(bb[e]) : "v"(co[e] + ra) : "memory"); } while (0)
#define NA_WAIT(N, k) asm volatile("s_waitcnt lgkmcnt(" #N ")" : "+v"(bb[8 * (k)]), "+v"(bb[8 * (k) + 1]), "+v"(bb[8 * (k) + 2]), "+v"(bb[8 * (k) + 3]), "+v"(bb[8 * (k) + 4]), "+v"(bb[8 * (k) + 5]), "+v"(bb[8 * (k) + 6]), "+v"(bb[8 * (k) + 7]) :: "memory")
                NA_RD(0); NA_RD(1); NA_WAIT(8, 0);
#pragma unroll
                for (int e = 0; e < 8; ++e) p0[e] += bb[e];
                NA_RD(2); NA_WAIT(8, 1);
#pragma unroll
                for (int e = 8; e < 16; ++e) p0[e] += bb[e];
                NA_RD(3); NA_WAIT(8, 2);
#pragma unroll
                for (int e = 0; e < 8; ++e) p1[e] += bb[16 + e];
                NA_WAIT(0, 3);
#pragma unroll
                for (int e = 8; e < 16; ++e) p1[e] += bb[16 + e];
#undef NA_RD
#undef NA_WAIT
                ATT_VRD(buf * VSLOT);
            }
            float rm0 = fmaxf(fmaxf(p0[0], p0[1]), p0[2]), rm1 = fmaxf(fmaxf(p1[0], p1[1]), p1[2]), rm2 = fmaxf(fmaxf(p0[3], p0[4]), p0[5]), rm3 = fmaxf(fmaxf(p1[3], p1[4]), p1[5]);
#pragma unroll
            for (int r = 6; r < 16; r += 2) { rm0 = fmaxf(fmaxf(rm0, p0[r]), p0[r + 1]); rm1 = fmaxf(fmaxf(rm1, p1[r]), p1[r + 1]); }
            float rm = fmaxf(fmaxf(rm0, rm1), fmaxf(rm2, rm3));
            rm = xhalf_max(rm);
            if (first || __any(rm > THR)) {
                const float dl = first ? rm : fmaxf(rm, 0.f);
                mhat += dl;
#pragma unroll
                for (int r = 0; r < 16; ++r) { p0[r] -= dl; p1[r] -= dl; negm[r] = -mhat; }
                if (!first) { const float f = exp2f(-dl); l_reg *= f; if (hi == 0) wsf[r32] = f;
#pragma unroll
                    for (int r = 0; r < 16; ++r) { const float fr_ = wsf[crow(r, hi)]; o[0][r] *= fr_; o[1][r] *= fr_; } }
                first = false;
            }
            u32x4 pw[4];
            float sa0 = 0.f, sa1 = 0.f, sa2 = 0.f, sa3 = 0.f;
#pragma unroll
            for (int r = 0; r < 16; r += 4) { p0[r] = __builtin_amdgcn_exp2f(p0[r]); p0[r + 1] = __builtin_amdgcn_exp2f(p0[r + 1]); p0[r + 2] = __builtin_amdgcn_exp2f(p0[r + 2]); p0[r + 3] = __builtin_amdgcn_exp2f(p0[r + 3]);
                sa0 += p0[r]; sa1 += p0[r + 1]; sa2 += p0[r + 2]; sa3 += p0[r + 3]; }
#pragma unroll
            for (int j = 0; j < 4; ++j) { pw[0][j] = cvtpk_s(p0[2 * j], p0[2 * j + 1]); pw[1][j] = cvtpk_s(p0[8 + 2 * j], p0[8 + 2 * j + 1]); }
            ATT_VWAIT();
#pragma unroll
            for (int kg = 0; kg < 2; ++kg)
#pragma unroll
                for (int dh = 0; dh < 2; ++dh) o[dh] = __builtin_amdgcn_mfma_f32_32x32x16_bf16(__builtin_bit_cast(bf16x8, pw[kg]), ATT_VF(kg, dh), o[dh], 0, 0, 0);
            __builtin_amdgcn_sched_barrier(0);
#pragma unroll
            for (int r = 0; r < 16; r += 4) { p1[r] = __builtin_amdgcn_exp2f(p1[r]); p1[r + 1] = __builtin_amdgcn_exp2f(p1[r + 1]); p1[r + 2] = __builtin_amdgcn_exp2f(p1[r + 2]); p1[r + 3] = __builtin_amdgcn_exp2f(p1[r + 3]);
                sa0 += p1[r]; sa1 += p1[r + 1]; sa2 += p1[r + 2]; sa3 += p1[r + 3]; }
            l_reg += (sa0 + sa1) + (sa2 + sa3);
#pragma unroll
            for (int j = 0; j < 4; ++j) { pw[2][j] = cvtpk_s(p1[2 * j], p1[2 * j + 1]); pw[3][j] = cvtpk_s(p1[8 + 2 * j], p1[8 + 2 * j + 1]); }
#pragma unroll
            for (int kg = 2; kg < 4; ++kg)
#pragma unroll
                for (int dh = 0; dh < 2; ++dh) o[dh] = __builtin_amdgcn_mfma_f32_32x32x16_bf16(__builtin_bit_cast(bf16x8, pw[kg]), ATT_VF(kg, dh), o[dh], 0, 0, 0);
        }
        if (t + 3 <= thi) { if constexpr (DQK == 96) asm volatile("s_waitcnt vmcnt(6) lgkmcnt(0)\n\ts_barrier" ::: "memory"); else asm volatile("s_waitcnt vmcnt(4) lgkmcnt(0)\n\ts_barrier" ::: "memory"); }
        else ATT_WAITBAR();
    }
#undef LDS_RD128
#undef LDS_RDTR
#undef ATT_KRD
#undef ATT_KW2
#undef ATT_QK2
#undef ATT_QKM
#undef ATT_VRD
#undef ATT_VWAIT
#undef ATT_VF
#undef ATT_QK
#undef ATT_ACTIVE
    l_reg = xhalf_sum(l_reg);
    if (hi == 0) wsf[32 + r32] = l_reg;
    float rli[16];
#pragma unroll
    for (int r = 0; r < 16; ++r) rli[r] = 1.0f / wsf[32 + crow(r, hi)];
    bf16_t* Ow = d.O + (rowbase + q0 + wid * 32) * (long)d.op;
    { ALAS bf16_t* stg = (ALAS bf16_t*)(shm + L_OST) + wid * 2048;
#pragma unroll
      for (int r = 0; r < 16; ++r) { const int orow = crow(r, hi);
#pragma unroll
          for (int dh = 0; dh < 2; ++dh) stg[orow * 64 + dh * 32 + r32] = (bf16_t)(cvtpk_s(o[dh][r] * rli[r], 0.f) & 0xffffu); }
      asm volatile("s_waitcnt lgkmcnt(0)" ::: "memory");
#pragma unroll
      for (int i = 0; i < 4; ++i) { const int row = i * 8 + (lane >> 3), ch = lane & 7; const u32x4 v = *(const ALAS u32x4*)(stg + row * 64 + ch * 8); *(u32x4*)(Ow + (long)row * d.op + ch * 8) = v; } }
    asm volatile("s_waitcnt lgkmcnt(0)\n\ts_barrier" ::: "memory");
#undef ATT_ISSUE_K
#undef ATT_ISSUE_V
#undef ATT_WAITBAR
}
}

constexpr int NWAVES = 8;
constexpr int M = 32768, D = 1024, SEQ = 8192, NB = 4, FF = 4096, NIN = 1440, NINP = 1536;
constexpr size_t MiB = 1u << 20;
constexpr size_t WS_PART = 2 * MiB;
constexpr size_t WS_WIN = 18 * MiB, WS_WUQ = 21 * MiB, WS_WUKV = 22 * MiB, WS_WO0 = 23 * MiB, WS_WUP0 = 25 * MiB, WS_WDN0 = 33 * MiB;
constexpr size_t WS_WQKV = 41 * MiB, WS_WO1 = 47 * MiB, WS_WUP1 = 49 * MiB, WS_WDN1 = 57 * MiB;
constexpr size_t WS_HB = 66 * MiB;
constexpr size_t WS_U = 130 * MiB;
constexpr size_t WS_Z = 130 * MiB, WS_MIX = 130 * MiB, WS_QA = 226 * MiB, WS_KA = 258 * MiB, WS_VA = 266 * MiB, WS_CQ = 274 * MiB, WS_CKV = 298 * MiB, WS_KR = 314 * MiB, WS_QB = 316 * MiB, WS_KVB = 386 * MiB;
constexpr size_t WS_QKV = 130 * MiB, WS_O1 = 322 * MiB;
constexpr size_t WS_END = 450 * MiB;
constexpr int LDS_BYTES = 135168;
static_assert(att::L_END <= 131072, "attention LDS");

#define LAS __attribute__((address_space(3)))
typedef unsigned short bf16;
typedef unsigned v4u __attribute__((ext_vector_type(4)));
typedef float f32x4 __attribute__((ext_vector_type(4)));
#define LDS_WAIT() asm volatile("s_waitcnt lgkmcnt(0)" ::: "memory")

__device__ __forceinline__ float wave_sum(float v) {
#pragma unroll
    for (int o = 1; o < 64; o <<= 1) v += __shfl_xor(v, o);
    return v;
}
__device__ __forceinline__ unsigned pk2(float lo, float hi) { return pg8::cvt_pk_bf16(lo, hi); }
__device__ __forceinline__ void transpose_item(const float* W, const float* gain, int K, int N, bf16* WT, LAS float* scr, int item, int lane) {
    const int nblk = N / 32, kb = item / nblk, nb = item % nblk, k0 = 64 * kb, n0 = 32 * nb;
#pragma unroll 8
    for (int i = 0; i < 32; ++i) { const int kk = 2 * i + (lane >> 5); const float g = gain ? gain[k0 + kk] : 1.f; scr[kk * 33 + (lane & 31)] = W[(size_t)(k0 + kk) * N + n0 + (lane & 31)] * g; }
    LDS_WAIT(); asm volatile("" ::: "memory");
    const int c = lane & 7;
#pragma unroll
    for (int j = 0; j < 4; ++j) { const int n = (lane >> 3) + 8 * j; const LAS float* s = scr + (8 * c) * 33 + n;
        v4u o; o.x = pk2(s[0 * 33], s[1 * 33]); o.y = pk2(s[2 * 33], s[3 * 33]); o.z = pk2(s[4 * 33], s[5 * 33]); o.w = pk2(s[6 * 33], s[7 * 33]);
        *(v4u*)(WT + (size_t)(n0 + n) * K + k0 + 8 * c) = o; }
    LDS_WAIT(); asm volatile("" ::: "memory");
}

#define XB_TMO      128
#define XB_XCNT(j)  (256  + 64 * (j))
#define XB_XSUB(j)  (1280 + 64 * (j))
#define XB_XGEN(j)  (2304 + 64 * (j))
#define XB_TOP      3328
#define XB_TOPGEN   3392
#define XCD_BAR_WORDS 3456
#define XB_SPIN_CAP (1u << 18)

__device__ __forceinline__ unsigned xb_ld(unsigned* p)              { return __hip_atomic_load(p, __ATOMIC_RELAXED, __HIP_MEMORY_SCOPE_AGENT); }
__device__ __forceinline__ unsigned xb_add(unsigned* p, unsigned v) { return __hip_atomic_fetch_add(p, v, __ATOMIC_RELAXED, __HIP_MEMORY_SCOPE_AGENT); }
__device__ __forceinline__ unsigned xb_xcc_id() { return (unsigned)__builtin_amdgcn_s_getreg((3 << 11) | 20) & 0xFu; }
#define XB_SPIN(cond, bar) do { unsigned _sp = 0; while (cond) { __builtin_amdgcn_s_sleep(1); \
    if ((++_sp & 255u) == 0u) { if (xb_ld(&(bar)[XB_TMO])) break; if (_sp > XB_SPIN_CAP) { atomicAdd(&(bar)[XB_TMO], 1u); break; } } } } while (0)

struct XcdBarrier {
    unsigned* bar; unsigned x;
    volatile LAS unsigned* st;
};

__device__ __forceinline__ XcdBarrier xcd_barrier_post(unsigned* bar, volatile LAS unsigned* st) {
    XcdBarrier b; b.bar = bar; b.x = xb_xcc_id(); b.st = st;
    if (threadIdx.x == 0) (void)xb_add(&bar[XB_XCNT(b.x)], 1u);
    return b;
}
__device__ __forceinline__ void xcd_barrier_complete(unsigned* bar, unsigned x, unsigned& nloc, unsigned& nx) {
    const unsigned G = gridDim.x * gridDim.y * gridDim.z;
    unsigned sum, cnt, mine, sp = 0u;
    for (;;) {
        sum = 0u; cnt = 0u; mine = 0u;
#pragma unroll
        for (unsigned j = 0; j < 16; ++j) { const unsigned c = xb_ld(&bar[XB_XCNT(j)]); sum += c; cnt += (c > 0u) ? 1u : 0u; mine = (j == x) ? c : mine; }
        if (sum == G) break;
        __builtin_amdgcn_s_sleep(1);
        if ((++sp & 255u) == 0u) { if (xb_ld(&bar[XB_TMO])) break; if (sp > XB_SPIN_CAP) { atomicAdd(&bar[XB_TMO], 1u); break; } }
    }
    nloc = mine > 0u ? mine : 1u; nx = cnt > 0u ? cnt : 1u;
}

__device__ __forceinline__ void xcd_barrier(const XcdBarrier& b) {
    asm volatile("s_waitcnt vmcnt(0)" ::: "memory");
    __syncthreads();
    if (threadIdx.x == 0) {
        unsigned* bar = b.bar;
        __builtin_amdgcn_s_waitcnt(0);
        unsigned nloc = b.st[0], nx = b.st[1];
        if (nloc == 0u) { xcd_barrier_complete(bar, b.x, nloc, nx); b.st[0] = nloc; b.st[1] = nx; }
        const unsigned old = xb_add(&bar[XB_XSUB(b.x)], 1u);
        const unsigned gen = old / nloc;
        if (old + 1u == (gen + 1u) * nloc) {
            __builtin_amdgcn_fence(__ATOMIC_RELEASE, "agent");
            asm volatile("s_waitcnt vmcnt(0)" ::: "memory");
            const unsigned og = xb_add(&bar[XB_TOP], 1u);
            const unsigned tg = og / nx;
            if (og + 1u == (tg + 1u) * nx) xb_add(&bar[XB_TOPGEN], 1u);
            else XB_SPIN(xb_ld(&bar[XB_TOPGEN]) == tg, bar);
            __builtin_amdgcn_fence(__ATOMIC_ACQUIRE, "agent");
            xb_add(&bar[XB_XGEN(b.x)], 1u);
            asm volatile("s_waitcnt vmcnt(0)" ::: "memory");
        } else {
            XB_SPIN(xb_ld(&bar[XB_XGEN(b.x)]) == gen, bar);
            __builtin_amdgcn_fence(__ATOMIC_ACQUIRE, "agent");
            asm volatile("s_waitcnt vmcnt(0)" ::: "memory");
        }
    }
    __syncthreads();
}

struct Args { const float* in[17]; float* out; unsigned char* ws; int ph_lo, ph_hi; };

__device__ __forceinline__ void ld8(const bf16* p, float (&v)[8]) { const v4u w = *(const v4u*)p;
#pragma unroll
    for (int j = 0; j < 4; ++j) { v[2 * j] = __uint_as_float(w[j] << 16); v[2 * j + 1] = __uint_as_float(w[j] & 0xffff0000u); } }
__device__ __forceinline__ void st8(bf16* p, const float (&v)[8]) { v4u o; o.x = pk2(v[0], v[1]); o.y = pk2(v[2], v[3]); o.z = pk2(v[4], v[5]); o.w = pk2(v[6], v[7]); *(v4u*)p = o; }

__device__ __forceinline__ void head_norm_rope(float (&v)[8], const float* gain, int j, float prow, float pcol, float scale) {
    float ss = 0.f;
#pragma unroll
    for (int e = 0; e < 8; ++e) ss += v[e] * v[e];
    ss += __shfl_xor(ss, 1); ss += __shfl_xor(ss, 2); ss += __shfl_xor(ss, 4);
    const float rstd = 1.0f / sqrtf(ss * (1.0f / 64.0f) + pg8::NORM_EPS);
    const float pos = (j < 4) ? prow : pcol;
#pragma unroll
    for (int e = 0; e < 8; ++e) {
        const float y = v[e] * rstd * gain[j * 8 + e]; const float py = __shfl_xor(y, 2);
        const int i = (j & 1) * 8 + e; const float inv = exp2f(-(float)i * (13.287712379549449f / 16.0f)); float s, c; att::sincos_acc(pos * inv, s, c);
        v[e] = (((j & 2) == 0) ? y * c - py * s : y * c + py * s) * scale;
    }
}

__global__ void __launch_bounds__(NWAVES * 64, 2) fwd_kernel(Args args) {
    extern __shared__ __attribute__((aligned(16))) unsigned char lds[];
    cg::grid_group grid = cg::this_grid();
    LAS unsigned char* L = (LAS unsigned char*)lds;
    const int tid = threadIdx.x, lane = tid & 63, wave = __builtin_amdgcn_readfirstlane(tid >> 6);
    const int G = gridDim.x; const int bx = blockIdx.x;
    const int vcu = (G % 8 == 0) ? (bx % 8) * (G / 8) + bx / 8 : bx;
    const int gw = vcu * NWAVES + wave, NGW = G * NWAVES;
    unsigned char* ws = args.ws;
    const float* x = args.in[0]; float* out = args.out;
    float* PART = (float*)(ws + WS_PART);
#define PARTN(k) (PART + (size_t)(k) * M * 16)
    bf16 *HB = (bf16*)(ws + WS_HB), *U = (bf16*)(ws + WS_U), *Z = (bf16*)(ws + WS_Z), *MIX = (bf16*)(ws + WS_MIX);
    bf16 *QA = (bf16*)(ws + WS_QA), *KA = (bf16*)(ws + WS_KA), *VA = (bf16*)(ws + WS_VA), *CQ = (bf16*)(ws + WS_CQ), *CKV = (bf16*)(ws + WS_CKV), *KR = (bf16*)(ws + WS_KR);
    bf16 *QB = (bf16*)(ws + WS_QB), *KVB = (bf16*)(ws + WS_KVB), *QKV = (bf16*)(ws + WS_QKV), *O1 = (bf16*)(ws + WS_O1);
    bf16 *WIN = (bf16*)(ws + WS_WIN), *WUQ = (bf16*)(ws + WS_WUQ), *WUKV = (bf16*)(ws + WS_WUKV), *WO0 = (bf16*)(ws + WS_WO0), *WUP0 = (bf16*)(ws + WS_WUP0), *WDN0 = (bf16*)(ws + WS_WDN0);
    bf16 *WQKV = (bf16*)(ws + WS_WQKV), *WO1 = (bf16*)(ws + WS_WO1), *WUP1 = (bf16*)(ws + WS_WUP1), *WDN1 = (bf16*)(ws + WS_WDN1);
    const int lo = args.ph_lo, hi = args.ph_hi;
    volatile LAS unsigned* MISC = (volatile LAS unsigned*)(L + 131072);
    if (tid < 2) MISC[tid] = 0u;
    __syncthreads();
    unsigned* BARW = (unsigned*)(ws + 8192);
    XcdBarrier xbar; xbar.bar = BARW; xbar.x = 0; xbar.st = MISC;
#ifndef PROBE_PHASE
#define PROBE_PHASE -1
#endif
#define IN(k) (lo <= (k) && (k) < hi)
#define REPS(k) ((PROBE_PHASE == (k)) ? 2 : 1)
#define SEAM(k) do { if (IN(k) && IN((k) + 1)) { if ((k) == 0) { grid.sync(); xbar = xcd_barrier_post(BARW, MISC); } else xcd_barrier(xbar); } } while (0)
    constexpr float C2A = 0.125f * att::LOG2E;
    constexpr float C2B = 0.10206207261596577f * att::LOG2E;

    if (IN(0)) {
        if (bx == 0) for (int i = tid; i < XCD_BAR_WORDS; i += NWAVES * 64) BARW[i] = 0u;
        LAS float* scr = (LAS float*)(L + wave * 16384);
        constexpr int I0 = 16 * 45, I1 = 6 * 24, I2 = 4 * 32, I3 = 16 * 32, I4 = 16 * 128, I5 = 64 * 32, I6 = 16 * 96, I7 = 16 * 32, I8 = I4, I9 = I5;
        constexpr int NITEMS = I0 + I1 + I2 + I3 + I4 + I5 + I6 + I7 + I8 + I9;
        for (int it = gw; it < NITEMS; it += NGW) {
            int r = it;
            if (r < I0) { transpose_item(args.in[2], args.in[1], D, NIN, WIN, scr, r, lane); continue; } r -= I0;
            if (r < I1) { transpose_item(args.in[6], args.in[5], 384, 768, WUQ, scr, r, lane); continue; } r -= I1;
            if (r < I2) { transpose_item(args.in[8], args.in[7], 256, 1024, WUKV, scr, r, lane); continue; } r -= I2;
            if (r < I3) { transpose_item(args.in[9], nullptr, D, D, WO0, scr, r, lane); continue; } r -= I3;
            if (r < I4) { transpose_item(args.in[14], args.in[13], D, FF, WUP0, scr, r, lane); continue; } r -= I4;
            if (r < I5) { transpose_item(args.in[15], nullptr, FF, D, WDN0, scr, r, lane); continue; } r -= I5;
            if (r < I6) { transpose_item(args.in[10], args.in[1] + D, D, 3 * D, WQKV, scr, r, lane); continue; } r -= I6;
            if (r < I7) { transpose_item(args.in[12], nullptr, D, D, WO1, scr, r, lane); continue; } r -= I7;
            if (r < I8) { transpose_item(args.in[14] + (size_t)D * FF, args.in[13] + D, D, FF, WUP1, scr, r, lane); continue; } r -= I8;
            transpose_item(args.in[15] + (size_t)FF * D, nullptr, FF, D, WDN1, scr, r, lane);
        }
        { v4u* p = (v4u*)(WIN + (size_t)NIN * D); const int n16 = (NINP - NIN) * D * 2 / 16; for (int i = bx * 512 + tid; i < n16; i += G * 512) p[i] = (v4u){0u, 0u, 0u, 0u}; }
        for (int m = gw; m < M; m += NGW) {
            const f32x4* xr = (const f32x4*)(x + (size_t)m * D) + lane; f32x4 v[4]; float s = 0.f;
#pragma unroll
            for (int j = 0; j < 4; ++j) { v[j] = xr[64 * j]; s += (v[j].x * v[j].x + v[j].y * v[j].y) + (v[j].z * v[j].z + v[j].w * v[j].w); }
            s = wave_sum(s);
            unsigned long long* o8 = (unsigned long long*)(HB + (size_t)m * D) + lane;
#pragma unroll
            for (int j = 0; j < 4; ++j) o8[64 * j] = (unsigned long long)pk2(v[j].x, v[j].y) | ((unsigned long long)pk2(v[j].z, v[j].w) << 32);
            if (lane < 16) PARTN(0)[(size_t)m * 16 + lane] = (lane == 0) ? s : 0.f;
        }
    }
    SEAM(0);
    if (IN(1)) {
        pg8::Gemm g{HB, WIN, M, NINP, D}; pg8::StaticOrder S; S.init(M, NINP, G, bx); S.rep = REPS(1);
        pg8::EpiScale<0> E{Z, NINP, PARTN(0), 1.0f / D, 0, 1.f};
        pg8::gemm_phase<pg8::EpiScale<0>, pg8::StaticOrder, true, true>(L, g, S, E);
    }
    SEAM(1);
    if (IN(2)) {
        const float* gq = args.in[3]; const float* gk = args.in[4];
        for (int m = gw; m < M; m += NGW) {
            const bf16* zr = Z + (size_t)m * NINP; const int t = m & (SEQ - 1); const float prow = (float)(t >> 6), pcol = (float)(t & 63); const int j = lane & 7;
            float v1[8], v2[8], v3[8];
            ld8(zr + lane * 8, v1); ld8(zr + 512 + lane * 8, v2); ld8(zr + 1024 + lane * 8, v3);
            float ss2 = 0.f, ss3 = 0.f;
#pragma unroll
            for (int e = 0; e < 8; ++e) { ss2 += v2[e] * v2[e]; ss3 += v3[e] * v3[e]; }
            const float s_cq = wave_sum((lane >= 32 ? ss2 : 0.f) + (lane < 16 ? ss3 : 0.f));
            const float s_ckv = wave_sum((lane >= 16 && lane < 48) ? ss3 : 0.f);
            const float r_cq = 1.0f / sqrtf(s_cq * (1.0f / 384.0f) + pg8::NORM_EPS), r_ckv = 1.0f / sqrtf(s_ckv * (1.0f / 256.0f) + pg8::NORM_EPS);
            head_norm_rope(v1, gq, j, prow, pcol, C2A);
            st8(QA + (size_t)m * 512 + lane * 8, v1);
            float k2[8];
#pragma unroll
            for (int e = 0; e < 8; ++e) k2[e] = v2[e];
            head_norm_rope(k2, gk, j, prow, pcol, 1.f);
            float kr8[8];
            { const int jj = lane & 3; const float pos = (jj < 2) ? prow : pcol;
#pragma unroll
              for (int e = 0; e < 8; ++e) { const float y = v3[e], py = __shfl_xor(y, 1); const float inv = exp2f(-(float)e * (13.287712379549449f / 8.0f)); float s, c; att::sincos_acc(pos * inv, s, c);
                  kr8[e] = ((jj & 1) == 0) ? y * c - py * s : y * c + py * s; } }
            if (lane < 16) st8(KA + (size_t)m * 128 + lane * 8, k2);
            else if (lane < 32) st8(VA + (size_t)m * 128 + (lane - 16) * 8, v2);
            else { float c8[8];
#pragma unroll
                for (int e = 0; e < 8; ++e) c8[e] = v2[e] * r_cq;
                st8(CQ + (size_t)m * 384 + (lane - 32) * 8, c8); }
            if (lane < 16) { float c8[8];
#pragma unroll
                for (int e = 0; e < 8; ++e) c8[e] = v3[e] * r_cq;
                st8(CQ + (size_t)m * 384 + 256 + lane * 8, c8); }
            else if (lane < 48) { float c8[8];
#pragma unroll
                for (int e = 0; e < 8; ++e) c8[e] = v3[e] * r_ckv;
                st8(CKV + (size_t)m * 256 + (lane - 16) * 8, c8); }
            else if (lane < 52) st8(KR + (size_t)m * 32 + (lane - 48) * 8, kr8);
        }
    }
    SEAM(2);
    if (IN(3)) {
        { pg8::Gemm g{CQ, WUQ, M, 768, 384}; pg8::StaticOrder S; S.init(M, 768, G, bx);
          pg8::EpiScale<0> E{QB, 768, nullptr, 0.f, 3, C2B};
          pg8::gemm_phase<pg8::EpiScale<0>, pg8::StaticOrder, true, true>(L, g, S, E); }
        { pg8::Gemm g{CKV, WUKV, M, 1024, 256}; pg8::StaticOrder S; S.init(M, 1024, G, bx);
          pg8::EpiScale<0> E{KVB, 1024, nullptr, 0.f, 0, 1.f};
          pg8::gemm_phase<pg8::EpiScale<0>, pg8::StaticOrder, true, true>(L, g, S, E); }
    }
    SEAM(3);
    if (IN(4)) {
        for (int uu = vcu; uu < 2048 * REPS(4); uu += G) { const int u = uu & 2047;
            const int pair = u >> 5, qb = u & 31; const int typ = (pair >> 3) & 1; const int idx = (pair >> 4) * 8 + (pair & 7); const int b = idx >> 3, h = idx & 7;
            const long rowbase = (long)b * SEQ;
            if (typ == 0) { att::Desc d{QA + h * 64, nullptr, KA + (h >> 2) * 64, nullptr, VA + (h >> 2) * 64, MIX + h * 64, 512, 0, 128, 0, 128, 1024};
                att::unit<64, 0>(d, rowbase, qb * 256, 0, SEQ / 64 - 1, nullptr, L); }
            else { att::Desc d{QB + h * 96, QB + h * 96 + 64, KVB + h * 128, KR, KVB + h * 128 + 64, MIX + 512 + h * 64, 768, 768, 1024, 32, 1024, 1024};
                att::unit<96, 0>(d, rowbase, qb * 256, 0, SEQ / 64 - 1, nullptr, L); }
        }
    }
    SEAM(4);
    if (IN(5)) {
        pg8::Gemm g{MIX, WO0, M, D, D}; pg8::StaticOrder S; S.init(M, D, G, bx); S.rep = REPS(5);
        pg8::EpiRes E{x, out, HB, PARTN(1), D};
        pg8::gemm_phase<pg8::EpiRes, pg8::StaticOrder, true, true>(L, g, S, E);
    }
    SEAM(5);
    if (IN(6)) {
        pg8::Gemm g{HB, WUP0, M, FF, D}; pg8::StaticOrder S; S.init(M, FF, G, bx); S.rep = REPS(6);
        pg8::EpiScale<1> E{U, FF, PARTN(1), 1.0f / D, 0, 1.f};
        pg8::gemm_phase<pg8::EpiScale<1>, pg8::StaticOrder, true, true>(L, g, S, E);
    }
    SEAM(6);
    if (IN(7)) {
        pg8::Gemm g{U, WDN0, M, D, FF}; pg8::StaticOrder S; S.init(M, D, G, bx);
        pg8::EpiRes E{out, out, HB, PARTN(2), D};
        pg8::gemm_phase<pg8::EpiRes, pg8::StaticOrder, true, true>(L, g, S, E);
    }
    SEAM(7);
    if (IN(8)) {
        pg8::Gemm g{HB, WQKV, M, 3 * D, D}; pg8::StaticOrder S; S.init(M, 3 * D, G, bx); S.rep = REPS(8);
        pg8::EpiScale<0> E{QKV, 3 * D, PARTN(2), 1.0f / D, 4, C2A, M};
        pg8::gemm_phase<pg8::EpiScale<0>, pg8::StaticOrder, true, true>(L, g, S, E);
    }
    SEAM(8);
    if (IN(9)) {
        for (int uu = vcu; uu < 2048 * REPS(9); uu += G) { const int u = uu & 2047;
            const int pair = u >> 5, qb = u & 31; const int b = pair >> 4, h = pair & 15;
            const int R0 = qb * 4; const int tlo = min(max(R0 - 4, 0), 120), thi = min(max(R0 + 3 - 4, 0), 120) + 7;
            att::Desc d{QKV + (size_t)h * M * 64, nullptr, QKV + (size_t)(16 + h) * M * 64, nullptr, QKV + (size_t)(32 + h) * M * 64, O1 + h * 64, 64, 0, 64, 0, 64, D};
            att::unit<64, 1>(d, (long)b * SEQ, qb * 256, tlo, thi, args.in[11] + h * 465, L);
        }
    }
    SEAM(9);
    if (IN(10)) {
        pg8::Gemm g{O1, WO1, M, D, D}; pg8::StaticOrder S; S.init(M, D, G, bx);
        pg8::EpiRes E{out, out, HB, PARTN(3), D};
        pg8::gemm_phase<pg8::EpiRes, pg8::StaticOrder, true, true>(L, g, S, E);
    }
    SEAM(10);
    if (IN(11)) {
        pg8::Gemm g{HB, WUP1, M, FF, D}; pg8::StaticOrder S; S.init(M, FF, G, bx);
        pg8::EpiScale<1> E{U, FF, PARTN(3), 1.0f / D, 0, 1.f};
        pg8::gemm_phase<pg8::EpiScale<1>, pg8::StaticOrder, true, true>(L, g, S, E);
    }
    SEAM(11);
    if (IN(12)) {
        pg8::Gemm g{U, WDN1, M, D, FF}; pg8::StaticOrder S; S.init(M, D, G, bx);
        pg8::EpiRes E{out, out, HB, PARTN(4), D};
        pg8::gemm_phase<pg8::EpiRes, pg8::StaticOrder, true, true>(L, g, S, E);
    }
    SEAM(12);
    if (IN(13)) {
        const float* gf = args.in[16];
        for (int m = gw; m < M; m += NGW) {
            f32x4* xr = (f32x4*)(out + (size_t)m * D) + lane; const f32x4* pp = (const f32x4*)(PARTN(4) + (size_t)m * 16);
            const f32x4 a = pp[0], b = pp[1], c = pp[2], d4 = pp[3];
            const float s = ((a[0] + a[1]) + (a[2] + a[3])) + ((b[0] + b[1]) + (b[2] + b[3])) + ((c[0] + c[1]) + (c[2] + c[3])) + ((d4[0] + d4[1]) + (d4[2] + d4[3]));
            const float rstd = 1.0f / sqrtf(s * (1.0f / D) + pg8::NORM_EPS);
#pragma unroll
            for (int j = 0; j < 4; ++j) { const f32x4 v = xr[64 * j]; const f32x4 gg = ((const f32x4*)gf)[lane + 64 * j]; xr[64 * j] = v * rstd * gg; }
        }
    }
#undef IN
#undef SEAM
}

#ifndef MK_PER_PHASE
#define MK_PER_PHASE 0
#endif
extern "C" void kernel_launch(void* const* d_in, const int* in_sizes, int n_in, void* d_out, int out_size, void* d_ws, size_t ws_size, hipStream_t stream) {
    static int grid = 0;
    if (grid == 0) {
        if (n_in != 17 || in_sizes[0] != M * D || out_size != M * D || ws_size < WS_END) { fprintf(stderr, "kernel_launch: unexpected shapes / workspace (n_in %d, in0 %d, out %d, ws %zu)\n", n_in, n_in > 0 ? in_sizes[0] : -1, out_size, ws_size); grid = -1; return; }
        int dev = 0, cus = 0, per_cu = 0;
        if (hipGetDevice(&dev) != hipSuccess || hipDeviceGetAttribute(&cus, hipDeviceAttributeMultiprocessorCount, dev) != hipSuccess) { grid = -1; return; }
        if (hipFuncSetAttribute((const void*)fwd_kernel, hipFuncAttributeMaxDynamicSharedMemorySize, LDS_BYTES) != hipSuccess) { fprintf(stderr, "kernel_launch: hipFuncSetAttribute failed\n"); grid = -1; return; }
        if (hipOccupancyMaxActiveBlocksPerMultiprocessor(&per_cu, (const void*)fwd_kernel, NWAVES * 64, LDS_BYTES) != hipSuccess || per_cu < 1) { fprintf(stderr, "kernel_launch: occupancy query says %d\n", per_cu); per_cu = 1; }
        (void)hipGetLastError();
        grid = cus * per_cu;
        fprintf(stderr, "kernel_launch: grid %d (cus %d x %d)\n", grid, cus, per_cu);
    }
    if (grid < 0) return;
    Args a{};
    for (int i = 0; i < 17; ++i) a.in[i] = (const float*)d_in[i];
    a.out = (float*)d_out; a.ws = (unsigned char*)d_ws;
#if MK_PER_PHASE
    for (int p = 0; p < 14; ++p) { a.ph_lo = p; a.ph_hi = p + 1; hipLaunchKernelGGL(fwd_kernel, dim3(grid), dim3(NWAVES * 64), LDS_BYTES, stream, a); }
#else
    a.ph_lo = 0; a.ph_hi = 14;
    void* kargs[] = {&a};
    hipError_t e = hipLaunchCooperativeKernel((const void*)fwd_kernel, dim3(grid), dim3(NWAVES * 64), kargs, LDS_BYTES, stream);
    if (e != hipSuccess) fprintf(stderr, "cooperative launch failed: %s (grid %d)\n", hipGetErrorString(e), grid);
#endif
}
```

```cpp
#include <hip/hip_runtime.h>
#include <hip/hip_cooperative_groups.h>
#include <cstdio>
#include <cstdint>
#include <cmath>
namespace cg = cooperative_groups;
namespace pg8 {
#define PG8_LAS __attribute__((address_space(3)))
typedef unsigned short bf16_t;
typedef short bf16x8 __attribute__((ext_vector_type(8)));
typedef float f32x4 __attribute__((ext_vector_type(4)));
typedef unsigned u32x4 __attribute__((ext_vector_type(4)));
constexpr int BM = 256, BK = 64, HALF = 128, HTB = HALF * BK * 2  , STAGE_BYTES = 8 * HTB, NXCD = 8, WGM = 8;

__host__ __device__ __forceinline__ int lds_byte(int r, int c) { const int st = (r >> 4) * 2 + (c >> 5), rr = r & 15, cc = c & 31, ob = rr * 64 + cc * 2; return st * 1024 + (ob ^ (((ob >> 9) & 1) << 5)); }
__host__ __device__ __forceinline__ void stage_rc(int b, int& R, int& C) { const int st = b / 1024, sb = b % 1024, swz = sb ^ (((sb >> 9) & 1) << 5); R = (st >> 1) * 16 + swz / 64; C = (st & 1) * 32 + (swz % 64) / 2; }
__host__ __device__ __forceinline__ int perm32(int rho) { const int n = rho >> 4, i = rho & 15; return 8 * (i >> 2) + 4 * n + (i & 3); }

struct Unit { int pm, pn; };
struct Gemm { const bf16_t* A; const bf16_t* Bt; int M, N, K; };

struct StaticOrder {
    int nM, nN, nwg, G, c, rep = 1;
    __host__ __device__ void init(int M, int N, int G_, int c_) { nM = M / BM; nN = N / BM; nwg = nM * nN; G = G_; c = c_; }
    __host__ __device__ bool next(int i, Unit& u) const {
        const long L = (long)i * G + c; if (L >= (long)nwg * rep) return false;
        int wgid = (int)(L % nwg); { const int q = nwg / NXCD, r = nwg % NXCD, xcd = wgid % NXCD, off = wgid / NXCD; wgid = (xcd < r ? xcd * (q + 1) : r * (q + 1) + (xcd - r) * q) + off; }
        const int nig = WGM * nN, gid = wgid / nig, fm = gid * WGM, gsz = (nM - fm) < WGM ? (nM - fm) : WGM;
        u.pm = fm + ((wgid % nig) % gsz); u.pn = (wgid % nig) / gsz; return true;
    }
    __device__ __forceinline__ void a_ready(const Unit&) const {}
    __device__ __forceinline__ void done(const Unit&) const {}
};
__device__ __forceinline__ unsigned cvt_pk_bf16(float lo, float hi) { unsigned r; asm volatile("v_cvt_pk_bf16_f32 %0, %1, %2" : "=v"(r) : "v"(lo), "v"(hi)); return r; }
constexpr float NORM_EPS = 1e-6f;
template <int ACT> struct EpiScale {
    static constexpr bool PERM = true, AFTER_DRAIN = false;
    bf16_t* O; int ldc; const float* part; float inv_dim; int nq_tiles; float qscale; int hm = 0;
    __device__ __forceinline__ void operator()(const f32x4 (&acc)[2][2][4][2], const Unit& u, int wr, int wc, int fr, int fq) const {
        const int row0 = u.pm * BM + wr * 64 + fr; const int col0 = u.pn * BM + wc * 32 + 8 * fq;
        const float sc = (u.pn < nq_tiles) ? qscale : 1.f;
#pragma unroll
        for (int ai = 0; ai < 2; ++ai)
#pragma unroll
            for (int m = 0; m < 4; ++m) { const int row = row0 + ai * HALF + m * 16; float rs = 1.f;
                if (part) { const f32x4* pp = (const f32x4*)(part + (size_t)row * 16); const f32x4 a = pp[0], b = pp[1], c = pp[2], d = pp[3];
                    const float s = ((a[0] + a[1]) + (a[2] + a[3])) + ((b[0] + b[1]) + (b[2] + b[3])) + ((c[0] + c[1]) + (c[2] + c[3])) + ((d[0] + d[1]) + (d[2] + d[3]));
                    rs = 1.0f / sqrtf(s * inv_dim + NORM_EPS); }
                if (ACT == 0) rs *= sc;
                bf16_t* rowp = hm ? O + ((size_t)(col0 >> 6) * hm + row) * 64 + (col0 & 63) : O + (size_t)row * ldc + col0;
#pragma unroll
                for (int bj = 0; bj < 2; ++bj) { f32x4 v0 = acc[ai][bj][m][0] * rs, v1 = acc[ai][bj][m][1] * rs;
                    if (ACT == 1) {
#pragma unroll
                        for (int e = 0; e < 4; ++e) { float a = fmaxf(v0[e], 0.f), b = fmaxf(v1[e], 0.f); v0[e] = a * a; v1[e] = b * b; } }
                    u32x4 w; w.x = cvt_pk_bf16(v0[0], v0[1]); w.y = cvt_pk_bf16(v0[2], v0[3]); w.z = cvt_pk_bf16(v1[0], v1[1]); w.w = cvt_pk_bf16(v1[2], v1[3]);
                    *(u32x4*)(rowp + (hm ? (size_t)bj * 2 * hm * 64 : (size_t)(bj * HALF))) = w; } }
    }
};
struct EpiRes {
    static constexpr bool PERM = true, AFTER_DRAIN = false;
    const float* base; float* out; bf16_t* ob; float* part; int ldc;
    __device__ __forceinline__ void operator()(const f32x4 (&acc)[2][2][4][2], const Unit& u, int wr, int wc, int fr, int fq) const {
        const int row0 = u.pm * BM + wr * 64 + fr; const int col0 = u.pn * BM + wc * 32 + 8 * fq;
#pragma unroll
        for (int ai = 0; ai < 2; ++ai)
#pragma unroll
            for (int m = 0; m < 4; ++m) { const int row = row0 + ai * HALF + m * 16; const size_t off = (size_t)row * ldc + col0; float ss = 0.f;
#pragma unroll
                for (int bj = 0; bj < 2; ++bj) { const f32x4 b0 = *(const f32x4*)(base + off + bj * HALF), b1 = *(const f32x4*)(base + off + bj * HALF + 4);
                    const f32x4 v0 = acc[ai][bj][m][0] + b0, v1 = acc[ai][bj][m][1] + b1;
                    *(f32x4*)(out + off + bj * HALF) = v0; *(f32x4*)(out + off + bj * HALF + 4) = v1;
                    u32x4 w; w.x = cvt_pk_bf16(v0[0], v0[1]); w.y = cvt_pk_bf16(v0[2], v0[3]); w.z = cvt_pk_bf16(v1[0], v1[1]); w.w = cvt_pk_bf16(v1[2], v1[3]);
                    *(u32x4*)(ob + off + bj * HALF) = w;
                    ss += (v0[0] * v0[0] + v0[1] * v0[1]) + (v0[2] * v0[2] + v0[3] * v0[3]) + (v1[0] * v1[0] + v1[1] * v1[1]) + (v1[2] * v1[2] + v1[3] * v1[3]); }
                ss += __shfl_xor(ss, 16); ss += __shfl_xor(ss, 32);
                if (fq == 0) part[(size_t)row * 16 + u.pn * 4 + wc] = ss; }
    }
};

template <class Epi, class Sched, bool ALIGN_EPI = false, bool SP2 = false>
__device__ __forceinline__ void gemm_phase(PG8_LAS unsigned char* lds, const Gemm g, const Sched& S, const Epi& E) {
    const int tid = threadIdx.x, wid = __builtin_amdgcn_readfirstlane(tid >> 6), lane = tid & 63, wr = wid >> 2, wc = wid & 3, fr = lane & 15, fq = lane >> 4;
    const int K = g.K, nt = K / BK;
    unsigned voffA[2], voffB[2];
#pragma unroll
    for (int i = 0; i < 2; ++i) { int R, C; stage_rc(tid * 16 + i * 8192, R, C); const int Rb = Epi::PERM ? ((R & ~31) + perm32(R & 31)) : R;
        voffA[i] = (unsigned)(R * K + C) * 2u; voffB[i] = (unsigned)(Rb * K + C) * 2u; }
    const size_t kstep = (size_t)(BK * 2);
    const size_t hstep = (size_t)HALF * K * 2;
    const size_t tstep = 2 * hstep;
    const unsigned ldsw = (unsigned)wid * 1024u;
    const int aoff = lds_byte(wr * 64 + fr, fq * 8), boff = lds_byte(wc * 32 + fr, fq * 8);
#define PG8_SA(b, h) (((b) * 2 + (h)) * HTB)
#define PG8_SB(b, h) ((4 + (b) * 2 + (h)) * HTB)
#define PG8_STAGE(bufoff, gbase, voff) do { _Pragma("unroll") for (int _i = 0; _i < 2; ++_i) \
        __builtin_amdgcn_global_load_lds((const unsigned*)((const char*)(gbase) + (voff)[_i]), (PG8_LAS unsigned*)(lds + (bufoff) + ldsw + _i * 8192), 16, 0, 0); } while (0)
#define PG8_LDA(dst, b, h) do { _Pragma("unroll") for (int m = 0; m < 4; ++m) _Pragma("unroll") for (int k = 0; k < 2; ++k) dst[m][k] = *(const PG8_LAS bf16x8*)(lds + PG8_SA(b, h) + aoff + m * 2048 + k * 1024); } while (0)
#define PG8_LDB(dst, b, h) do { _Pragma("unroll") for (int n = 0; n < 2; ++n) _Pragma("unroll") for (int k = 0; k < 2; ++k) dst[n][k] = *(const PG8_LAS bf16x8*)(lds + PG8_SB(b, h) + boff + n * 2048 + k * 1024); } while (0)
#define PG8_MMA(ai, bj, At, Bt) do { __builtin_amdgcn_s_setprio(1); _Pragma("unroll") for (int m = 0; m < 4; ++m) _Pragma("unroll") for (int n = 0; n < 2; ++n) _Pragma("unroll") for (int k = 0; k < 2; ++k) \
        acc[ai][bj][m][n] = __builtin_amdgcn_mfma_f32_16x16x32_bf16(Bt[n][k], At[m][k], acc[ai][bj][m][n], 0, 0, 0); __builtin_amdgcn_s_setprio(0); } while (0)
#define PG8_WAIT_V(n) asm volatile("s_waitcnt vmcnt(" #n ")" ::: "memory")
#define PG8_WAIT_L(n) asm volatile("s_waitcnt lgkmcnt(" #n ")" ::: "memory")
#define PG8_BAR __builtin_amdgcn_s_barrier()
#define PG8_SCHED __builtin_amdgcn_sched_barrier(0)
    Unit cur, nxt; int ui = 0;
    if (!S.next(0, cur)) return;
    f32x4 acc[2][2][4][2];
#pragma unroll
    for (int a = 0; a < 2; ++a)
#pragma unroll
        for (int b = 0; b < 2; ++b)
#pragma unroll
            for (int m = 0; m < 4; ++m)
#pragma unroll
                for (int n = 0; n < 2; ++n) acc[a][b][m][n] = (f32x4){0.f, 0.f, 0.f, 0.f};
    bf16x8 At[4][2], B0[2][2], B1[2][2];
    const char* cA = (const char*)g.A + (size_t)cur.pm * tstep; const char* cB = (const char*)g.Bt + (size_t)cur.pn * tstep;
    S.a_ready(cur);
    if constexpr (SP2) {
        PG8_STAGE(PG8_SB(0, 0), cB, voffB); PG8_STAGE(PG8_SB(0, 1), cB + hstep, voffB); PG8_STAGE(PG8_SA(0, 0), cA, voffA); PG8_STAGE(PG8_SA(0, 1), cA + hstep, voffA);
        if (wr == 1) PG8_BAR;
        PG8_WAIT_V(2); PG8_BAR;
        PG8_STAGE(PG8_SB(1, 0), cB + kstep, voffB); PG8_STAGE(PG8_SA(1, 0), cA + kstep, voffA); PG8_STAGE(PG8_SB(1, 1), cB + hstep + kstep, voffB);
        PG8_WAIT_V(6); PG8_BAR;
    } else {
        PG8_STAGE(PG8_SB(0, 0), cB, voffB); PG8_STAGE(PG8_SA(0, 0), cA, voffA); PG8_STAGE(PG8_SB(0, 1), cB + hstep, voffB); PG8_STAGE(PG8_SA(0, 1), cA + hstep, voffA);
        if (wr == 1) PG8_BAR;
        PG8_WAIT_V(4); PG8_BAR;
        PG8_STAGE(PG8_SB(1, 0), cB + kstep, voffB); PG8_STAGE(PG8_SA(1, 0), cA + kstep, voffA); PG8_STAGE(PG8_SB(1, 1), cB + hstep + kstep, voffB);
        PG8_WAIT_V(6); PG8_BAR;
    }
    for (;;) {
        const bool has_next = S.next(ui + 1, nxt);
        const char* nA = has_next ? (const char*)g.A + (size_t)nxt.pm * tstep : cA; const char* nB = has_next ? (const char*)g.Bt + (size_t)nxt.pn * tstep : cB;
        for (int t = 0; t < nt; t += 2) {
            const bool last = (t == nt - 2);
            const char* a1 = cA + (size_t)(t + 1) * kstep;
            const char* a2 = last ? nA : cA + (size_t)(t + 2) * kstep; const char* b2 = last ? nB : cB + (size_t)(t + 2) * kstep;
            const char* a3 = a2 + kstep; const char* b3 = b2 + kstep;
            if (last && has_next) S.a_ready(nxt);
            if constexpr (SP2) {
            PG8_LDB(B0, 0, 0); PG8_LDB(B1, 0, 1); PG8_SCHED; PG8_LDA(At, 0, 0); PG8_STAGE(PG8_SA(1, 1), a1 + hstep, voffA);
            PG8_WAIT_V(8); PG8_WAIT_L(0); PG8_BAR; PG8_MMA(0, 0, At, B0); PG8_MMA(0, 1, At, B1); PG8_BAR; PG8_SCHED;
            PG8_LDA(At, 0, 1); PG8_STAGE(PG8_SB(0, 0), b2, voffB); PG8_STAGE(PG8_SB(0, 1), b2 + hstep, voffB); PG8_STAGE(PG8_SA(0, 0), a2, voffA);
            PG8_WAIT_V(8); PG8_WAIT_L(0); PG8_BAR; PG8_MMA(1, 0, At, B0); PG8_MMA(1, 1, At, B1); PG8_BAR; PG8_SCHED;
            PG8_LDB(B0, 1, 0); PG8_LDB(B1, 1, 1); PG8_SCHED; PG8_LDA(At, 1, 0); PG8_STAGE(PG8_SA(0, 1), a2 + hstep, voffA);
            PG8_WAIT_V(8); PG8_WAIT_L(0); PG8_BAR; PG8_MMA(0, 0, At, B0); PG8_MMA(0, 1, At, B1); PG8_BAR; PG8_SCHED;
            PG8_LDA(At, 1, 1); PG8_STAGE(PG8_SB(1, 0), b3, voffB); PG8_STAGE(PG8_SB(1, 1), b3 + hstep, voffB); PG8_STAGE(PG8_SA(1, 0), a3, voffA);
            PG8_WAIT_V(8); PG8_WAIT_L(0); PG8_BAR; PG8_MMA(1, 0, At, B0); PG8_MMA(1, 1, At, B1); PG8_BAR; PG8_SCHED;
            } else {
            PG8_LDB(B0, 0, 0); PG8_SCHED; PG8_LDA(At, 0, 0); PG8_STAGE(PG8_SA(1, 1), a1 + hstep, voffA);
            PG8_WAIT_L(8); PG8_BAR; PG8_WAIT_L(0); PG8_MMA(0, 0, At, B0); PG8_BAR; PG8_SCHED;
            PG8_LDB(B1, 0, 1); PG8_STAGE(PG8_SB(0, 0), b2, voffB);
            PG8_BAR; PG8_WAIT_L(0); PG8_MMA(0, 1, At, B1); PG8_BAR;
            PG8_LDA(At, 0, 1); PG8_STAGE(PG8_SA(0, 0), a2, voffA);
            PG8_BAR; PG8_WAIT_L(0); PG8_MMA(1, 0, At, B0); PG8_BAR; PG8_SCHED;
            PG8_STAGE(PG8_SB(0, 1), b2 + hstep, voffB);
            PG8_WAIT_V(6); PG8_BAR; PG8_MMA(1, 1, At, B1); PG8_BAR;
            PG8_LDB(B0, 1, 0); PG8_SCHED; PG8_LDA(At, 1, 0); PG8_STAGE(PG8_SA(0, 1), a2 + hstep, voffA);
            PG8_WAIT_L(8); PG8_BAR; PG8_WAIT_L(0); PG8_MMA(0, 0, At, B0); PG8_BAR; PG8_SCHED;
            PG8_LDB(B1, 1, 1); PG8_STAGE(PG8_SB(1, 0), b3, voffB);
            PG8_BAR; PG8_WAIT_L(0); PG8_MMA(0, 1, At, B1); PG8_BAR;
            PG8_LDA(At, 1, 1); PG8_STAGE(PG8_SA(1, 0), a3, voffA);
            PG8_BAR; PG8_WAIT_L(0); PG8_MMA(1, 0, At, B0); PG8_BAR; PG8_SCHED;
            PG8_STAGE(PG8_SB(1, 1), b3 + hstep, voffB);
            PG8_WAIT_V(6); PG8_BAR; PG8_MMA(1, 1, At, B1); PG8_BAR;
            }
        }
        if constexpr (ALIGN_EPI) { if (wr == 0) PG8_BAR; }
        if constexpr (!Epi::AFTER_DRAIN) { E(acc, cur, wr, wc, fr, fq); S.done(cur); }
        if (!has_next) break;
#pragma unroll
        for (int a = 0; a < 2; ++a)
#pragma unroll
            for (int b = 0; b < 2; ++b)
#pragma unroll
                for (int m = 0; m < 4; ++m)
#pragma unroll
                    for (int n = 0; n < 2; ++n) acc[a][b][m][n] = (f32x4){0.f, 0.f, 0.f, 0.f};
        cur = nxt; cA = nA; cB = nB; ++ui;
        if constexpr (ALIGN_EPI) { if (wr == 1) PG8_BAR; }
    }
    PG8_WAIT_V(0);
    if constexpr (!ALIGN_EPI) { if (wr == 0) PG8_BAR; }
    PG8_BAR;
    if constexpr (Epi::AFTER_DRAIN) { E.fused(acc, cur, wr, wc, fr, fq, lds, wid, lane); S.done(cur); }
#undef PG8_SA
#undef PG8_SB
#undef PG8_STAGE
#undef PG8_LDA
#undef PG8_LDB
#undef PG8_MMA
#undef PG8_WAIT_V
#undef PG8_WAIT_L
#undef PG8_BAR
#undef PG8_SCHED
}
}
namespace att {
using bf16x8 = __attribute__((ext_vector_type(8))) short;
using s16x4 = __attribute__((ext_vector_type(4))) short;
using f32x16 = __attribute__((ext_vector_type(16))) float;
using u32x4 = __attribute__((ext_vector_type(4))) unsigned;
typedef unsigned short bf16_t;
#define ALAS __attribute__((address_space(3)))
constexpr int KSLOT = 12288, VSLOT = 8192;
constexpr int NSLOT = 4;
constexpr int L_K = 0, L_V = NSLOT * KSLOT, L_WS = L_V + NSLOT * VSLOT, L_OST = L_WS + 8 * 64 * 4, L_RPB = L_OST + 8 * 4096, L_END = L_RPB + 2048;
constexpr float THR = 8.f;
constexpr float LOG2E = 1.4426950408889634f;
struct Desc { const bf16_t *Q0, *Q1, *K0, *K1, *V; bf16_t* O; int q0p, q1p, k0p, k1p, vp, op; };
struct Next { const bf16_t *K0, *K1, *V; int k0p, k1p, vp; long rowbase; int tlo, thi, dqk; };

__device__ __forceinline__ int crow(int r, int hi) { return (r & 3) + 8 * (r >> 2) + 4 * hi; }
typedef float f32x2_t __attribute__((ext_vector_type(2))); typedef __bf16 bf16x2_t __attribute__((ext_vector_type(2)));
__device__ __forceinline__ unsigned cvtpk_s(float lo, float hi) { f32x2_t v = {lo, hi}; bf16x2_t b = __builtin_convertvector(v, bf16x2_t); return __builtin_bit_cast(unsigned, b); }
__device__ __forceinline__ float bf2f(short s) { return __uint_as_float(((unsigned)(unsigned short)s) << 16); }
typedef short v4i16_t __attribute__((ext_vector_type(4)));
__device__ __forceinline__ s16x4 vtr(const ALAS unsigned char* p) { return __builtin_bit_cast(s16x4, __builtin_amdgcn_ds_read_tr16_b64_v4i16((ALAS v4i16_t*)p)); }
__device__ __forceinline__ void dma16(const void* g, ALAS unsigned char* l) { __builtin_amdgcn_global_load_lds((const unsigned*)g, (ALAS unsigned*)l, 16, 0, 0); }
__device__ __forceinline__ float xhalf_max(float m) { auto rr = __builtin_amdgcn_permlane32_swap(__float_as_uint(m), __float_as_uint(m), false, false); return fmaxf(__uint_as_float(rr[0]), __uint_as_float(rr[1])); }
__device__ __forceinline__ float xhalf_sum(float m) { auto rr = __builtin_amdgcn_permlane32_swap(__float_as_uint(m), __float_as_uint(m), false, false); return __uint_as_float(rr[0]) + __uint_as_float(rr[1]); }
__device__ __forceinline__ void sincos_acc(float x, float& s, float& c) {
    const float k = rintf(x * 0.6366197723675814f);
    float r = fmaf(-k, 1.5707962513e+00f, x); r = fmaf(-k, 7.5497894159e-08f, r); r = fmaf(-k, 5.3903029534e-15f, r);
    const int q = ((int)k) & 3; const float r2 = r * r;
    const float sp = r + r * r2 * (-1.6666654611e-1f + r2 * (8.3321608736e-3f + r2 * (-1.9515295891e-4f)));
    const float cp = 1.f + r2 * (-0.5f + r2 * (4.166664568298827e-2f + r2 * (-1.388731625493765e-3f + r2 * 2.443315711809948e-5f)));
    const float s0 = (q & 1) ? cp : sp, c0 = (q & 1) ? sp : cp;
    s = (q & 2) ? -s0 : s0; c = ((q + 1) & 2) ? -c0 : c0;
}

template <int DQK, int MODE>
__device__ __forceinline__ void unit(const Desc& d, long rowbase, int q0, int tlo, int thi, const float* rpb_h, ALAS unsigned char* shm, bool pre, bool has_next, const Next& nx) {
    constexpr int ND = DQK / 16;
    const int tid = threadIdx.x, lane = tid & 63, r32 = lane & 31, hi = lane >> 5;
    const int wid = __builtin_amdgcn_readfirstlane(tid >> 6);
    ALAS float* wsf = (ALAS float*)(shm + L_WS) + wid * 64;
    ALAS float* rpbs = (ALAS float*)(shm + L_RPB);
    const bf16_t* ksrc0 = d.K0 + (rowbase + lane) * (long)d.k0p + wid * 8;
    const bf16_t* ksrc1 = d.K1 + (rowbase + lane) * (long)d.k1p + (wid & 3) * 8;
    const bf16_t* vsrc = d.V + (rowbase + 16 * (wid & 3) + (lane >> 2)) * (long)d.vp + (wid >> 2) * 32 + (lane & 3) * 8;
#define ATT_ISSUE_K(t, koff) do { \
        dma16(ksrc0 + (long)(t) * 64 * d.k0p, shm + L_K + (koff) + wid * 1024); \
        if (DQK == 96) { dma16(ksrc1 + (long)(t) * 64 * d.k1p, shm + L_K + (koff) + (8 + (wid & 3)) * 1024); } } while (0)
#define ATT_ISSUE_V(t, voff) dma16(vsrc + (long)(t) * 64 * d.vp, shm + L_V + (voff) + wid * 1024)
#define ATT_WAITBAR() asm volatile("s_waitcnt vmcnt(0) lgkmcnt(0)\n\ts_barrier" ::: "memory")
    if (!pre) {
    ATT_ISSUE_K(tlo, 0); ATT_ISSUE_V(tlo, 0);
    if (tlo + 1 <= thi) { ATT_ISSUE_K(tlo + 1, KSLOT); ATT_ISSUE_V(tlo + 1, VSLOT); }
    if (tlo + 2 <= thi) { ATT_ISSUE_K(tlo + 2, 2 * KSLOT); ATT_ISSUE_V(tlo + 2, 2 * VSLOT); }
    }
    const int tq = q0 + wid * 32 + r32;
    if (MODE == 1) { for (int i = tid; i < 15 * 32; i += 512) { const int dr = i >> 5, j = i & 31; rpbs[i] = (j < 31) ? rpb_h[dr * 31 + j] * LOG2E : -INFINITY; } }
    bf16x8 qr[ND];
    { const bf16_t* qp = d.Q0 + (rowbase + tq) * (long)d.q0p + hi * 8;
#pragma unroll
      for (int d0 = 0; d0 < 4; ++d0) qr[d0] = *(const bf16x8*)(qp + d0 * 16); }
    if constexpr (DQK == 96) {
        const bf16_t* qp = d.Q1 + (rowbase + tq) * (long)d.q1p + hi * 8;
#pragma unroll
        for (int dd = 0; dd < 2; ++dd) {
            const bf16x8 raw = *(const bf16x8*)(qp + dd * 16); const u32x4 w = __builtin_bit_cast(u32x4, raw); u32x4 pw;
#pragma unroll
            for (int j = 0; j < 4; ++j) pw[j] = (unsigned)__shfl_xor((int)w[j], 32);
            const bf16x8 par = __builtin_bit_cast(bf16x8, pw);
            const float pos = (dd == 0) ? (float)(tq >> 6) : (float)(tq & 63);
            float ov[8];
#pragma unroll
            for (int e = 0; e < 8; ++e) { const float inv = exp2f(-(float)e * (13.287712379549449f / 8.0f)); float s, c; sincos_acc(pos * inv, s, c);
                const float x = bf2f(raw[e]), y = bf2f(par[e]); ov[e] = hi == 0 ? x * c - y * s : x * c + y * s; }
            u32x4 o4; o4.x = cvtpk_s(ov[0], ov[1]); o4.y = cvtpk_s(ov[2], ov[3]); o4.z = cvtpk_s(ov[4], ov[5]); o4.w = cvtpk_s(ov[6], ov[7]);
            qr[4 + dd] = __builtin_bit_cast(bf16x8, o4);
        }
    }
    float mhat = 0.f, l_reg = 0.f; f32x16 o[2]; o[0] = f32x16{}; o[1] = f32x16{}; f32x16 negm = f32x16{};
    bool first = true;
    const int qrow = tq >> 6, qc = tq & 63;
    const int wrow = __builtin_amdgcn_readfirstlane(qrow);
    const int rs = min(max(wrow - 4, 0), 120);
    const int cs = min(max(qc - 8, 0), 48);
    unsigned co[32];
    if (MODE == 1) {
#pragma unroll
        for (int r = 0; r < 16; ++r) { const int kc = crow(r, hi), kc1 = kc + 32;
            co[r] = (((unsigned)(kc - cs) < 16u) ? (unsigned)(kc - qc + 15) : 31u) * 4u; co[16 + r] = (((unsigned)(kc1 - cs) < 16u) ? (unsigned)(kc1 - qc + 15) : 31u) * 4u; }
    }
    const unsigned tb_addr = (unsigned)(uintptr_t)(shm + L_RPB);
#define LDS_RD128(dst, addr, off) asm volatile("ds_read_b128 %0, %1 offset:%c2" : "=&v"(dst) : "v"(addr), "i"(off) : "memory")
#define LDS_RDTR(dst, addr, off) asm volatile("ds_read_b64_tr_b16 %0, %1 offset:%c2" : "=v"(dst) : "v"(addr), "i"(off) : "memory")
#define ATT_KRD(KOFF) do { const unsigned ka_ = kaddr0 + (unsigned)(KOFF); \
        _Pragma("unroll") for (int d0 = 0; d0 < ND; ++d0) { LDS_RD128(kf[2 * d0], ka_, d0 * 2048); LDS_RD128(kf[2 * d0 + 1], ka_, d0 * 2048 + 512); } } while (0)
#define ATT_KW2(N, A, B) asm volatile("s_waitcnt lgkmcnt(" #N ")" : "+v"(A), "+v"(B) :: "memory")
#define ATT_QK2(P0, P1, d0) do { if ((d0) == 0) { P0 = __builtin_amdgcn_mfma_f32_32x32x16_bf16(kf[0], qr[0], negm, 0, 0, 0); P1 = __builtin_amdgcn_mfma_f32_32x32x16_bf16(kf[1], qr[0], negm, 0, 0, 0); } \
            else { P0 = __builtin_amdgcn_mfma_f32_32x32x16_bf16(kf[2 * (d0)], qr[d0], P0, 0, 0, 0); P1 = __builtin_amdgcn_mfma_f32_32x32x16_bf16(kf[2 * (d0) + 1], qr[d0], P1, 0, 0, 0); } } while (0)
#define ATT_QKM(P0, P1) do { if constexpr (ND == 4) { \
            ATT_KW2(6, kf[0], kf[1]); ATT_QK2(P0, P1, 0); ATT_KW2(4, kf[2], kf[3]); ATT_QK2(P0, P1, 1); ATT_KW2(2, kf[4], kf[5]); ATT_QK2(P0, P1, 2); ATT_KW2(0, kf[6], kf[7]); ATT_QK2(P0, P1, 3); } \
        else { ATT_KW2(10, kf[0], kf[1]); ATT_QK2(P0, P1, 0); ATT_KW2(8, kf[2], kf[3]); ATT_QK2(P0, P1, 1); ATT_KW2(6, kf[4], kf[5]); ATT_QK2(P0, P1, 2); ATT_KW2(4, kf[6], kf[7]); ATT_QK2(P0, P1, 3); \
               ATT_KW2(2, kf[8 % (2 * ND)], kf[9 % (2 * ND)]); ATT_QK2(P0, P1, 4 % ND); ATT_KW2(0, kf[10 % (2 * ND)], kf[11 % (2 * ND)]); ATT_QK2(P0, P1, 5 % ND); } } while (0)
#define ATT_VRD(VOFF) do { const unsigned va_ = vaddr0 + (unsigned)(VOFF); \
        _Pragma("unroll") for (int kg = 0; kg < 4; ++kg) _Pragma("unroll") for (int dh = 0; dh < 2; ++dh) { \
            LDS_RDTR(vf[(kg * 2 + dh) * 2], va_, dh * 4096 + kg * 1024); LDS_RDTR(vf[(kg * 2 + dh) * 2 + 1], va_, dh * 4096 + kg * 1024 + 512); } } while (0)
#define ATT_VWAIT() asm volatile("s_waitcnt lgkmcnt(0)" : "+v"(vf[0]), "+v"(vf[1]), "+v"(vf[2]), "+v"(vf[3]), "+v"(vf[4]), "+v"(vf[5]), "+v"(vf[6]), "+v"(vf[7]), "+v"(vf[8]), "+v"(vf[9]), "+v"(vf[10]), "+v"(vf[11]), "+v"(vf[12]), "+v"(vf[13]), "+v"(vf[14]), "+v"(vf[15]) :: "memory")
#define ATT_VF(kg, dh) ((bf16x8){vf[((kg) * 2 + (dh)) * 2][0], vf[((kg) * 2 + (dh)) * 2][1], vf[((kg) * 2 + (dh)) * 2][2], vf[((kg) * 2 + (dh)) * 2][3], vf[((kg) * 2 + (dh)) * 2 + 1][0], vf[((kg) * 2 + (dh)) * 2 + 1][1], vf[((kg) * 2 + (dh)) * 2 + 1][2], vf[((kg) * 2 + (dh)) * 2 + 1][3]})
#define ATT_ACTIVE(t) ((MODE == 0) || ((t) >= rs && (t) <= rs + 7))
    const unsigned kaddr0 = (unsigned)(uintptr_t)(shm + L_K) + hi * 1024 + r32 * 16;
    const unsigned vaddr0 = (unsigned)(uintptr_t)(shm + L_V) + ((lane >> 4) & 1) * 32 + (lane & 3) * 8 + (4 * hi + ((lane & 15) >> 2)) * 64;
    bf16x8 kf[2 * ND]; s16x4 vf[16];
    f32x16 p0 = f32x16{}, p1 = f32x16{};
    ATT_WAITBAR();
    for (int t = tlo; t <= thi; ++t) {
        const int buf = (t - tlo) & 3;
        if (t + 3 <= thi) { ATT_ISSUE_K(t + 3, ((buf + 3) & 3) * KSLOT); ATT_ISSUE_V(t + 3, ((buf + 3) & 3) * VSLOT); }
        const bool act = ATT_ACTIVE(t);
        if (act) { ATT_KRD(buf * KSLOT); ATT_QKM(p0, p1); if (MODE == 0) ATT_VRD(buf * VSLOT); }
        __builtin_amdgcn_sched_barrier(0);
        if (act) {
            if (MODE == 1) {
                const unsigned ra = tb_addr + (unsigned)(t - wrow + 7) * 128u;
                float bb[32];
#define NA_RD(k) do { _Pragma("unroll") for (int e = 8 * (k); e < 8 * (k) + 8; ++e) asm volatile("ds_read_b32 %0, %1" : "=v"(bb[e]) : "v"(co[e] + ra) : "memory"); } while (0)
#define NA_WAIT(N, k) asm volatile("s_waitcnt lgkmcnt(" #N ")" : "+v"(bb[8 * (k)]), "+v"(bb[8 * (k) + 1]), "+v"(bb[8 * (k) + 2]), "+v"(bb[8 * (k) + 3]), "+v"(bb[8 * (k) + 4]), "+v"(bb[8 * (k) + 5]), "+v"(bb[8 * (k) + 6]), "+v"(bb[8 * (k) + 7]) :: "memory")
                NA_RD(0); NA_RD(1); NA_WAIT(8, 0);
#pragma unroll
                for (int e = 0; e < 8; ++e) p0[e] += bb[e];
                NA_RD(2); NA_WAIT(8, 1);
#pragma unroll
                for (int e = 8; e < 16; ++e) p0[e] += bb[e];
                NA_RD(3); NA_WAIT(8, 2);
#pragma unroll
                for (int e = 0; e < 8; ++e) p1[e] += bb[16 + e];
                NA_WAIT(0, 3);
#pragma unroll
                for (int e = 8; e < 16; ++e) p1[e] += bb[16 + e];
#undef NA_RD
#undef NA_WAIT
                ATT_VRD(buf * VSLOT);
            }
            float rm0 = fmaxf(fmaxf(p0[0], p0[1]), p0[2]), rm1 = fmaxf(fmaxf(p1[0], p1[1]), p1[2]), rm2 = fmaxf(fmaxf(p0[3], p0[4]), p0[5]), rm3 = fmaxf(fmaxf(p1[3], p1[4]), p1[5]);
#pragma unroll
            for (int r = 6; r < 16; r += 2) { rm0 = fmaxf(fmaxf(rm0, p0[r]), p0[r + 1]); rm1 = fmaxf(fmaxf(rm1, p1[r]), p1[r + 1]); }
            float rm = fmaxf(fmaxf(rm0, rm1), fmaxf(rm2, rm3));
            rm = xhalf_max(rm);
            if (first || __any(rm > THR)) {
                const float dl = first ? rm : fmaxf(rm, 0.f);
                mhat += dl;
#pragma unroll
                for (int r = 0; r < 16; ++r) { p0[r] -= dl; p1[r] -= dl; negm[r] = -mhat; }
                if (!first) { const float f = exp2f(-dl); l_reg *= f; if (hi == 0) wsf[r32] = f;
#pragma unroll
                    for (int r = 0; r < 16; ++r) { const float fr_ = wsf[crow(r, hi)]; o[0][r] *= fr_; o[1][r] *= fr_; } }
                first = false;
            }
            u32x4 pw[4];
            float sa0 = 0.f, sa1 = 0.f, sa2 = 0.f, sa3 = 0.f;
#pragma unroll
            for (int r = 0; r < 16; r += 4) { p0[r] = __builtin_amdgcn_exp2f(p0[r]); p0[r + 1] = __builtin_amdgcn_exp2f(p0[r + 1]); p0[r + 2] = __builtin_amdgcn_exp2f(p0[r + 2]); p0[r + 3] = __builtin_amdgcn_exp2f(p0[r + 3]);
                sa0 += p0[r]; sa1 += p0[r + 1]; sa2 += p0[r + 2]; sa3 += p0[r + 3]; }
#pragma unroll
            for (int j = 0; j < 4; ++j) { pw[0][j] = cvtpk_s(p0[2 * j], p0[2 * j + 1]); pw[1][j] = cvtpk_s(p0[8 + 2 * j], p0[8 + 2 * j + 1]); }
            ATT_VWAIT();
#pragma unroll
            for (int kg = 0; kg < 2; ++kg)
#pragma unroll
                for (int dh = 0; dh < 2; ++dh) o[dh] = __builtin_amdgcn_mfma_f32_32x32x16_bf16(__builtin_bit_cast(bf16x8, pw[kg]), ATT_VF(kg, dh), o[dh], 0, 0, 0);
            __builtin_amdgcn_sched_barrier(0);
#pragma unroll
            for (int r = 0; r < 16; r += 4) { p1[r] = __builtin_amdgcn_exp2f(p1[r]); p1[r + 1] = __builtin_amdgcn_exp2f(p1[r + 1]); p1[r + 2] = __builtin_amdgcn_exp2f(p1[r + 2]); p1[r + 3] = __builtin_amdgcn_exp2f(p1[r + 3]);
                sa0 += p1[r]; sa1 += p1[r + 1]; sa2 += p1[r + 2]; sa3 += p1[r + 3]; }
            l_reg += (sa0 + sa1) + (sa2 + sa3);
#pragma unroll
            for (int j = 0; j < 4; ++j) { pw[2][j] = cvtpk_s(p1[2 * j], p1[2 * j + 1]); pw[3][j] = cvtpk_s(p1[8 + 2 * j], p1[8 + 2 * j + 1]); }
#pragma unroll
            for (int kg = 2; kg < 4; ++kg)
#pragma unroll
                for (int dh = 0; dh < 2; ++dh) o[dh] = __builtin_amdgcn_mfma_f32_32x32x16_bf16(__builtin_bit_cast(bf16x8, pw[kg]), ATT_VF(kg, dh), o[dh], 0, 0, 0);
        }
        if (t + 3 <= thi) { if constexpr (DQK == 96) asm volatile("s_waitcnt vmcnt(6) lgkmcnt(0)\n\ts_barrier" ::: "memory"); else asm volatile("s_waitcnt vmcnt(4) lgkmcnt(0)\n\ts_barrier" ::: "memory"); }
        else ATT_WAITBAR();
    }
#undef LDS_RD128
#undef LDS_RDTR
#undef ATT_KRD
#undef ATT_KW2
#undef ATT_QK2
#undef ATT_QKM
#undef ATT_VRD
#undef ATT_VWAIT
#undef ATT_VF
#undef ATT_QK
#undef ATT_ACTIVE
    if (has_next) {
        const bf16_t* nk0 = nx.K0 + (nx.rowbase + lane) * (long)nx.k0p + wid * 8;
        const bf16_t* nk1 = nx.K1 + (nx.rowbase + lane) * (long)nx.k1p + (wid & 3) * 8;
        const bf16_t* nv = nx.V + (nx.rowbase + 16 * (wid & 3) + (lane >> 2)) * (long)nx.vp + (wid >> 2) * 32 + (lane & 3) * 8;
#pragma unroll
        for (int i = 0; i < 3; ++i) if (nx.tlo + i <= nx.thi) {
            dma16(nk0 + (long)(nx.tlo + i) * 64 * nx.k0p, shm + L_K + i * KSLOT + wid * 1024);
            if (nx.dqk == 96) dma16(nk1 + (long)(nx.tlo + i) * 64 * nx.k1p, shm + L_K + i * KSLOT + (8 + (wid & 3)) * 1024);
            dma16(nv + (long)(nx.tlo + i) * 64 * nx.vp, shm + L_V + i * VSLOT + wid * 1024); }
    }
    l_reg = xhalf_sum(l_reg);
    if (hi == 0) wsf[32 + r32] = l_reg;
    float rli[16];
#pragma unroll
    for (int r = 0; r < 16; ++r) rli[r] = 1.0f / wsf[32 + crow(r, hi)];
    bf16_t* Ow = d.O + (rowbase + q0 + wid * 32) * (long)d.op;
    { ALAS bf16_t* stg = (ALAS bf16_t*)(shm + L_OST) + wid * 2048;
#pragma unroll
      for (int r = 0; r < 16; ++r) { const int orow = crow(r, hi);
#pragma unroll
          for (int dh = 0; dh < 2; ++dh) stg[orow * 64 + dh * 32 + r32] = (bf16_t)(cvtpk_s(o[dh][r] * rli[r], 0.f) & 0xffffu); }
      asm volatile("s_waitcnt lgkmcnt(0)" ::: "memory");
#pragma unroll
      for (int i = 0; i < 4; ++i) { const int row = i * 8 + (lane >> 3), ch = lane & 7; const u32x4 v = *(const ALAS u32x4*)(stg + row * 64 + ch * 8); *(u32x4*)(Ow + (long)row * d.op + ch * 8) = v; } }
    asm volatile("s_waitcnt lgkmcnt(0)\n\ts_barrier" ::: "memory");
#undef ATT_ISSUE_K
#undef ATT_ISSUE_V
#undef ATT_WAITBAR
}
}

constexpr int NWAVES = 8;
constexpr int M = 32768, D = 1024, SEQ = 8192, NB = 4, FF = 4096, NIN = 1440, NINP = 1536;
constexpr size_t MiB = 1u << 20;
constexpr size_t WS_PART = 2 * MiB;
constexpr size_t WS_WIN = 18 * MiB, WS_WUQ = 21 * MiB, WS_WUKV = 22 * MiB, WS_WO0 = 23 * MiB, WS_WUP0 = 25 * MiB, WS_WDN0 = 33 * MiB;
constexpr size_t WS_WQKV = 41 * MiB, WS_WO1 = 47 * MiB, WS_WUP1 = 49 * MiB, WS_WDN1 = 57 * MiB;
constexpr size_t WS_HB = 66 * MiB;
constexpr size_t WS_U = 130 * MiB;
constexpr size_t WS_Z = 130 * MiB, WS_MIX = 130 * MiB, WS_QA = 226 * MiB, WS_KA = 258 * MiB, WS_VA = 266 * MiB, WS_CQ = 274 * MiB, WS_CKV = 298 * MiB, WS_KR = 314 * MiB, WS_QB = 316 * MiB, WS_KVB = 386 * MiB;
constexpr size_t WS_QKV = 130 * MiB, WS_O1 = 322 * MiB;
constexpr size_t WS_END = 450 * MiB;
constexpr int LDS_BYTES = 135168;
static_assert(att::L_END <= 131072, "attention LDS");

#define LAS __attribute__((address_space(3)))
typedef unsigned short bf16;
typedef unsigned v4u __attribute__((ext_vector_type(4)));
typedef float f32x4 __attribute__((ext_vector_type(4)));
#define LDS_WAIT() asm volatile("s_waitcnt lgkmcnt(0)" ::: "memory")

__device__ __forceinline__ float wave_sum(float v) {
#pragma unroll
    for (int o = 1; o < 64; o <<= 1) v += __shfl_xor(v, o);
    return v;
}
__device__ __forceinline__ unsigned pk2(float lo, float hi) { return pg8::cvt_pk_bf16(lo, hi); }
__device__ __forceinline__ void transpose_item(const float* W, const float* gain, int K, int N, bf16* WT, LAS float* scr, int item, int lane) {
    const int nblk = N / 32, kb = item / nblk, nb = item % nblk, k0 = 64 * kb, n0 = 32 * nb;
#pragma unroll 8
    for (int i = 0; i < 32; ++i) { const int kk = 2 * i + (lane >> 5); const float g = gain ? gain[k0 + kk] : 1.f; scr[kk * 33 + (lane & 31)] = W[(size_t)(k0 + kk) * N + n0 + (lane & 31)] * g; }
    LDS_WAIT(); asm volatile("" ::: "memory");
    const int c = lane & 7;
#pragma unroll
    for (int j = 0; j < 4; ++j) { const int n = (lane >> 3) + 8 * j; const LAS float* s = scr + (8 * c) * 33 + n;
        v4u o; o.x = pk2(s[0 * 33], s[1 * 33]); o.y = pk2(s[2 * 33], s[3 * 33]); o.z = pk2(s[4 * 33], s[5 * 33]); o.w = pk2(s[6 * 33], s[7 * 33]);
        *(v4u*)(WT + (size_t)(n0 + n) * K + k0 + 8 * c) = o; }
    LDS_WAIT(); asm volatile("" ::: "memory");
}

#define XB_TMO      128
#define XB_XCNT(j)  (256  + 64 * (j))
#define XB_XSUB(j)  (1280 + 64 * (j))
#define XB_XGEN(j)  (2304 + 64 * (j))
#define XB_TOP      3328
#define XB_TOPGEN   3392
#define XCD_BAR_WORDS 3456
#define XB_SPIN_CAP (1u << 18)

__device__ __forceinline__ unsigned xb_ld(unsigned* p)              { return __hip_atomic_load(p, __ATOMIC_RELAXED, __HIP_MEMORY_SCOPE_AGENT); }
__device__ __forceinline__ unsigned xb_add(unsigned* p, unsigned v) { return __hip_atomic_fetch_add(p, v, __ATOMIC_RELAXED, __HIP_MEMORY_SCOPE_AGENT); }
__device__ __forceinline__ unsigned xb_xcc_id() { return (unsigned)__builtin_amdgcn_s_getreg((3 << 11) | 20) & 0xFu; }
#define XB_SPIN(cond, bar) do { unsigned _sp = 0; while (cond) { __builtin_amdgcn_s_sleep(1); \
    if ((++_sp & 255u) == 0u) { if (xb_ld(&(bar)[XB_TMO])) break; if (_sp > XB_SPIN_CAP) { atomicAdd(&(bar)[XB_TMO], 1u); break; } } } } while (0)

struct XcdBarrier {
    unsigned* bar; unsigned x;
    volatile LAS unsigned* st;
};

__device__ __forceinline__ XcdBarrier xcd_barrier_post(unsigned* bar, volatile LAS unsigned* st) {
    XcdBarrier b; b.bar = bar; b.x = xb_xcc_id(); b.st = st;
    if (threadIdx.x == 0) (void)xb_add(&bar[XB_XCNT(b.x)], 1u);
    return b;
}
__device__ __forceinline__ void xcd_barrier_complete(unsigned* bar, unsigned x, unsigned& nloc, unsigned& nx) {
    const unsigned G = gridDim.x * gridDim.y * gridDim.z;
    unsigned sum, cnt, mine, sp = 0u;
    for (;;) {
        sum = 0u; cnt = 0u; mine = 0u;
#pragma unroll
        for (unsigned j = 0; j < 16; ++j) { const unsigned c = xb_ld(&bar[XB_XCNT(j)]); sum += c; cnt += (c > 0u) ? 1u : 0u; mine = (j == x) ? c : mine; }
        if (sum == G) break;
        __builtin_amdgcn_s_sleep(1);
        if ((++sp & 255u) == 0u) { if (xb_ld(&bar[XB_TMO])) break; if (sp > XB_SPIN_CAP) { atomicAdd(&bar[XB_TMO], 1u); break; } }
    }
    nloc = mine > 0u ? mine : 1u; nx = cnt > 0u ? cnt : 1u;
}

__device__ __forceinline__ void xcd_barrier(const XcdBarrier& b) {
    asm volatile("s_waitcnt vmcnt(0)" ::: "memory");
    __syncthreads();
    if (threadIdx.x == 0) {
        unsigned* bar = b.bar;
        __builtin_amdgcn_s_waitcnt(0);
        unsigned nloc = b.st[0], nx = b.st[1];
        if (nloc == 0u) { xcd_barrier_complete(bar, b.x, nloc, nx); b.st[0] = nloc; b.st[1] = nx; }
        const unsigned old = xb_add(&bar[XB_XSUB(b.x)], 1u);
        const unsigned gen = old / nloc;
        if (old + 1u == (gen + 1u) * nloc) {
            __builtin_amdgcn_fence(__ATOMIC_RELEASE, "agent");
            asm volatile("s_waitcnt vmcnt(0)" ::: "memory");
            const unsigned og = xb_add(&bar[XB_TOP], 1u);
            const unsigned tg = og / nx;
            if (og + 1u == (tg + 1u) * nx) xb_add(&bar[XB_TOPGEN], 1u);
            else XB_SPIN(xb_ld(&bar[XB_TOPGEN]) == tg, bar);
            __builtin_amdgcn_fence(__ATOMIC_ACQUIRE, "agent");
            xb_add(&bar[XB_XGEN(b.x)], 1u);
            asm volatile("s_waitcnt vmcnt(0)" ::: "memory");
        } else {
            XB_SPIN(xb_ld(&bar[XB_XGEN(b.x)]) == gen, bar);
            __builtin_amdgcn_fence(__ATOMIC_ACQUIRE, "agent");
            asm volatile("s_waitcnt vmcnt(0)" ::: "memory");
        }
    }
    __syncthreads();
}

struct Args { const float* in[17]; float* out; unsigned char* ws; int ph_lo, ph_hi; };

__device__ __forceinline__ void ld8(const bf16* p, float (&v)[8]) { const v4u w = *(const v4u*)p;
#pragma unroll
    for (int j = 0; j < 4; ++j) { v[2 * j] = __uint_as_float(w[j] << 16); v[2 * j + 1] = __uint_as_float(w[j] & 0xffff0000u); } }
__device__ __forceinline__ void st8(bf16* p, const float (&v)[8]) { v4u o; o.x = pk2(v[0], v[1]); o.y = pk2(v[2], v[3]); o.z = pk2(v[4], v[5]); o.w = pk2(v[6], v[7]); *(v4u*)p = o; }

__device__ __forceinline__ void head_norm_rope(float (&v)[8], const float* gain, int j, float prow, float pcol, float scale) {
    float ss = 0.f;
#pragma unroll
    for (int e = 0; e < 8; ++e) ss += v[e] * v[e];
    ss += __shfl_xor(ss, 1); ss += __shfl_xor(ss, 2); ss += __shfl_xor(ss, 4);
    const float rstd = 1.0f / sqrtf(ss * (1.0f / 64.0f) + pg8::NORM_EPS);
    const float pos = (j < 4) ? prow : pcol;
#pragma unroll
    for (int e = 0; e < 8; ++e) {
        const float y = v[e] * rstd * gain[j * 8 + e]; const float py = __shfl_xor(y, 2);
        const int i = (j & 1) * 8 + e; const float inv = exp2f(-(float)i * (13.287712379549449f / 16.0f)); float s, c; att::sincos_acc(pos * inv, s, c);
        v[e] = (((j & 2) == 0) ? y * c - py * s : y * c + py * s) * scale;
    }
}

__global__ void __launch_bounds__(NWAVES * 64, 2) fwd_kernel(Args args) {
    extern __shared__ __attribute__((aligned(16))) unsigned char lds[];
    cg::grid_group grid = cg::this_grid();
    LAS unsigned char* L = (LAS unsigned char*)lds;
    const int tid = threadIdx.x, lane = tid & 63, wave = __builtin_amdgcn_readfirstlane(tid >> 6);
    const int G = gridDim.x; const int bx = blockIdx.x;
    const int vcu = (G % 8 == 0) ? (bx % 8) * (G / 8) + bx / 8 : bx;
    const int gw = vcu * NWAVES + wave, NGW = G * NWAVES;
    unsigned char* ws = args.ws;
    const float* x = args.in[0]; float* out = args.out;
    float* PART = (float*)(ws + WS_PART);
#define PARTN(k) (PART + (size_t)(k) * M * 16)
    bf16 *HB = (bf16*)(ws + WS_HB), *U = (bf16*)(ws + WS_U), *Z = (bf16*)(ws + WS_Z), *MIX = (bf16*)(ws + WS_MIX);
    bf16 *QA = (bf16*)(ws + WS_QA), *KA = (bf16*)(ws + WS_KA), *VA = (bf16*)(ws + WS_VA), *CQ = (bf16*)(ws + WS_CQ), *CKV = (bf16*)(ws + WS_CKV), *KR = (bf16*)(ws + WS_KR);
    bf16 *QB = (bf16*)(ws + WS_QB), *KVB = (bf16*)(ws + WS_KVB), *QKV = (bf16*)(ws + WS_QKV), *O1 = (bf16*)(ws + WS_O1);
    bf16 *WIN = (bf16*)(ws + WS_WIN), *WUQ = (bf16*)(ws + WS_WUQ), *WUKV = (bf16*)(ws + WS_WUKV), *WO0 = (bf16*)(ws + WS_WO0), *WUP0 = (bf16*)(ws + WS_WUP0), *WDN0 = (bf16*)(ws + WS_WDN0);
    bf16 *WQKV = (bf16*)(ws + WS_WQKV), *WO1 = (bf16*)(ws + WS_WO1), *WUP1 = (bf16*)(ws + WS_WUP1), *WDN1 = (bf16*)(ws + WS_WDN1);
    const int lo = args.ph_lo, hi = args.ph_hi;
    volatile LAS unsigned* MISC = (volatile LAS unsigned*)(L + 131072);
    if (tid < 2) MISC[tid] = 0u;
    __syncthreads();
    unsigned* BARW = (unsigned*)(ws + 8192);
    XcdBarrier xbar; xbar.bar = BARW; xbar.x = 0; xbar.st = MISC;
#ifndef PROBE_PHASE
#define PROBE_PHASE -1
#endif
#define IN(k) (lo <= (k) && (k) < hi)
#define REPS(k) ((PROBE_PHASE == (k)) ? 2 : 1)
#define SEAM(k) do { if (IN(k) && IN((k) + 1)) { if ((k) == 0) { grid.sync(); xbar = xcd_barrier_post(BARW, MISC); } else xcd_barrier(xbar); } } while (0)
    constexpr float C2A = 0.125f * att::LOG2E;
    constexpr float C2B = 0.10206207261596577f * att::LOG2E;

    if (IN(0)) {
        if (bx == 0) for (int i = tid; i < XCD_BAR_WORDS; i += NWAVES * 64) BARW[i] = 0u;
        LAS float* scr = (LAS float*)(L + wave * 16384);
        constexpr int I0 = 16 * 45, I1 = 6 * 24, I2 = 4 * 32, I3 = 16 * 32, I4 = 16 * 128, I5 = 64 * 32, I6 = 16 * 96, I7 = 16 * 32, I8 = I4, I9 = I5;
        constexpr int NITEMS = I0 + I1 + I2 + I3 + I4 + I5 + I6 + I7 + I8 + I9;
        for (int it = gw; it < NITEMS; it += NGW) {
            int r = it;
            if (r < I0) { transpose_item(args.in[2], args.in[1], D, NIN, WIN, scr, r, lane); continue; } r -= I0;
            if (r < I1) { transpose_item(args.in[6], args.in[5], 384, 768, WUQ, scr, r, lane); continue; } r -= I1;
            if (r < I2) { transpose_item(args.in[8], args.in[7], 256, 1024, WUKV, scr, r, lane); continue; } r -= I2;
            if (r < I3) { transpose_item(args.in[9], nullptr, D, D, WO0, scr, r, lane); continue; } r -= I3;
            if (r < I4) { transpose_item(args.in[14], args.in[13], D, FF, WUP0, scr, r, lane); continue; } r -= I4;
            if (r < I5) { transpose_item(args.in[15], nullptr, FF, D, WDN0, scr, r, lane); continue; } r -= I5;
            if (r < I6) { transpose_item(args.in[10], args.in[1] + D, D, 3 * D, WQKV, scr, r, lane); continue; } r -= I6;
            if (r < I7) { transpose_item(args.in[12], nullptr, D, D, WO1, scr, r, lane); continue; } r -= I7;
            if (r < I8) { transpose_item(args.in[14] + (size_t)D * FF, args.in[13] + D, D, FF, WUP1, scr, r, lane); continue; } r -= I8;
            transpose_item(args.in[15] + (size_t)FF * D, nullptr, FF, D, WDN1, scr, r, lane);
        }
        { v4u* p = (v4u*)(WIN + (size_t)NIN * D); const int n16 = (NINP - NIN) * D * 2 / 16; for (int i = bx * 512 + tid; i < n16; i += G * 512) p[i] = (v4u){0u, 0u, 0u, 0u}; }
        for (int m = gw; m < M; m += NGW) {
            const f32x4* xr = (const f32x4*)(x + (size_t)m * D) + lane; f32x4 v[4]; float s = 0.f;
#pragma unroll
            for (int j = 0; j < 4; ++j) { v[j] = xr[64 * j]; s += (v[j].x * v[j].x + v[j].y * v[j].y) + (v[j].z * v[j].z + v[j].w * v[j].w); }
            s = wave_sum(s);
            unsigned long long* o8 = (unsigned long long*)(HB + (size_t)m * D) + lane;
#pragma unroll
            for (int j = 0; j < 4; ++j) o8[64 * j] = (unsigned long long)pk2(v[j].x, v[j].y) | ((unsigned long long)pk2(v[j].z, v[j].w) << 32);
            if (lane < 16) PARTN(0)[(size_t)m * 16 + lane] = (lane == 0) ? s : 0.f;
        }
    }
    SEAM(0);
    if (IN(1)) {
        pg8::Gemm g{HB, WIN, M, NINP, D}; pg8::StaticOrder S; S.init(M, NINP, G, bx); S.rep = REPS(1);
        pg8::EpiScale<0> E{Z, NINP, PARTN(0), 1.0f / D, 0, 1.f};
        pg8::gemm_phase<pg8::EpiScale<0>, pg8::StaticOrder, true, true>(L, g, S, E);
    }
    SEAM(1);
    if (IN(2)) {
        const float* gq = args.in[3]; const float* gk = args.in[4];
        for (int m = gw; m < M; m += NGW) {
            const bf16* zr = Z + (size_t)m * NINP; const int t = m & (SEQ - 1); const float prow = (float)(t >> 6), pcol = (float)(t & 63); const int j = lane & 7;
            float v1[8], v2[8], v3[8];
            ld8(zr + lane * 8, v1); ld8(zr + 512 + lane * 8, v2); ld8(zr + 1024 + lane * 8, v3);
            float ss2 = 0.f, ss3 = 0.f;
#pragma unroll
            for (int e = 0; e < 8; ++e) { ss2 += v2[e] * v2[e]; ss3 += v3[e] * v3[e]; }
            const float s_cq = wave_sum((lane >= 32 ? ss2 : 0.f) + (lane < 16 ? ss3 : 0.f));
            const float s_ckv = wave_sum((lane >= 16 && lane < 48) ? ss3 : 0.f);
            const float r_cq = 1.0f / sqrtf(s_cq * (1.0f / 384.0f) + pg8::NORM_EPS), r_ckv = 1.0f / sqrtf(s_ckv * (1.0f / 256.0f) + pg8::NORM_EPS);
            head_norm_rope(v1, gq, j, prow, pcol, C2A);
            st8(QA + (size_t)m * 512 + lane * 8, v1);
            float k2[8];
#pragma unroll
            for (int e = 0; e < 8; ++e) k2[e] = v2[e];
            head_norm_rope(k2, gk, j, prow, pcol, 1.f);
            float kr8[8];
            { const int jj = lane & 3; const float pos = (jj < 2) ? prow : pcol;
#pragma unroll
              for (int e = 0; e < 8; ++e) { const float y = v3[e], py = __shfl_xor(y, 1); const float inv = exp2f(-(float)e * (13.287712379549449f / 8.0f)); float s, c; att::sincos_acc(pos * inv, s, c);
                  kr8[e] = ((jj & 1) == 0) ? y * c - py * s : y * c + py * s; } }
            if (lane < 16) st8(KA + (size_t)m * 128 + lane * 8, k2);
            else if (lane < 32) st8(VA + (size_t)m * 128 + (lane - 16) * 8, v2);
            else { float c8[8];
#pragma unroll
                for (int e = 0; e < 8; ++e) c8[e] = v2[e] * r_cq;
                st8(CQ + (size_t)m * 384 + (lane - 32) * 8, c8); }
            if (lane < 16) { float c8[8];
#pragma unroll
                for (int e = 0; e < 8; ++e) c8[e] = v3[e] * r_cq;
                st8(CQ + (size_t)m * 384 + 256 + lane * 8, c8); }
            else if (lane < 48) { float c8[8];
#pragma unroll
                for (int e = 0; e < 8; ++e) c8[e] = v3[e] * r_ckv;
                st8(CKV + (size_t)m * 256 + (lane - 16) * 8, c8); }
            else if (lane < 52) st8(KR + (size_t)m * 32 + (lane - 48) * 8, kr8);
        }
    }
    SEAM(2);
    if (IN(3)) {
        { pg8::Gemm g{CQ, WUQ, M, 768, 384}; pg8::StaticOrder S; S.init(M, 768, G, bx);
          pg8::EpiScale<0> E{QB, 768, nullptr, 0.f, 3, C2B};
          pg8::gemm_phase<pg8::EpiScale<0>, pg8::StaticOrder, true, true>(L, g, S, E); }
        { pg8::Gemm g{CKV, WUKV, M, 1024, 256}; pg8::StaticOrder S; S.init(M, 1024, G, bx);
          pg8::EpiScale<0> E{KVB, 1024, nullptr, 0.f, 0, 1.f};
          pg8::gemm_phase<pg8::EpiScale<0>, pg8::StaticOrder, true, true>(L, g, S, E); }
    }
    SEAM(3);
    if (IN(4)) {
        for (int uu = vcu; uu < 2048 * REPS(4); uu += G) { const int u = uu & 2047;
            const int pair = u >> 5, qb = u & 31; const int typ = (pair >> 3) & 1; const int idx = (pair >> 4) * 8 + (pair & 7); const int b = idx >> 3, h = idx & 7;
            const long rowbase = (long)b * SEQ;
            const bool has_next = (uu + G) < 2048 * REPS(4); const int un = (uu + G) & 2047; const int pairn = un >> 5; const int typn = (pairn >> 3) & 1; const int idxn = (pairn >> 4) * 8 + (pairn & 7); const int bn = idxn >> 3, hn = idxn & 7;
            att::Next nx;
            if (typn == 0) nx = att::Next{KA + (hn >> 2) * 64, KR, VA + (hn >> 2) * 64, 128, 32, 128, (long)bn * SEQ, 0, SEQ / 64 - 1, 64};
            else nx = att::Next{KVB + hn * 128, KR, KVB + hn * 128 + 64, 1024, 32, 1024, (long)bn * SEQ, 0, SEQ / 64 - 1, 96};
            if (typ == 0) { att::Desc d{QA + h * 64, nullptr, KA + (h >> 2) * 64, nullptr, VA + (h >> 2) * 64, MIX + h * 64, 512, 0, 128, 0, 128, 1024};
                att::unit<64, 0>(d, rowbase, qb * 256, 0, SEQ / 64 - 1, nullptr, L, uu != vcu, has_next, nx); }
            else { att::Desc d{QB + h * 96, QB + h * 96 + 64, KVB + h * 128, KR, KVB + h * 128 + 64, MIX + 512 + h * 64, 768, 768, 1024, 32, 1024, 1024};
                att::unit<96, 0>(d, rowbase, qb * 256, 0, SEQ / 64 - 1, nullptr, L, uu != vcu, has_next, nx); }
        }
    }
    SEAM(4);
    if (IN(5)) {
        pg8::Gemm g{MIX, WO0, M, D, D}; pg8::StaticOrder S; S.init(M, D, G, bx); S.rep = REPS(5);
        pg8::EpiRes E{x, out, HB, PARTN(1), D};
        pg8::gemm_phase<pg8::EpiRes, pg8::StaticOrder, true, true>(L, g, S, E);
    }
    SEAM(5);
    if (IN(6)) {
        pg8::Gemm g{HB, WUP0, M, FF, D}; pg8::StaticOrder S; S.init(M, FF, G, bx); S.rep = REPS(6);
        pg8::EpiScale<1> E{U, FF, PARTN(1), 1.0f / D, 0, 1.f};
        pg8::gemm_phase<pg8::EpiScale<1>, pg8::StaticOrder, true, true>(L, g, S, E);
    }
    SEAM(6);
    if (IN(7)) {
        pg8::Gemm g{U, WDN0, M, D, FF}; pg8::StaticOrder S; S.init(M, D, G, bx);
        pg8::EpiRes E{out, out, HB, PARTN(2), D};
        pg8::gemm_phase<pg8::EpiRes, pg8::StaticOrder, true, true>(L, g, S, E);
    }
    SEAM(7);
    if (IN(8)) {
        pg8::Gemm g{HB, WQKV, M, 3 * D, D}; pg8::StaticOrder S; S.init(M, 3 * D, G, bx); S.rep = REPS(8);
        pg8::EpiScale<0> E{QKV, 3 * D, PARTN(2), 1.0f / D, 4, C2A, M};
        pg8::gemm_phase<pg8::EpiScale<0>, pg8::StaticOrder, true, true>(L, g, S, E);
    }
    SEAM(8);
    if (IN(9)) {
        for (int uu = vcu; uu < 2048 * REPS(9); uu += G) { const int u = uu & 2047;
            const int pair = u >> 5, qb = u & 31; const int b = pair >> 4, h = pair & 15;
            const int R0 = qb * 4; const int tlo = min(max(R0 - 4, 0), 120), thi = min(max(R0 + 3 - 4, 0), 120) + 7;
            att::Desc d{QKV + (size_t)h * M * 64, nullptr, QKV + (size_t)(16 + h) * M * 64, nullptr, QKV + (size_t)(32 + h) * M * 64, O1 + h * 64, 64, 0, 64, 0, 64, D};
            const bool has_next = (uu + G) < 2048 * REPS(9); const int un = (uu + G) & 2047; const int pairn = un >> 5, qbn = un & 31; const int bn = pairn >> 4, hn = pairn & 15;
            const int R0n = qbn * 4; const int tlon = min(max(R0n - 4, 0), 120), thin = min(max(R0n + 3 - 4, 0), 120) + 7;
            const att::Next nx{QKV + (size_t)(16 + hn) * M * 64, KR, QKV + (size_t)(32 + hn) * M * 64, 64, 32, 64, (long)bn * SEQ, tlon, thin, 64};
            att::unit<64, 1>(d, (long)b * SEQ, qb * 256, tlo, thi, args.in[11] + h * 465, L, uu != vcu, has_next, nx);
        }
    }
    SEAM(9);
    if (IN(10)) {
        pg8::Gemm g{O1, WO1, M, D, D}; pg8::StaticOrder S; S.init(M, D, G, bx);
        pg8::EpiRes E{out, out, HB, PARTN(3), D};
        pg8::gemm_phase<pg8::EpiRes, pg8::StaticOrder, true, true>(L, g, S, E);
    }
    SEAM(10);
    if (IN(11)) {
        pg8::Gemm g{HB, WUP1, M, FF, D}; pg8::StaticOrder S; S.init(M, FF, G, bx);
        pg8::EpiScale<1> E{U, FF, PARTN(3), 1.0f / D, 0, 1.f};
        pg8::gemm_phase<pg8::EpiScale<1>, pg8::StaticOrder, true, true>(L, g, S, E);
    }
    SEAM(11);
    if (IN(12)) {
        pg8::Gemm g{U, WDN1, M, D, FF}; pg8::StaticOrder S; S.init(M, D, G, bx);
        pg8::EpiRes E{out, out, HB, PARTN(4), D};
        pg8::gemm_phase<pg8::EpiRes, pg8::StaticOrder, true, true>(L, g, S, E);
    }
    SEAM(12);
    if (IN(13)) {
        const float* gf = args.in[16];
        for (int m = gw; m < M; m += NGW) {
            f32x4* xr = (f32x4*)(out + (size_t)m * D) + lane; const f32x4* pp = (const f32x4*)(PARTN(4) + (size_t)m * 16);
            const f32x4 a = pp[0], b = pp[1], c = pp[2], d4 = pp[3];
            const float s = ((a[0] + a[1]) + (a[2] + a[3])) + ((b[0] + b[1]) + (b[2] + b[3])) + ((c[0] + c[1]) + (c[2] + c[3])) + ((d4[0] + d4[1]) + (d4[2] + d4[3]));
            const float rstd = 1.0f / sqrtf(s * (1.0f / D) + pg8::NORM_EPS);
#pragma unroll
            for (int j = 0; j < 4; ++j) { const f32x4 v = xr[64 * j]; const f32x4 gg = ((const f32x4*)gf)[lane + 64 * j]; xr[64 * j] = v * rstd * gg; }
        }
    }
#undef IN
#undef SEAM
}

#ifndef MK_PER_PHASE
#define MK_PER_PHASE 0
#endif
extern "C" void kernel_launch(void* const* d_in, const int* in_sizes, int n_in, void* d_out, int out_size, void* d_ws, size_t ws_size, hipStream_t stream) {
    static int grid = 0;
    if (grid == 0) {
        if (n_in != 17 || in_sizes[0] != M * D || out_size != M * D || ws_size < WS_END) { fprintf(stderr, "kernel_launch: unexpected shapes / workspace (n_in %d, in0 %d, out %d, ws %zu)\n", n_in, n_in > 0 ? in_sizes[0] : -1, out_size, ws_size); grid = -1; return; }
        int dev = 0, cus = 0, per_cu = 0;
        if (hipGetDevice(&dev) != hipSuccess || hipDeviceGetAttribute(&cus, hipDeviceAttributeMultiprocessorCount, dev) != hipSuccess) { grid = -1; return; }
        if (hipFuncSetAttribute((const void*)fwd_kernel, hipFuncAttributeMaxDynamicSharedMemorySize, LDS_BYTES) != hipSuccess) { fprintf(stderr, "kernel_launch: hipFuncSetAttribute failed\n"); grid = -1; return; }
        if (hipOccupancyMaxActiveBlocksPerMultiprocessor(&per_cu, (const void*)fwd_kernel, NWAVES * 64, LDS_BYTES) != hipSuccess || per_cu < 1) { fprintf(stderr, "kernel_launch: occupancy query says %d\n", per_cu); per_cu = 1; }
        (void)hipGetLastError();
        grid = cus * per_cu;
        fprintf(stderr, "kernel_launch: grid %d (cus %d x %d)\n", grid, cus, per_cu);
    }
    if (grid < 0) return;
    Args a{};
    for (int i = 0; i < 17; ++i) a.in[i] = (const float*)d_in[i];
    a.out = (float*)d_out; a.ws = (unsigned char*)d_ws;
#if MK_PER_PHASE
    for (int p = 0; p < 14; ++p) { a.ph_lo = p; a.ph_hi = p + 1; hipLaunchKernelGGL(fwd_kernel, dim3(grid), dim3(NWAVES * 64), LDS_BYTES, stream, a); }
#else
    a.ph_lo = 0; a.ph_hi = 14;
    void* kargs[] = {&a};
    hipError_t e = hipLaunchCooperativeKernel((const void*)fwd_kernel, dim3(grid), dim3(NWAVES * 64), kargs, LDS_BYTES, stream);
    if (e != hipSuccess) fprintf(stderr, "cooperative launch failed: %s (grid %d)\n", hipGetErrorString(e), grid);
#endif
}
```

```cpp
#include <hip/hip_runtime.h>
#include <hip/hip_cooperative_groups.h>
#include <cstdio>
#include <cstdint>
#include <cmath>
namespace cg = cooperative_groups;
namespace pg8 {
#define PG8_LAS __attribute__((address_space(3)))
typedef unsigned short bf16_t;
typedef short bf16x8 __attribute__((ext_vector_type(8)));
typedef float f32x4 __attribute__((ext_vector_type(4)));
typedef unsigned u32x4 __attribute__((ext_vector_type(4)));
constexpr int BM = 256, BK = 64, HALF = 128, HTB = HALF * BK * 2  , STAGE_BYTES = 8 * HTB, NXCD = 8, WGM = 8;

__host__ __device__ __forceinline__ int lds_byte(int r, int c) { const int st = (r >> 4) * 2 + (c >> 5), rr = r & 15, cc = c & 31, ob = rr * 64 + cc * 2; return st * 1024 + (ob ^ (((ob >> 9) & 1) << 5)); }
__host__ __device__ __forceinline__ void stage_rc(int b, int& R, int& C) { const int st = b / 1024, sb = b % 1024, swz = sb ^ (((sb >> 9) & 1) << 5); R = (st >> 1) * 16 + swz / 64; C = (st & 1) * 32 + (swz % 64) / 2; }
__host__ __device__ __forceinline__ int perm32(int rho) { const int n = rho >> 4, i = rho & 15; return 8 * (i >> 2) + 4 * n + (i & 3); }

struct Unit { int pm, pn; };
struct Gemm { const bf16_t* A; const bf16_t* Bt; int M, N, K; };

struct StaticOrder {
    int nM, nN, nwg, G, c, rep = 1;
    __host__ __device__ void init(int M, int N, int G_, int c_) { nM = M / BM; nN = N / BM; nwg = nM * nN; G = G_; c = c_; }
    __host__ __device__ bool next(int i, Unit& u) const {
        const long L = (long)i * G + c; if (L >= (long)nwg * rep) return false;
        int wgid = (int)(L % nwg); { const int q = nwg / NXCD, r = nwg % NXCD, xcd = wgid % NXCD, off = wgid / NXCD; wgid = (xcd < r ? xcd * (q + 1) : r * (q + 1) + (xcd - r) * q) + off; }
        const int nig = WGM * nN, gid = wgid / nig, fm = gid * WGM, gsz = (nM - fm) < WGM ? (nM - fm) : WGM;
        u.pm = fm + ((wgid % nig) % gsz); u.pn = (wgid % nig) / gsz; return true;
    }
    __device__ __forceinline__ void a_ready(const Unit&) const {}
    __device__ __forceinline__ void done(const Unit&) const {}
};
__device__ __forceinline__ unsigned cvt_pk_bf16(float lo, float hi) { unsigned r; asm volatile("v_cvt_pk_bf16_f32 %0, %1, %2" : "=v"(r) : "v"(lo), "v"(hi)); return r; }
constexpr float NORM_EPS = 1e-6f;
template <int ACT> struct EpiScale {
    static constexpr bool PERM = true, AFTER_DRAIN = false;
    bf16_t* O; int ldc; const float* part; float inv_dim; int nq_tiles; float qscale; int hm = 0;
    __device__ __forceinline__ void operator()(const f32x4 (&acc)[2][2][4][2], const Unit& u, int wr, int wc, int fr, int fq) const {
        const int row0 = u.pm * BM + wr * 64 + fr; const int col0 = u.pn * BM + wc * 32 + 8 * fq;
        const float sc = (u.pn < nq_tiles) ? qscale : 1.f;
#pragma unroll
        for (int ai = 0; ai < 2; ++ai)
#pragma unroll
            for (int m = 0; m < 4; ++m) { const int row = row0 + ai * HALF + m * 16; float rs = 1.f;
                if (part) { const f32x4* pp = (const f32x4*)(part + (size_t)row * 16); const f32x4 a = pp[0], b = pp[1], c = pp[2], d = pp[3];
                    const float s = ((a[0] + a[1]) + (a[2] + a[3])) + ((b[0] + b[1]) + (b[2] + b[3])) + ((c[0] + c[1]) + (c[2] + c[3])) + ((d[0] + d[1]) + (d[2] + d[3]));
                    rs = 1.0f / sqrtf(s * inv_dim + NORM_EPS); }
                if (ACT == 0) rs *= sc;
                bf16_t* rowp = hm ? O + ((size_t)(col0 >> 6) * hm + row) * 64 + (col0 & 63) : O + (size_t)row * ldc + col0;
#pragma unroll
                for (int bj = 0; bj < 2; ++bj) { f32x4 v0 = acc[ai][bj][m][0] * rs, v1 = acc[ai][bj][m][1] * rs;
                    if (ACT == 1) {
#pragma unroll
                        for (int e = 0; e < 4; ++e) { float a = fmaxf(v0[e], 0.f), b = fmaxf(v1[e], 0.f); v0[e] = a * a; v1[e] = b * b; } }
                    u32x4 w; w.x = cvt_pk_bf16(v0[0], v0[1]); w.y = cvt_pk_bf16(v0[2], v0[3]); w.z = cvt_pk_bf16(v1[0], v1[1]); w.w = cvt_pk_bf16(v1[2], v1[3]);
                    *(u32x4*)(rowp + (hm ? (size_t)bj * 2 * hm * 64 : (size_t)(bj * HALF))) = w; } }
    }
};
struct EpiRes {
    static constexpr bool PERM = true, AFTER_DRAIN = false;
    const float* base; float* out; bf16_t* ob; float* part; int ldc;
    __device__ __forceinline__ void operator()(const f32x4 (&acc)[2][2][4][2], const Unit& u, int wr, int wc, int fr, int fq) const {
        const int row0 = u.pm * BM + wr * 64 + fr; const int col0 = u.pn * BM + wc * 32 + 8 * fq;
#pragma unroll
        for (int ai = 0; ai < 2; ++ai)
#pragma unroll
            for (int m = 0; m < 4; ++m) { const int row = row0 + ai * HALF + m * 16; const size_t off = (size_t)row * ldc + col0; float ss = 0.f;
#pragma unroll
                for (int bj = 0; bj < 2; ++bj) { const f32x4 b0 = *(const f32x4*)(base + off + bj * HALF), b1 = *(const f32x4*)(base + off + bj * HALF + 4);
                    const f32x4 v0 = acc[ai][bj][m][0] + b0, v1 = acc[ai][bj][m][1] + b1;
                    *(f32x4*)(out + off + bj * HALF) = v0; *(f32x4*)(out + off + bj * HALF + 4) = v1;
                    u32x4 w; w.x = cvt_pk_bf16(v0[0], v0[1]); w.y = cvt_pk_bf16(v0[2], v0[3]); w.z = cvt_pk_bf16(v1[0], v1[1]); w.w = cvt_pk_bf16(v1[2], v1[3]);
                    *(u32x4*)(ob + off + bj * HALF) = w;
                    ss += (v0[0] * v0[0] + v0[1] * v0[1]) + (v0[2] * v0[2] + v0[3] * v0[3]) + (v1[0] * v1[0] + v1[1] * v1[1]) + (v1[2] * v1[2] + v1[3] * v1[3]); }
                ss += __shfl_xor(ss, 16); ss += __shfl_xor(ss, 32);
                if (fq == 0) part[(size_t)row * 16 + u.pn * 4 + wc] = ss; }
    }
};

template <class Epi, class Sched, bool ALIGN_EPI = false, bool SP2 = false>
__device__ __forceinline__ void gemm_phase(PG8_LAS unsigned char* lds, const Gemm g, const Sched& S, const Epi& E) {
    const int tid = threadIdx.x, wid = __builtin_amdgcn_readfirstlane(tid >> 6), lane = tid & 63, wr = wid >> 2, wc = wid & 3, fr = lane & 15, fq = lane >> 4;
    const int K = g.K, nt = K / BK;
    unsigned voffA[2], voffB[2];
#pragma unroll
    for (int i = 0; i < 2; ++i) { int R, C; stage_rc(tid * 16 + i * 8192, R, C); const int Rb = Epi::PERM ? ((R & ~31) + perm32(R & 31)) : R;
        voffA[i] = (unsigned)(R * K + C) * 2u; voffB[i] = (unsigned)(Rb * K + C) * 2u; }
    const size_t kstep = (size_t)(BK * 2);
    const size_t hstep = (size_t)HALF * K * 2;
    const size_t tstep = 2 * hstep;
    const unsigned ldsw = (unsigned)wid * 1024u;
    const int aoff = lds_byte(wr * 64 + fr, fq * 8), boff = lds_byte(wc * 32 + fr, fq * 8);
#define PG8_SA(b, h) (((b) * 2 + (h)) * HTB)
#define PG8_SB(b, h) ((4 + (b) * 2 + (h)) * HTB)
#define PG8_STAGE(bufoff, gbase, voff) do { _Pragma("unroll") for (int _i = 0; _i < 2; ++_i) \
        __builtin_amdgcn_global_load_lds((const unsigned*)((const char*)(gbase) + (voff)[_i]), (PG8_LAS unsigned*)(lds + (bufoff) + ldsw + _i * 8192), 16, 0, 0); } while (0)
#define PG8_LDA(dst, b, h) do { _Pragma("unroll") for (int m = 0; m < 4; ++m) _Pragma("unroll") for (int k = 0; k < 2; ++k) dst[m][k] = *(const PG8_LAS bf16x8*)(lds + PG8_SA(b, h) + aoff + m * 2048 + k * 1024); } while (0)
#define PG8_LDB(dst, b, h) do { _Pragma("unroll") for (int n = 0; n < 2; ++n) _Pragma("unroll") for (int k = 0; k < 2; ++k) dst[n][k] = *(const PG8_LAS bf16x8*)(lds + PG8_SB(b, h) + boff + n * 2048 + k * 1024); } while (0)
#define PG8_MMA(ai, bj, At, Bt) do { __builtin_amdgcn_s_setprio(1); _Pragma("unroll") for (int m = 0; m < 4; ++m) _Pragma("unroll") for (int n = 0; n < 2; ++n) _Pragma("unroll") for (int k = 0; k < 2; ++k) \
        acc[ai][bj][m][n] = __builtin_amdgcn_mfma_f32_16x16x32_bf16(Bt[n][k], At[m][k], acc[ai][bj][m][n], 0, 0, 0); __builtin_amdgcn_s_setprio(0); } while (0)
#define PG8_WAIT_V(n) asm volatile("s_waitcnt vmcnt(" #n ")" ::: "memory")
#define PG8_WAIT_L(n) asm volatile("s_waitcnt lgkmcnt(" #n ")" ::: "memory")
#define PG8_BAR __builtin_amdgcn_s_barrier()
#define PG8_SCHED __builtin_amdgcn_sched_barrier(0)
    Unit cur, nxt; int ui = 0;
    if (!S.next(0, cur)) return;
    f32x4 acc[2][2][4][2];
#pragma unroll
    for (int a = 0; a < 2; ++a)
#pragma unroll
        for (int b = 0; b < 2; ++b)
#pragma unroll
            for (int m = 0; m < 4; ++m)
#pragma unroll
                for (int n = 0; n < 2; ++n) acc[a][b][m][n] = (f32x4){0.f, 0.f, 0.f, 0.f};
    bf16x8 At[4][2], B0[2][2], B1[2][2];
    const char* cA = (const char*)g.A + (size_t)cur.pm * tstep; const char* cB = (const char*)g.Bt + (size_t)cur.pn * tstep;
    S.a_ready(cur);
    if constexpr (SP2) {
        PG8_STAGE(PG8_SB(0, 0), cB, voffB); PG8_STAGE(PG8_SB(0, 1), cB + hstep, voffB); PG8_STAGE(PG8_SA(0, 0), cA, voffA); PG8_STAGE(PG8_SA(0, 1), cA + hstep, voffA);
        if (wr == 1) PG8_BAR;
        PG8_WAIT_V(2); PG8_BAR;
        PG8_STAGE(PG8_SB(1, 0), cB + kstep, voffB); PG8_STAGE(PG8_SA(1, 0), cA + kstep, voffA); PG8_STAGE(PG8_SB(1, 1), cB + hstep + kstep, voffB);
        PG8_WAIT_V(6); PG8_BAR;
    } else {
        PG8_STAGE(PG8_SB(0, 0), cB, voffB); PG8_STAGE(PG8_SA(0, 0), cA, voffA); PG8_STAGE(PG8_SB(0, 1), cB + hstep, voffB); PG8_STAGE(PG8_SA(0, 1), cA + hstep, voffA);
        if (wr == 1) PG8_BAR;
        PG8_WAIT_V(4); PG8_BAR;
        PG8_STAGE(PG8_SB(1, 0), cB + kstep, voffB); PG8_STAGE(PG8_SA(1, 0), cA + kstep, voffA); PG8_STAGE(PG8_SB(1, 1), cB + hstep + kstep, voffB);
        PG8_WAIT_V(6); PG8_BAR;
    }
    for (;;) {
        const bool has_next = S.next(ui + 1, nxt);
        const char* nA = has_next ? (const char*)g.A + (size_t)nxt.pm * tstep : cA; const char* nB = has_next ? (const char*)g.Bt + (size_t)nxt.pn * tstep : cB;
        for (int t = 0; t < nt; t += 2) {
            const bool last = (t == nt - 2);
            const char* a1 = cA + (size_t)(t + 1) * kstep;
            const char* a2 = last ? nA : cA + (size_t)(t + 2) * kstep; const char* b2 = last ? nB : cB + (size_t)(t + 2) * kstep;
            const char* a3 = a2 + kstep; const char* b3 = b2 + kstep;
            if (last && has_next) S.a_ready(nxt);
            if constexpr (SP2) {
            PG8_LDB(B0, 0, 0); PG8_LDB(B1, 0, 1); PG8_SCHED; PG8_LDA(At, 0, 0); PG8_STAGE(PG8_SA(1, 1), a1 + hstep, voffA);
            PG8_WAIT_V(8); PG8_WAIT_L(0); PG8_BAR; PG8_MMA(0, 0, At, B0); PG8_MMA(0, 1, At, B1); PG8_BAR; PG8_SCHED;
            PG8_LDA(At, 0, 1); PG8_STAGE(PG8_SB(0, 0), b2, voffB); PG8_STAGE(PG8_SB(0, 1), b2 + hstep, voffB); PG8_STAGE(PG8_SA(0, 0), a2, voffA);
            PG8_WAIT_V(8); PG8_WAIT_L(0); PG8_BAR; PG8_MMA(1, 0, At, B0); PG8_MMA(1, 1, At, B1); PG8_BAR; PG8_SCHED;
            PG8_LDB(B0, 1, 0); PG8_LDB(B1, 1, 1); PG8_SCHED; PG8_LDA(At, 1, 0); PG8_STAGE(PG8_SA(0, 1), a2 + hstep, voffA);
            PG8_WAIT_V(8); PG8_WAIT_L(0); PG8_BAR; PG8_MMA(0, 0, At, B0); PG8_MMA(0, 1, At, B1); PG8_BAR; PG8_SCHED;
            PG8_LDA(At, 1, 1); PG8_STAGE(PG8_SB(1, 0), b3, voffB); PG8_STAGE(PG8_SB(1, 1), b3 + hstep, voffB); PG8_STAGE(PG8_SA(1, 0), a3, voffA);
            PG8_WAIT_V(8); PG8_WAIT_L(0); PG8_BAR; PG8_MMA(1, 0, At, B0); PG8_MMA(1, 1, At, B1); PG8_BAR; PG8_SCHED;
            } else {
            PG8_LDB(B0, 0, 0); PG8_SCHED; PG8_LDA(At, 0, 0); PG8_STAGE(PG8_SA(1, 1), a1 + hstep, voffA);
            PG8_WAIT_L(8); PG8_BAR; PG8_WAIT_L(0); PG8_MMA(0, 0, At, B0); PG8_BAR; PG8_SCHED;
            PG8_LDB(B1, 0, 1); PG8_STAGE(PG8_SB(0, 0), b2, voffB);
            PG8_BAR; PG8_WAIT_L(0); PG8_MMA(0, 1, At, B1); PG8_BAR;
            PG8_LDA(At, 0, 1); PG8_STAGE(PG8_SA(0, 0), a2, voffA);
            PG8_BAR; PG8_WAIT_L(0); PG8_MMA(1, 0, At, B0); PG8_BAR; PG8_SCHED;
            PG8_STAGE(PG8_SB(0, 1), b2 + hstep, voffB);
            PG8_WAIT_V(6); PG8_BAR; PG8_MMA(1, 1, At, B1); PG8_BAR;
            PG8_LDB(B0, 1, 0); PG8_SCHED; PG8_LDA(At, 1, 0); PG8_STAGE(PG8_SA(0, 1), a2 + hstep, voffA);
            PG8_WAIT_L(8); PG8_BAR; PG8_WAIT_L(0); PG8_MMA(0, 0, At, B0); PG8_BAR; PG8_SCHED;
            PG8_LDB(B1, 1, 1); PG8_STAGE(PG8_SB(1, 0), b3, voffB);
            PG8_BAR; PG8_WAIT_L(0); PG8_MMA(0, 1, At, B1); PG8_BAR;
            PG8_LDA(At, 1, 1); PG8_STAGE(PG8_SA(1, 0), a3, voffA);
            PG8_BAR; PG8_WAIT_L(0); PG8_MMA(1, 0, At, B0); PG8_BAR; PG8_SCHED;
            PG8_STAGE(PG8_SB(1, 1), b3 + hstep, voffB);
            PG8_WAIT_V(6); PG8_BAR; PG8_MMA(1, 1, At, B1); PG8_BAR;
            }
        }
        if constexpr (ALIGN_EPI) { if (wr == 0) PG8_BAR; }
        if constexpr (!Epi::AFTER_DRAIN) { E(acc, cur, wr, wc, fr, fq); S.done(cur); }
        if (!has_next) break;
#pragma unroll
        for (int a = 0; a < 2; ++a)
#pragma unroll
            for (int b = 0; b < 2; ++b)
#pragma unroll
                for (int m = 0; m < 4; ++m)
#pragma unroll
                    for (int n = 0; n < 2; ++n) acc[a][b][m][n] = (f32x4){0.f, 0.f, 0.f, 0.f};
        cur = nxt; cA = nA; cB = nB; ++ui;
        if constexpr (ALIGN_EPI) { if (wr == 1) PG8_BAR; }
    }
    PG8_WAIT_V(0);
    if constexpr (!ALIGN_EPI) { if (wr == 0) PG8_BAR; }
    PG8_BAR;
    if constexpr (Epi::AFTER_DRAIN) { E.fused(acc, cur, wr, wc, fr, fq, lds, wid, lane); S.done(cur); }
#undef PG8_SA
#undef PG8_SB
#undef PG8_STAGE
#undef PG8_LDA
#undef PG8_LDB
#undef PG8_MMA
#undef PG8_WAIT_V
#undef PG8_WAIT_L
#undef PG8_BAR
#undef PG8_SCHED
}
}
namespace att {
using bf16x8 = __attribute__((ext_vector_type(8))) short;
using s16x4 = __attribute__((ext_vector_type(4))) short;
using f32x16 = __attribute__((ext_vector_type(16))) float;
using u32x4 = __attribute__((ext_vector_type(4))) unsigned;
typedef unsigned short bf16_t;
#define ALAS __attribute__((address_space(3)))
constexpr int KSLOT = 12288, VSLOT = 8192;
constexpr int NSLOT = 4;
constexpr int L_K = 0, L_V = NSLOT * KSLOT, L_WS = L_V + NSLOT * VSLOT, L_OST = L_WS + 8 * 64 * 4, L_RPB = L_OST + 8 * 4096, L_END = L_RPB + 2048;
constexpr float THR = 8.f;
constexpr float LOG2E = 1.4426950408889634f;
struct Desc { const bf16_t *Q0, *Q1, *K0, *K1, *V; bf16_t* O; int q0p, q1p, k0p, k1p, vp, op; };
struct Next { const bf16_t *K0, *K1, *V; int k0p, k1p, vp; long rowbase; int tlo, thi, dqk; };

__device__ __forceinline__ int crow(int r, int hi) { return (r & 3) + 8 * (r >> 2) + 4 * hi; }
typedef float f32x2_t __attribute__((ext_vector_type(2))); typedef __bf16 bf16x2_t __attribute__((ext_vector_type(2)));
__device__ __forceinline__ unsigned cvtpk_s(float lo, float hi) { f32x2_t v = {lo, hi}; bf16x2_t b = __builtin_convertvector(v, bf16x2_t); return __builtin_bit_cast(unsigned, b); }
__device__ __forceinline__ float bf2f(short s) { return __uint_as_float(((unsigned)(unsigned short)s) << 16); }
typedef short v4i16_t __attribute__((ext_vector_type(4)));
__device__ __forceinline__ s16x4 vtr(const ALAS unsigned char* p) { return __builtin_bit_cast(s16x4, __builtin_amdgcn_ds_read_tr16_b64_v4i16((ALAS v4i16_t*)p)); }
__device__ __forceinline__ void dma16(const void* g, ALAS unsigned char* l) { __builtin_amdgcn_global_load_lds((const unsigned*)g, (ALAS unsigned*)l, 16, 0, 0); }
__device__ __forceinline__ float xhalf_max(float m) { auto rr = __builtin_amdgcn_permlane32_swap(__float_as_uint(m), __float_as_uint(m), false, false); return fmaxf(__uint_as_float(rr[0]), __uint_as_float(rr[1])); }
__device__ __forceinline__ float xhalf_sum(float m) { auto rr = __builtin_amdgcn_permlane32_swap(__float_as_uint(m), __float_as_uint(m), false, false); return __uint_as_float(rr[0]) + __uint_as_float(rr[1]); }
__device__ __forceinline__ void sincos_acc(float x, float& s, float& c) {
    const float k = rintf(x * 0.6366197723675814f);
    float r = fmaf(-k, 1.5707962513e+00f, x); r = fmaf(-k, 7.5497894159e-08f, r); r = fmaf(-k, 5.3903029534e-15f, r);
    const int q = ((int)k) & 3; const float r2 = r * r;
    const float sp = r + r * r2 * (-1.6666654611e-1f + r2 * (8.3321608736e-3f + r2 * (-1.9515295891e-4f)));
    const float cp = 1.f + r2 * (-0.5f + r2 * (4.166664568298827e-2f + r2 * (-1.388731625493765e-3f + r2 * 2.443315711809948e-5f)));
    const float s0 = (q & 1) ? cp : sp, c0 = (q & 1) ? sp : cp;
    s = (q & 2) ? -s0 : s0; c = ((q + 1) & 2) ? -c0 : c0;
}

template <int DQK, int MODE>
__device__ __forceinline__ void unit(const Desc& d, long rowbase, int q0, int tlo, int thi, const float* rpb_h, ALAS unsigned char* shm, bool pre, bool has_next, const Next& nx) {
    constexpr int ND = DQK / 16;
    const int tid = threadIdx.x, lane = tid & 63, r32 = lane & 31, hi = lane >> 5;
    const int wid = __builtin_amdgcn_readfirstlane(tid >> 6);
    ALAS float* wsf = (ALAS float*)(shm + L_WS) + wid * 64;
    ALAS float* rpbs = (ALAS float*)(shm + L_RPB);
    const bf16_t* ksrc0 = d.K0 + (rowbase + lane) * (long)d.k0p + wid * 8;
    const bf16_t* ksrc1 = d.K1 + (rowbase + lane) * (long)d.k1p + (wid & 3) * 8;
    const bf16_t* vsrc = d.V + (rowbase + 16 * (wid & 3) + (lane >> 2)) * (long)d.vp + (wid >> 2) * 32 + (lane & 3) * 8;
#define ATT_ISSUE_K(t, koff) do { \
        dma16(ksrc0 + (long)(t) * 64 * d.k0p, shm + L_K + (koff) + wid * 1024); \
        if (DQK == 96) { dma16(ksrc1 + (long)(t) * 64 * d.k1p, shm + L_K + (koff) + (8 + (wid & 3)) * 1024); } } while (0)
#define ATT_ISSUE_V(t, voff) dma16(vsrc + (long)(t) * 64 * d.vp, shm + L_V + (voff) + wid * 1024)
#define ATT_WAITBAR() asm volatile("s_waitcnt vmcnt(0) lgkmcnt(0)\n\ts_barrier" ::: "memory")
    if (!pre) {
    ATT_ISSUE_K(tlo, 0); ATT_ISSUE_V(tlo, 0);
    if (tlo + 1 <= thi) { ATT_ISSUE_K(tlo + 1, KSLOT); ATT_ISSUE_V(tlo + 1, VSLOT); }
    if (tlo + 2 <= thi) { ATT_ISSUE_K(tlo + 2, 2 * KSLOT); ATT_ISSUE_V(tlo + 2, 2 * VSLOT); }
    }
    const int tq = q0 + wid * 32 + r32;
    if (MODE == 1) { for (int i = tid; i < 15 * 32; i += 512) { const int dr = i >> 5, j = i & 31; rpbs[i] = (j < 31) ? rpb_h[dr * 31 + j] * LOG2E : -INFINITY; } }
    bf16x8 qr[ND];
    { const bf16_t* qp = d.Q0 + (rowbase + tq) * (long)d.q0p + hi * 8;
#pragma unroll
      for (int d0 = 0; d0 < 4; ++d0) qr[d0] = *(const bf16x8*)(qp + d0 * 16); }
    if constexpr (DQK == 96) {
        const bf16_t* qp = d.Q1 + (rowbase + tq) * (long)d.q1p + hi * 8;
#pragma unroll
        for (int dd = 0; dd < 2; ++dd) {
            const bf16x8 raw = *(const bf16x8*)(qp + dd * 16); const u32x4 w = __builtin_bit_cast(u32x4, raw); u32x4 pw;
#pragma unroll
            for (int j = 0; j < 4; ++j) pw[j] = (unsigned)__shfl_xor((int)w[j], 32);
            const bf16x8 par = __builtin_bit_cast(bf16x8, pw);
            const float pos = (dd == 0) ? (float)(tq >> 6) : (float)(tq & 63);
            float ov[8];
#pragma unroll
            for (int e = 0; e < 8; ++e) { const float inv = exp2f(-(float)e * (13.287712379549449f / 8.0f)); float s, c; sincos_acc(pos * inv, s, c);
                const float x = bf2f(raw[e]), y = bf2f(par[e]); ov[e] = hi == 0 ? x * c - y * s : x * c + y * s; }
            u32x4 o4; o4.x = cvtpk_s(ov[0], ov[1]); o4.y = cvtpk_s(ov[2], ov[3]); o4.z = cvtpk_s(ov[4], ov[5]); o4.w = cvtpk_s(ov[6], ov[7]);
            qr[4 + dd] = __builtin_bit_cast(bf16x8, o4);
        }
    }
    float mhat = 0.f, l_reg = 0.f; f32x16 o[2]; o[0] = f32x16{}; o[1] = f32x16{}; f32x16 negm = f32x16{};
    bool first = true;
    const int qrow = tq >> 6, qc = tq & 63;
    const int wrow = __builtin_amdgcn_readfirstlane(qrow);
    const int rs = min(max(wrow - 4, 0), 120);
    const int cs = min(max(qc - 8, 0), 48);
    unsigned co[32];
    if (MODE == 1) {
#pragma unroll
        for (int r = 0; r < 16; ++r) { const int kc = crow(r, hi), kc1 = kc + 32;
            co[r] = (((unsigned)(kc - cs) < 16u) ? (unsigned)(kc - qc + 15) : 31u) * 4u; co[16 + r] = (((unsigned)(kc1 - cs) < 16u) ? (unsigned)(kc1 - qc + 15) : 31u) * 4u; }
    }
    const unsigned tb_addr = (unsigned)(uintptr_t)(shm + L_RPB);
#define LDS_RD128(dst, addr, off) asm volatile("ds_read_b128 %0, %1 offset:%c2" : "=&v"(dst) : "v"(addr), "i"(off) : "memory")
#define LDS_RDTR(dst, addr, off) asm volatile("ds_read_b64_tr_b16 %0, %1 offset:%c2" : "=v"(dst) : "v"(addr), "i"(off) : "memory")
#define ATT_KRD(KOFF) do { const unsigned ka_ = kaddr0 + (unsigned)(KOFF); \
        _Pragma("unroll") for (int d0 = 0; d0 < ND; ++d0) { LDS_RD128(kf[2 * d0], ka_, d0 * 2048); LDS_RD128(kf[2 * d0 + 1], ka_, d0 * 2048 + 512); } } while (0)
#define ATT_KW2(N, A, B) asm volatile("s_waitcnt lgkmcnt(" #N ")" : "+v"(A), "+v"(B) :: "memory")
#define ATT_QK2(P0, P1, d0) do { if ((d0) == 0) { P0 = __builtin_amdgcn_mfma_f32_32x32x16_bf16(kf[0], qr[0], negm, 0, 0, 0); P1 = __builtin_amdgcn_mfma_f32_32x32x16_bf16(kf[1], qr[0], negm, 0, 0, 0); } \
            else { P0 = __builtin_amdgcn_mfma_f32_32x32x16_bf16(kf[2 * (d0)], qr[d0], P0, 0, 0, 0); P1 = __builtin_amdgcn_mfma_f32_32x32x16_bf16(kf[2 * (d0) + 1], qr[d0], P1, 0, 0, 0); } } while (0)
#define ATT_QKM(P0, P1) do { if constexpr (ND == 4) { \
            ATT_KW2(6, kf[0], kf[1]); ATT_QK2(P0, P1, 0); ATT_KW2(4, kf[2], kf[3]); ATT_QK2(P0, P1, 1); ATT_KW2(2, kf[4], kf[5]); ATT_QK2(P0, P1, 2); ATT_KW2(0, kf[6], kf[7]); ATT_QK2(P0, P1, 3); } \
        else { ATT_KW2(10, kf[0], kf[1]); ATT_QK2(P0, P1, 0); ATT_KW2(8, kf[2], kf[3]); ATT_QK2(P0, P1, 1); ATT_KW2(6, kf[4], kf[5]); ATT_QK2(P0, P1, 2); ATT_KW2(4, kf[6], kf[7]); ATT_QK2(P0, P1, 3); \
               ATT_KW2(2, kf[8 % (2 * ND)], kf[9 % (2 * ND)]); ATT_QK2(P0, P1, 4 % ND); ATT_KW2(0, kf[10 % (2 * ND)], kf[11 % (2 * ND)]); ATT_QK2(P0, P1, 5 % ND); } } while (0)
#define ATT_VRD(VOFF) do { const unsigned va_ = vaddr0 + (unsigned)(VOFF); \
        _Pragma("unroll") for (int kg = 0; kg < 4; ++kg) _Pragma("unroll") for (int dh = 0; dh < 2; ++dh) { \
            LDS_RDTR(vf[(kg * 2 + dh) * 2], va_, dh * 4096 + kg * 1024); LDS_RDTR(vf[(kg * 2 + dh) * 2 + 1], va_, dh * 4096 + kg * 1024 + 512); } } while (0)
#define ATT_VWAIT() asm volatile("s_waitcnt lgkmcnt(0)" : "+v"(vf[0]), "+v"(vf[1]), "+v"(vf[2]), "+v"(vf[3]), "+v"(vf[4]), "+v"(vf[5]), "+v"(vf[6]), "+v"(vf[7]), "+v"(vf[8]), "+v"(vf[9]), "+v"(vf[10]), "+v"(vf[11]), "+v"(vf[12]), "+v"(vf[13]), "+v"(vf[14]), "+v"(vf[15]) :: "memory")
#define ATT_VF(kg, dh) ((bf16x8){vf[((kg) * 2 + (dh)) * 2][0], vf[((kg) * 2 + (dh)) * 2][1], vf[((kg) * 2 + (dh)) * 2][2], vf[((kg) * 2 + (dh)) * 2][3], vf[((kg) * 2 + (dh)) * 2 + 1][0], vf[((kg) * 2 + (dh)) * 2 + 1][1], vf[((kg) * 2 + (dh)) * 2 + 1][2], vf[((kg) * 2 + (dh)) * 2 + 1][3]})
#define ATT_ACTIVE(t) ((MODE == 0) || ((t) >= rs && (t) <= rs + 7))
    const unsigned kaddr0 = (unsigned)(uintptr_t)(shm + L_K) + hi * 1024 + r32 * 16;
    const unsigned vaddr0 = (unsigned)(uintptr_t)(shm + L_V) + ((lane >> 4) & 1) * 32 + (lane & 3) * 8 + (4 * hi + ((lane & 15) >> 2)) * 64;
    bf16x8 kf[2 * ND]; s16x4 vf[16];
    f32x16 p0 = f32x16{}, p1 = f32x16{};
    ATT_WAITBAR();
    for (int t = tlo; t <= thi; ++t) {
        const int buf = (t - tlo) & 3;
        if (t + 3 <= thi) { ATT_ISSUE_K(t + 3, ((buf + 3) & 3) * KSLOT); ATT_ISSUE_V(t + 3, ((buf + 3) & 3) * VSLOT); }
        const bool act = ATT_ACTIVE(t);
        if (act) { ATT_KRD(buf * KSLOT); ATT_QKM(p0, p1); if (MODE == 0) ATT_VRD(buf * VSLOT); }
        __builtin_amdgcn_sched_barrier(0);
        if (act) {
            if (MODE == 1) {
                const unsigned ra = tb_addr + (unsigned)(t - wrow + 7) * 128u;
                float bb[32];
#define NA_RD(k) do { _Pragma("unroll") for (int e = 8 * (k); e < 8 * (k) + 8; ++e) asm volatile("ds_read_b32 %0, %1" : "=v"(bb[e]) : "v"(co[e] + ra) : "memory"); } while (0)
#define NA_WAIT(N, k) asm volatile("s_waitcnt lgkmcnt(" #N ")" : "+v"(bb[8 * (k)]), "+v"(bb[8 * (k) + 1]), "+v"(bb[8 * (k) + 2]), "+v"(bb[8 * (k) + 3]), "+v"(bb[8 * (k) + 4]), "+v"(bb[8 * (k) + 5]), "+v"(bb[8 * (k) + 6]), "+v"(bb[8 * (k) + 7]) :: "memory")
                NA_RD(0); NA_RD(1); NA_WAIT(8, 0);
#pragma unroll
                for (int e = 0; e < 8; ++e) p0[e] += bb[e];
                NA_RD(2); NA_WAIT(8, 1);
#pragma unroll
                for (int e = 8; e < 16; ++e) p0[e] += bb[e];
                NA_RD(3); NA_WAIT(8, 2);
#pragma unroll
                for (int e = 0; e < 8; ++e) p1[e] += bb[16 + e];
                NA_WAIT(0, 3);
#pragma unroll
                for (int e = 8; e < 16; ++e) p1[e] += bb[16 + e];
#undef NA_RD
#undef NA_WAIT
                ATT_VRD(buf * VSLOT);
            }
            float rm0 = fmaxf(fmaxf(p0[0], p0[1]), p0[2]), rm1 = fmaxf(fmaxf(p1[0], p1[1]), p1[2]), rm2 = fmaxf(fmaxf(p0[3], p0[4]), p0[5]), rm3 = fmaxf(fmaxf(p1[3], p1[4]), p1[5]);
#pragma unroll
            for (int r = 6; r < 16; r += 2) { rm0 = fmaxf(fmaxf(rm0, p0[r]), p0[r + 1]); rm1 = fmaxf(fmaxf(rm1, p1[r]), p1[r + 1]); }
            float rm = fmaxf(fmaxf(rm0, rm1), fmaxf(rm2, rm3));
            rm = xhalf_max(rm);
            if (first || __any(rm > THR)) {
                const float dl = first ? rm : fmaxf(rm, 0.f);
                mhat += dl;
#pragma unroll
                for (int r = 0; r < 16; ++r) { p0[r] -= dl; p1[r] -= dl; negm[r] = -mhat; }
                if (!first) { const float f = exp2f(-dl); l_reg *= f; if (hi == 0) wsf[r32] = f;
#pragma unroll
                    for (int r = 0; r < 16; ++r) { const float fr_ = wsf[crow(r, hi)]; o[0][r] *= fr_; o[1][r] *= fr_; } }
                first = false;
            }
            u32x4 pw[4];
            float sa0 = 0.f, sa1 = 0.f, sa2 = 0.f, sa3 = 0.f;
#pragma unroll
            for (int r = 0; r < 16; r += 4) { p0[r] = __builtin_amdgcn_exp2f(p0[r]); p0[r + 1] = __builtin_amdgcn_exp2f(p0[r + 1]); p0[r + 2] = __builtin_amdgcn_exp2f(p0[r + 2]); p0[r + 3] = __builtin_amdgcn_exp2f(p0[r + 3]);
                sa0 += p0[r]; sa1 += p0[r + 1]; sa2 += p0[r + 2]; sa3 += p0[r + 3]; }
#pragma unroll
            for (int j = 0; j < 4; ++j) { pw[0][j] = cvtpk_s(p0[2 * j], p0[2 * j + 1]); pw[1][j] = cvtpk_s(p0[8 + 2 * j], p0[8 + 2 * j + 1]); }
            ATT_VWAIT();
#pragma unroll
            for (int kg = 0; kg < 2; ++kg)
#pragma unroll
                for (int dh = 0; dh < 2; ++dh) o[dh] = __builtin_amdgcn_mfma_f32_32x32x16_bf16(__builtin_bit_cast(bf16x8, pw[kg]), ATT_VF(kg, dh), o[dh], 0, 0, 0);
            __builtin_amdgcn_sched_barrier(0);
#pragma unroll
            for (int r = 0; r < 16; r += 4) { p1[r] = __builtin_amdgcn_exp2f(p1[r]); p1[r + 1] = __builtin_amdgcn_exp2f(p1[r + 1]); p1[r + 2] = __builtin_amdgcn_exp2f(p1[r + 2]); p1[r + 3] = __builtin_amdgcn_exp2f(p1[r + 3]);
                sa0 += p1[r]; sa1 += p1[r + 1]; sa2 += p1[r + 2]; sa3 += p1[r + 3]; }
            l_reg += (sa0 + sa1) + (sa2 + sa3);
#pragma unroll
            for (int j = 0; j < 4; ++j) { pw[2][j] = cvtpk_s(p1[2 * j], p1[2 * j + 1]); pw[3][j] = cvtpk_s(p1[8 + 2 * j], p1[8 + 2 * j + 1]); }
#pragma unroll
            for (int kg = 2; kg < 4; ++kg)
#pragma unroll
                for (int dh = 0; dh < 2; ++dh) o[dh] = __builtin_amdgcn_mfma_f32_32x32x16_bf16(__builtin_bit_cast(bf16x8, pw[kg]), ATT_VF(kg, dh), o[dh], 0, 0, 0);
        }
        if (t + 3 <= thi) { if constexpr (DQK == 96) asm volatile("s_waitcnt vmcnt(6) lgkmcnt(0)\n\ts_barrier" ::: "memory"); else asm volatile("s_waitcnt vmcnt(4) lgkmcnt(0)\n\ts_barrier" ::: "memory"); }
        else ATT_WAITBAR();
    }
#undef LDS_RD128
#undef LDS_RDTR
#undef ATT_KRD
#undef ATT_KW2
#undef ATT_QK2
#undef ATT_QKM
#undef ATT_VRD
#undef ATT_VWAIT
#undef ATT_VF
#undef ATT_QK
#undef ATT_ACTIVE
    if (has_next) {
        const bf16_t* nk0 = nx.K0 + (nx.rowbase + lane) * (long)nx.k0p + wid * 8;
        const bf16_t* nk1 = nx.K1 + (nx.rowbase + lane) * (long)nx.k1p + (wid & 3) * 8;
        const bf16_t* nv = nx.V + (nx.rowbase + 16 * (wid & 3) + (lane >> 2)) * (long)nx.vp + (wid >> 2) * 32 + (lane & 3) * 8;
#pragma unroll
        for (int i = 0; i < 3; ++i) if (nx.tlo + i <= nx.thi) {
            dma16(nk0 + (long)(nx.tlo + i) * 64 * nx.k0p, shm + L_K + i * KSLOT + wid * 1024);
            if (nx.dqk == 96) dma16(nk1 + (long)(nx.tlo + i) * 64 * nx.k1p, shm + L_K + i * KSLOT + (8 + (wid & 3)) * 1024);
            dma16(nv + (long)(nx.tlo + i) * 64 * nx.vp, shm + L_V + i * VSLOT + wid * 1024); }
    }
    l_reg = xhalf_sum(l_reg);
    if (hi == 0) wsf[32 + r32] = l_reg;
    float rli[16];
#pragma unroll
    for (int r = 0; r < 16; ++r) rli[r] = 1.0f / wsf[32 + crow(r, hi)];
    bf16_t* Ow = d.O + (rowbase + q0 + wid * 32) * (long)d.op;
    { ALAS bf16_t* stg = (ALAS bf16_t*)(shm + L_OST) + wid * 2048;
#pragma unroll
      for (int r = 0; r < 16; ++r) { const int orow = crow(r, hi);
#pragma unroll
          for (int dh = 0; dh < 2; ++dh) stg[orow * 64 + dh * 32 + r32] = (bf16_t)(cvtpk_s(o[dh][r] * rli[r], 0.f) & 0xffffu); }
      asm volatile("s_waitcnt lgkmcnt(0)" ::: "memory");
#pragma unroll
      for (int i = 0; i < 4; ++i) { const int row = i * 8 + (lane >> 3), ch = lane & 7; const u32x4 v = *(const ALAS u32x4*)(stg + row * 64 + ch * 8); *(u32x4*)(Ow + (long)row * d.op + ch * 8) = v; } }
    asm volatile("s_waitcnt lgkmcnt(0)\n\ts_barrier" ::: "memory");
#undef ATT_ISSUE_K
#undef ATT_ISSUE_V
#undef ATT_WAITBAR
}
}

constexpr int NWAVES = 8;
constexpr int M = 32768, D = 1024, SEQ = 8192, NB = 4, FF = 4096, NIN = 1440, NINP = 1536;
constexpr size_t MiB = 1u << 20;
constexpr size_t WS_PART = 2 * MiB;
constexpr size_t WS_WIN = 18 * MiB, WS_WUQ = 21 * MiB, WS_WUKV = 22 * MiB, WS_WO0 = 23 * MiB, WS_WUP0 = 25 * MiB, WS_WDN0 = 33 * MiB;
constexpr size_t WS_WQKV = 41 * MiB, WS_WO1 = 47 * MiB, WS_WUP1 = 49 * MiB, WS_WDN1 = 57 * MiB;
constexpr size_t WS_HB = 66 * MiB;
constexpr size_t WS_U = 130 * MiB;
constexpr size_t WS_Z = 130 * MiB, WS_MIX = 130 * MiB, WS_QA = 226 * MiB, WS_KA = 258 * MiB, WS_VA = 266 * MiB, WS_CQ = 274 * MiB, WS_CKV = 298 * MiB, WS_KR = 314 * MiB, WS_QB = 316 * MiB, WS_KVB = 386 * MiB;
constexpr size_t WS_QKV = 130 * MiB, WS_O1 = 322 * MiB;
constexpr size_t WS_END = 450 * MiB;
constexpr int LDS_BYTES = 135168;
static_assert(att::L_END <= 131072, "attention LDS");

#define LAS __attribute__((address_space(3)))
typedef unsigned short bf16;
typedef unsigned v4u __attribute__((ext_vector_type(4)));
typedef float f32x4 __attribute__((ext_vector_type(4)));
#define LDS_WAIT() asm volatile("s_waitcnt lgkmcnt(0)" ::: "memory")

__device__ __forceinline__ float wave_sum(float v) {
#pragma unroll
    for (int o = 1; o < 64; o <<= 1) v += __shfl_xor(v, o);
    return v;
}
__device__ __forceinline__ unsigned pk2(float lo, float hi) { return pg8::cvt_pk_bf16(lo, hi); }
__device__ __forceinline__ void transpose_item(const float* W, const float* gain, int K, int N, bf16* WT, LAS float* scr, int item, int lane) {
    const int nblk = N / 32, kb = item / nblk, nb = item % nblk, k0 = 64 * kb, n0 = 32 * nb;
#pragma unroll 8
    for (int i = 0; i < 32; ++i) { const int kk = 2 * i + (lane >> 5); const float g = gain ? gain[k0 + kk] : 1.f; scr[kk * 33 + (lane & 31)] = W[(size_t)(k0 + kk) * N + n0 + (lane & 31)] * g; }
    LDS_WAIT(); asm volatile("" ::: "memory");
    const int c = lane & 7;
#pragma unroll
    for (int j = 0; j < 4; ++j) { const int n = (lane >> 3) + 8 * j; const LAS float* s = scr + (8 * c) * 33 + n;
        v4u o; o.x = pk2(s[0 * 33], s[1 * 33]); o.y = pk2(s[2 * 33], s[3 * 33]); o.z = pk2(s[4 * 33], s[5 * 33]); o.w = pk2(s[6 * 33], s[7 * 33]);
        *(v4u*)(WT + (size_t)(n0 + n) * K + k0 + 8 * c) = o; }
    LDS_WAIT(); asm volatile("" ::: "memory");
}

#define XB_TMO      128
#define XB_XCNT(j)  (256  + 64 * (j))
#define XB_XSUB(j)  (1280 + 64 * (j))
#define XB_XGEN(j)  (2304 + 64 * (j))
#define XB_TOP      3328
#define XB_TOPGEN   3392
#define XCD_BAR_WORDS 3456
#define XB_SPIN_CAP (1u << 18)

__device__ __forceinline__ unsigned xb_ld(unsigned* p)              { return __hip_atomic_load(p, __ATOMIC_RELAXED, __HIP_MEMORY_SCOPE_AGENT); }
__device__ __forceinline__ unsigned xb_add(unsigned* p, unsigned v) { return __hip_atomic_fetch_add(p, v, __ATOMIC_RELAXED, __HIP_MEMORY_SCOPE_AGENT); }
__device__ __forceinline__ unsigned xb_xcc_id() { return (unsigned)__builtin_amdgcn_s_getreg((3 << 11) | 20) & 0xFu; }
#define XB_SPIN(cond, bar) do { unsigned _sp = 0; while (cond) { __builtin_amdgcn_s_sleep(1); \
    if ((++_sp & 255u) == 0u) { if (xb_ld(&(bar)[XB_TMO])) break; if (_sp > XB_SPIN_CAP) { atomicAdd(&(bar)[XB_TMO], 1u); break; } } } } while (0)

struct XcdBarrier {
    unsigned* bar; unsigned x;
    volatile LAS unsigned* st;
};

__device__ __forceinline__ XcdBarrier xcd_barrier_post(unsigned* bar, volatile LAS unsigned* st) {
    XcdBarrier b; b.bar = bar; b.x = xb_xcc_id(); b.st = st;
    if (threadIdx.x == 0) (void)xb_add(&bar[XB_XCNT(b.x)], 1u);
    return b;
}
__device__ __forceinline__ void xcd_barrier_complete(unsigned* bar, unsigned x, unsigned& nloc, unsigned& nx) {
    const unsigned G = gridDim.x * gridDim.y * gridDim.z;
    unsigned sum, cnt, mine, sp = 0u;
    for (;;) {
        sum = 0u; cnt = 0u; mine = 0u;
#pragma unroll
        for (unsigned j = 0; j < 16; ++j) { const unsigned c = xb_ld(&bar[XB_XCNT(j)]); sum += c; cnt += (c > 0u) ? 1u : 0u; mine = (j == x) ? c : mine; }
        if (sum == G) break;
        __builtin_amdgcn_s_sleep(1);
        if ((++sp & 255u) == 0u) { if (xb_ld(&bar[XB_TMO])) break; if (sp > XB_SPIN_CAP) { atomicAdd(&bar[XB_TMO], 1u); break; } }
    }
    nloc = mine > 0u ? mine : 1u; nx = cnt > 0u ? cnt : 1u;
}

__device__ __forceinline__ void xcd_barrier(const XcdBarrier& b) {
    asm volatile("s_waitcnt vmcnt(0)" ::: "memory");
    __syncthreads();
    if (threadIdx.x == 0) {
        unsigned* bar = b.bar;
        __builtin_amdgcn_s_waitcnt(0);
        unsigned nloc = b.st[0], nx = b.st[1];
        if (nloc == 0u) { xcd_barrier_complete(bar, b.x, nloc, nx); b.st[0] = nloc; b.st[1] = nx; }
        const unsigned old = xb_add(&bar[XB_XSUB(b.x)], 1u);
        const unsigned gen = old / nloc;
        if (old + 1u == (gen + 1u) * nloc) {
            __builtin_amdgcn_fence(__ATOMIC_RELEASE, "agent");
            asm volatile("s_waitcnt vmcnt(0)" ::: "memory");
            const unsigned og = xb_add(&bar[XB_TOP], 1u);
            const unsigned tg = og / nx;
            if (og + 1u == (tg + 1u) * nx) xb_add(&bar[XB_TOPGEN], 1u);
            else XB_SPIN(xb_ld(&bar[XB_TOPGEN]) == tg, bar);
            __builtin_amdgcn_fence(__ATOMIC_ACQUIRE, "agent");
            xb_add(&bar[XB_XGEN(b.x)], 1u);
            asm volatile("s_waitcnt vmcnt(0)" ::: "memory");
        } else {
            XB_SPIN(xb_ld(&bar[XB_XGEN(b.x)]) == gen, bar);
            __builtin_amdgcn_fence(__ATOMIC_ACQUIRE, "agent");
            asm volatile("s_waitcnt vmcnt(0)" ::: "memory");
        }
    }
    __syncthreads();
}

struct Args { const float* in[17]; float* out; unsigned char* ws; int ph_lo, ph_hi; };

__device__ __forceinline__ void ld8(const bf16* p, float (&v)[8]) { const v4u w = *(const v4u*)p;
#pragma unroll
    for (int j = 0; j < 4; ++j) { v[2 * j] = __uint_as_float(w[j] << 16); v[2 * j + 1] = __uint_as_float(w[j] & 0xffff0000u); } }
__device__ __forceinline__ void st8(bf16* p, const float (&v)[8]) { v4u o; o.x = pk2(v[0], v[1]); o.y = pk2(v[2], v[3]); o.z = pk2(v[4], v[5]); o.w = pk2(v[6], v[7]); *(v4u*)p = o; }

__device__ __forceinline__ void head_norm_rope(float (&v)[8], const float* gain, int j, float prow, float pcol, float scale) {
    float ss = 0.f;
#pragma unroll
    for (int e = 0; e < 8; ++e) ss += v[e] * v[e];
    ss += __shfl_xor(ss, 1); ss += __shfl_xor(ss, 2); ss += __shfl_xor(ss, 4);
    const float rstd = 1.0f / sqrtf(ss * (1.0f / 64.0f) + pg8::NORM_EPS);
    const float pos = (j < 4) ? prow : pcol;
#pragma unroll
    for (int e = 0; e < 8; ++e) {
        const float y = v[e] * rstd * gain[j * 8 + e]; const float py = __shfl_xor(y, 2);
        const int i = (j & 1) * 8 + e; const float inv = exp2f(-(float)i * (13.287712379549449f / 16.0f)); float s, c; att::sincos_acc(pos * inv, s, c);
        v[e] = (((j & 2) == 0) ? y * c - py * s : y * c + py * s) * scale;
    }
}

__global__ void __launch_bounds__(NWAVES * 64, 2) fwd_kernel(Args args) {
    extern __shared__ __attribute__((aligned(16))) unsigned char lds[];
    cg::grid_group grid = cg::this_grid();
    LAS unsigned char* L = (LAS unsigned char*)lds;
    const int tid = threadIdx.x, lane = tid & 63, wave = __builtin_amdgcn_readfirstlane(tid >> 6);
    const int G = gridDim.x; const int bx = blockIdx.x;
    const int vcu = (G % 8 == 0) ? (bx % 8) * (G / 8) + bx / 8 : bx;
    const int gw = vcu * NWAVES + wave, NGW = G * NWAVES;
    unsigned char* ws = args.ws;
    const float* x = args.in[0]; float* out = args.out;
    float* PART = (float*)(ws + WS_PART);
#define PARTN(k) (PART + (size_t)(k) * M * 16)
    bf16 *HB = (bf16*)(ws + WS_HB), *U = (bf16*)(ws + WS_U), *Z = (bf16*)(ws + WS_Z), *MIX = (bf16*)(ws + WS_MIX);
    bf16 *QA = (bf16*)(ws + WS_QA), *KA = (bf16*)(ws + WS_KA), *VA = (bf16*)(ws + WS_VA), *CQ = (bf16*)(ws + WS_CQ), *CKV = (bf16*)(ws + WS_CKV), *KR = (bf16*)(ws + WS_KR);
    bf16 *QB = (bf16*)(ws + WS_QB), *KVB = (bf16*)(ws + WS_KVB), *QKV = (bf16*)(ws + WS_QKV), *O1 = (bf16*)(ws + WS_O1);
    bf16 *WIN = (bf16*)(ws + WS_WIN), *WUQ = (bf16*)(ws + WS_WUQ), *WUKV = (bf16*)(ws + WS_WUKV), *WO0 = (bf16*)(ws + WS_WO0), *WUP0 = (bf16*)(ws + WS_WUP0), *WDN0 = (bf16*)(ws + WS_WDN0);
    bf16 *WQKV = (bf16*)(ws + WS_WQKV), *WO1 = (bf16*)(ws + WS_WO1), *WUP1 = (bf16*)(ws + WS_WUP1), *WDN1 = (bf16*)(ws + WS_WDN1);
    const int lo = args.ph_lo, hi = args.ph_hi;
    volatile LAS unsigned* MISC = (volatile LAS unsigned*)(L + 131072);
    if (tid < 2) MISC[tid] = 0u;
    __syncthreads();
    unsigned* BARW = (unsigned*)(ws + 8192);
    XcdBarrier xbar = xcd_barrier_post(BARW, MISC);
    if (args.ph_lo < 0) grid.sync();
#ifndef PROBE_PHASE
#define PROBE_PHASE -1
#endif
#define IN(k) (lo <= (k) && (k) < hi)
#define REPS(k) ((PROBE_PHASE == (k)) ? 2 : 1)
#define SEAM(k) do { if (IN(k) && IN((k) + 1)) xcd_barrier(xbar); } while (0)
    constexpr float C2A = 0.125f * att::LOG2E;
    constexpr float C2B = 0.10206207261596577f * att::LOG2E;

    if (IN(0)) {
        LAS float* scr = (LAS float*)(L + wave * 16384);
        constexpr int I0 = 16 * 45, I1 = 6 * 24, I2 = 4 * 32, I3 = 16 * 32, I4 = 16 * 128, I5 = 64 * 32, I6 = 16 * 96, I7 = 16 * 32, I8 = I4, I9 = I5;
        constexpr int NITEMS = I0 + I1 + I2 + I3 + I4 + I5 + I6 + I7 + I8 + I9;
        for (int it = gw; it < NITEMS; it += NGW) {
            int r = it;
            if (r < I0) { transpose_item(args.in[2], args.in[1], D, NIN, WIN, scr, r, lane); continue; } r -= I0;
            if (r < I1) { transpose_item(args.in[6], args.in[5], 384, 768, WUQ, scr, r, lane); continue; } r -= I1;
            if (r < I2) { transpose_item(args.in[8], args.in[7], 256, 1024, WUKV, scr, r, lane); continue; } r -= I2;
            if (r < I3) { transpose_item(args.in[9], nullptr, D, D, WO0, scr, r, lane); continue; } r -= I3;
            if (r < I4) { transpose_item(args.in[14], args.in[13], D, FF, WUP0, scr, r, lane); continue; } r -= I4;
            if (r < I5) { transpose_item(args.in[15], nullptr, FF, D, WDN0, scr, r, lane); continue; } r -= I5;
            if (r < I6) { transpose_item(args.in[10], args.in[1] + D, D, 3 * D, WQKV, scr, r, lane); continue; } r -= I6;
            if (r < I7) { transpose_item(args.in[12], nullptr, D, D, WO1, scr, r, lane); continue; } r -= I7;
            if (r < I8) { transpose_item(args.in[14] + (size_t)D * FF, args.in[13] + D, D, FF, WUP1, scr, r, lane); continue; } r -= I8;
            transpose_item(args.in[15] + (size_t)FF * D, nullptr, FF, D, WDN1, scr, r, lane);
        }
        { v4u* p = (v4u*)(WIN + (size_t)NIN * D); const int n16 = (NINP - NIN) * D * 2 / 16; for (int i = bx * 512 + tid; i < n16; i += G * 512) p[i] = (v4u){0u, 0u, 0u, 0u}; }
        for (int m = gw; m < M; m += NGW) {
            const f32x4* xr = (const f32x4*)(x + (size_t)m * D) + lane; f32x4 v[4]; float s = 0.f;
#pragma unroll
            for (int j = 0; j < 4; ++j) { v[j] = xr[64 * j]; s += (v[j].x * v[j].x + v[j].y * v[j].y) + (v[j].z * v[j].z + v[j].w * v[j].w); }
            s = wave_sum(s);
            unsigned long long* o8 = (unsigned long long*)(HB + (size_t)m * D) + lane;
#pragma unroll
            for (int j = 0; j < 4; ++j) o8[64 * j] = (unsigned long long)pk2(v[j].x, v[j].y) | ((unsigned long long)pk2(v[j].z, v[j].w) << 32);
            if (lane < 16) PARTN(0)[(size_t)m * 16 + lane] = (lane == 0) ? s : 0.f;
        }
    }
    SEAM(0);
    if (IN(1)) {
        pg8::Gemm g{HB, WIN, M, NINP, D}; pg8::StaticOrder S; S.init(M, NINP, G, bx); S.rep = REPS(1);
        pg8::EpiScale<0> E{Z, NINP, PARTN(0), 1.0f / D, 0, 1.f};
        pg8::gemm_phase<pg8::EpiScale<0>, pg8::StaticOrder, true, true>(L, g, S, E);
    }
    SEAM(1);
    if (IN(2)) {
        const float* gq = args.in[3]; const float* gk = args.in[4];
        for (int m = gw; m < M; m += NGW) {
            const bf16* zr = Z + (size_t)m * NINP; const int t = m & (SEQ - 1); const float prow = (float)(t >> 6), pcol = (float)(t & 63); const int j = lane & 7;
            float v1[8], v2[8], v3[8];
            ld8(zr + lane * 8, v1); ld8(zr + 512 + lane * 8, v2); ld8(zr + 1024 + lane * 8, v3);
            float ss2 = 0.f, ss3 = 0.f;
#pragma unroll
            for (int e = 0; e < 8; ++e) { ss2 += v2[e] * v2[e]; ss3 += v3[e] * v3[e]; }
            const float s_cq = wave_sum((lane >= 32 ? ss2 : 0.f) + (lane < 16 ? ss3 : 0.f));
            const float s_ckv = wave_sum((lane >= 16 && lane < 48) ? ss3 : 0.f);
            const float r_cq = 1.0f / sqrtf(s_cq * (1.0f / 384.0f) + pg8::NORM_EPS), r_ckv = 1.0f / sqrtf(s_ckv * (1.0f / 256.0f) + pg8::NORM_EPS);
            head_norm_rope(v1, gq, j, prow, pcol, C2A);
            st8(QA + (size_t)m * 512 + lane * 8, v1);
            float k2[8];
#pragma unroll
            for (int e = 0; e < 8; ++e) k2[e] = v2[e];
            head_norm_rope(k2, gk, j, prow, pcol, 1.f);
            float kr8[8];
            { const int jj = lane & 3; const float pos = (jj < 2) ? prow : pcol;
#pragma unroll
              for (int e = 0; e < 8; ++e) { const float y = v3[e], py = __shfl_xor(y, 1); const float inv = exp2f(-(float)e * (13.287712379549449f / 8.0f)); float s, c; att::sincos_acc(pos * inv, s, c);
                  kr8[e] = ((jj & 1) == 0) ? y * c - py * s : y * c + py * s; } }
            if (lane < 16) st8(KA + (size_t)m * 128 + lane * 8, k2);
            else if (lane < 32) st8(VA + (size_t)m * 128 + (lane - 16) * 8, v2);
            else { float c8[8];
#pragma unroll
                for (int e = 0; e < 8; ++e) c8[e] = v2[e] * r_cq;
                st8(CQ + (size_t)m * 384 + (lane - 32) * 8, c8); }
            if (lane < 16) { float c8[8];
#pragma unroll
                for (int e = 0; e < 8; ++e) c8[e] = v3[e] * r_cq;
                st8(CQ + (size_t)m * 384 + 256 + lane * 8, c8); }
            else if (lane < 48) { float c8[8];
#pragma unroll
                for (int e = 0; e < 8; ++e) c8[e] = v3[e] * r_ckv;
                st8(CKV + (size_t)m * 256 + (lane - 16) * 8, c8); }
            else if (lane < 52) st8(KR + (size_t)m * 32 + (lane - 48) * 8, kr8);
        }
    }
    SEAM(2);
    if (IN(3)) {
        { pg8::Gemm g{CQ, WUQ, M, 768, 384}; pg8::StaticOrder S; S.init(M, 768, G, bx);
          pg8::EpiScale<0> E{QB, 768, nullptr, 0.f, 3, C2B};
          pg8::gemm_phase<pg8::EpiScale<0>, pg8::StaticOrder, true, true>(L, g, S, E); }
        { pg8::Gemm g{CKV, WUKV, M, 1024, 256}; pg8::StaticOrder S; S.init(M, 1024, G, bx);
          pg8::EpiScale<0> E{KVB, 1024, nullptr, 0.f, 0, 1.f};
          pg8::gemm_phase<pg8::EpiScale<0>, pg8::StaticOrder, true, true>(L, g, S, E); }
    }
    SEAM(3);
    if (IN(4)) {
        for (int uu = vcu; uu < 2048 * REPS(4); uu += G) { const int u = uu & 2047;
            const int pair = u >> 5, qb = u & 31; const int typ = (pair >> 3) & 1; const int idx = (pair >> 4) * 8 + (pair & 7); const int b = idx >> 3, h = idx & 7;
            const long rowbase = (long)b * SEQ;
            const bool has_next = (uu + G) < 2048 * REPS(4); const int un = (uu + G) & 2047; const int pairn = un >> 5; const int typn = (pairn >> 3) & 1; const int idxn = (pairn >> 4) * 8 + (pairn & 7); const int bn = idxn >> 3, hn = idxn & 7;
            att::Next nx;
            if (typn == 0) nx = att::Next{KA + (hn >> 2) * 64, KR, VA + (hn >> 2) * 64, 128, 32, 128, (long)bn * SEQ, 0, SEQ / 64 - 1, 64};
            else nx = att::Next{KVB + hn * 128, KR, KVB + hn * 128 + 64, 1024, 32, 1024, (long)bn * SEQ, 0, SEQ / 64 - 1, 96};
            if (typ == 0) { att::Desc d{QA + h * 64, nullptr, KA + (h >> 2) * 64, nullptr, VA + (h >> 2) * 64, MIX + h * 64, 512, 0, 128, 0, 128, 1024};
                att::unit<64, 0>(d, rowbase, qb * 256, 0, SEQ / 64 - 1, nullptr, L, uu != vcu, has_next, nx); }
            else { att::Desc d{QB + h * 96, QB + h * 96 + 64, KVB + h * 128, KR, KVB + h * 128 + 64, MIX + 512 + h * 64, 768, 768, 1024, 32, 1024, 1024};
                att::unit<96, 0>(d, rowbase, qb * 256, 0, SEQ / 64 - 1, nullptr, L, uu != vcu, has_next, nx); }
        }
    }
    SEAM(4);
    if (IN(5)) {
        pg8::Gemm g{MIX, WO0, M, D, D}; pg8::StaticOrder S; S.init(M, D, G, bx); S.rep = REPS(5);
        pg8::EpiRes E{x, out, HB, PARTN(1), D};
        pg8::gemm_phase<pg8::EpiRes, pg8::StaticOrder, true, true>(L, g, S, E);
    }
    SEAM(5);
    if (IN(6)) {
        pg8::Gemm g{HB, WUP0, M, FF, D}; pg8::StaticOrder S; S.init(M, FF, G, bx); S.rep = REPS(6);
        pg8::EpiScale<1> E{U, FF, PARTN(1), 1.0f / D, 0, 1.f};
        pg8::gemm_phase<pg8::EpiScale<1>, pg8::StaticOrder, true, true>(L, g, S, E);
    }
    SEAM(6);
    if (IN(7)) {
        pg8::Gemm g{U, WDN0, M, D, FF}; pg8::StaticOrder S; S.init(M, D, G, bx);
        pg8::EpiRes E{out, out, HB, PARTN(2), D};
        pg8::gemm_phase<pg8::EpiRes, pg8::StaticOrder, true, true>(L, g, S, E);
    }
    SEAM(7);
    if (IN(8)) {
        pg8::Gemm g{HB, WQKV, M, 3 * D, D}; pg8::StaticOrder S; S.init(M, 3 * D, G, bx); S.rep = REPS(8);
        pg8::EpiScale<0> E{QKV, 3 * D, PARTN(2), 1.0f / D, 4, C2A, M};
        pg8::gemm_phase<pg8::EpiScale<0>, pg8::StaticOrder, true, true>(L, g, S, E);
    }
    SEAM(8);
    if (IN(9)) {
        for (int uu = vcu; uu < 2048 * REPS(9); uu += G) { const int u = uu & 2047;
            const int pair = u >> 5, qb = u & 31; const int b = pair >> 4, h = pair & 15;
            const int R0 = qb * 4; const int tlo = min(max(R0 - 4, 0), 120), thi = min(max(R0 + 3 - 4, 0), 120) + 7;
            att::Desc d{QKV + (size_t)h * M * 64, nullptr, QKV + (size_t)(16 + h) * M * 64, nullptr, QKV + (size_t)(32 + h) * M * 64, O1 + h * 64, 64, 0, 64, 0, 64, D};
            const bool has_next = (uu + G) < 2048 * REPS(9); const int un = (uu + G) & 2047; const int pairn = un >> 5, qbn = un & 31; const int bn = pairn >> 4, hn = pairn & 15;
            const int R0n = qbn * 4; const int tlon = min(max(R0n - 4, 0), 120), thin = min(max(R0n + 3 - 4, 0), 120) + 7;
            const att::Next nx{QKV + (size_t)(16 + hn) * M * 64, KR, QKV + (size_t)(32 + hn) * M * 64, 64, 32, 64, (long)bn * SEQ, tlon, thin, 64};
            att::unit<64, 1>(d, (long)b * SEQ, qb * 256, tlo, thi, args.in[11] + h * 465, L, uu != vcu, has_next, nx);
        }
    }
    SEAM(9);
    if (IN(10)) {
        pg8::Gemm g{O1, WO1, M, D, D}; pg8::StaticOrder S; S.init(M, D, G, bx);
        pg8::EpiRes E{out, out, HB, PARTN(3), D};
        pg8::gemm_phase<pg8::EpiRes, pg8::StaticOrder, true, true>(L, g, S, E);
    }
    SEAM(10);
    if (IN(11)) {
        pg8::Gemm g{HB, WUP1, M, FF, D}; pg8::StaticOrder S; S.init(M, FF, G, bx);
        pg8::EpiScale<1> E{U, FF, PARTN(3), 1.0f / D, 0, 1.f};
        pg8::gemm_phase<pg8::EpiScale<1>, pg8::StaticOrder, true, true>(L, g, S, E);
    }
    SEAM(11);
    if (IN(12)) {
        pg8::Gemm g{U, WDN1, M, D, FF}; pg8::StaticOrder S; S.init(M, D, G, bx);
        pg8::EpiRes E{out, out, HB, PARTN(4), D};
        pg8::gemm_phase<pg8::EpiRes, pg8::StaticOrder, true, true>(L, g, S, E);
    }
    SEAM(12);
    if (IN(13)) {
        const float* gf = args.in[16];
        for (int m = gw; m < M; m += NGW) {
            f32x4* xr = (f32x4*)(out + (size_t)m * D) + lane; const f32x4* pp = (const f32x4*)(PARTN(4) + (size_t)m * 16);
            const f32x4 a = pp[0], b = pp[1], c = pp[2], d4 = pp[3];
            const float s = ((a[0] + a[1]) + (a[2] + a[3])) + ((b[0] + b[1]) + (b[2] + b[3])) + ((c[0] + c[1]) + (c[2] + c[3])) + ((d4[0] + d4[1]) + (d4[2] + d4[3]));
            const float rstd = 1.0f / sqrtf(s * (1.0f / D) + pg8::NORM_EPS);
#pragma unroll
            for (int j = 0; j < 4; ++j) { const f32x4 v = xr[64 * j]; const f32x4 gg = ((const f32x4*)gf)[lane + 64 * j]; xr[64 * j] = v * rstd * gg; }
        }
    }
#undef IN
#undef SEAM
}

#ifndef MK_PER_PHASE
#define MK_PER_PHASE 0
#endif
extern "C" void kernel_launch(void* const* d_in, const int* in_sizes, int n_in, void* d_out, int out_size, void* d_ws, size_t ws_size, hipStream_t stream) {
    static int grid = 0;
    if (grid == 0) {
        if (n_in != 17 || in_sizes[0] != M * D || out_size != M * D || ws_size < WS_END) { fprintf(stderr, "kernel_launch: unexpected shapes / workspace (n_in %d, in0 %d, out %d, ws %zu)\n", n_in, n_in > 0 ? in_sizes[0] : -1, out_size, ws_size); grid = -1; return; }
        int dev = 0, cus = 0, per_cu = 0;
        if (hipGetDevice(&dev) != hipSuccess || hipDeviceGetAttribute(&cus, hipDeviceAttributeMultiprocessorCount, dev) != hipSuccess) { grid = -1; return; }
        if (hipFuncSetAttribute((const void*)fwd_kernel, hipFuncAttributeMaxDynamicSharedMemorySize, LDS_BYTES) != hipSuccess) { fprintf(stderr, "kernel_launch: hipFuncSetAttribute failed\n"); grid = -1; return; }
        if (hipOccupancyMaxActiveBlocksPerMultiprocessor(&per_cu, (const void*)fwd_kernel, NWAVES * 64, LDS_BYTES) != hipSuccess || per_cu < 1) { fprintf(stderr, "kernel_launch: occupancy query says %d\n", per_cu); per_cu = 1; }
        (void)hipGetLastError();
        grid = cus * per_cu;
        fprintf(stderr, "kernel_launch: grid %d (cus %d x %d)\n", grid, cus, per_cu);
    }
    if (grid < 0) return;
    Args a{};
    for (int i = 0; i < 17; ++i) a.in[i] = (const float*)d_in[i];
    a.out = (float*)d_out; a.ws = (unsigned char*)d_ws;
#if MK_PER_PHASE
    for (int p = 0; p < 14; ++p) { a.ph_lo = p; a.ph_hi = p + 1; hipLaunchKernelGGL(fwd_kernel, dim3(grid), dim3(NWAVES * 64), LDS_BYTES, stream, a); }
#else
    a.ph_lo = 0; a.ph_hi = 14;
    if (hipMemsetAsync((char*)d_ws + 8192, 0, XCD_BAR_WORDS * 4, stream) != hipSuccess) { fprintf(stderr, "kernel_launch: memset of the barrier words failed\n"); return; }
    void* kargs[] = {&a};
    hipError_t e = hipLaunchCooperativeKernel((const void*)fwd_kernel, dim3(grid), dim3(NWAVES * 64), kargs, LDS_BYTES, stream);
    if (e != hipSuccess) fprintf(stderr, "cooperative launch failed: %s (grid %d)\n", hipGetErrorString(e), grid);
#endif
}
```

```cpp
#include <hip/hip_runtime.h>
#include <hip/hip_cooperative_groups.h>
#include <hip/hip_bf16.h>
#include <cstdio>
#include <cstdint>
#include <cmath>
namespace cg = cooperative_groups;
namespace pg8 {
#define PG8_LAS __attribute__((address_space(3)))
typedef unsigned short bf16_t;
typedef short bf16x8 __attribute__((ext_vector_type(8)));
typedef float f32x4 __attribute__((ext_vector_type(4)));
typedef unsigned u32x4 __attribute__((ext_vector_type(4)));
constexpr int BM = 256, BK = 64, HALF = 128, HTB = HALF * BK * 2  , STAGE_BYTES = 8 * HTB, NXCD = 8, WGM = 8;

__host__ __device__ __forceinline__ int lds_byte(int r, int c) { const int st = (r >> 4) * 2 + (c >> 5), rr = r & 15, cc = c & 31, ob = rr * 64 + cc * 2; return st * 1024 + (ob ^ (((ob >> 9) & 1) << 5)); }
__host__ __device__ __forceinline__ void stage_rc(int b, int& R, int& C) { const int st = b / 1024, sb = b % 1024, swz = sb ^ (((sb >> 9) & 1) << 5); R = (st >> 1) * 16 + swz / 64; C = (st & 1) * 32 + (swz % 64) / 2; }
__host__ __device__ __forceinline__ int perm32(int rho) { const int n = rho >> 4, i = rho & 15; return 8 * (i >> 2) + 4 * n + (i & 3); }

struct Unit { int pm, pn; };
struct Gemm { const bf16_t* A; const bf16_t* Bt; int M, N, K; };

struct StaticOrder {
    int nM, nN, nwg, G, c, rep = 1;
    __host__ __device__ void init(int M, int N, int G_, int c_) { nM = M / BM; nN = N / BM; nwg = nM * nN; G = G_; c = c_; }
    __host__ __device__ bool next(int i, Unit& u) const {
        const long L = (long)i * G + c; if (L >= (long)nwg * rep) return false;
        int wgid = (int)(L % nwg); { const int q = nwg / NXCD, r = nwg % NXCD, xcd = wgid % NXCD, off = wgid / NXCD; wgid = (xcd < r ? xcd * (q + 1) : r * (q + 1) + (xcd - r) * q) + off; }
        const int nig = WGM * nN, gid = wgid / nig, fm = gid * WGM, gsz = (nM - fm) < WGM ? (nM - fm) : WGM;
        u.pm = fm + ((wgid % nig) % gsz); u.pn = (wgid % nig) / gsz; return true;
    }
    __device__ __forceinline__ void a_ready(const Unit&) const {}
    __device__ __forceinline__ void done(const Unit&) const {}
};
__device__ __forceinline__ unsigned cvt_pk_bf16(float lo, float hi) { unsigned r; asm volatile("v_cvt_pk_bf16_f32 %0, %1, %2" : "=v"(r) : "v"(lo), "v"(hi)); return r; }
constexpr float NORM_EPS = 1e-6f;
template <int ACT> struct EpiScale {
    static constexpr bool PERM = true, AFTER_DRAIN = false;
    bf16_t* O; int ldc; const float* part; float inv_dim; int nq_tiles; float qscale; int hm = 0;
    __device__ __forceinline__ void operator()(const f32x4 (&acc)[2][2][4][2], const Unit& u, int wr, int wc, int fr, int fq) const {
        const int row0 = u.pm * BM + wr * 64 + fr; const int col0 = u.pn * BM + wc * 32 + 8 * fq;
        const float sc = (u.pn < nq_tiles) ? qscale : 1.f;
#pragma unroll
        for (int ai = 0; ai < 2; ++ai)
#pragma unroll
            for (int m = 0; m < 4; ++m) { const int row = row0 + ai * HALF + m * 16; float rs = 1.f;
                if (part) { const f32x4* pp = (const f32x4*)(part + (size_t)row * 16); const f32x4 a = pp[0], b = pp[1], c = pp[2], d = pp[3];
                    const float s = ((a[0] + a[1]) + (a[2] + a[3])) + ((b[0] + b[1]) + (b[2] + b[3])) + ((c[0] + c[1]) + (c[2] + c[3])) + ((d[0] + d[1]) + (d[2] + d[3]));
                    rs = 1.0f / sqrtf(s * inv_dim + NORM_EPS); }
                if (ACT == 0) rs *= sc;
                bf16_t* rowp = hm ? O + ((size_t)(col0 >> 6) * hm + row) * 64 + (col0 & 63) : O + (size_t)row * ldc + col0;
#pragma unroll
                for (int bj = 0; bj < 2; ++bj) { f32x4 v0 = acc[ai][bj][m][0] * rs, v1 = acc[ai][bj][m][1] * rs;
                    if (ACT == 1) {
#pragma unroll
                        for (int e = 0; e < 4; ++e) { float a = fmaxf(v0[e], 0.f), b = fmaxf(v1[e], 0.f); v0[e] = a * a; v1[e] = b * b; } }
                    u32x4 w; w.x = cvt_pk_bf16(v0[0], v0[1]); w.y = cvt_pk_bf16(v0[2], v0[3]); w.z = cvt_pk_bf16(v1[0], v1[1]); w.w = cvt_pk_bf16(v1[2], v1[3]);
                    *(u32x4*)(rowp + (hm ? (size_t)bj * 2 * hm * 64 : (size_t)(bj * HALF))) = w; } }
    }
};
struct EpiIn {
    static constexpr bool PERM = true, AFTER_DRAIN = false;
    const float* part0; bf16_t *QA, *KA, *VA, *CQ, *CKV, *KR; float *pcq, *pckv; const float *gq, *gk, *tac, *tas, *tbc, *tbs; float qscale;
    __device__ __forceinline__ void st16(bf16_t* p, const f32x4 a, const f32x4 b) const { u32x4 w; w.x = cvt_pk_bf16(a[0], a[1]); w.y = cvt_pk_bf16(a[2], a[3]); w.z = cvt_pk_bf16(b[0], b[1]); w.w = cvt_pk_bf16(b[2], b[3]); *(u32x4*)p = w; }
    __device__ __forceinline__ float sq8(const f32x4 a, const f32x4 b) const { return (a[0] * a[0] + a[1] * a[1]) + (a[2] * a[2] + a[3] * a[3]) + (b[0] * b[0] + b[1] * b[1]) + (b[2] * b[2] + b[3] * b[3]); }
    __device__ __forceinline__ void operator()(const f32x4 (&acc)[2][2][4][2], const Unit& u, int wr, int wc, int fr, int fq) const {
        const int row0 = u.pm * BM + wr * 64 + fr; const int pn = u.pn;
#pragma unroll
        for (int ai = 0; ai < 2; ++ai)
#pragma unroll
            for (int m = 0; m < 4; ++m) { const int row = row0 + ai * HALF + m * 16;
                const float rsx = 1.0f / sqrtf(part0[(size_t)row * 16] * (1.0f / 1024.0f) + NORM_EPS);
                const int t = row & 8191; const int prow = t >> 6, pcol = t & 63;
                f32x4 z[2][2];
#pragma unroll
                for (int bj = 0; bj < 2; ++bj)
#pragma unroll
                    for (int n = 0; n < 2; ++n) z[bj][n] = acc[ai][bj][m][n] * rsx;
                if (pn <= 2) {
                    if (pn == 2 && wc >= 2) {
#pragma unroll
                        for (int bj = 0; bj < 2; ++bj) st16(VA + (size_t)row * 128 + (wc - 2) * 64 + 32 * bj + 8 * fq, z[bj][0], z[bj][1]);
                    } else {
                        float ss = sq8(z[0][0], z[0][1]) + sq8(z[1][0], z[1][1]);
                        ss += __shfl_xor(ss, 16); ss += __shfl_xor(ss, 32);
                        const float hr = 1.0f / sqrtf(ss * (1.0f / 64.0f) + NORM_EPS);
                        const float* gain = (pn == 2) ? gk : gq; const float sc = (pn == 2) ? 1.f : qscale;
                        bf16_t* dst = (pn == 2) ? KA + (size_t)row * 128 + wc * 64 : QA + (size_t)row * 512 + (4 * pn + wc) * 64;
#pragma unroll
                        for (int bj = 0; bj < 2; ++bj) { const int pos = bj ? pcol : prow; f32x4 o2[2];
#pragma unroll
                            for (int n = 0; n < 2; ++n) { const int ti = pos * 16 + 8 * (fq & 1) + 4 * n;
                                const f32x4 c4 = *(const f32x4*)(tac + ti), s4 = *(const f32x4*)(tas + ti), g4 = *(const f32x4*)(gain + 32 * bj + 8 * fq + 4 * n);
#pragma unroll
                                for (int e = 0; e < 4; ++e) { const float y = z[bj][n][e] * hr * g4[e]; const float py = __shfl_xor(y, 32);
                                    o2[n][e] = (((fq & 2) == 0) ? y * c4[e] - py * s4[e] : y * c4[e] + py * s4[e]) * sc; } }
                            st16(dst + 32 * bj + 8 * fq, o2[0], o2[1]); }
                    }
                } else if (pn == 3) {
#pragma unroll
                    for (int bj = 0; bj < 2; ++bj) st16(CQ + (size_t)row * 384 + 128 * bj + 32 * wc + 8 * fq, z[bj][0], z[bj][1]);
                    float ss = sq8(z[0][0], z[0][1]) + sq8(z[1][0], z[1][1]); ss += __shfl_xor(ss, 16); ss += __shfl_xor(ss, 32);
                    if (fq == 0) { pcq[(size_t)row * 16 + wc] = ss; pcq[(size_t)row * 16 + 8 + wc] = 0.f; }
                } else if (pn == 4) {
                    st16(CQ + (size_t)row * 384 + 256 + 32 * wc + 8 * fq, z[0][0], z[0][1]);
                    st16(CKV + (size_t)row * 256 + 32 * wc + 8 * fq, z[1][0], z[1][1]);
                    float s0 = sq8(z[0][0], z[0][1]), s1 = sq8(z[1][0], z[1][1]); s0 += __shfl_xor(s0, 16); s0 += __shfl_xor(s0, 32); s1 += __shfl_xor(s1, 16); s1 += __shfl_xor(s1, 32);
                    if (fq == 0) { pcq[(size_t)row * 16 + 4 + wc] = s0; pcq[(size_t)row * 16 + 12 + wc] = 0.f; pckv[(size_t)row * 16 + wc] = s1; }
                } else {
                    st16(CKV + (size_t)row * 256 + 128 + 32 * wc + 8 * fq, z[0][0], z[0][1]);
                    float s0 = sq8(z[0][0], z[0][1]); s0 += __shfl_xor(s0, 16); s0 += __shfl_xor(s0, 32);
                    if (fq == 0) { pckv[(size_t)row * 16 + 4 + wc] = s0; pckv[(size_t)row * 16 + 8 + wc] = 0.f; pckv[(size_t)row * 16 + 12 + wc] = 0.f; }
                    if (wc == 0) {
                        const int pos = (fq < 2) ? prow : pcol; f32x4 o2[2];
#pragma unroll
                        for (int n = 0; n < 2; ++n) { const f32x4 c4 = *(const f32x4*)(tbc + pos * 8 + 4 * n), s4 = *(const f32x4*)(tbs + pos * 8 + 4 * n);
#pragma unroll
                            for (int e = 0; e < 4; ++e) { const float y = z[1][n][e]; const float py = __shfl_xor(y, 16);
                                o2[n][e] = ((fq & 1) == 0) ? y * c4[e] - py * s4[e] : y * c4[e] + py * s4[e]; } }
                        st16(KR + (size_t)row * 32 + 8 * fq, o2[0], o2[1]);
                    }
                }
            }
    }
};

struct EpiRes {
    static constexpr bool PERM = true, AFTER_DRAIN = false;
    const float* base; float* out; bf16_t* ob; float* part; int ldc;
    __device__ __forceinline__ void operator()(const f32x4 (&acc)[2][2][4][2], const Unit& u, int wr, int wc, int fr, int fq) const {
        const int row0 = u.pm * BM + wr * 64 + fr; const int col0 = u.pn * BM + wc * 32 + 8 * fq;
#pragma unroll
        for (int ai = 0; ai < 2; ++ai)
#pragma unroll
            for (int m = 0; m < 4; ++m) { const int row = row0 + ai * HALF + m * 16; const size_t off = (size_t)row * ldc + col0; float ss = 0.f;
#pragma unroll
                for (int bj = 0; bj < 2; ++bj) { const f32x4 b0 = *(const f32x4*)(base + off + bj * HALF), b1 = *(const f32x4*)(base + off + bj * HALF + 4);
                    const f32x4 v0 = acc[ai][bj][m][0] + b0, v1 = acc[ai][bj][m][1] + b1;
                    *(f32x4*)(out + off + bj * HALF) = v0; *(f32x4*)(out + off + bj * HALF + 4) = v1;
                    u32x4 w; w.x = cvt_pk_bf16(v0[0], v0[1]); w.y = cvt_pk_bf16(v0[2], v0[3]); w.z = cvt_pk_bf16(v1[0], v1[1]); w.w = cvt_pk_bf16(v1[2], v1[3]);
                    if (ob) *(u32x4*)(ob + off + bj * HALF) = w;
                    ss += (v0[0] * v0[0] + v0[1] * v0[1]) + (v0[2] * v0[2] + v0[3] * v0[3]) + (v1[0] * v1[0] + v1[1] * v1[1]) + (v1[2] * v1[2] + v1[3] * v1[3]); }
                ss += __shfl_xor(ss, 16); ss += __shfl_xor(ss, 32);
                if (fq == 0) part[(size_t)row * 16 + u.pn * 4 + wc] = ss; }
    }
};

template <class Epi, class Sched, bool ALIGN_EPI = false, bool SP2 = false>
__device__ __forceinline__ void gemm_phase(PG8_LAS unsigned char* lds, const Gemm g, const Sched& S, const Epi& E) {
    const int tid = threadIdx.x, wid = __builtin_amdgcn_readfirstlane(tid >> 6), lane = tid & 63, wr = wid >> 2, wc = wid & 3, fr = lane & 15, fq = lane >> 4;
    const int K = g.K, nt = K / BK;
    unsigned voffA[2], voffB[2];
#pragma unroll
    for (int i = 0; i < 2; ++i) { int R, C; stage_rc(tid * 16 + i * 8192, R, C); const int Rb = Epi::PERM ? ((R & ~31) + perm32(R & 31)) : R;
        voffA[i] = (unsigned)(R * K + C) * 2u; voffB[i] = (unsigned)(Rb * K + C) * 2u; }
    const size_t kstep = (size_t)(BK * 2);
    const size_t hstep = (size_t)HALF * K * 2;
    const size_t tstep = 2 * hstep;
    const unsigned ldsw = (unsigned)wid * 1024u;
    const int aoff = lds_byte(wr * 64 + fr, fq * 8), boff = lds_byte(wc * 32 + fr, fq * 8);
#define PG8_SA(b, h) (((b) * 2 + (h)) * HTB)
#define PG8_SB(b, h) ((4 + (b) * 2 + (h)) * HTB)
#define PG8_STAGE(bufoff, gbase, voff) do { _Pragma("unroll") for (int _i = 0; _i < 2; ++_i) \
        __builtin_amdgcn_global_load_lds((const unsigned*)((const char*)(gbase) + (voff)[_i]), (PG8_LAS unsigned*)(lds + (bufoff) + ldsw + _i * 8192), 16, 0, 0); } while (0)
#define PG8_LDA(dst, b, h) do { _Pragma("unroll") for (int m = 0; m < 4; ++m) _Pragma("unroll") for (int k = 0; k < 2; ++k) dst[m][k] = *(const PG8_LAS bf16x8*)(lds + PG8_SA(b, h) + aoff + m * 2048 + k * 1024); } while (0)
#define PG8_LDB(dst, b, h) do { _Pragma("unroll") for (int n = 0; n < 2; ++n) _Pragma("unroll") for (int k = 0; k < 2; ++k) dst[n][k] = *(const PG8_LAS bf16x8*)(lds + PG8_SB(b, h) + boff + n * 2048 + k * 1024); } while (0)
#define PG8_MMA(ai, bj, At, Bt) do { __builtin_amdgcn_s_setprio(1); _Pragma("unroll") for (int m = 0; m < 4; ++m) _Pragma("unroll") for (int n = 0; n < 2; ++n) _Pragma("unroll") for (int k = 0; k < 2; ++k) \
        acc[ai][bj][m][n] = __builtin_amdgcn_mfma_f32_16x16x32_bf16(Bt[n][k], At[m][k], acc[ai][bj][m][n], 0, 0, 0); __builtin_amdgcn_s_setprio(0); } while (0)
#define PG8_WAIT_V(n) asm volatile("s_waitcnt vmcnt(" #n ")" ::: "memory")
#define PG8_WAIT_L(n) asm volatile("s_waitcnt lgkmcnt(" #n ")" ::: "memory")
#define PG8_BAR __builtin_amdgcn_s_barrier()
#define PG8_SCHED __builtin_amdgcn_sched_barrier(0)
    Unit cur, nxt; int ui = 0;
    if (!S.next(0, cur)) return;
    f32x4 acc[2][2][4][2];
#pragma unroll
    for (int a = 0; a < 2; ++a)
#pragma unroll
        for (int b = 0; b < 2; ++b)
#pragma unroll
            for (int m = 0; m < 4; ++m)
#pragma unroll
                for (int n = 0; n < 2; ++n) acc[a][b][m][n] = (f32x4){0.f, 0.f, 0.f, 0.f};
    bf16x8 At[4][2], B0[2][2], B1[2][2];
    const char* cA = (const char*)g.A + (size_t)cur.pm * tstep; const char* cB = (const char*)g.Bt + (size_t)cur.pn * tstep;
    S.a_ready(cur);
    if constexpr (SP2) {
        PG8_STAGE(PG8_SB(0, 0), cB, voffB); PG8_STAGE(PG8_SB(0, 1), cB + hstep, voffB); PG8_STAGE(PG8_SA(0, 0), cA, voffA); PG8_STAGE(PG8_SA(0, 1), cA + hstep, voffA);
        if (wr == 1) PG8_BAR;
        PG8_WAIT_V(2); PG8_BAR;
        PG8_STAGE(PG8_SB(1, 0), cB + kstep, voffB); PG8_STAGE(PG8_SA(1, 0), cA + kstep, voffA); PG8_STAGE(PG8_SB(1, 1), cB + hstep + kstep, voffB);
        PG8_WAIT_V(6); PG8_BAR;
    } else {
        PG8_STAGE(PG8_SB(0, 0), cB, voffB); PG8_STAGE(PG8_SA(0, 0), cA, voffA); PG8_STAGE(PG8_SB(0, 1), cB + hstep, voffB); PG8_STAGE(PG8_SA(0, 1), cA + hstep, voffA);
        if (wr == 1) PG8_BAR;
        PG8_WAIT_V(4); PG8_BAR;
        PG8_STAGE(PG8_SB(1, 0), cB + kstep, voffB); PG8_STAGE(PG8_SA(1, 0), cA + kstep, voffA); PG8_STAGE(PG8_SB(1, 1), cB + hstep + kstep, voffB);
        PG8_WAIT_V(6); PG8_BAR;
    }
    for (;;) {
        const bool has_next = S.next(ui + 1, nxt);
        const char* nA = has_next ? (const char*)g.A + (size_t)nxt.pm * tstep : cA; const char* nB = has_next ? (const char*)g.Bt + (size_t)nxt.pn * tstep : cB;
        for (int t = 0; t < nt; t += 2) {
            const bool last = (t == nt - 2);
            const char* a1 = cA + (size_t)(t + 1) * kstep;
            const char* a2 = last ? nA : cA + (size_t)(t + 2) * kstep; const char* b2 = last ? nB : cB + (size_t)(t + 2) * kstep;
            const char* a3 = a2 + kstep; const char* b3 = b2 + kstep;
            if (last && has_next) S.a_ready(nxt);
            if constexpr (SP2) {
            PG8_LDB(B0, 0, 0); PG8_LDB(B1, 0, 1); PG8_SCHED; PG8_LDA(At, 0, 0); PG8_STAGE(PG8_SA(1, 1), a1 + hstep, voffA);
            PG8_WAIT_V(8); PG8_WAIT_L(0); PG8_BAR; PG8_MMA(0, 0, At, B0); PG8_MMA(0, 1, At, B1); PG8_BAR; PG8_SCHED;
            PG8_LDA(At, 0, 1); PG8_STAGE(PG8_SB(0, 0), b2, voffB); PG8_STAGE(PG8_SB(0, 1), b2 + hstep, voffB); PG8_STAGE(PG8_SA(0, 0), a2, voffA);
            PG8_WAIT_V(8); PG8_WAIT_L(0); PG8_BAR; PG8_MMA(1, 0, At, B0); PG8_MMA(1, 1, At, B1); PG8_BAR; PG8_SCHED;
            PG8_LDB(B0, 1, 0); PG8_LDB(B1, 1, 1); PG8_SCHED; PG8_LDA(At, 1, 0); PG8_STAGE(PG8_SA(0, 1), a2 + hstep, voffA);
            PG8_WAIT_V(8); PG8_WAIT_L(0); PG8_BAR; PG8_MMA(0, 0, At, B0); PG8_MMA(0, 1, At, B1); PG8_BAR; PG8_SCHED;
            PG8_LDA(At, 1, 1); PG8_STAGE(PG8_SB(1, 0), b3, voffB); PG8_STAGE(PG8_SB(1, 1), b3 + hstep, voffB); PG8_STAGE(PG8_SA(1, 0), a3, voffA);
            PG8_WAIT_V(8); PG8_WAIT_L(0); PG8_BAR; PG8_MMA(1, 0, At, B0); PG8_MMA(1, 1, At, B1); PG8_BAR; PG8_SCHED;
            } else {
            PG8_LDB(B0, 0, 0); PG8_SCHED; PG8_LDA(At, 0, 0); PG8_STAGE(PG8_SA(1, 1), a1 + hstep, voffA);
            PG8_WAIT_L(8); PG8_BAR; PG8_WAIT_L(0); PG8_MMA(0, 0, At, B0); PG8_BAR; PG8_SCHED;
            PG8_LDB(B1, 0, 1); PG8_STAGE(PG8_SB(0, 0), b2, voffB);
            PG8_BAR; PG8_WAIT_L(0); PG8_MMA(0, 1, At, B1); PG8_BAR;
            PG8_LDA(At, 0, 1); PG8_STAGE(PG8_SA(0, 0), a2, voffA);
            PG8_BAR; PG8_WAIT_L(0); PG8_MMA(1, 0, At, B0); PG8_BAR; PG8_SCHED;
            PG8_STAGE(PG8_SB(0, 1), b2 + hstep, voffB);
            PG8_WAIT_V(6); PG8_BAR; PG8_MMA(1, 1, At, B1); PG8_BAR;
            PG8_LDB(B0, 1, 0); PG8_SCHED; PG8_LDA(At, 1, 0); PG8_STAGE(PG8_SA(0, 1), a2 + hstep, voffA);
            PG8_WAIT_L(8); PG8_BAR; PG8_WAIT_L(0); PG8_MMA(0, 0, At, B0); PG8_BAR; PG8_SCHED;
            PG8_LDB(B1, 1, 1); PG8_STAGE(PG8_SB(1, 0), b3, voffB);
            PG8_BAR; PG8_WAIT_L(0); PG8_MMA(0, 1, At, B1); PG8_BAR;
            PG8_LDA(At, 1, 1); PG8_STAGE(PG8_SA(1, 0), a3, voffA);
            PG8_BAR; PG8_WAIT_L(0); PG8_MMA(1, 0, At, B0); PG8_BAR; PG8_SCHED;
            PG8_STAGE(PG8_SB(1, 1), b3 + hstep, voffB);
            PG8_WAIT_V(6); PG8_BAR; PG8_MMA(1, 1, At, B1); PG8_BAR;
            }
        }
        if constexpr (ALIGN_EPI) { if (wr == 0) PG8_BAR; }
        if constexpr (!Epi::AFTER_DRAIN) { E(acc, cur, wr, wc, fr, fq); S.done(cur); }
        if (!has_next) break;
#pragma unroll
        for (int a = 0; a < 2; ++a)
#pragma unroll
            for (int b = 0; b < 2; ++b)
#pragma unroll
                for (int m = 0; m < 4; ++m)
#pragma unroll
                    for (int n = 0; n < 2; ++n) acc[a][b][m][n] = (f32x4){0.f, 0.f, 0.f, 0.f};
        cur = nxt; cA = nA; cB = nB; ++ui;
        if constexpr (ALIGN_EPI) { if (wr == 1) PG8_BAR; }
    }
    PG8_WAIT_V(0);
    if constexpr (!ALIGN_EPI) { if (wr == 0) PG8_BAR; }
    PG8_BAR;
    if constexpr (Epi::AFTER_DRAIN) { E.fused(acc, cur, wr, wc, fr, fq, lds, wid, lane); S.done(cur); }
#undef PG8_SA
#undef PG8_SB
#undef PG8_STAGE
#undef PG8_LDA
#undef PG8_LDB
#undef PG8_MMA
#undef PG8_WAIT_V
#undef PG8_WAIT_L
#undef PG8_BAR
#undef PG8_SCHED
}
}
namespace att {
using bf16x8 = __attribute__((ext_vector_type(8))) short;
using s16x4 = __attribute__((ext_vector_type(4))) short;
using f32x16 = __attribute__((ext_vector_type(16))) float;
using u32x4 = __attribute__((ext_vector_type(4))) unsigned;
typedef unsigned short bf16_t;
#define ALAS __attribute__((address_space(3)))
constexpr int KSLOT = 12288, VSLOT = 8192;
constexpr int NSLOT = 4;
constexpr int L_K = 0, L_V = NSLOT * KSLOT, L_WS = L_V + NSLOT * VSLOT, L_OST = L_WS + 8 * 64 * 4, L_RPB = L_OST + 8 * 4096, L_END = L_RPB + 2048;
constexpr float THR = 8.f;
constexpr float LOG2E = 1.4426950408889634f;
struct Desc { const bf16_t *Q0, *Q1, *K0, *K1, *V; bf16_t* O; int q0p, q1p, k0p, k1p, vp, op; };
struct Next { const bf16_t *K0, *K1, *V; int k0p, k1p, vp; long rowbase; int tlo, thi, dqk; };

__device__ __forceinline__ int crow(int r, int hi) { return (r & 3) + 8 * (r >> 2) + 4 * hi; }
typedef float f32x2_t __attribute__((ext_vector_type(2))); typedef __bf16 bf16x2_t __attribute__((ext_vector_type(2)));
__device__ __forceinline__ unsigned cvtpk_s(float lo, float hi) { f32x2_t v = {lo, hi}; bf16x2_t b = __builtin_convertvector(v, bf16x2_t); return __builtin_bit_cast(unsigned, b); }
__device__ __forceinline__ float bf2f(short s) { return __uint_as_float(((unsigned)(unsigned short)s) << 16); }
typedef short v4i16_t __attribute__((ext_vector_type(4)));
__device__ __forceinline__ s16x4 vtr(const ALAS unsigned char* p) { return __builtin_bit_cast(s16x4, __builtin_amdgcn_ds_read_tr16_b64_v4i16((ALAS v4i16_t*)p)); }
__device__ __forceinline__ void dma16(const void* g, ALAS unsigned char* l) { unsigned keep; const unsigned dst = (unsigned)__builtin_amdgcn_readfirstlane((int)(unsigned)(uintptr_t)l);
    asm volatile("s_mov_b32 %0, m0\n\ts_mov_b32 m0, %2\n\ts_nop 0\n\tglobal_load_lds_dwordx4 %1, off\n\ts_mov_b32 m0, %0" : "=&s"(keep) : "v"(g), "s"(dst) : "memory"); }
__device__ __forceinline__ float xhalf_max(float m) { auto rr = __builtin_amdgcn_permlane32_swap(__float_as_uint(m), __float_as_uint(m), false, false); return fmaxf(__uint_as_float(rr[0]), __uint_as_float(rr[1])); }
__device__ __forceinline__ float xhalf_sum(float m) { auto rr = __builtin_amdgcn_permlane32_swap(__float_as_uint(m), __float_as_uint(m), false, false); return __uint_as_float(rr[0]) + __uint_as_float(rr[1]); }
__device__ __forceinline__ void sincos_acc(float x, float& s, float& c) {
    const float k = rintf(x * 0.6366197723675814f);
    float r = fmaf(-k, 1.5707962513e+00f, x); r = fmaf(-k, 7.5497894159e-08f, r); r = fmaf(-k, 5.3903029534e-15f, r);
    const int q = ((int)k) & 3; const float r2 = r * r;
    const float sp = r + r * r2 * (-1.6666654611e-1f + r2 * (8.3321608736e-3f + r2 * (-1.9515295891e-4f)));
    const float cp = 1.f + r2 * (-0.5f + r2 * (4.166664568298827e-2f + r2 * (-1.388731625493765e-3f + r2 * 2.443315711809948e-5f)));
    const float s0 = (q & 1) ? cp : sp, c0 = (q & 1) ? sp : cp;
    s = (q & 2) ? -s0 : s0; c = ((q + 1) & 2) ? -c0 : c0;
}

template <int DQK, int MODE, int HALF = -1>
__device__ __forceinline__ void unit(const Desc& d, long rowbase, int q0, int tlo, int thi, const float* rpb_h, ALAS unsigned char* shm, bool pre, bool has_next, const Next& nx) {
    constexpr int ND = DQK / 16;
#define N0(r) ((HALF != 1) || (r) >= 12)
#define N1(r) ((HALF != 0) || (r) < 4)
#define NKG(kg) ((kg) == 0 ? (HALF != 1) : (kg) == 3 ? (HALF != 0) : true)
    const int tid = threadIdx.x, lane = tid & 63, r32 = lane & 31, hi = lane >> 5;
    const int wid = __builtin_amdgcn_readfirstlane(tid >> 6);
    ALAS float* wsf = (ALAS float*)(shm + L_WS) + wid * 64;
    ALAS float* rpbs = (ALAS float*)(shm + L_RPB);
    const bf16_t* ksrc0 = d.K0 + (rowbase + lane) * (long)d.k0p + wid * 8;
    const bf16_t* ksrc1 = d.K1 + (rowbase + lane) * (long)d.k1p + (wid & 3) * 8;
    const bf16_t* vsrc = d.V + (rowbase + 16 * (wid & 3) + (lane >> 2)) * (long)d.vp + (wid >> 2) * 32 + (lane & 3) * 8;
#define ATT_ISSUE_K(t, koff) do { \
        dma16(ksrc0 + (long)(t) * 64 * d.k0p, shm + L_K + (koff) + wid * 1024); \
        if (DQK == 96) { dma16(ksrc1 + (long)(t) * 64 * d.k1p, shm + L_K + (koff) + (8 + (wid & 3)) * 1024); } } while (0)
#define ATT_ISSUE_V(t, voff) dma16(vsrc + (long)(t) * 64 * d.vp, shm + L_V + (voff) + wid * 1024)
#define ATT_WAITBAR() asm volatile("s_waitcnt vmcnt(0) lgkmcnt(0)\n\ts_barrier" ::: "memory")
    if (!pre) {
    ATT_ISSUE_K(tlo, 0); ATT_ISSUE_V(tlo, 0);
    if (tlo + 1 <= thi) { ATT_ISSUE_K(tlo + 1, KSLOT); ATT_ISSUE_V(tlo + 1, VSLOT); }
    if (tlo + 2 <= thi) { ATT_ISSUE_K(tlo + 2, 2 * KSLOT); ATT_ISSUE_V(tlo + 2, 2 * VSLOT); }
    }
    const int tq = q0 + wid * 32 + r32;
    if (MODE == 1) { for (int i = tid; i < 15 * 32; i += 512) { const int dr = i >> 5, j = i & 31; rpbs[i] = (j < 31) ? rpb_h[dr * 31 + j] * LOG2E : -INFINITY; } }
    bf16x8 qr[ND];
    { const bf16_t* qp = d.Q0 + (rowbase + tq) * (long)d.q0p + hi * 8;
#pragma unroll
      for (int d0 = 0; d0 < 4; ++d0) qr[d0] = *(const bf16x8*)(qp + d0 * 16); }
    if constexpr (DQK == 96) {
        const bf16_t* qp = d.Q1 + (rowbase + tq) * (long)d.q1p + hi * 8;
#pragma unroll
        for (int dd = 0; dd < 2; ++dd) {
            const bf16x8 raw = *(const bf16x8*)(qp + dd * 16); const u32x4 w = __builtin_bit_cast(u32x4, raw); u32x4 pw;
#pragma unroll
            for (int j = 0; j < 4; ++j) pw[j] = (unsigned)__shfl_xor((int)w[j], 32);
            const bf16x8 par = __builtin_bit_cast(bf16x8, pw);
            const float pos = (dd == 0) ? (float)(tq >> 6) : (float)(tq & 63);
            float ov[8];
#pragma unroll
            for (int e = 0; e < 8; ++e) { const float inv = exp2f(-(float)e * (13.287712379549449f / 8.0f)); float s, c; sincos_acc(pos * inv, s, c);
                const float x = bf2f(raw[e]), y = bf2f(par[e]); ov[e] = hi == 0 ? x * c - y * s : x * c + y * s; }
            u32x4 o4; o4.x = cvtpk_s(ov[0], ov[1]); o4.y = cvtpk_s(ov[2], ov[3]); o4.z = cvtpk_s(ov[4], ov[5]); o4.w = cvtpk_s(ov[6], ov[7]);
            qr[4 + dd] = __builtin_bit_cast(bf16x8, o4);
        }
    }
    float mhat = 0.f, l_reg = 0.f; f32x16 o[2]; o[0] = f32x16{}; o[1] = f32x16{}; f32x16 negm = f32x16{};
    bool first = true;
    const int qrow = tq >> 6, qc = tq & 63;
    const int wrow = __builtin_amdgcn_readfirstlane(qrow);
    const int rs = min(max(wrow - 4, 0), 120);
    const int cs = min(max(qc - 8, 0), 48);
    unsigned co[32];
    if (MODE == 1) {
#pragma unroll
        for (int r = 0; r < 16; ++r) { const int kc = crow(r, hi), kc1 = kc + 32;
            co[r] = (((unsigned)(kc - cs) < 16u) ? (unsigned)(kc - qc + 15) : 31u) * 4u; co[16 + r] = (((unsigned)(kc1 - cs) < 16u) ? (unsigned)(kc1 - qc + 15) : 31u) * 4u; }
    }
    const unsigned tb_addr = (unsigned)(uintptr_t)(shm + L_RPB);
#define ATT_KRD(KOFF) do { const ALAS unsigned char* ka_ = shm + L_K + (KOFF) + hi * 1024 + r32 * 16; \
        _Pragma("unroll") for (int d0 = 0; d0 < ND; ++d0) { kf[2 * d0] = *(const ALAS bf16x8*)(ka_ + d0 * 2048); kf[2 * d0 + 1] = *(const ALAS bf16x8*)(ka_ + d0 * 2048 + 512); } } while (0)
#define ATT_QK2(P0, P1, d0) do { if ((d0) == 0) { P0 = __builtin_amdgcn_mfma_f32_32x32x16_bf16(kf[0], qr[0], negm, 0, 0, 0); P1 = __builtin_amdgcn_mfma_f32_32x32x16_bf16(kf[1], qr[0], negm, 0, 0, 0); } \
            else { P0 = __builtin_amdgcn_mfma_f32_32x32x16_bf16(kf[2 * (d0)], qr[d0], P0, 0, 0, 0); P1 = __builtin_amdgcn_mfma_f32_32x32x16_bf16(kf[2 * (d0) + 1], qr[d0], P1, 0, 0, 0); } } while (0)
#define ATT_QKM(P0, P1) do { _Pragma("unroll") for (int d0 = 0; d0 < ND; ++d0) ATT_QK2(P0, P1, d0); } while (0)
#define ATT_VRD(VOFF) do { const ALAS unsigned char* va_ = shm + L_V + (VOFF) + ((lane >> 4) & 1) * 32 + (lane & 3) * 8 + (4 * hi + ((lane & 15) >> 2)) * 64; \
        _Pragma("unroll") for (int kg = 0; kg < 4; ++kg) _Pragma("unroll") for (int dh = 0; dh < 2; ++dh) if (NKG(kg)) { \
            vf[(kg * 2 + dh) * 2] = vtr(va_ + dh * 4096 + kg * 1024); vf[(kg * 2 + dh) * 2 + 1] = vtr(va_ + dh * 4096 + kg * 1024 + 512); } } while (0)
#define ATT_VWAIT() do {} while (0)
#define ATT_VF(kg, dh) ((bf16x8){vf[((kg) * 2 + (dh)) * 2][0], vf[((kg) * 2 + (dh)) * 2][1], vf[((kg) * 2 + (dh)) * 2][2], vf[((kg) * 2 + (dh)) * 2][3], vf[((kg) * 2 + (dh)) * 2 + 1][0], vf[((kg) * 2 + (dh)) * 2 + 1][1], vf[((kg) * 2 + (dh)) * 2 + 1][2], vf[((kg) * 2 + (dh)) * 2 + 1][3]})
#define ATT_ACTIVE(t) ((MODE == 0) || ((t) >= rs && (t) <= rs + 7))
    const unsigned kaddr0 = (unsigned)(uintptr_t)(shm + L_K) + hi * 1024 + r32 * 16;
    const unsigned vaddr0 = (unsigned)(uintptr_t)(shm + L_V) + ((lane >> 4) & 1) * 32 + (lane & 3) * 8 + (4 * hi + ((lane & 15) >> 2)) * 64;
    bf16x8 kf[2 * ND]; s16x4 vf[16];
    f32x16 p0 = f32x16{}, p1 = f32x16{};
    u32x4 pw[4] = {};
#define ATT_KEEP_PV() do { asm volatile("" :: "v"(pw[0]), "v"(pw[1]), "v"(pw[2]), "v"(pw[3])); \
        asm volatile("" :: "v"(vf[0]), "v"(vf[1]), "v"(vf[2]), "v"(vf[3]), "v"(vf[4]), "v"(vf[5]), "v"(vf[6]), "v"(vf[7]), "v"(vf[8]), "v"(vf[9]), "v"(vf[10]), "v"(vf[11]), "v"(vf[12]), "v"(vf[13]), "v"(vf[14]), "v"(vf[15])); } while (0)
#define ATT_KEEP_K() do { if constexpr (ND == 4) asm volatile("" :: "v"(kf[0]), "v"(kf[1]), "v"(kf[2]), "v"(kf[3]), "v"(kf[4]), "v"(kf[5]), "v"(kf[6]), "v"(kf[7])); \
        else asm volatile("" :: "v"(kf[0]), "v"(kf[1]), "v"(kf[2]), "v"(kf[3]), "v"(kf[4]), "v"(kf[5]), "v"(kf[6]), "v"(kf[7]), "v"(kf[8 % (2 * ND)]), "v"(kf[9 % (2 * ND)]), "v"(kf[10 % (2 * ND)]), "v"(kf[11 % (2 * ND)])); } while (0)
    ATT_WAITBAR();
    for (int t = tlo; t <= thi; ++t) {
        const int buf = (t - tlo) & 3;
        if (t + 3 <= thi) { ATT_ISSUE_K(t + 3, ((buf + 3) & 3) * KSLOT); ATT_ISSUE_V(t + 3, ((buf + 3) & 3) * VSLOT); }
        const bool act = ATT_ACTIVE(t);
        if (act) { ATT_KRD(buf * KSLOT); ATT_QKM(p0, p1); if (MODE == 0) ATT_VRD(buf * VSLOT); }
        __builtin_amdgcn_sched_barrier(0);
        if (act) {
            if (MODE == 1) {
                float bb[32];
                const ALAS unsigned char* rb = shm + L_RPB + (t - wrow + 7) * 128;
#pragma unroll
                for (int e = 0; e < 16; ++e) { bb[e] = N0(e) ? *(const ALAS float*)(rb + co[e]) : 0.f; bb[16 + e] = N1(e) ? *(const ALAS float*)(rb + co[16 + e]) : 0.f; }
#pragma unroll
                for (int e = 0; e < 16; ++e) { if (N0(e)) p0[e] += bb[e]; if (N1(e)) p1[e] += bb[16 + e]; }
                ATT_VRD(buf * VSLOT);
            }
            float rm0 = -INFINITY, rm1 = -INFINITY;
#pragma unroll
            for (int r = 0; r < 16; r += 2) { if (N0(r)) rm0 = fmaxf(fmaxf(rm0, p0[r]), p0[r + 1]); if (N1(r)) rm1 = fmaxf(fmaxf(rm1, p1[r]), p1[r + 1]); }
            float rm = fmaxf(rm0, rm1);
            rm = xhalf_max(rm);
            if (first || __any(rm > THR)) {
                const float dl = first ? rm : fmaxf(rm, 0.f);
                mhat += dl;
#pragma unroll
                for (int r = 0; r < 16; ++r) { if (N0(r)) p0[r] -= dl; if (N1(r)) p1[r] -= dl; negm[r] = -mhat; }
                if (!first) { const float f = exp2f(-dl); l_reg *= f; if (hi == 0) wsf[r32] = f;
#pragma unroll
                    for (int r = 0; r < 16; ++r) { const float fr_ = wsf[crow(r, hi)]; o[0][r] *= fr_; o[1][r] *= fr_; } }
                first = false;
            }
            float sa0 = 0.f, sa1 = 0.f, sa2 = 0.f, sa3 = 0.f;
#pragma unroll
            for (int r = 0; r < 16; r += 4) { if (N0(r)) { p0[r] = __builtin_amdgcn_exp2f(p0[r]); p0[r + 1] = __builtin_amdgcn_exp2f(p0[r + 1]); p0[r + 2] = __builtin_amdgcn_exp2f(p0[r + 2]); p0[r + 3] = __builtin_amdgcn_exp2f(p0[r + 3]);
                sa0 += p0[r]; sa1 += p0[r + 1]; sa2 += p0[r + 2]; sa3 += p0[r + 3]; } else { p0[r] = 0.f; p0[r + 1] = 0.f; p0[r + 2] = 0.f; p0[r + 3] = 0.f; } }
#pragma unroll
            for (int j = 0; j < 4; ++j) { pw[0][j] = cvtpk_s(p0[2 * j], p0[2 * j + 1]); pw[1][j] = cvtpk_s(p0[8 + 2 * j], p0[8 + 2 * j + 1]); }
            ATT_VWAIT();
#pragma unroll
            for (int kg = 0; kg < 2; ++kg)
#pragma unroll
                for (int dh = 0; dh < 2; ++dh) if (NKG(kg)) o[dh] = __builtin_amdgcn_mfma_f32_32x32x16_bf16(__builtin_bit_cast(bf16x8, pw[kg]), ATT_VF(kg, dh), o[dh], 0, 0, 0);
            __builtin_amdgcn_sched_barrier(0);
#pragma unroll
            for (int r = 0; r < 16; r += 4) { if (N1(r)) { p1[r] = __builtin_amdgcn_exp2f(p1[r]); p1[r + 1] = __builtin_amdgcn_exp2f(p1[r + 1]); p1[r + 2] = __builtin_amdgcn_exp2f(p1[r + 2]); p1[r + 3] = __builtin_amdgcn_exp2f(p1[r + 3]);
                sa0 += p1[r]; sa1 += p1[r + 1]; sa2 += p1[r + 2]; sa3 += p1[r + 3]; } else { p1[r] = 0.f; p1[r + 1] = 0.f; p1[r + 2] = 0.f; p1[r + 3] = 0.f; } }
            l_reg += (sa0 + sa1) + (sa2 + sa3);
#pragma unroll
            for (int j = 0; j < 4; ++j) { pw[2][j] = cvtpk_s(p1[2 * j], p1[2 * j + 1]); pw[3][j] = cvtpk_s(p1[8 + 2 * j], p1[8 + 2 * j + 1]); }
#pragma unroll
            for (int kg = 2; kg < 4; ++kg)
#pragma unroll
                for (int dh = 0; dh < 2; ++dh) if (NKG(kg)) o[dh] = __builtin_amdgcn_mfma_f32_32x32x16_bf16(__builtin_bit_cast(bf16x8, pw[kg]), ATT_VF(kg, dh), o[dh], 0, 0, 0);
        }
        if (t + 3 <= thi) { if constexpr (DQK == 96) asm volatile("s_waitcnt vmcnt(6) lgkmcnt(0)\n\ts_barrier" ::: "memory"); else asm volatile("s_waitcnt vmcnt(4) lgkmcnt(0)\n\ts_barrier" ::: "memory"); }
        else ATT_WAITBAR();
    }
#undef ATT_KEEP_PV
#undef ATT_KEEP_K
#undef ATT_KRD
#undef ATT_QK2
#undef ATT_QKM
#undef ATT_VRD
#undef ATT_VWAIT
#undef ATT_VF
#undef ATT_QK
#undef ATT_ACTIVE
#undef N0
#undef N1
#undef NKG
    if (has_next) {
        const bf16_t* nk0 = nx.K0 + (nx.rowbase + lane) * (long)nx.k0p + wid * 8;
        const bf16_t* nk1 = nx.K1 + (nx.rowbase + lane) * (long)nx.k1p + (wid & 3) * 8;
        const bf16_t* nv = nx.V + (nx.rowbase + 16 * (wid & 3) + (lane >> 2)) * (long)nx.vp + (wid >> 2) * 32 + (lane & 3) * 8;
#pragma unroll
        for (int i = 0; i < 3; ++i) if (nx.tlo + i <= nx.thi) {
            dma16(nk0 + (long)(nx.tlo + i) * 64 * nx.k0p, shm + L_K + i * KSLOT + wid * 1024);
            if (nx.dqk == 96) dma16(nk1 + (long)(nx.tlo + i) * 64 * nx.k1p, shm + L_K + i * KSLOT + (8 + (wid & 3)) * 1024);
            dma16(nv + (long)(nx.tlo + i) * 64 * nx.vp, shm + L_V + i * VSLOT + wid * 1024); }
    }
    l_reg = xhalf_sum(l_reg);
    if (hi == 0) wsf[32 + r32] = l_reg;
    float rli[16];
#pragma unroll
    for (int r = 0; r < 16; ++r) rli[r] = 1.0f / wsf[32 + crow(r, hi)];
    bf16_t* Ow = d.O + (rowbase + q0 + wid * 32) * (long)d.op;
    { ALAS bf16_t* stg = (ALAS bf16_t*)(shm + L_OST) + wid * 2048;
#pragma unroll
      for (int r = 0; r < 16; ++r) { const int orow = crow(r, hi);
#pragma unroll
          for (int dh = 0; dh < 2; ++dh) stg[orow * 64 + dh * 32 + r32] = (bf16_t)(cvtpk_s(o[dh][r] * rli[r], 0.f) & 0xffffu); }
      asm volatile("s_waitcnt lgkmcnt(0)" ::: "memory");
#pragma unroll
      for (int i = 0; i < 4; ++i) { const int row = i * 8 + (lane >> 3), ch = lane & 7; const u32x4 v = *(const ALAS u32x4*)(stg + row * 64 + ch * 8); *(u32x4*)(Ow + (long)row * d.op + ch * 8) = v; } }
    asm volatile("s_waitcnt lgkmcnt(0)\n\ts_barrier" ::: "memory");
#undef ATT_ISSUE_K
#undef ATT_ISSUE_V
#undef ATT_WAITBAR
}
}

namespace attn_ex {
using bf16=__hip_bfloat16;
using bf16x8=__attribute__((ext_vector_type(8)))short;
using s16x4=__attribute__((ext_vector_type(4)))short;
using f32x16=__attribute__((ext_vector_type(16)))float;
using u32x4=__attribute__((ext_vector_type(4)))unsigned;
constexpr int SEQ=8192,D=64;
constexpr int NW=8,QBLK=32,QB=QBLK*NW,KVBLK=64,NQB=SEQ/QB;
constexpr int ATTN_UNIT_ROWS=QB;
__device__ __forceinline__ int crow(int r,int hi){return (r&3)+8*(r>>2)+4*hi;}
#define SBAR() __builtin_amdgcn_sched_barrier(0)
__device__ __forceinline__ void cmask(f32x16&p0,f32x16&p1,int jb,int qrel,int hi){
  const float NEG=-INFINITY; int kb=64*jb+4*hi;
  #pragma unroll
  for(int r=0;r<16;++r){int kv=kb+(r&3)+8*(r>>2); if(kv>qrel)p0[r]=NEG; if(kv+32>qrel)p1[r]=NEG;}
}

constexpr int NSLOT=3, SLOTB=8192;
constexpr int LDS_K=0, LDS_V=NSLOT*SLOTB, LDS_WS=2*NSLOT*SLOTB, LDS_OST=LDS_WS+NW*64*4, LDS_BYTES=LDS_OST+NW*4096;
constexpr float C2=0.125f*1.4426950408889634f;
__device__ __forceinline__ void glds16(const void*gsrc,unsigned lds_dst){unsigned keep;
  asm volatile("s_mov_b32 %0, m0\n\ts_mov_b32 m0, %2\n\ts_nop 0\n\tglobal_load_lds_dwordx4 %1, off\n\ts_mov_b32 m0, %0":"=&s"(keep):"v"(gsrc),"s"(lds_dst):"memory");}
__device__ __forceinline__ float max3f(float a,float b,float c){float r;asm("v_max3_f32 %0, %1, %2, %3":"=v"(r):"v"(a),"v"(b),"v"(c));return r;}
__device__ __forceinline__ float max2f(float a,float b){float r;asm("v_max_f32_e32 %0, %1, %2":"=v"(r):"v"(a),"v"(b));return r;}
__device__ __forceinline__ float fadd_s(float a,float b){float r;asm("v_add_f32_e32 %0, %1, %2":"=v"(r):"v"(a),"v"(b));return r;}
__device__ __forceinline__ float fsub_s(float a,float b){float r;asm("v_sub_f32_e32 %0, %1, %2":"=v"(r):"v"(a),"v"(b));return r;}
typedef float f32x2_t __attribute__((ext_vector_type(2))); typedef __bf16 bf16x2_t __attribute__((ext_vector_type(2)));
__device__ __forceinline__ unsigned cvtpk_s(float lo,float hi){f32x2_t v={lo,hi};bf16x2_t b=__builtin_convertvector(v,bf16x2_t);return __builtin_bit_cast(unsigned,b);}
#define WAIT_BAR(N) asm volatile("s_waitcnt vmcnt(" #N ") lgkmcnt(0)\n\ts_barrier":::"memory")

__device__ __forceinline__ void qkt(f32x16&p0,f32x16&p1,const char*Kslot,const bf16x8*qr,const f32x16&negm,int r32,int hi){
  const char*kb=Kslot+hi*1024+r32*16;
  #pragma unroll
  for(int d0=0;d0<4;++d0){
    const bf16x8 b0=*reinterpret_cast<const bf16x8*>(kb+d0*2048);
    const bf16x8 b1=*reinterpret_cast<const bf16x8*>(kb+d0*2048+512);
    if(d0==0){p0=__builtin_amdgcn_mfma_f32_32x32x16_bf16(b0,qr[0],negm,0,0,0);p1=__builtin_amdgcn_mfma_f32_32x32x16_bf16(b1,qr[0],negm,0,0,0);}
    else{p0=__builtin_amdgcn_mfma_f32_32x32x16_bf16(b0,qr[d0],p0,0,0,0);p1=__builtin_amdgcn_mfma_f32_32x32x16_bf16(b1,qr[d0],p1,0,0,0);}}
}
typedef __attribute__((address_space(3))) const char* lds_cptr;
typedef short v4i16_t __attribute__((ext_vector_type(4)));
__device__ __forceinline__ void kload8(bf16x8*kf,lds_cptr kp){
  kf[0]=*(const __attribute__((address_space(3))) bf16x8*)(kp);      kf[1]=*(const __attribute__((address_space(3))) bf16x8*)(kp+512);
  kf[2]=*(const __attribute__((address_space(3))) bf16x8*)(kp+2048); kf[3]=*(const __attribute__((address_space(3))) bf16x8*)(kp+2560);
  kf[4]=*(const __attribute__((address_space(3))) bf16x8*)(kp+4096); kf[5]=*(const __attribute__((address_space(3))) bf16x8*)(kp+4608);
  kf[6]=*(const __attribute__((address_space(3))) bf16x8*)(kp+6144); kf[7]=*(const __attribute__((address_space(3))) bf16x8*)(kp+6656);
}
__device__ __forceinline__ void kload2(bf16x8*kf,lds_cptr kp,int j){ kf[2*j]=*(const __attribute__((address_space(3))) bf16x8*)(kp+j*2048); kf[2*j+1]=*(const __attribute__((address_space(3))) bf16x8*)(kp+j*2048+512); }
__device__ __forceinline__ s16x4 vtr(lds_cptr p){ return __builtin_bit_cast(s16x4,__builtin_amdgcn_ds_read_tr16_b64_v4i16((__attribute__((address_space(3))) v4i16_t*)p)); }
__device__ __forceinline__ float rowmax(const f32x16&p0,const f32x16&p1){
  float a=max3f(p0[0],p0[1],p1[0]),b=max3f(p0[2],p0[3],p1[1]);a=max3f(a,p1[2],p1[3]);
  #pragma unroll
  for(int r=4;r<16;r+=4){a=max3f(a,p0[r],p0[r+1]);b=max3f(b,p0[r+2],p0[r+3]);a=max3f(a,p1[r],p1[r+1]);b=max3f(b,p1[r+2],p1[r+3]);}
  const float m=max2f(a,b);
  auto rr=__builtin_amdgcn_permlane32_swap(__float_as_uint(m),__float_as_uint(m),false,false);
  return max2f(__uint_as_float(rr[0]),__uint_as_float(rr[1]));
}
__device__ __forceinline__ void pv(f32x16*o,int vb,bf16x8 pa0,bf16x8 pa1,bf16x8 pa2,bf16x8 pa3){
  #pragma unroll
  for(int d0=0;d0<2;++d0){s16x4 lo[4],hi[4];
    #pragma unroll
    for(int ks=0;ks<4;++ks){
      asm volatile("ds_read_b64_tr_b16 %0,%1 offset:%c2":"=&v"(lo[ks]):"v"(vb),"i"(d0*4096+ks*1024):"memory");
      asm volatile("ds_read_b64_tr_b16 %0,%1 offset:%c2":"=&v"(hi[ks]):"v"(vb),"i"(d0*4096+ks*1024+512):"memory");}
    asm volatile("s_waitcnt lgkmcnt(0)":::"memory");SBAR();
    #define PK(k) (bf16x8){lo[k][0],lo[k][1],lo[k][2],lo[k][3],hi[k][0],hi[k][1],hi[k][2],hi[k][3]}
    o[d0]=__builtin_amdgcn_mfma_f32_32x32x16_bf16(pa0,PK(0),o[d0],0,0,0);
    o[d0]=__builtin_amdgcn_mfma_f32_32x32x16_bf16(pa1,PK(1),o[d0],0,0,0);
    o[d0]=__builtin_amdgcn_mfma_f32_32x32x16_bf16(pa2,PK(2),o[d0],0,0,0);
    o[d0]=__builtin_amdgcn_mfma_f32_32x32x16_bf16(pa3,PK(3),o[d0],0,0,0);
    #undef PK
  }
}

#ifndef ATTN_STORE16
#define ATTN_STORE16(p,v) (*(u32x4*)(p)=(v))
#endif
template<int THRL,int QP,int KP,int VP,int OP> __device__ __forceinline__ void attn_unit(const bf16*Qb,const bf16*__restrict__ Kh,const bf16*__restrict__ Vh,bf16*Ob,char*shm){
  const int tid=threadIdx.x,lane=tid&63,r32=lane&31,hi=lane>>5; const int wid=__builtin_amdgcn_readfirstlane(tid>>6);
  const bf16*Qw=Qb+(long)(wid*QBLK)*QP;
  const unsigned lds0=(unsigned)(uintptr_t)shm;
  float*wsf=(float*)(shm+LDS_WS)+wid*64;
  const bf16*ksrc=Kh+(long)lane*KP+wid*8;
  const bf16*vsrc=Vh+(long)(16*(wid&3)+(lane>>2))*VP+(wid>>2)*32+(lane&3)*8;
  const unsigned kdst=lds0+LDS_K+wid*1024, vdst=lds0+LDS_V+wid*1024;
  #define DMA_K(t,slot) glds16(ksrc+(long)(t)*KVBLK*KP,(unsigned)__builtin_amdgcn_readfirstlane(kdst+(slot)))
  #define DMA_V(t,slot) glds16(vsrc+(long)(t)*KVBLK*VP,(unsigned)__builtin_amdgcn_readfirstlane(vdst+(slot)))
  const int vb0=(int)(lds0+LDS_V)+((lane>>4)&1)*32+(lane&3)*8+(4*hi+((lane&15)>>2))*64;
  const char*Kbase=shm+LDS_K; bf16x8 kf[8];
  const lds_cptr shm3=(lds_cptr)shm; const lds_cptr kp0=shm3+LDS_K+hi*1024+r32*16; const lds_cptr vp0=shm3+LDS_V+((lane>>4)&1)*32+(lane&3)*8+(4*hi+((lane&15)>>2))*64;
  constexpr int NT=SEQ/KVBLK;
  DMA_K(0,0);DMA_V(0,0);DMA_K(1,SLOTB);
  bf16x8 qr[4];
  #pragma unroll
  for(int d0=0;d0<4;++d0)qr[d0]=*reinterpret_cast<const bf16x8*>(&Qw[(long)r32*QP+d0*16+hi*8]);
  float mhat=0.f,l_reg=0.f;f32x16 o[2];o[0]=f32x16{};o[1]=f32x16{};f32x16 negm=f32x16{};asm volatile("":"+v"(negm));
  #define CMASK(P0,P1,t) do{}while(0)
  bool resc=false;
  #define START(P0,P1) do{ const float rm=rowmax(P0,P1); resc=false; \
    { const float dl=rm; mhat=fadd_s(mhat,dl); \
      _Pragma("unroll") for(int r=0;r<16;++r){P0[r]=fsub_s(P0[r],dl);P1[r]=fsub_s(P1[r],dl);} \
      _Pragma("unroll") for(int r=0;r<16;++r)negm[r]=-mhat; asm volatile("":"+v"(negm)); } \
    _Pragma("unroll") for(int r=0;r<16;++r)P0[r]=__builtin_amdgcn_exp2f(P0[r]); }while(0)
  #define RESC() do{ if(resc){ asm volatile("s_waitcnt lgkmcnt(0)":::"memory"); \
      _Pragma("unroll") for(int d_=0;d_<2;++d_) _Pragma("unroll") for(int r=0;r<16;++r)o[d_][r]*=wsf[crow(r,hi)]; } }while(0)
  f32x16 pA0,pA1,pB0,pB1;
  int sl_prev=0,sl_cur=0,sl_next=SLOTB;
  #define ROT() do{sl_prev=sl_cur;sl_cur=sl_next;sl_next=(sl_next==(NSLOT-1)*SLOTB)?0:sl_next+SLOTB;}while(0)
  DMA_K(2,2*SLOTB);
  WAIT_BAR(3);
  qkt(pA0,pA1,Kbase,qr,negm,r32,hi);asm volatile("s_nop 15\n\ts_nop 7":"+v"(pA0),"+v"(pA1));CMASK(pA0,pA1,0);
  START(pA0,pA1);
  _Pragma("unroll") for(int r=0;r<16;++r)pA1[r]=__builtin_amdgcn_exp2f(pA1[r]);
  WAIT_BAR(0);
  DMA_K(3,0);DMA_V(1,SLOTB);
  ROT();
  kload8(kf,kp0+sl_cur);
  WAIT_BAR(2);
  s16x4 vlo[8],vhi[8]; u32x4 pw0,pw1,pw2,pw3;
  #define PKW(P,B) cvtpk_s(P[B],P[B+1])
  #define PAF(k) __builtin_bit_cast(bf16x8,pw##k)
  #define VFR(i) (bf16x8){vlo[i][0],vlo[i][1],vlo[i][2],vlo[i][3],vhi[i][0],vhi[i][1],vhi[i][2],vhi[i][3]}
  #define PIN(x) asm volatile("":"+v"(x))
  #define MX3(a,b,c) __builtin_fmaxf(__builtin_fmaxf((a),(b)),(c))
  #define GAPA(MF,A0,A1,A2,A3,W0,W1,PW) do{ MF; sacc+=A0; sacc+=A1; sacc+=A2; sacc+=A3; PIN(sacc); W0; W1; PIN(PW); SBAR(); }while(0)
  #define EX(v) __builtin_amdgcn_exp2f(v)
  #define GAPB(MF,X,B) do{ MF; X[B]=EX(X[B]); X[B+1]=EX(X[B+1]); X[B+2]=EX(X[B+2]); X[B+3]=EX(X[B+3]); PIN(X); SBAR(); }while(0)
  #define VRD(i) do{ vlo[i]=vtr(vp_+(((i)>>2)*4096+((i)&3)*1024)); vhi[i]=vtr(vp_+(((i)>>2)*4096+((i)&3)*1024+512)); }while(0)
  #define KRD(G,j) do{ if(G){ kload2(kf,kp0+sl_next,j); SBAR(); } }while(0)
  #define STEP(C0,C1,P0,P1,t,GK,GV,GL) do{ SBAR(); \
    const lds_cptr vp_=vp0+sl_prev; \
    VRD(0); SBAR(); float sacc=(P0[0]+P0[1]); \
    GAPA(C0=__builtin_amdgcn_mfma_f32_32x32x16_bf16(kf[0],qr[0],negm,0,0,0), P0[2],P0[3],P0[4],P0[5],     pw0[0]=PKW(P0,0), pw0[1]=PKW(P0,2), pw0); \
    VRD(4); SBAR(); GAPA(C1=__builtin_amdgcn_mfma_f32_32x32x16_bf16(kf[1],qr[0],negm,0,0,0), P0[6],P0[7],P0[8],P0[9],     pw0[2]=PKW(P0,4), pw0[3]=PKW(P0,6), pw0); \
    VRD(1); SBAR(); GAPA(C0=__builtin_amdgcn_mfma_f32_32x32x16_bf16(kf[2],qr[1],C0,0,0,0),   P0[10],P0[11],P0[12],P0[13], pw1[0]=PKW(P0,8), pw1[1]=PKW(P0,10), pw1); \
    VRD(5); SBAR(); GAPA(C1=__builtin_amdgcn_mfma_f32_32x32x16_bf16(kf[3],qr[1],C1,0,0,0),   P0[14],P0[15],P1[0],P1[1],   pw1[2]=PKW(P0,12),pw1[3]=PKW(P0,14), pw1); \
    VRD(2); SBAR(); GAPA(C0=__builtin_amdgcn_mfma_f32_32x32x16_bf16(kf[4],qr[2],C0,0,0,0),   P1[2],P1[3],P1[4],P1[5],     pw2[0]=PKW(P1,0), pw2[1]=PKW(P1,2), pw2); \
    VRD(6); SBAR(); GAPA(C1=__builtin_amdgcn_mfma_f32_32x32x16_bf16(kf[5],qr[2],C1,0,0,0),   P1[6],P1[7],P1[8],P1[9],     pw2[2]=PKW(P1,4), pw2[3]=PKW(P1,6), pw2); \
    VRD(3); SBAR(); GAPA(C0=__builtin_amdgcn_mfma_f32_32x32x16_bf16(kf[6],qr[3],C0,0,0,0),   P1[10],P1[11],P1[12],P1[13], pw3[0]=PKW(P1,8), pw3[1]=PKW(P1,10), pw3); \
    VRD(7); SBAR(); GAPA(C1=__builtin_amdgcn_mfma_f32_32x32x16_bf16(kf[7],qr[3],C1,0,0,0),   P1[14],P1[15],0.f,0.f,       pw3[2]=PKW(P1,12),pw3[3]=PKW(P1,14), pw3); \
    l_reg+=sacc; \
    if(GK){DMA_K((t)+3,sl_cur);} if(GV){DMA_V((t)+1,sl_next);} \
    CMASK(C0,C1,t); \
    { float a=MX3(C0[0],C0[1],C1[0]),b=MX3(C0[2],C0[3],C1[1]); a=MX3(a,C1[2],C1[3]); \
      _Pragma("unroll") for(int r=4;r<16;r+=4){a=MX3(a,C0[r],C0[r+1]);b=MX3(b,C0[r+2],C0[r+3]);a=MX3(a,C1[r],C1[r+1]);b=MX3(b,C1[r+2],C1[r+3]);} \
      float rm=__builtin_fmaxf(a,b); { auto rr=__builtin_amdgcn_permlane32_swap(__float_as_uint(rm),__float_as_uint(rm),false,false); rm=__builtin_fmaxf(__uint_as_float(rr[0]),__uint_as_float(rr[1])); } \
      resc=false; \
      if(__builtin_expect(__any(rm>(float)THRL),0)){ const float dl=__builtin_fmaxf(rm,0.f); mhat+=dl; \
        _Pragma("unroll") for(int r=0;r<16;++r){C0[r]-=dl;C1[r]-=dl;} \
        _Pragma("unroll") for(int r=0;r<16;++r)negm[r]=-mhat; asm volatile("":"+v"(negm)); \
        const float f=__builtin_amdgcn_exp2f(-dl); l_reg*=f; if(hi==0)wsf[r32]=f; resc=true; } } \
    SBAR(); \
    GAPB(o[0]=__builtin_amdgcn_mfma_f32_32x32x16_bf16(PAF(0),VFR(0),o[0],0,0,0), C0,0); \
    GAPB(o[1]=__builtin_amdgcn_mfma_f32_32x32x16_bf16(PAF(0),VFR(4),o[1],0,0,0), C0,4); \
    KRD(GL,0); GAPB(o[0]=__builtin_amdgcn_mfma_f32_32x32x16_bf16(PAF(1),VFR(1),o[0],0,0,0), C0,8); \
    KRD(GL,1); GAPB(o[1]=__builtin_amdgcn_mfma_f32_32x32x16_bf16(PAF(1),VFR(5),o[1],0,0,0), C0,12); \
    KRD(GL,2); GAPB(o[0]=__builtin_amdgcn_mfma_f32_32x32x16_bf16(PAF(2),VFR(2),o[0],0,0,0), C1,0); \
    KRD(GL,3); GAPB(o[1]=__builtin_amdgcn_mfma_f32_32x32x16_bf16(PAF(2),VFR(6),o[1],0,0,0), C1,4); \
    GAPB(o[0]=__builtin_amdgcn_mfma_f32_32x32x16_bf16(PAF(3),VFR(3),o[0],0,0,0), C1,8); \
    GAPB(o[1]=__builtin_amdgcn_mfma_f32_32x32x16_bf16(PAF(3),VFR(7),o[1],0,0,0), C1,12); \
    }while(0)
  int t=1;
  #undef CMASK
  #define CMASK(P0,P1,t) do{}while(0)
  for(;t+5<NT;t+=2){
    STEP(pB0,pB1,pA0,pA1,t,true,true,true);     WAIT_BAR(2); RESC(); ROT();
    STEP(pA0,pA1,pB0,pB1,t+1,true,true,true);   WAIT_BAR(2); RESC(); ROT();
  }
  #undef CMASK
  #define CMASK(P0,P1,t) do{}while(0)
  #define ENDW(tt) do{ if((tt)+3<NT){WAIT_BAR(2);} else if((tt)+2<NT){WAIT_BAR(1);} else {WAIT_BAR(0);} }while(0)
  for(;t+1<NT;t+=2){
    STEP(pB0,pB1,pA0,pA1,t,(t+3<NT),(t+1<NT),(t+1<NT));       ENDW(t);   RESC(); ROT();
    STEP(pA0,pA1,pB0,pB1,t+1,(t+4<NT),(t+2<NT),(t+2<NT));     ENDW(t+1); RESC(); ROT();
  }
  STEP(pB0,pB1,pA0,pA1,NT-1,false,false,false); RESC();
  { float sacc=pB0[0]+pB0[1]; _Pragma("unroll") for(int r=2;r<16;++r)sacc+=pB0[r]; _Pragma("unroll") for(int r=0;r<16;++r)sacc+=pB1[r]; l_reg+=sacc;
    pw0=(u32x4){PKW(pB0,0),PKW(pB0,2),PKW(pB0,4),PKW(pB0,6)};pw1=(u32x4){PKW(pB0,8),PKW(pB0,10),PKW(pB0,12),PKW(pB0,14)};pw2=(u32x4){PKW(pB1,0),PKW(pB1,2),PKW(pB1,4),PKW(pB1,6)};pw3=(u32x4){PKW(pB1,8),PKW(pB1,10),PKW(pB1,12),PKW(pB1,14)};
    SBAR(); pv(o,vb0+sl_cur,PAF(0),PAF(1),PAF(2),PAF(3)); }
  #undef PKW
  #undef PAF
  #undef VFR
  #undef PIN
  #undef MX3
  #undef GAPA
  #undef GAPB
  #undef EX
  #undef VRD
  #undef KRD
  #undef STEP
  #undef ENDW
  {auto rr=__builtin_amdgcn_permlane32_swap(__float_as_uint(l_reg),__float_as_uint(l_reg),false,false);l_reg=__uint_as_float(rr[0])+__uint_as_float(rr[1]);}
  if(hi==0)wsf[32+r32]=l_reg;asm volatile("s_waitcnt lgkmcnt(0)":::"memory");
  float rli[16];
  #pragma unroll
  for(int r=0;r<16;++r)rli[r]=__builtin_amdgcn_rcpf(wsf[32+crow(r,hi)]);
  bf16*Ow=Ob+(long)(wid*QBLK)*OP;
  { bf16*stg=(bf16*)(shm+LDS_OST)+wid*2048;
    #pragma unroll
    for(int r=0;r<16;++r){const int orow=crow(r,hi);
      #pragma unroll
      for(int d0=0;d0<2;++d0)stg[orow*64+d0*32+r32]=__float2bfloat16(o[d0][r]*rli[r]);}
    asm volatile("s_waitcnt lgkmcnt(0)":::"memory");
    #pragma unroll
    for(int i=0;i<4;++i){const int row=i*8+(lane>>3),ch=lane&7; const u32x4 v=*(const u32x4*)(stg+row*64+ch*8); ATTN_STORE16(Ow+(long)row*OP+ch*8,v);} }
  asm volatile("s_waitcnt lgkmcnt(0)\n\ts_barrier":::"memory");
  #undef DMA_K
  #undef DMA_V
  #undef CMASK
  #undef START
  #undef RESC
  #undef ROT
}
constexpr int ATTN_LDS_BYTES=LDS_BYTES;
#undef SBAR
#undef WAIT_BAR
}

namespace attn_ex96 {
using bf16=__hip_bfloat16;
using bf16x8=__attribute__((ext_vector_type(8)))short;
using s16x4=__attribute__((ext_vector_type(4)))short;
using f32x16=__attribute__((ext_vector_type(16)))float;
using u32x4=__attribute__((ext_vector_type(4)))unsigned;
constexpr int SEQ=8192,D=64;
constexpr int NW=8,QBLK=32,QB=QBLK*NW,KVBLK=64,NQB=SEQ/QB;
constexpr int ATTN_UNIT_ROWS=QB;
__device__ __forceinline__ int crow(int r,int hi){return (r&3)+8*(r>>2)+4*hi;}
#define SBAR() __builtin_amdgcn_sched_barrier(0)
__device__ __forceinline__ void cmask(f32x16&p0,f32x16&p1,int jb,int qrel,int hi){
  const float NEG=-INFINITY; int kb=64*jb+4*hi;
  #pragma unroll
  for(int r=0;r<16;++r){int kv=kb+(r&3)+8*(r>>2); if(kv>qrel)p0[r]=NEG; if(kv+32>qrel)p1[r]=NEG;}
}

constexpr int NSLOT=3, SLOTB=12288;
constexpr int LDS_K=0, LDS_V=NSLOT*SLOTB, LDS_WS=2*NSLOT*SLOTB, LDS_OST=LDS_WS+NW*64*4, LDS_BYTES=LDS_OST+NW*4096;
constexpr float C2=0.125f*1.4426950408889634f;
__device__ __forceinline__ void glds16(const void*gsrc,unsigned lds_dst){unsigned keep;
  asm volatile("s_mov_b32 %0, m0\n\ts_mov_b32 m0, %2\n\ts_nop 0\n\tglobal_load_lds_dwordx4 %1, off\n\ts_mov_b32 m0, %0":"=&s"(keep):"v"(gsrc),"s"(lds_dst):"memory");}
__device__ __forceinline__ float max3f(float a,float b,float c){float r;asm("v_max3_f32 %0, %1, %2, %3":"=v"(r):"v"(a),"v"(b),"v"(c));return r;}
__device__ __forceinline__ float max2f(float a,float b){float r;asm("v_max_f32_e32 %0, %1, %2":"=v"(r):"v"(a),"v"(b));return r;}
__device__ __forceinline__ float fadd_s(float a,float b){float r;asm("v_add_f32_e32 %0, %1, %2":"=v"(r):"v"(a),"v"(b));return r;}
__device__ __forceinline__ float fsub_s(float a,float b){float r;asm("v_sub_f32_e32 %0, %1, %2":"=v"(r):"v"(a),"v"(b));return r;}
typedef float f32x2_t __attribute__((ext_vector_type(2))); typedef __bf16 bf16x2_t __attribute__((ext_vector_type(2)));
__device__ __forceinline__ unsigned cvtpk_s(float lo,float hi){f32x2_t v={lo,hi};bf16x2_t b=__builtin_convertvector(v,bf16x2_t);return __builtin_bit_cast(unsigned,b);}
#define WAIT_BAR(N) asm volatile("s_waitcnt vmcnt(" #N ") lgkmcnt(0)\n\ts_barrier":::"memory")

__device__ __forceinline__ void qkt(f32x16&p0,f32x16&p1,const char*Kslot,const bf16x8*qr,int r32,int hi){ const f32x16 zero=f32x16{};
  const char*kb=Kslot+hi*1024+r32*16;
  #pragma unroll
  for(int d0=0;d0<6;++d0){
    const bf16x8 b0=*reinterpret_cast<const bf16x8*>(kb+d0*2048);
    const bf16x8 b1=*reinterpret_cast<const bf16x8*>(kb+d0*2048+512);
    if(d0==0){p0=__builtin_amdgcn_mfma_f32_32x32x16_bf16(b0,qr[0],zero,0,0,0);p1=__builtin_amdgcn_mfma_f32_32x32x16_bf16(b1,qr[0],zero,0,0,0);}
    else{p0=__builtin_amdgcn_mfma_f32_32x32x16_bf16(b0,qr[d0],p0,0,0,0);p1=__builtin_amdgcn_mfma_f32_32x32x16_bf16(b1,qr[d0],p1,0,0,0);}}
}
typedef __attribute__((address_space(3))) const char* lds_cptr;
typedef short v4i16_t __attribute__((ext_vector_type(4)));
__device__ __forceinline__ void kload8(bf16x8*kf,lds_cptr kp){
  kf[0]=*(const __attribute__((address_space(3))) bf16x8*)(kp);      kf[1]=*(const __attribute__((address_space(3))) bf16x8*)(kp+512);
  kf[2]=*(const __attribute__((address_space(3))) bf16x8*)(kp+2048); kf[3]=*(const __attribute__((address_space(3))) bf16x8*)(kp+2560);
  kf[4]=*(const __attribute__((address_space(3))) bf16x8*)(kp+4096); kf[5]=*(const __attribute__((address_space(3))) bf16x8*)(kp+4608);
  kf[6]=*(const __attribute__((address_space(3))) bf16x8*)(kp+6144); kf[7]=*(const __attribute__((address_space(3))) bf16x8*)(kp+6656);
}
__device__ __forceinline__ void kload2(bf16x8*kf,lds_cptr kp,int j){ kf[2*j]=*(const __attribute__((address_space(3))) bf16x8*)(kp+j*2048); kf[2*j+1]=*(const __attribute__((address_space(3))) bf16x8*)(kp+j*2048+512); }
__device__ __forceinline__ s16x4 vtr(lds_cptr p){ return __builtin_bit_cast(s16x4,__builtin_amdgcn_ds_read_tr16_b64_v4i16((__attribute__((address_space(3))) v4i16_t*)p)); }
__device__ __forceinline__ float rowmax(const f32x16&p0,const f32x16&p1){
  float a=max3f(p0[0],p0[1],p1[0]),b=max3f(p0[2],p0[3],p1[1]);a=max3f(a,p1[2],p1[3]);
  #pragma unroll
  for(int r=4;r<16;r+=4){a=max3f(a,p0[r],p0[r+1]);b=max3f(b,p0[r+2],p0[r+3]);a=max3f(a,p1[r],p1[r+1]);b=max3f(b,p1[r+2],p1[r+3]);}
  const float m=max2f(a,b);
  auto rr=__builtin_amdgcn_permlane32_swap(__float_as_uint(m),__float_as_uint(m),false,false);
  return max2f(__uint_as_float(rr[0]),__uint_as_float(rr[1]));
}
__device__ __forceinline__ void pv(f32x16*o,int vb,bf16x8 pa0,bf16x8 pa1,bf16x8 pa2,bf16x8 pa3){
  #pragma unroll
  for(int d0=0;d0<2;++d0){s16x4 lo[4],hi[4];
    #pragma unroll
    for(int ks=0;ks<4;++ks){
      asm volatile("ds_read_b64_tr_b16 %0,%1 offset:%c2":"=&v"(lo[ks]):"v"(vb),"i"(d0*4096+ks*1024):"memory");
      asm volatile("ds_read_b64_tr_b16 %0,%1 offset:%c2":"=&v"(hi[ks]):"v"(vb),"i"(d0*4096+ks*1024+512):"memory");}
    asm volatile("s_waitcnt lgkmcnt(0)":::"memory");SBAR();
    #define PK(k) (bf16x8){lo[k][0],lo[k][1],lo[k][2],lo[k][3],hi[k][0],hi[k][1],hi[k][2],hi[k][3]}
    o[d0]=__builtin_amdgcn_mfma_f32_32x32x16_bf16(pa0,PK(0),o[d0],0,0,0);
    o[d0]=__builtin_amdgcn_mfma_f32_32x32x16_bf16(pa1,PK(1),o[d0],0,0,0);
    o[d0]=__builtin_amdgcn_mfma_f32_32x32x16_bf16(pa2,PK(2),o[d0],0,0,0);
    o[d0]=__builtin_amdgcn_mfma_f32_32x32x16_bf16(pa3,PK(3),o[d0],0,0,0);
    #undef PK
  }
}

#ifndef ATTN_STORE16
#define ATTN_STORE16(p,v) (*(u32x4*)(p)=(v))
#endif
template<int THRL,int QP,int KP,int VP,int OP> __device__ __forceinline__ void attn_unit(const bf16*Qb,const bf16*Qr,const bf16*__restrict__ Kh,const bf16*__restrict__ Kr,const bf16*__restrict__ Vh,bf16*Ob,int tq0,char*shm){
  const int tid=threadIdx.x,lane=tid&63,r32=lane&31,hi=lane>>5; const int wid=__builtin_amdgcn_readfirstlane(tid>>6);
  const bf16*Qw=Qb+(long)(wid*QBLK)*QP;
  const unsigned lds0=(unsigned)(uintptr_t)shm;
  float*wsf=(float*)(shm+LDS_WS)+wid*64;
  const bf16*ksrc=Kh+(long)lane*KP+wid*8; const bf16*rsrc=Kr+(long)lane*32+(wid&3)*8;
  const bf16*vsrc=Vh+(long)(16*(wid&3)+(lane>>2))*VP+(wid>>2)*32+(lane&3)*8;
  const unsigned kdst=lds0+LDS_K+wid*1024, vdst=lds0+LDS_V+wid*1024;
  #define DMA_KN(t,slot) glds16(ksrc+(long)(t)*KVBLK*KP,(unsigned)__builtin_amdgcn_readfirstlane(kdst+(slot)))
  #define DMA_R(t,slot) glds16(rsrc+(long)(t)*KVBLK*32,(unsigned)__builtin_amdgcn_readfirstlane(lds0+LDS_K+(8+(wid&3))*1024+(slot)))
  #define DMA_K(t,slot) do{ DMA_KN(t,slot); DMA_R(t,slot); }while(0)
  #define DMA_V(t,slot) glds16(vsrc+(long)(t)*KVBLK*VP,(unsigned)__builtin_amdgcn_readfirstlane(vdst+(slot)))
  const int vb0=(int)(lds0+LDS_V)+((lane>>4)&1)*32+(lane&3)*8+(4*hi+((lane&15)>>2))*64;
  const char*Kbase=shm+LDS_K; bf16x8 kf[8];
  const lds_cptr shm3=(lds_cptr)shm; const lds_cptr kp0=shm3+LDS_K+hi*1024+r32*16; const lds_cptr vp0=shm3+LDS_V+((lane>>4)&1)*32+(lane&3)*8+(4*hi+((lane&15)>>2))*64;
  constexpr int NT=SEQ/KVBLK;
  DMA_K(0,0);DMA_V(0,0);DMA_K(1,SLOTB);
  bf16x8 qr[6];
  #pragma unroll
  for(int d0=0;d0<4;++d0)qr[d0]=*reinterpret_cast<const bf16x8*>(&Qw[(long)r32*QP+d0*16+hi*8]);
  { const int tq=tq0+wid*QBLK+r32; const bf16*qp=Qr+(long)(wid*QBLK+r32)*QP+hi*8;
    #pragma unroll
    for(int dd=0;dd<2;++dd){ const bf16x8 raw=*reinterpret_cast<const bf16x8*>(qp+dd*16); const u32x4 w=__builtin_bit_cast(u32x4,raw); u32x4 pwx;
      #pragma unroll
      for(int j=0;j<4;++j)pwx[j]=(unsigned)__shfl_xor((int)w[j],32);
      const bf16x8 par=__builtin_bit_cast(bf16x8,pwx); const float pos=(dd==0)?(float)(tq>>6):(float)(tq&63); float ov[8];
      #pragma unroll
      for(int e=0;e<8;++e){ const float inv=exp2f(-(float)e*(13.287712379549449f/8.0f)); float s,c; att::sincos_acc(pos*inv,s,c);
        const float x=att::bf2f(raw[e]),y=att::bf2f(par[e]); ov[e]=hi==0?x*c-y*s:x*c+y*s; }
      u32x4 o4; o4.x=cvtpk_s(ov[0],ov[1]); o4.y=cvtpk_s(ov[2],ov[3]); o4.z=cvtpk_s(ov[4],ov[5]); o4.w=cvtpk_s(ov[6],ov[7]); qr[4+dd]=__builtin_bit_cast(bf16x8,o4); } }
  float mhat=0.f,l_reg=0.f;f32x16 o[2];o[0]=f32x16{};o[1]=f32x16{};const f32x16 zero=f32x16{};
  #define CMASK(P0,P1,t) do{}while(0)
  bool resc=false;
  #define START(P0,P1) do{ const float rm=rowmax(P0,P1); resc=false; \
    { const float dl=rm; mhat=fadd_s(mhat,dl); \
      _Pragma("unroll") for(int r=0;r<16;++r){P0[r]=fsub_s(P0[r],dl);P1[r]=fsub_s(P1[r],dl);} \
      } \
    _Pragma("unroll") for(int r=0;r<16;++r)P0[r]=__builtin_amdgcn_exp2f(P0[r]); }while(0)
  #define RESC() do{ if(resc){ asm volatile("s_waitcnt lgkmcnt(0)":::"memory"); \
      _Pragma("unroll") for(int d_=0;d_<2;++d_) _Pragma("unroll") for(int r=0;r<16;++r)o[d_][r]*=wsf[crow(r,hi)]; } }while(0)
  f32x16 pA0,pA1,pB0,pB1;
  int sl_prev=0,sl_cur=0,sl_next=SLOTB;
  #define ROT() do{sl_prev=sl_cur;sl_cur=sl_next;sl_next=(sl_next==(NSLOT-1)*SLOTB)?0:sl_next+SLOTB;}while(0)
  DMA_K(2,2*SLOTB);
  WAIT_BAR(3);
  qkt(pA0,pA1,Kbase,qr,r32,hi);asm volatile("s_nop 15\n\ts_nop 7":"+v"(pA0),"+v"(pA1));CMASK(pA0,pA1,0);
  START(pA0,pA1);
  _Pragma("unroll") for(int r=0;r<16;++r)pA1[r]=__builtin_amdgcn_exp2f(pA1[r]);
  WAIT_BAR(0);
  DMA_KN(3,0);DMA_V(1,SLOTB);
  ROT();
  kload8(kf,kp0+sl_cur);
  WAIT_BAR(2);
  s16x4 vlo[8],vhi[8]; u32x4 pw0,pw1,pw2,pw3;
  #define PKW(P,B) cvtpk_s(P[B],P[B+1])
  #define PAF(k) __builtin_bit_cast(bf16x8,pw##k)
  #define VFR(i) (bf16x8){vlo[i][0],vlo[i][1],vlo[i][2],vlo[i][3],vhi[i][0],vhi[i][1],vhi[i][2],vhi[i][3]}
  #define PIN(x) asm volatile("":"+v"(x))
  #define MX3(a,b,c) __builtin_fmaxf(__builtin_fmaxf((a),(b)),(c))
  #define GAPA(MF,A0,A1,A2,A3,W0,W1,PW) do{ MF; sacc+=A0; sacc+=A1; sacc+=A2; sacc+=A3; PIN(sacc); W0; W1; PIN(PW); SBAR(); }while(0)
  #define EX(v) __builtin_amdgcn_exp2f(v)
  #define GAPB(MF,X,B) do{ MF; X[B]=EX(X[B]); X[B+1]=EX(X[B+1]); X[B+2]=EX(X[B+2]); X[B+3]=EX(X[B+3]); PIN(X); SBAR(); }while(0)
  #define VRD(i) do{ vlo[i]=vtr(vp_+(((i)>>2)*4096+((i)&3)*1024)); vhi[i]=vtr(vp_+(((i)>>2)*4096+((i)&3)*1024+512)); }while(0)
  #define KRD(G,j) do{ if(G){ kload2(kf,kp0+sl_next,j); SBAR(); } }while(0)
  #define STEP(C0,C1,P0,P1,t,GK,GV,GL) do{ SBAR(); \
    const lds_cptr vp_=vp0+sl_prev; \
    VRD(0); SBAR(); float sacc=(P0[0]+P0[1]); \
    GAPA(C0=__builtin_amdgcn_mfma_f32_32x32x16_bf16(kf[0],qr[0],zero,0,0,0), P0[2],P0[3],P0[4],P0[5],     pw0[0]=PKW(P0,0), pw0[1]=PKW(P0,2), pw0); \
    VRD(4); SBAR(); GAPA(C1=__builtin_amdgcn_mfma_f32_32x32x16_bf16(kf[1],qr[0],zero,0,0,0), P0[6],P0[7],P0[8],P0[9],     pw0[2]=PKW(P0,4), pw0[3]=PKW(P0,6), pw0); \
    VRD(1); SBAR(); GAPA(C0=__builtin_amdgcn_mfma_f32_32x32x16_bf16(kf[2],qr[1],C0,0,0,0),   P0[10],P0[11],P0[12],P0[13], pw1[0]=PKW(P0,8), pw1[1]=PKW(P0,10), pw1); \
    VRD(5); SBAR(); GAPA(C1=__builtin_amdgcn_mfma_f32_32x32x16_bf16(kf[3],qr[1],C1,0,0,0),   P0[14],P0[15],P1[0],P1[1],   pw1[2]=PKW(P0,12),pw1[3]=PKW(P0,14), pw1); \
    VRD(2); SBAR(); GAPA(C0=__builtin_amdgcn_mfma_f32_32x32x16_bf16(kf[4],qr[2],C0,0,0,0),   P1[2],P1[3],P1[4],P1[5],     pw2[0]=PKW(P1,0), pw2[1]=PKW(P1,2), pw2); \
    VRD(6); SBAR(); GAPA(C1=__builtin_amdgcn_mfma_f32_32x32x16_bf16(kf[5],qr[2],C1,0,0,0),   P1[6],P1[7],P1[8],P1[9],     pw2[2]=PKW(P1,4), pw2[3]=PKW(P1,6), pw2); \
    VRD(3); SBAR(); GAPA(C0=__builtin_amdgcn_mfma_f32_32x32x16_bf16(kf[6],qr[3],C0,0,0,0),   P1[10],P1[11],P1[12],P1[13], pw3[0]=PKW(P1,8), pw3[1]=PKW(P1,10), pw3); \
    VRD(7); SBAR(); GAPA(C1=__builtin_amdgcn_mfma_f32_32x32x16_bf16(kf[7],qr[3],C1,0,0,0),   P1[14],P1[15],0.f,0.f,       pw3[2]=PKW(P1,12),pw3[3]=PKW(P1,14), pw3); \
    l_reg+=sacc; \
    { const lds_cptr rp_=kp0+sl_cur+8192; \
      const bf16x8 r0_=*(const __attribute__((address_space(3))) bf16x8*)(rp_), r1_=*(const __attribute__((address_space(3))) bf16x8*)(rp_+512), r2_=*(const __attribute__((address_space(3))) bf16x8*)(rp_+2048), r3_=*(const __attribute__((address_space(3))) bf16x8*)(rp_+2560); \
      C0=__builtin_amdgcn_mfma_f32_32x32x16_bf16(r0_,qr[4],C0,0,0,0); C1=__builtin_amdgcn_mfma_f32_32x32x16_bf16(r1_,qr[4],C1,0,0,0); \
      C0=__builtin_amdgcn_mfma_f32_32x32x16_bf16(r2_,qr[5],C0,0,0,0); C1=__builtin_amdgcn_mfma_f32_32x32x16_bf16(r3_,qr[5],C1,0,0,0); \
      _Pragma("unroll") for(int r=0;r<16;++r){C0[r]-=mhat;C1[r]-=mhat;} } \
    SBAR(); \
    if(GK){DMA_KN((t)+3,sl_cur);} if(GV){DMA_V((t)+1,sl_next);} \
    CMASK(C0,C1,t); \
    { float a=MX3(C0[0],C0[1],C1[0]),b=MX3(C0[2],C0[3],C1[1]); a=MX3(a,C1[2],C1[3]); \
      _Pragma("unroll") for(int r=4;r<16;r+=4){a=MX3(a,C0[r],C0[r+1]);b=MX3(b,C0[r+2],C0[r+3]);a=MX3(a,C1[r],C1[r+1]);b=MX3(b,C1[r+2],C1[r+3]);} \
      float rm=__builtin_fmaxf(a,b); { auto rr=__builtin_amdgcn_permlane32_swap(__float_as_uint(rm),__float_as_uint(rm),false,false); rm=__builtin_fmaxf(__uint_as_float(rr[0]),__uint_as_float(rr[1])); } \
      resc=false; \
      if(__builtin_expect(__any(rm>(float)THRL),0)){ const float dl=__builtin_fmaxf(rm,0.f); mhat+=dl; \
        _Pragma("unroll") for(int r=0;r<16;++r){C0[r]-=dl;C1[r]-=dl;} \
        const float f=__builtin_amdgcn_exp2f(-dl); l_reg*=f; if(hi==0)wsf[r32]=f; resc=true; } } \
    SBAR(); \
    GAPB(o[0]=__builtin_amdgcn_mfma_f32_32x32x16_bf16(PAF(0),VFR(0),o[0],0,0,0), C0,0); \
    GAPB(o[1]=__builtin_amdgcn_mfma_f32_32x32x16_bf16(PAF(0),VFR(4),o[1],0,0,0), C0,4); \
    KRD(GL,0); GAPB(o[0]=__builtin_amdgcn_mfma_f32_32x32x16_bf16(PAF(1),VFR(1),o[0],0,0,0), C0,8); \
    KRD(GL,1); GAPB(o[1]=__builtin_amdgcn_mfma_f32_32x32x16_bf16(PAF(1),VFR(5),o[1],0,0,0), C0,12); \
    KRD(GL,2); GAPB(o[0]=__builtin_amdgcn_mfma_f32_32x32x16_bf16(PAF(2),VFR(2),o[0],0,0,0), C1,0); \
    KRD(GL,3); GAPB(o[1]=__builtin_amdgcn_mfma_f32_32x32x16_bf16(PAF(2),VFR(6),o[1],0,0,0), C1,4); \
    GAPB(o[0]=__builtin_amdgcn_mfma_f32_32x32x16_bf16(PAF(3),VFR(3),o[0],0,0,0), C1,8); \
    GAPB(o[1]=__builtin_amdgcn_mfma_f32_32x32x16_bf16(PAF(3),VFR(7),o[1],0,0,0), C1,12); \
    }while(0)
  int t=1;
  #undef CMASK
  #define CMASK(P0,P1,t) do{}while(0)
  for(;t+5<NT;t+=2){
    DMA_R(t+2,sl_prev); STEP(pB0,pB1,pA0,pA1,t,true,true,true);     WAIT_BAR(3); RESC(); ROT();
    DMA_R(t+3,sl_prev); STEP(pA0,pA1,pB0,pB1,t+1,true,true,true);   WAIT_BAR(3); RESC(); ROT();
  }
  #undef CMASK
  #define CMASK(P0,P1,t) do{}while(0)
  #define ENDW(tt) do{ if((tt)+3<NT){WAIT_BAR(3);} else if((tt)+2<NT){WAIT_BAR(1);} else {WAIT_BAR(0);} }while(0)
  for(;t+1<NT;t+=2){
    if(t+2<NT){DMA_R(t+2,sl_prev);} STEP(pB0,pB1,pA0,pA1,t,(t+3<NT),(t+1<NT),(t+1<NT));       ENDW(t);   RESC(); ROT();
    if(t+3<NT){DMA_R(t+3,sl_prev);} STEP(pA0,pA1,pB0,pB1,t+1,(t+4<NT),(t+2<NT),(t+2<NT));     ENDW(t+1); RESC(); ROT();
  }
  STEP(pB0,pB1,pA0,pA1,NT-1,false,false,false); RESC();
  { float sacc=pB0[0]+pB0[1]; _Pragma("unroll") for(int r=2;r<16;++r)sacc+=pB0[r]; _Pragma("unroll") for(int r=0;r<16;++r)sacc+=pB1[r]; l_reg+=sacc;
    pw0=(u32x4){PKW(pB0,0),PKW(pB0,2),PKW(pB0,4),PKW(pB0,6)};pw1=(u32x4){PKW(pB0,8),PKW(pB0,10),PKW(pB0,12),PKW(pB0,14)};pw2=(u32x4){PKW(pB1,0),PKW(pB1,2),PKW(pB1,4),PKW(pB1,6)};pw3=(u32x4){PKW(pB1,8),PKW(pB1,10),PKW(pB1,12),PKW(pB1,14)};
    SBAR(); pv(o,vb0+sl_cur,PAF(0),PAF(1),PAF(2),PAF(3)); }
  #undef PKW
  #undef PAF
  #undef VFR
  #undef PIN
  #undef MX3
  #undef GAPA
  #undef GAPB
  #undef EX
  #undef VRD
  #undef KRD
  #undef STEP
  #undef ENDW
  {auto rr=__builtin_amdgcn_permlane32_swap(__float_as_uint(l_reg),__float_as_uint(l_reg),false,false);l_reg=__uint_as_float(rr[0])+__uint_as_float(rr[1]);}
  if(hi==0)wsf[32+r32]=l_reg;asm volatile("s_waitcnt lgkmcnt(0)":::"memory");
  float rli[16];
  #pragma unroll
  for(int r=0;r<16;++r)rli[r]=__builtin_amdgcn_rcpf(wsf[32+crow(r,hi)]);
  bf16*Ow=Ob+(long)(wid*QBLK)*OP;
  { bf16*stg=(bf16*)(shm+LDS_OST)+wid*2048;
    #pragma unroll
    for(int r=0;r<16;++r){const int orow=crow(r,hi);
      #pragma unroll
      for(int d0=0;d0<2;++d0)stg[orow*64+d0*32+r32]=__float2bfloat16(o[d0][r]*rli[r]);}
    asm volatile("s_waitcnt lgkmcnt(0)":::"memory");
    #pragma unroll
    for(int i=0;i<4;++i){const int row=i*8+(lane>>3),ch=lane&7; const u32x4 v=*(const u32x4*)(stg+row*64+ch*8); ATTN_STORE16(Ow+(long)row*OP+ch*8,v);} }
  asm volatile("s_waitcnt lgkmcnt(0)\n\ts_barrier":::"memory");
  #undef DMA_K
  #undef DMA_KN
  #undef DMA_R
  #undef DMA_V
  #undef CMASK
  #undef START
  #undef RESC
  #undef ROT
}
constexpr int ATTN_LDS_BYTES=LDS_BYTES;
#undef SBAR
#undef WAIT_BAR
}

constexpr int NWAVES = 8;
constexpr int M = 32768, D = 1024, SEQ = 8192, NB = 4, FF = 4096, NIN = 1440, NINP = 1536;
constexpr size_t MiB = 1u << 20;
constexpr size_t WS_PART = 2 * MiB;
constexpr size_t WS_WIN = 18 * MiB, WS_WUQ = 21 * MiB, WS_WUKV = 22 * MiB, WS_WO0 = 23 * MiB, WS_WUP0 = 25 * MiB, WS_WDN0 = 33 * MiB;
constexpr size_t WS_WQKV = 41 * MiB, WS_WO1 = 47 * MiB, WS_WUP1 = 49 * MiB, WS_WDN1 = 57 * MiB;
constexpr size_t WS_HB = 66 * MiB;
constexpr size_t WS_U = 130 * MiB;
constexpr size_t WS_Z = 130 * MiB, WS_MIX = 130 * MiB, WS_QA = 226 * MiB, WS_KA = 258 * MiB, WS_VA = 266 * MiB, WS_CQ = 274 * MiB, WS_CKV = 298 * MiB, WS_KR = 314 * MiB, WS_QB = 316 * MiB, WS_KVB = 386 * MiB;
constexpr size_t WS_QKV = 130 * MiB, WS_O1 = 322 * MiB;
constexpr size_t WS_END = 450 * MiB;
constexpr int LDS_BYTES = 135168;
static_assert(att::L_END <= 131072, "attention LDS");

#define LAS __attribute__((address_space(3)))
typedef unsigned short bf16;
typedef unsigned v4u __attribute__((ext_vector_type(4)));
typedef float f32x4 __attribute__((ext_vector_type(4)));
#define LDS_WAIT() asm volatile("s_waitcnt lgkmcnt(0)" ::: "memory")

__device__ __forceinline__ float wave_sum(float v) {
#pragma unroll
    for (int o = 1; o < 64; o <<= 1) v += __shfl_xor(v, o);
    return v;
}
__device__ __forceinline__ unsigned pk2(float lo, float hi) { return pg8::cvt_pk_bf16(lo, hi); }
__device__ __forceinline__ void transpose_item(const float* W, const float* gain, int K, int N, bf16* WT, LAS float* scr, int item, int lane, bool headperm = false) {
    const int nblk = N / 32, kb = item / nblk, nb = item % nblk, k0 = 64 * kb, n0 = 32 * nb;
#pragma unroll 8
    for (int i = 0; i < 32; ++i) { const int kk = 2 * i + (lane >> 5); const float g = gain ? gain[k0 + kk] : 1.f; scr[kk * 33 + (lane & 31)] = W[(size_t)(k0 + kk) * N + n0 + (lane & 31)] * g; }
    LDS_WAIT(); asm volatile("" ::: "memory");
    const int c = lane & 7;
#pragma unroll
    for (int j = 0; j < 4; ++j) { const int n = (lane >> 3) + 8 * j; const LAS float* s = scr + (8 * c) * 33 + n;
        v4u o; o.x = pk2(s[0 * 33], s[1 * 33]); o.y = pk2(s[2 * 33], s[3 * 33]); o.z = pk2(s[4 * 33], s[5 * 33]); o.w = pk2(s[6 * 33], s[7 * 33]);
        int nn = n0 + n; if (headperm && nn < 768) { const int d = nn & 63, hh = (nn >> 6) & 3; nn = (nn & ~255) + 128 * (d >> 5) + 32 * hh + (d & 31); }
        *(v4u*)(WT + (size_t)nn * K + k0 + 8 * c) = o; }
    LDS_WAIT(); asm volatile("" ::: "memory");
}

#define XB_TMO      128
#define XB_XCNT(j)  (256  + 64 * (j))
#define XB_XSUB(j)  (1280 + 64 * (j))
#define XB_XGEN(j)  (2304 + 64 * (j))
#define XB_TOP      3328
#define XB_TOPGEN   3392
#define XCD_BAR_WORDS 3456
#define XB_SPIN_CAP (1u << 22)

__device__ __forceinline__ unsigned xb_ld(unsigned* p)              { return __hip_atomic_load(p, __ATOMIC_RELAXED, __HIP_MEMORY_SCOPE_AGENT); }
__device__ __forceinline__ unsigned xb_add(unsigned* p, unsigned v) { return __hip_atomic_fetch_add(p, v, __ATOMIC_RELAXED, __HIP_MEMORY_SCOPE_AGENT); }
__device__ __forceinline__ unsigned xb_xcc_id() { return (unsigned)__builtin_amdgcn_s_getreg((3 << 11) | 20) & 0xFu; }
#define XB_SPIN(cond, bar) do { unsigned _sp = 0; while (cond) { __builtin_amdgcn_s_sleep(1); \
    if ((++_sp & 255u) == 0u) { if (xb_ld(&(bar)[XB_TMO])) break; if (_sp > XB_SPIN_CAP) { atomicAdd(&(bar)[XB_TMO], 1u); break; } } } } while (0)

struct XcdBarrier {
    unsigned* bar; unsigned x;
    volatile LAS unsigned* st;
};

__device__ __forceinline__ XcdBarrier xcd_barrier_post(unsigned* bar, volatile LAS unsigned* st) {
    XcdBarrier b; b.bar = bar; b.x = xb_xcc_id(); b.st = st;
    if (threadIdx.x == 0) (void)xb_add(&bar[XB_XCNT(b.x)], 1u);
    return b;
}
__device__ __forceinline__ void xcd_barrier_complete(unsigned* bar, unsigned x, unsigned& nloc, unsigned& nx) {
    const unsigned G = gridDim.x * gridDim.y * gridDim.z;
    unsigned sum, cnt, mine, sp = 0u;
    for (;;) {
        sum = 0u; cnt = 0u; mine = 0u;
#pragma unroll
        for (unsigned j = 0; j < 16; ++j) { const unsigned c = xb_ld(&bar[XB_XCNT(j)]); sum += c; cnt += (c > 0u) ? 1u : 0u; mine = (j == x) ? c : mine; }
        if (sum == G) break;
        __builtin_amdgcn_s_sleep(1);
        if ((++sp & 255u) == 0u) { if (xb_ld(&bar[XB_TMO])) break; if (sp > XB_SPIN_CAP) { atomicAdd(&bar[XB_TMO], 1u); break; } }
    }
    nloc = mine > 0u ? mine : 1u; nx = cnt > 0u ? cnt : 1u;
}

__device__ __forceinline__ void xcd_barrier(const XcdBarrier& b) {
    asm volatile("s_waitcnt vmcnt(0)" ::: "memory");
    __syncthreads();
    if (threadIdx.x == 0) {
        unsigned* bar = b.bar;
        __builtin_amdgcn_s_waitcnt(0);
        unsigned nloc = b.st[0], nx = b.st[1];
        if (nloc == 0u) { xcd_barrier_complete(bar, b.x, nloc, nx); b.st[0] = nloc; b.st[1] = nx; }
        const unsigned old = xb_add(&bar[XB_XSUB(b.x)], 1u);
        const unsigned gen = old / nloc;
        if (old + 1u == (gen + 1u) * nloc) {
            __builtin_amdgcn_fence(__ATOMIC_RELEASE, "agent");
            asm volatile("s_waitcnt vmcnt(0)" ::: "memory");
            (void)xb_add(&bar[XB_TOP], 1u);
        }
        { const unsigned want = (gen + 1u) * nx; XB_SPIN(xb_ld(&bar[XB_TOP]) < want, bar); }
        __builtin_amdgcn_fence(__ATOMIC_ACQUIRE, "agent");
        asm volatile("s_waitcnt vmcnt(0)" ::: "memory");
    }
    __syncthreads();
}

struct Args { const float* in[17]; float* out; unsigned char* ws; int ph_lo, ph_hi; };

__device__ __forceinline__ void ld8(const bf16* p, float (&v)[8]) { const v4u w = *(const v4u*)p;
#pragma unroll
    for (int j = 0; j < 4; ++j) { v[2 * j] = __uint_as_float(w[j] << 16); v[2 * j + 1] = __uint_as_float(w[j] & 0xffff0000u); } }
__device__ __forceinline__ void up8(const v4u w, float (&v)[8]) {
#pragma unroll
    for (int j = 0; j < 4; ++j) { v[2 * j] = __uint_as_float(w[j] << 16); v[2 * j + 1] = __uint_as_float(w[j] & 0xffff0000u); } }
__device__ __forceinline__ void st8(bf16* p, const float (&v)[8]) { v4u o; o.x = pk2(v[0], v[1]); o.y = pk2(v[2], v[3]); o.z = pk2(v[4], v[5]); o.w = pk2(v[6], v[7]); *(v4u*)p = o; }

__device__ __forceinline__ void head_norm_rope(float (&v)[8], const float* gain, int j, int prow, int pcol, float scale, const float* tc, const float* ts) {
    float ss = 0.f;
#pragma unroll
    for (int e = 0; e < 8; ++e) ss += v[e] * v[e];
    ss += __shfl_xor(ss, 1); ss += __shfl_xor(ss, 2); ss += __shfl_xor(ss, 4);
    const float rstd = 1.0f / sqrtf(ss * (1.0f / 64.0f) + pg8::NORM_EPS);
    const int pos = (j < 4) ? prow : pcol; const int o16 = pos * 16 + (j & 1) * 8;
    const f32x4 c0 = *(const f32x4*)(tc + o16), c1 = *(const f32x4*)(tc + o16 + 4), s0 = *(const f32x4*)(ts + o16), s1 = *(const f32x4*)(ts + o16 + 4);
    const f32x4 g0 = *(const f32x4*)(gain + j * 8), g1 = *(const f32x4*)(gain + j * 8 + 4);
#pragma unroll
    for (int e = 0; e < 8; ++e) {
        const float g = e < 4 ? g0[e & 3] : g1[e & 3], c = e < 4 ? c0[e & 3] : c1[e & 3], s = e < 4 ? s0[e & 3] : s1[e & 3];
        const float y = v[e] * rstd * g; const float py = __shfl_xor(y, 2);
        v[e] = (((j & 2) == 0) ? y * c - py * s : y * c + py * s) * scale;
    }
}

__global__ void __launch_bounds__(NWAVES * 64, 2) fwd_kernel(Args args) {
    extern __shared__ __attribute__((aligned(16))) unsigned char lds[];
    cg::grid_group grid = cg::this_grid();
    LAS unsigned char* L = (LAS unsigned char*)lds;
    const int tid = threadIdx.x, lane = tid & 63, wave = __builtin_amdgcn_readfirstlane(tid >> 6);
    const int G = gridDim.x; const int bx = blockIdx.x;
    const int vcu = (G % 8 == 0) ? (bx % 8) * (G / 8) + bx / 8 : bx;
    const int gw = vcu * NWAVES + wave, NGW = G * NWAVES;
    unsigned char* ws = args.ws;
    const float* x = args.in[0]; float* out = args.out;
    float* PART = (float*)(ws + WS_PART);
#define PARTN(k) (PART + (size_t)(k) * M * 16)
    bf16 *HB = (bf16*)(ws + WS_HB), *U = (bf16*)(ws + WS_U), *Z = (bf16*)(ws + WS_Z), *MIX = (bf16*)(ws + WS_MIX);
    bf16 *QA = (bf16*)(ws + WS_QA), *KA = (bf16*)(ws + WS_KA), *VA = (bf16*)(ws + WS_VA), *CQ = (bf16*)(ws + WS_CQ), *CKV = (bf16*)(ws + WS_CKV), *KR = (bf16*)(ws + WS_KR);
    bf16 *QB = (bf16*)(ws + WS_QB), *KVB = (bf16*)(ws + WS_KVB), *QKV = (bf16*)(ws + WS_QKV), *O1 = (bf16*)(ws + WS_O1);
    bf16 *WIN = (bf16*)(ws + WS_WIN), *WUQ = (bf16*)(ws + WS_WUQ), *WUKV = (bf16*)(ws + WS_WUKV), *WO0 = (bf16*)(ws + WS_WO0), *WUP0 = (bf16*)(ws + WS_WUP0), *WDN0 = (bf16*)(ws + WS_WDN0);
    bf16 *WQKV = (bf16*)(ws + WS_WQKV), *WO1 = (bf16*)(ws + WS_WO1), *WUP1 = (bf16*)(ws + WS_WUP1), *WDN1 = (bf16*)(ws + WS_WDN1);
    const int lo = args.ph_lo, hi = args.ph_hi;
    float* TAC = (float*)(ws + MiB); float* TAS = TAC + 2048; float* TBC = TAS + 2048; float* TBS = TBC + 1024;
    volatile LAS unsigned* MISC = (volatile LAS unsigned*)(L + 131072);
    if (tid < 2) MISC[tid] = 0u;
    __syncthreads();
    unsigned* BARW = (unsigned*)(ws + 8192);
    XcdBarrier xbar; xbar.bar = BARW; xbar.x = 0; xbar.st = MISC;
#ifndef PROBE_PHASE
#define PROBE_PHASE -1
#endif
#define IN(k) (lo <= (k) && (k) < hi)
#define REPS(k) ((PROBE_PHASE == (k)) ? 2 : 1)
#define SEAM(k) do { if (IN(k) && IN((k) + 1)) { if ((k) == 0) { grid.sync(); xbar = xcd_barrier_post(BARW, MISC); } else xcd_barrier(xbar); } } while (0)
    constexpr float C2A = 0.125f * att::LOG2E;
    constexpr float C2B = 0.10206207261596577f * att::LOG2E;

    if (IN(0)) {
        if (bx == 0) for (int i = tid; i < XCD_BAR_WORDS; i += NWAVES * 64) BARW[i] = 0u;
        LAS float* scr = (LAS float*)(L + wave * 16384);
        constexpr int I0 = 16 * 45, I1 = 6 * 24, I2 = 4 * 32, I3 = 16 * 32, I4 = 16 * 128, I5 = 64 * 32, I6 = 16 * 96, I7 = 16 * 32, I8 = I4, I9 = I5;
        constexpr int NITEMS = I0 + I1 + I2 + I3 + I4 + I5 + I6 + I7 + I8 + I9;
        for (int it = gw; it < NITEMS; it += NGW) {
            int r = it;
            if (r < I0) { transpose_item(args.in[2], args.in[1], D, NIN, WIN, scr, r, lane, true); continue; } r -= I0;
            if (r < I1) { transpose_item(args.in[6], args.in[5], 384, 768, WUQ, scr, r, lane); continue; } r -= I1;
            if (r < I2) { transpose_item(args.in[8], args.in[7], 256, 1024, WUKV, scr, r, lane); continue; } r -= I2;
            if (r < I3) { transpose_item(args.in[9], nullptr, D, D, WO0, scr, r, lane); continue; } r -= I3;
            if (r < I4) { transpose_item(args.in[14], args.in[13], D, FF, WUP0, scr, r, lane); continue; } r -= I4;
            if (r < I5) { transpose_item(args.in[15], nullptr, FF, D, WDN0, scr, r, lane); continue; } r -= I5;
            if (r < I6) { transpose_item(args.in[10], args.in[1] + D, D, 3 * D, WQKV, scr, r, lane); continue; } r -= I6;
            if (r < I7) { transpose_item(args.in[12], nullptr, D, D, WO1, scr, r, lane); continue; } r -= I7;
            if (r < I8) { transpose_item(args.in[14] + (size_t)D * FF, args.in[13] + D, D, FF, WUP1, scr, r, lane); continue; } r -= I8;
            transpose_item(args.in[15] + (size_t)FF * D, nullptr, FF, D, WDN1, scr, r, lane);
        }
        for (int i = bx * 512 + tid; i < 128 * 16; i += G * 512) { const int pos = i >> 4, f = i & 15; float s, c; att::sincos_acc((float)pos * exp2f(-(float)f * (13.287712379549449f / 16.0f)), s, c); TAC[i] = c; TAS[i] = s; }
        for (int i = bx * 512 + tid; i < 128 * 8; i += G * 512) { const int pos = i >> 3, f = i & 7; float s, c; att::sincos_acc((float)pos * exp2f(-(float)f * (13.287712379549449f / 8.0f)), s, c); TBC[i] = c; TBS[i] = s; }
        { v4u* p = (v4u*)(WIN + (size_t)NIN * D); const int n16 = (NINP - NIN) * D * 2 / 16; for (int i = bx * 512 + tid; i < n16; i += G * 512) p[i] = (v4u){0u, 0u, 0u, 0u}; }
        for (int m = gw; m < M; m += NGW) {
            const f32x4* xr = (const f32x4*)(x + (size_t)m * D) + lane; f32x4 v[4]; float s = 0.f;
#pragma unroll
            for (int j = 0; j < 4; ++j) { v[j] = xr[64 * j]; s += (v[j].x * v[j].x + v[j].y * v[j].y) + (v[j].z * v[j].z + v[j].w * v[j].w); }
            s = wave_sum(s);
            unsigned long long* o8 = (unsigned long long*)(HB + (size_t)m * D) + lane;
#pragma unroll
            for (int j = 0; j < 4; ++j) o8[64 * j] = (unsigned long long)pk2(v[j].x, v[j].y) | ((unsigned long long)pk2(v[j].z, v[j].w) << 32);
            if (lane < 16) PARTN(0)[(size_t)m * 16 + lane] = (lane == 0) ? s : 0.f;
        }
    }
    SEAM(0);
    if (IN(1)) {
        pg8::Gemm g{HB, WIN, M, NINP, D}; pg8::StaticOrder S; S.init(M, NINP, G, bx); S.rep = REPS(1);
        pg8::EpiIn E{PARTN(0), QA, KA, VA, CQ, CKV, KR, PARTN(5), PARTN(6), args.in[3], args.in[4], TAC, TAS, TBC, TBS, C2A};
        pg8::gemm_phase<pg8::EpiIn, pg8::StaticOrder, true, true>(L, g, S, E);
    }
    SEAM(1);
    if (IN(3)) {
        { pg8::Gemm g{CQ, WUQ, M, 768, 384}; pg8::StaticOrder S; S.init(M, 768, G, bx);
          pg8::EpiScale<0> E{QB, 768, PARTN(5), 1.0f / 384.0f, 3, C2B};
          pg8::gemm_phase<pg8::EpiScale<0>, pg8::StaticOrder, true, true>(L, g, S, E); }
        { pg8::Gemm g{CKV, WUKV, M, 1024, 256}; pg8::StaticOrder S; S.init(M, 1024, G, bx);
          pg8::EpiScale<0> E{KVB, 1024, PARTN(6), 1.0f / 256.0f, 0, 1.f};
          pg8::gemm_phase<pg8::EpiScale<0>, pg8::StaticOrder, true, true>(L, g, S, E); }
    }
    SEAM(3);
    if (IN(4)) {
        for (int uu = vcu; uu < 2048 * REPS(4); uu += G) { const int u = uu & 2047;
            const int pair = u >> 5, qb = u & 31; const int typ = (pair >> 3) & 1; const int idx = (pair >> 4) * 8 + (pair & 7); const int b = idx >> 3, h = idx & 7;
            const long rowbase = (long)b * SEQ;
            const bool has_next = (uu + G) < 2048 * REPS(4); const int un = (uu + G) & 2047; const int pairn = un >> 5; const int typn = (pairn >> 3) & 1; const int idxn = (pairn >> 4) * 8 + (pairn & 7); const int bn = idxn >> 3, hn = idxn & 7;
            att::Next nx;
            if (typn == 0) nx = att::Next{KA + (hn >> 2) * 64, KR, VA + (hn >> 2) * 64, 128, 32, 128, (long)bn * SEQ, 0, SEQ / 64 - 1, 64};
            else nx = att::Next{KVB + hn * 128, KR, KVB + hn * 128 + 64, 1024, 32, 1024, (long)bn * SEQ, 0, SEQ / 64 - 1, 96};
            if (typ == 0) { att::Desc d{QA + h * 64, nullptr, KA + (h >> 2) * 64, nullptr, VA + (h >> 2) * 64, MIX + h * 64, 512, 0, 128, 0, 128, 1024};
                (void)d; attn_ex::attn_unit<8, 512, 128, 128, 1024>((const attn_ex::bf16*)(QA + (size_t)(rowbase + qb * 256) * 512 + h * 64), (const attn_ex::bf16*)(KA + (size_t)rowbase * 128 + (h >> 2) * 64),
                    (const attn_ex::bf16*)(VA + (size_t)rowbase * 128 + (h >> 2) * 64), (attn_ex::bf16*)(MIX + (size_t)(rowbase + qb * 256) * 1024 + h * 64), (char*)lds); }
            else { att::Desc d{QB + h * 96, QB + h * 96 + 64, KVB + h * 128, KR, KVB + h * 128 + 64, MIX + 512 + h * 64, 768, 768, 1024, 32, 1024, 1024};
                (void)d; attn_ex96::attn_unit<8, 768, 1024, 1024, 1024>((const attn_ex96::bf16*)(QB + (size_t)(rowbase + qb * 256) * 768 + h * 96), (const attn_ex96::bf16*)(QB + (size_t)(rowbase + qb * 256) * 768 + h * 96 + 64),
                    (const attn_ex96::bf16*)(KVB + (size_t)rowbase * 1024 + h * 128), (const attn_ex96::bf16*)(KR + (size_t)rowbase * 32), (const attn_ex96::bf16*)(KVB + (size_t)rowbase * 1024 + h * 128 + 64),
                    (attn_ex96::bf16*)(MIX + (size_t)(rowbase + qb * 256) * 1024 + 512 + h * 64), qb * 256, (char*)lds); }
        }
    }
    SEAM(4);
    if (IN(5)) {
        pg8::Gemm g{MIX, WO0, M, D, D}; pg8::StaticOrder S; S.init(M, D, G, bx); S.rep = REPS(5);
        pg8::EpiRes E{x, out, HB, PARTN(1), D};
        pg8::gemm_phase<pg8::EpiRes, pg8::StaticOrder, true, true>(L, g, S, E);
    }
    SEAM(5);
    if (IN(6)) {
        pg8::Gemm g{HB, WUP0, M, FF, D}; pg8::StaticOrder S; S.init(M, FF, G, bx); S.rep = REPS(6);
        pg8::EpiScale<1> E{U, FF, PARTN(1), 1.0f / D, 0, 1.f};
        pg8::gemm_phase<pg8::EpiScale<1>, pg8::StaticOrder, true, true>(L, g, S, E);
    }
    SEAM(6);
    if (IN(7)) {
        pg8::Gemm g{U, WDN0, M, D, FF}; pg8::StaticOrder S; S.init(M, D, G, bx);
        pg8::EpiRes E{out, out, HB, PARTN(2), D};
        pg8::gemm_phase<pg8::EpiRes, pg8::StaticOrder, true, true>(L, g, S, E);
    }
    SEAM(7);
    if (IN(8)) {
        pg8::Gemm g{HB, WQKV, M, 3 * D, D}; pg8::StaticOrder S; S.init(M, 3 * D, G, bx); S.rep = REPS(8);
        pg8::EpiScale<0> E{QKV, 3 * D, PARTN(2), 1.0f / D, 4, C2A, M};
        pg8::gemm_phase<pg8::EpiScale<0>, pg8::StaticOrder, true, true>(L, g, S, E);
    }
    SEAM(8);
    if (IN(9)) {
        for (int uu = vcu; uu < 2048 * REPS(9); uu += G) { const int u = uu & 2047;
            const int pair = u >> 5, qb = u & 31; const int b = pair >> 4, h = pair & 15;
            const int R0 = qb * 4; const int tlo = min(max(R0 - 4, 0), 120), thi = min(max(R0 + 3 - 4, 0), 120) + 7;
            att::Desc d{QKV + (size_t)h * M * 64, nullptr, QKV + (size_t)(16 + h) * M * 64, nullptr, QKV + (size_t)(32 + h) * M * 64, O1 + h * 64, 64, 0, 64, 0, 64, D};
            const bool has_next = (uu + G) < 2048 * REPS(9); const int un = (uu + G) & 2047; const int pairn = un >> 5, qbn = un & 31; const int bn = pairn >> 4, hn = pairn & 15;
            const int R0n = qbn * 4; const int tlon = min(max(R0n - 4, 0), 120), thin = min(max(R0n + 3 - 4, 0), 120) + 7;
            const att::Next nx{QKV + (size_t)(16 + hn) * M * 64, KR, QKV + (size_t)(32 + hn) * M * 64, 64, 32, 64, (long)bn * SEQ, tlon, thin, 64};
            if (wave & 1) att::unit<64, 1, 1>(d, (long)b * SEQ, qb * 256, tlo, thi, args.in[11] + h * 465, L, uu != vcu, has_next, nx);
            else att::unit<64, 1, 0>(d, (long)b * SEQ, qb * 256, tlo, thi, args.in[11] + h * 465, L, uu != vcu, has_next, nx);
        }
    }
    SEAM(9);
    if (IN(10)) {
        pg8::Gemm g{O1, WO1, M, D, D}; pg8::StaticOrder S; S.init(M, D, G, bx);
        pg8::EpiRes E{out, out, HB, PARTN(3), D};
        pg8::gemm_phase<pg8::EpiRes, pg8::StaticOrder, true, true>(L, g, S, E);
    }
    SEAM(10);
    if (IN(11)) {
        pg8::Gemm g{HB, WUP1, M, FF, D}; pg8::StaticOrder S; S.init(M, FF, G, bx);
        pg8::EpiScale<1> E{U, FF, PARTN(3), 1.0f / D, 0, 1.f};
        pg8::gemm_phase<pg8::EpiScale<1>, pg8::StaticOrder, true, true>(L, g, S, E);
    }
    SEAM(11);
    if (IN(12)) {
        pg8::Gemm g{U, WDN1, M, D, FF}; pg8::StaticOrder S; S.init(M, D, G, bx);
        pg8::EpiRes E{out, out, nullptr, PARTN(4), D};
        pg8::gemm_phase<pg8::EpiRes, pg8::StaticOrder, true, true>(L, g, S, E);
    }
    SEAM(12);
    if (IN(13)) {
        const float* gf = args.in[16];
        for (int m = gw; m < M; m += NGW) {
            f32x4* xr = (f32x4*)(out + (size_t)m * D) + lane; const f32x4* pp = (const f32x4*)(PARTN(4) + (size_t)m * 16);
            const f32x4 a = pp[0], b = pp[1], c = pp[2], d4 = pp[3];
            const float s = ((a[0] + a[1]) + (a[2] + a[3])) + ((b[0] + b[1]) + (b[2] + b[3])) + ((c[0] + c[1]) + (c[2] + c[3])) + ((d4[0] + d4[1]) + (d4[2] + d4[3]));
            const float rstd = 1.0f / sqrtf(s * (1.0f / D) + pg8::NORM_EPS);
#pragma unroll
            for (int j = 0; j < 4; ++j) { const f32x4 v = xr[64 * j]; const f32x4 gg = ((const f32x4*)gf)[lane + 64 * j]; xr[64 * j] = v * rstd * gg; }
        }
    }
#undef IN
#undef SEAM
}

#ifndef MK_PER_PHASE
#define MK_PER_PHASE 0
#endif
extern "C" void kernel_launch(void* const* d_in, const int* in_sizes, int n_in, void* d_out, int out_size, void* d_ws, size_t ws_size, hipStream_t stream) {
    static int grid = 0;
    if (grid == 0) {
        if (n_in != 17 || in_sizes[0] != M * D || out_size != M * D || ws_size < WS_END) { fprintf(stderr, "kernel_launch: unexpected shapes / workspace (n_in %d, in0 %d, out %d, ws %zu)\n", n_in, n_in > 0 ? in_sizes[0] : -1, out_size, ws_size); grid = -1; return; }
        int dev = 0, cus = 0, per_cu = 0;
        if (hipGetDevice(&dev) != hipSuccess || hipDeviceGetAttribute(&cus, hipDeviceAttributeMultiprocessorCount, dev) != hipSuccess) { grid = -1; return; }
        if (hipFuncSetAttribute((const void*)fwd_kernel, hipFuncAttributeMaxDynamicSharedMemorySize, LDS_BYTES) != hipSuccess) { fprintf(stderr, "kernel_launch: hipFuncSetAttribute failed\n"); grid = -1; return; }
        if (hipOccupancyMaxActiveBlocksPerMultiprocessor(&per_cu, (const void*)fwd_kernel, NWAVES * 64, LDS_BYTES) != hipSuccess || per_cu < 1) { fprintf(stderr, "kernel_launch: occupancy query says %d\n", per_cu); per_cu = 1; }
        (void)hipGetLastError();
        grid = cus * per_cu;
        fprintf(stderr, "kernel_launch: grid %d (cus %d x %d)\n", grid, cus, per_cu);
    }
    if (grid < 0) return;
    Args a{};
    for (int i = 0; i < 17; ++i) a.in[i] = (const float*)d_in[i];
    a.out = (float*)d_out; a.ws = (unsigned char*)d_ws;
#if MK_PER_PHASE
    for (int p = 0; p < 14; ++p) { a.ph_lo = p; a.ph_hi = p + 1; hipLaunchKernelGGL(fwd_kernel, dim3(grid), dim3(NWAVES * 64), LDS_BYTES, stream, a); }
#else
    a.ph_lo = 0; a.ph_hi = 14;
    void* kargs[] = {&a};
    hipError_t e = hipLaunchCooperativeKernel((const void*)fwd_kernel, dim3(grid), dim3(NWAVES * 64), kargs, LDS_BYTES, stream);
    if (e != hipSuccess) fprintf(stderr, "cooperative launch failed: %s (grid %d)\n", hipGetErrorString(e), grid);
#endif
}
```

```cpp
#include <hip/hip_runtime.h>
#include <hip/hip_cooperative_groups.h>
#include <hip/hip_bf16.h>
#include <cstdio>
#include <cstdint>
#include <cmath>
namespace cg = cooperative_groups;
namespace pg8 {
#define PG8_LAS __attribute__((address_space(3)))
typedef unsigned short bf16_t;
typedef short bf16x8 __attribute__((ext_vector_type(8)));
typedef float f32x4 __attribute__((ext_vector_type(4)));
typedef unsigned u32x4 __attribute__((ext_vector_type(4)));
constexpr int BM = 256, BK = 64, HALF = 128, HTB = HALF * BK * 2  , STAGE_BYTES = 8 * HTB, NXCD = 8, WGM = 8;

__host__ __device__ __forceinline__ int lds_byte(int r, int c) { const int st = (r >> 4) * 2 + (c >> 5), rr = r & 15, cc = c & 31, ob = rr * 64 + cc * 2; return st * 1024 + (ob ^ (((ob >> 9) & 1) << 5)); }
__host__ __device__ __forceinline__ void stage_rc(int b, int& R, int& C) { const int st = b / 1024, sb = b % 1024, swz = sb ^ (((sb >> 9) & 1) << 5); R = (st >> 1) * 16 + swz / 64; C = (st & 1) * 32 + (swz % 64) / 2; }
__host__ __device__ __forceinline__ int perm32(int rho) { const int n = rho >> 4, i = rho & 15; return 8 * (i >> 2) + 4 * n + (i & 3); }

struct Unit { int pm, pn; };
struct Gemm { const bf16_t* A; const bf16_t* Bt; int M, N, K; };

struct StaticOrder {
    int nM, nN, nwg, G, c, rep = 1;
    __host__ __device__ void init(int M, int N, int G_, int c_) { nM = M / BM; nN = N / BM; nwg = nM * nN; G = G_; c = c_; }
    __host__ __device__ bool next(int i, Unit& u) const {
        const long L = (long)i * G + c; if (L >= (long)nwg * rep) return false;
        int wgid = (int)(L % nwg); { const int q = nwg / NXCD, r = nwg % NXCD, xcd = wgid % NXCD, off = wgid / NXCD; wgid = (xcd < r ? xcd * (q + 1) : r * (q + 1) + (xcd - r) * q) + off; }
        const int nig = WGM * nN, gid = wgid / nig, fm = gid * WGM, gsz = (nM - fm) < WGM ? (nM - fm) : WGM;
        u.pm = fm + ((wgid % nig) % gsz); u.pn = (wgid % nig) / gsz; return true;
    }
    __device__ __forceinline__ void a_ready(const Unit&) const {}
    __device__ __forceinline__ void done(const Unit&) const {}
};
__device__ __forceinline__ unsigned cvt_pk_bf16(float lo, float hi) { unsigned r; asm volatile("v_cvt_pk_bf16_f32 %0, %1, %2" : "=v"(r) : "v"(lo), "v"(hi)); return r; }
constexpr float NORM_EPS = 1e-6f;
template <int ACT> struct EpiScale {
    static constexpr bool PERM = true, AFTER_DRAIN = false;
    bf16_t* O; int ldc; const float* part; float inv_dim; int nq_tiles; float qscale; int hm = 0;
    __device__ __forceinline__ void operator()(const f32x4 (&acc)[2][2][4][2], const Unit& u, int wr, int wc, int fr, int fq) const {
        const int row0 = u.pm * BM + wr * 64 + fr; const int col0 = u.pn * BM + wc * 32 + 8 * fq;
        const float sc = (u.pn < nq_tiles) ? qscale : 1.f;
#pragma unroll
        for (int ai = 0; ai < 2; ++ai)
#pragma unroll
            for (int m = 0; m < 4; ++m) { const int row = row0 + ai * HALF + m * 16; float rs = 1.f;
                if (part) { const f32x4* pp = (const f32x4*)(part + (size_t)row * 16); const f32x4 a = pp[0], b = pp[1], c = pp[2], d = pp[3];
                    const float s = ((a[0] + a[1]) + (a[2] + a[3])) + ((b[0] + b[1]) + (b[2] + b[3])) + ((c[0] + c[1]) + (c[2] + c[3])) + ((d[0] + d[1]) + (d[2] + d[3]));
                    rs = 1.0f / sqrtf(s * inv_dim + NORM_EPS); }
                if (ACT == 0) rs *= sc;
                bf16_t* rowp = hm ? O + ((size_t)(col0 >> 6) * hm + row) * 64 + (col0 & 63) : O + (size_t)row * ldc + col0;
#pragma unroll
                for (int bj = 0; bj < 2; ++bj) { f32x4 v0 = acc[ai][bj][m][0] * rs, v1 = acc[ai][bj][m][1] * rs;
                    if (ACT == 1) {
#pragma unroll
                        for (int e = 0; e < 4; ++e) { float a = fmaxf(v0[e], 0.f), b = fmaxf(v1[e], 0.f); v0[e] = a * a; v1[e] = b * b; } }
                    u32x4 w; w.x = cvt_pk_bf16(v0[0], v0[1]); w.y = cvt_pk_bf16(v0[2], v0[3]); w.z = cvt_pk_bf16(v1[0], v1[1]); w.w = cvt_pk_bf16(v1[2], v1[3]);
                    *(u32x4*)(rowp + (hm ? (size_t)bj * 2 * hm * 64 : (size_t)(bj * HALF))) = w; } }
    }
};
struct EpiIn {
    static constexpr bool PERM = true, AFTER_DRAIN = false;
    const float* part0; bf16_t *QA, *KA, *VA, *CQ, *CKV, *KR; float *pcq, *pckv; const float *gq, *gk, *tac, *tas, *tbc, *tbs; float qscale;
    __device__ __forceinline__ void st16(bf16_t* p, const f32x4 a, const f32x4 b) const { u32x4 w; w.x = cvt_pk_bf16(a[0], a[1]); w.y = cvt_pk_bf16(a[2], a[3]); w.z = cvt_pk_bf16(b[0], b[1]); w.w = cvt_pk_bf16(b[2], b[3]); *(u32x4*)p = w; }
    __device__ __forceinline__ float sq8(const f32x4 a, const f32x4 b) const { return (a[0] * a[0] + a[1] * a[1]) + (a[2] * a[2] + a[3] * a[3]) + (b[0] * b[0] + b[1] * b[1]) + (b[2] * b[2] + b[3] * b[3]); }
    __device__ __forceinline__ void operator()(const f32x4 (&acc)[2][2][4][2], const Unit& u, int wr, int wc, int fr, int fq) const {
        const int row0 = u.pm * BM + wr * 64 + fr; const int pn = u.pn;
#pragma unroll
        for (int ai = 0; ai < 2; ++ai)
#pragma unroll
            for (int m = 0; m < 4; ++m) { const int row = row0 + ai * HALF + m * 16;
                const float rsx = 1.0f / sqrtf(part0[(size_t)row * 16] * (1.0f / 1024.0f) + NORM_EPS);
                const int t = row & 8191; const int prow = t >> 6, pcol = t & 63;
                f32x4 z[2][2];
#pragma unroll
                for (int bj = 0; bj < 2; ++bj)
#pragma unroll
                    for (int n = 0; n < 2; ++n) z[bj][n] = acc[ai][bj][m][n] * rsx;
                if (pn <= 2) {
                    if (pn == 2 && wc >= 2) {
#pragma unroll
                        for (int bj = 0; bj < 2; ++bj) st16(VA + (size_t)row * 128 + (wc - 2) * 64 + 32 * bj + 8 * fq, z[bj][0], z[bj][1]);
                    } else {
                        float ss = sq8(z[0][0], z[0][1]) + sq8(z[1][0], z[1][1]);
                        ss += __shfl_xor(ss, 16); ss += __shfl_xor(ss, 32);
                        const float hr = 1.0f / sqrtf(ss * (1.0f / 64.0f) + NORM_EPS);
                        const float* gain = (pn == 2) ? gk : gq; const float sc = (pn == 2) ? 1.f : qscale;
                        bf16_t* dst = (pn == 2) ? KA + (size_t)row * 128 + wc * 64 : QA + (size_t)row * 512 + (4 * pn + wc) * 64;
#pragma unroll
                        for (int bj = 0; bj < 2; ++bj) { const int pos = bj ? pcol : prow; f32x4 o2[2];
#pragma unroll
                            for (int n = 0; n < 2; ++n) { const int ti = pos * 16 + 8 * (fq & 1) + 4 * n;
                                const f32x4 c4 = *(const f32x4*)(tac + ti), s4 = *(const f32x4*)(tas + ti), g4 = *(const f32x4*)(gain + 32 * bj + 8 * fq + 4 * n);
#pragma unroll
                                for (int e = 0; e < 4; ++e) { const float y = z[bj][n][e] * hr * g4[e]; const float py = __shfl_xor(y, 32);
                                    o2[n][e] = (((fq & 2) == 0) ? y * c4[e] - py * s4[e] : y * c4[e] + py * s4[e]) * sc; } }
                            st16(dst + 32 * bj + 8 * fq, o2[0], o2[1]); }
                    }
                } else if (pn == 3) {
#pragma unroll
                    for (int bj = 0; bj < 2; ++bj) st16(CQ + (size_t)row * 384 + 128 * bj + 32 * wc + 8 * fq, z[bj][0], z[bj][1]);
                    float ss = sq8(z[0][0], z[0][1]) + sq8(z[1][0], z[1][1]); ss += __shfl_xor(ss, 16); ss += __shfl_xor(ss, 32);
                    if (fq == 0) { pcq[(size_t)row * 16 + wc] = ss; pcq[(size_t)row * 16 + 8 + wc] = 0.f; }
                } else if (pn == 4) {
                    st16(CQ + (size_t)row * 384 + 256 + 32 * wc + 8 * fq, z[0][0], z[0][1]);
                    st16(CKV + (size_t)row * 256 + 32 * wc + 8 * fq, z[1][0], z[1][1]);
                    float s0 = sq8(z[0][0], z[0][1]), s1 = sq8(z[1][0], z[1][1]); s0 += __shfl_xor(s0, 16); s0 += __shfl_xor(s0, 32); s1 += __shfl_xor(s1, 16); s1 += __shfl_xor(s1, 32);
                    if (fq == 0) { pcq[(size_t)row * 16 + 4 + wc] = s0; pcq[(size_t)row * 16 + 12 + wc] = 0.f; pckv[(size_t)row * 16 + wc] = s1; }
                } else {
                    st16(CKV + (size_t)row * 256 + 128 + 32 * wc + 8 * fq, z[0][0], z[0][1]);
                    float s0 = sq8(z[0][0], z[0][1]); s0 += __shfl_xor(s0, 16); s0 += __shfl_xor(s0, 32);
                    if (fq == 0) { pckv[(size_t)row * 16 + 4 + wc] = s0; pckv[(size_t)row * 16 + 8 + wc] = 0.f; pckv[(size_t)row * 16 + 12 + wc] = 0.f; }
                    if (wc == 0) {
                        const int pos = (fq < 2) ? prow : pcol; f32x4 o2[2];
#pragma unroll
                        for (int n = 0; n < 2; ++n) { const f32x4 c4 = *(const f32x4*)(tbc + pos * 8 + 4 * n), s4 = *(const f32x4*)(tbs + pos * 8 + 4 * n);
#pragma unroll
                            for (int e = 0; e < 4; ++e) { const float y = z[1][n][e]; const float py = __shfl_xor(y, 16);
                                o2[n][e] = ((fq & 1) == 0) ? y * c4[e] - py * s4[e] : y * c4[e] + py * s4[e]; } }
                        st16(KR + (size_t)row * 32 + 8 * fq, o2[0], o2[1]);
                    }
                }
            }
    }
};

struct EpiRes {
    static constexpr bool PERM = true, AFTER_DRAIN = false;
    const float* base; float* out; bf16_t* ob; float* part; int ldc;
    __device__ __forceinline__ void operator()(const f32x4 (&acc)[2][2][4][2], const Unit& u, int wr, int wc, int fr, int fq) const {
        const int row0 = u.pm * BM + wr * 64 + fr; const int col0 = u.pn * BM + wc * 32 + 8 * fq;
#pragma unroll
        for (int ai = 0; ai < 2; ++ai)
#pragma unroll
            for (int m = 0; m < 4; ++m) { const int row = row0 + ai * HALF + m * 16; const size_t off = (size_t)row * ldc + col0; float ss = 0.f;
#pragma unroll
                for (int bj = 0; bj < 2; ++bj) { const f32x4 b0 = *(const f32x4*)(base + off + bj * HALF), b1 = *(const f32x4*)(base + off + bj * HALF + 4);
                    const f32x4 v0 = acc[ai][bj][m][0] + b0, v1 = acc[ai][bj][m][1] + b1;
                    *(f32x4*)(out + off + bj * HALF) = v0; *(f32x4*)(out + off + bj * HALF + 4) = v1;
                    u32x4 w; w.x = cvt_pk_bf16(v0[0], v0[1]); w.y = cvt_pk_bf16(v0[2], v0[3]); w.z = cvt_pk_bf16(v1[0], v1[1]); w.w = cvt_pk_bf16(v1[2], v1[3]);
                    if (ob) *(u32x4*)(ob + off + bj * HALF) = w;
                    ss += (v0[0] * v0[0] + v0[1] * v0[1]) + (v0[2] * v0[2] + v0[3] * v0[3]) + (v1[0] * v1[0] + v1[1] * v1[1]) + (v1[2] * v1[2] + v1[3] * v1[3]); }
                ss += __shfl_xor(ss, 16); ss += __shfl_xor(ss, 32);
                if (fq == 0) part[(size_t)row * 16 + u.pn * 4 + wc] = ss; }
    }
};

template <class Epi, class Sched, bool ALIGN_EPI = false, bool SP2 = false>
__device__ __forceinline__ void gemm_phase(PG8_LAS unsigned char* lds, const Gemm g, const Sched& S, const Epi& E) {
    const int tid = threadIdx.x, wid = __builtin_amdgcn_readfirstlane(tid >> 6), lane = tid & 63, wr = wid >> 2, wc = wid & 3, fr = lane & 15, fq = lane >> 4;
    const int K = g.K, nt = K / BK;
    unsigned voffA[2], voffB[2];
#pragma unroll
    for (int i = 0; i < 2; ++i) { int R, C; stage_rc(tid * 16 + i * 8192, R, C); const int Rb = Epi::PERM ? ((R & ~31) + perm32(R & 31)) : R;
        voffA[i] = (unsigned)(R * K + C) * 2u; voffB[i] = (unsigned)(Rb * K + C) * 2u; }
    const size_t kstep = (size_t)(BK * 2);
    const size_t hstep = (size_t)HALF * K * 2;
    const size_t tstep = 2 * hstep;
    const unsigned ldsw = (unsigned)wid * 1024u;
    const int aoff = lds_byte(wr * 64 + fr, fq * 8), boff = lds_byte(wc * 32 + fr, fq * 8);
#define PG8_SA(b, h) (((b) * 2 + (h)) * HTB)
#define PG8_SB(b, h) ((4 + (b) * 2 + (h)) * HTB)
#define PG8_STAGE(bufoff, gbase, voff) do { _Pragma("unroll") for (int _i = 0; _i < 2; ++_i) \
        __builtin_amdgcn_global_load_lds((const unsigned*)((const char*)(gbase) + (voff)[_i]), (PG8_LAS unsigned*)(lds + (bufoff) + ldsw + _i * 8192), 16, 0, 0); } while (0)
#define PG8_LDA(dst, b, h) do { _Pragma("unroll") for (int m = 0; m < 4; ++m) _Pragma("unroll") for (int k = 0; k < 2; ++k) dst[m][k] = *(const PG8_LAS bf16x8*)(lds + PG8_SA(b, h) + aoff + m * 2048 + k * 1024); } while (0)
#define PG8_LDB(dst, b, h) do { _Pragma("unroll") for (int n = 0; n < 2; ++n) _Pragma("unroll") for (int k = 0; k < 2; ++k) dst[n][k] = *(const PG8_LAS bf16x8*)(lds + PG8_SB(b, h) + boff + n * 2048 + k * 1024); } while (0)
#define PG8_MMA(ai, bj, At, Bt) do { __builtin_amdgcn_s_setprio(1); _Pragma("unroll") for (int m = 0; m < 4; ++m) _Pragma("unroll") for (int n = 0; n < 2; ++n) _Pragma("unroll") for (int k = 0; k < 2; ++k) \
        acc[ai][bj][m][n] = __builtin_amdgcn_mfma_f32_16x16x32_bf16(Bt[n][k], At[m][k], acc[ai][bj][m][n], 0, 0, 0); __builtin_amdgcn_s_setprio(0); } while (0)
#define PG8_WAIT_V(n) asm volatile("s_waitcnt vmcnt(" #n ")" ::: "memory")
#define PG8_WAIT_L(n) asm volatile("s_waitcnt lgkmcnt(" #n ")" ::: "memory")
#define PG8_BAR __builtin_amdgcn_s_barrier()
#define PG8_SCHED __builtin_amdgcn_sched_barrier(0)
    Unit cur, nxt; int ui = 0;
    if (!S.next(0, cur)) return;
    f32x4 acc[2][2][4][2];
#pragma unroll
    for (int a = 0; a < 2; ++a)
#pragma unroll
        for (int b = 0; b < 2; ++b)
#pragma unroll
            for (int m = 0; m < 4; ++m)
#pragma unroll
                for (int n = 0; n < 2; ++n) acc[a][b][m][n] = (f32x4){0.f, 0.f, 0.f, 0.f};
    bf16x8 At[4][2], B0[2][2], B1[2][2];
    const char* cA = (const char*)g.A + (size_t)cur.pm * tstep; const char* cB = (const char*)g.Bt + (size_t)cur.pn * tstep;
    S.a_ready(cur);
    if constexpr (SP2) {
        PG8_STAGE(PG8_SB(0, 0), cB, voffB); PG8_STAGE(PG8_SB(0, 1), cB + hstep, voffB); PG8_STAGE(PG8_SA(0, 0), cA, voffA); PG8_STAGE(PG8_SA(0, 1), cA + hstep, voffA);
        if (wr == 1) PG8_BAR;
        PG8_WAIT_V(2); PG8_BAR;
        PG8_STAGE(PG8_SB(1, 0), cB + kstep, voffB); PG8_STAGE(PG8_SA(1, 0), cA + kstep, voffA); PG8_STAGE(PG8_SB(1, 1), cB + hstep + kstep, voffB);
        PG8_WAIT_V(6); PG8_BAR;
    } else {
        PG8_STAGE(PG8_SB(0, 0), cB, voffB); PG8_STAGE(PG8_SA(0, 0), cA, voffA); PG8_STAGE(PG8_SB(0, 1), cB + hstep, voffB); PG8_STAGE(PG8_SA(0, 1), cA + hstep, voffA);
        if (wr == 1) PG8_BAR;
        PG8_WAIT_V(4); PG8_BAR;
        PG8_STAGE(PG8_SB(1, 0), cB + kstep, voffB); PG8_STAGE(PG8_SA(1, 0), cA + kstep, voffA); PG8_STAGE(PG8_SB(1, 1), cB + hstep + kstep, voffB);
        PG8_WAIT_V(6); PG8_BAR;
    }
    for (;;) {
        const bool has_next = S.next(ui + 1, nxt);
        const char* nA = has_next ? (const char*)g.A + (size_t)nxt.pm * tstep : cA; const char* nB = has_next ? (const char*)g.Bt + (size_t)nxt.pn * tstep : cB;
        for (int t = 0; t < nt; t += 2) {
            const bool last = (t == nt - 2);
            const char* a1 = cA + (size_t)(t + 1) * kstep;
            const char* a2 = last ? nA : cA + (size_t)(t + 2) * kstep; const char* b2 = last ? nB : cB + (size_t)(t + 2) * kstep;
            const char* a3 = a2 + kstep; const char* b3 = b2 + kstep;
            if (last && has_next) S.a_ready(nxt);
            if constexpr (SP2) {
            PG8_LDB(B0, 0, 0); PG8_LDB(B1, 0, 1); PG8_SCHED; PG8_LDA(At, 0, 0); PG8_STAGE(PG8_SA(1, 1), a1 + hstep, voffA);
            PG8_WAIT_V(8); PG8_WAIT_L(0); PG8_BAR; PG8_MMA(0, 0, At, B0); PG8_MMA(0, 1, At, B1); PG8_BAR; PG8_SCHED;
            PG8_LDA(At, 0, 1); PG8_STAGE(PG8_SB(0, 0), b2, voffB); PG8_STAGE(PG8_SB(0, 1), b2 + hstep, voffB); PG8_STAGE(PG8_SA(0, 0), a2, voffA);
            PG8_WAIT_V(8); PG8_WAIT_L(0); PG8_BAR; PG8_MMA(1, 0, At, B0); PG8_MMA(1, 1, At, B1); PG8_BAR; PG8_SCHED;
            PG8_LDB(B0, 1, 0); PG8_LDB(B1, 1, 1); PG8_SCHED; PG8_LDA(At, 1, 0); PG8_STAGE(PG8_SA(0, 1), a2 + hstep, voffA);
            PG8_WAIT_V(8); PG8_WAIT_L(0); PG8_BAR; PG8_MMA(0, 0, At, B0); PG8_MMA(0, 1, At, B1); PG8_BAR; PG8_SCHED;
            PG8_LDA(At, 1, 1); PG8_STAGE(PG8_SB(1, 0), b3, voffB); PG8_STAGE(PG8_SB(1, 1), b3 + hstep, voffB); PG8_STAGE(PG8_SA(1, 0), a3, voffA);
            PG8_WAIT_V(8); PG8_WAIT_L(0); PG8_BAR; PG8_MMA(1, 0, At, B0); PG8_MMA(1, 1, At, B1); PG8_BAR; PG8_SCHED;
            } else {
            PG8_LDB(B0, 0, 0); PG8_SCHED; PG8_LDA(At, 0, 0); PG8_STAGE(PG8_SA(1, 1), a1 + hstep, voffA);
            PG8_WAIT_L(8); PG8_BAR; PG8_WAIT_L(0); PG8_MMA(0, 0, At, B0); PG8_BAR; PG8_SCHED;
            PG8_LDB(B1, 0, 1); PG8_STAGE(PG8_SB(0, 0), b2, voffB);
            PG8_BAR; PG8_WAIT_L(0); PG8_MMA(0, 1, At, B1); PG8_BAR;
            PG8_LDA(At, 0, 1); PG8_STAGE(PG8_SA(0, 0), a2, voffA);
            PG8_BAR; PG8_WAIT_L(0); PG8_MMA(1, 0, At, B0); PG8_BAR; PG8_SCHED;
            PG8_STAGE(PG8_SB(0, 1), b2 + hstep, voffB);
            PG8_WAIT_V(6); PG8_BAR; PG8_MMA(1, 1, At, B1); PG8_BAR;
            PG8_LDB(B0, 1, 0); PG8_SCHED; PG8_LDA(At, 1, 0); PG8_STAGE(PG8_SA(0, 1), a2 + hstep, voffA);
            PG8_WAIT_L(8); PG8_BAR; PG8_WAIT_L(0); PG8_MMA(0, 0, At, B0); PG8_BAR; PG8_SCHED;
            PG8_LDB(B1, 1, 1); PG8_STAGE(PG8_SB(1, 0), b3, voffB);
            PG8_BAR; PG8_WAIT_L(0); PG8_MMA(0, 1, At, B1); PG8_BAR;
            PG8_LDA(At, 1, 1); PG8_STAGE(PG8_SA(1, 0), a3, voffA);
            PG8_BAR; PG8_WAIT_L(0); PG8_MMA(1, 0, At, B0); PG8_BAR; PG8_SCHED;
            PG8_STAGE(PG8_SB(1, 1), b3 + hstep, voffB);
            PG8_WAIT_V(6); PG8_BAR; PG8_MMA(1, 1, At, B1); PG8_BAR;
            }
        }
        if constexpr (ALIGN_EPI) { if (wr == 0) PG8_BAR; }
        if constexpr (!Epi::AFTER_DRAIN) { E(acc, cur, wr, wc, fr, fq); S.done(cur); }
        if (!has_next) break;
#pragma unroll
        for (int a = 0; a < 2; ++a)
#pragma unroll
            for (int b = 0; b < 2; ++b)
#pragma unroll
                for (int m = 0; m < 4; ++m)
#pragma unroll
                    for (int n = 0; n < 2; ++n) acc[a][b][m][n] = (f32x4){0.f, 0.f, 0.f, 0.f};
        cur = nxt; cA = nA; cB = nB; ++ui;
        if constexpr (ALIGN_EPI) { if (wr == 1) PG8_BAR; }
    }
    PG8_WAIT_V(0);
    if constexpr (!ALIGN_EPI) { if (wr == 0) PG8_BAR; }
    PG8_BAR;
    if constexpr (Epi::AFTER_DRAIN) { E.fused(acc, cur, wr, wc, fr, fq, lds, wid, lane); S.done(cur); }
#undef PG8_SA
#undef PG8_SB
#undef PG8_STAGE
#undef PG8_LDA
#undef PG8_LDB
#undef PG8_MMA
#undef PG8_WAIT_V
#undef PG8_WAIT_L
#undef PG8_BAR
#undef PG8_SCHED
}
}
namespace att {
using bf16x8 = __attribute__((ext_vector_type(8))) short;
using s16x4 = __attribute__((ext_vector_type(4))) short;
using f32x16 = __attribute__((ext_vector_type(16))) float;
using u32x4 = __attribute__((ext_vector_type(4))) unsigned;
typedef unsigned short bf16_t;
#define ALAS __attribute__((address_space(3)))
constexpr int KSLOT = 8192, VSLOT = 8192;
constexpr int NSLOT = 6;
constexpr int L_K = 0, L_V = NSLOT * KSLOT, L_WS = L_V + NSLOT * VSLOT, L_RPB = L_WS + 8 * 64 * 4, L_OST = L_RPB + 2048, L_END = L_OST + 8 * 4096;
constexpr float THR = 8.f;
constexpr float LOG2E = 1.4426950408889634f;
struct Desc { const bf16_t *Q0, *Q1, *K0, *K1, *V; bf16_t* O; int q0p, q1p, k0p, k1p, vp, op; };
struct Next { const bf16_t *K0, *K1, *V; int k0p, k1p, vp; long rowbase; int tlo, thi, dqk; };

__device__ __forceinline__ int crow(int r, int hi) { return (r & 3) + 8 * (r >> 2) + 4 * hi; }
typedef float f32x2_t __attribute__((ext_vector_type(2))); typedef __bf16 bf16x2_t __attribute__((ext_vector_type(2)));
__device__ __forceinline__ unsigned cvtpk_s(float lo, float hi) { f32x2_t v = {lo, hi}; bf16x2_t b = __builtin_convertvector(v, bf16x2_t); return __builtin_bit_cast(unsigned, b); }
__device__ __forceinline__ float bf2f(short s) { return __uint_as_float(((unsigned)(unsigned short)s) << 16); }
typedef short v4i16_t __attribute__((ext_vector_type(4)));
__device__ __forceinline__ s16x4 vtr(const ALAS unsigned char* p) { return __builtin_bit_cast(s16x4, __builtin_amdgcn_ds_read_tr16_b64_v4i16((ALAS v4i16_t*)p)); }
__device__ __forceinline__ void dma16(const void* g, ALAS unsigned char* l) { unsigned keep; const unsigned dst = (unsigned)__builtin_amdgcn_readfirstlane((int)(unsigned)(uintptr_t)l);
    asm volatile("s_mov_b32 %0, m0\n\ts_mov_b32 m0, %2\n\ts_nop 0\n\tglobal_load_lds_dwordx4 %1, off\n\ts_mov_b32 m0, %0" : "=&s"(keep) : "v"(g), "s"(dst) : "memory"); }
__device__ __forceinline__ float xhalf_max(float m) { auto rr = __builtin_amdgcn_permlane32_swap(__float_as_uint(m), __float_as_uint(m), false, false); return fmaxf(__uint_as_float(rr[0]), __uint_as_float(rr[1])); }
__device__ __forceinline__ float xhalf_sum(float m) { auto rr = __builtin_amdgcn_permlane32_swap(__float_as_uint(m), __float_as_uint(m), false, false); return __uint_as_float(rr[0]) + __uint_as_float(rr[1]); }
__device__ __forceinline__ void sincos_acc(float x, float& s, float& c) {
    const float k = rintf(x * 0.6366197723675814f);
    float r = fmaf(-k, 1.5707962513e+00f, x); r = fmaf(-k, 7.5497894159e-08f, r); r = fmaf(-k, 5.3903029534e-15f, r);
    const int q = ((int)k) & 3; const float r2 = r * r;
    const float sp = r + r * r2 * (-1.6666654611e-1f + r2 * (8.3321608736e-3f + r2 * (-1.9515295891e-4f)));
    const float cp = 1.f + r2 * (-0.5f + r2 * (4.166664568298827e-2f + r2 * (-1.388731625493765e-3f + r2 * 2.443315711809948e-5f)));
    const float s0 = (q & 1) ? cp : sp, c0 = (q & 1) ? sp : cp;
    s = (q & 2) ? -s0 : s0; c = ((q + 1) & 2) ? -c0 : c0;
}

template <int DQK, int MODE, int HALF = -1>
__device__ __forceinline__ void unit(const Desc& d, long rowbase, int q0, int tlo, int thi, const float* rpb_h, ALAS unsigned char* shm, bool pre, bool has_next, const Next& nx) {
    constexpr int ND = DQK / 16;
#define N0(r) ((HALF != 1) || (r) >= 12)
#define N1(r) ((HALF != 0) || (r) < 4)
#define NKG(kg) ((kg) == 0 ? (HALF != 1) : (kg) == 3 ? (HALF != 0) : true)
    const int tid = threadIdx.x, lane = tid & 63, r32 = lane & 31, hi = lane >> 5;
    const int wid = __builtin_amdgcn_readfirstlane(tid >> 6);
    ALAS float* wsf = (ALAS float*)(shm + L_WS) + wid * 64;
    ALAS float* rpbs = (ALAS float*)(shm + L_RPB);
    const bf16_t* ksrc0 = d.K0 + (rowbase + lane) * (long)d.k0p + wid * 8;
    const bf16_t* ksrc1 = d.K1 + (rowbase + lane) * (long)d.k1p + (wid & 3) * 8;
    const bf16_t* vsrc = d.V + (rowbase + 16 * (wid & 3) + (lane >> 2)) * (long)d.vp + (wid >> 2) * 32 + (lane & 3) * 8;
#define ATT_ISSUE_K(t, koff) do { \
        dma16(ksrc0 + (long)(t) * 64 * d.k0p, shm + L_K + (koff) + wid * 1024); \
        if (DQK == 96) { dma16(ksrc1 + (long)(t) * 64 * d.k1p, shm + L_K + (koff) + (8 + (wid & 3)) * 1024); } } while (0)
#define ATT_ISSUE_V(t, voff) dma16(vsrc + (long)(t) * 64 * d.vp, shm + L_V + (voff) + wid * 1024)
#define ATT_WAITBAR() asm volatile("s_waitcnt vmcnt(0) lgkmcnt(0)\n\ts_barrier" ::: "memory")
    if (!pre) {
    ATT_ISSUE_K(tlo, 0); ATT_ISSUE_V(tlo, 0);
#pragma unroll
    for (int i = 1; i < 5; ++i) if (tlo + i <= thi) { ATT_ISSUE_K(tlo + i, i * KSLOT); ATT_ISSUE_V(tlo + i, i * VSLOT); }
    }
    const int tq = q0 + wid * 32 + r32;
    if (MODE == 1) { for (int i = tid; i < 15 * 32; i += 512) { const int dr = i >> 5, j = i & 31; rpbs[i] = (j < 31) ? rpb_h[dr * 31 + j] * LOG2E : -INFINITY; } }
    bf16x8 qr[ND];
    { const bf16_t* qp = d.Q0 + (rowbase + tq) * (long)d.q0p + hi * 8;
#pragma unroll
      for (int d0 = 0; d0 < 4; ++d0) qr[d0] = *(const bf16x8*)(qp + d0 * 16); }
    if constexpr (DQK == 96) {
        const bf16_t* qp = d.Q1 + (rowbase + tq) * (long)d.q1p + hi * 8;
#pragma unroll
        for (int dd = 0; dd < 2; ++dd) {
            const bf16x8 raw = *(const bf16x8*)(qp + dd * 16); const u32x4 w = __builtin_bit_cast(u32x4, raw); u32x4 pw;
#pragma unroll
            for (int j = 0; j < 4; ++j) pw[j] = (unsigned)__shfl_xor((int)w[j], 32);
            const bf16x8 par = __builtin_bit_cast(bf16x8, pw);
            const float pos = (dd == 0) ? (float)(tq >> 6) : (float)(tq & 63);
            float ov[8];
#pragma unroll
            for (int e = 0; e < 8; ++e) { const float inv = exp2f(-(float)e * (13.287712379549449f / 8.0f)); float s, c; sincos_acc(pos * inv, s, c);
                const float x = bf2f(raw[e]), y = bf2f(par[e]); ov[e] = hi == 0 ? x * c - y * s : x * c + y * s; }
            u32x4 o4; o4.x = cvtpk_s(ov[0], ov[1]); o4.y = cvtpk_s(ov[2], ov[3]); o4.z = cvtpk_s(ov[4], ov[5]); o4.w = cvtpk_s(ov[6], ov[7]);
            qr[4 + dd] = __builtin_bit_cast(bf16x8, o4);
        }
    }
    float mhat = 0.f, l_reg = 0.f; f32x16 o[2]; o[0] = f32x16{}; o[1] = f32x16{}; f32x16 negm = f32x16{};
    bool first = true;
    const int qrow = tq >> 6, qc = tq & 63;
    const int wrow = __builtin_amdgcn_readfirstlane(qrow);
    const int rs = min(max(wrow - 4, 0), 120);
    const int cs = min(max(qc - 8, 0), 48);
    unsigned co[32];
    if (MODE == 1) {
#pragma unroll
        for (int r = 0; r < 16; ++r) { const int kc = crow(r, hi), kc1 = kc + 32;
            co[r] = (((unsigned)(kc - cs) < 16u) ? (unsigned)(kc - qc + 15) : 31u) * 4u; co[16 + r] = (((unsigned)(kc1 - cs) < 16u) ? (unsigned)(kc1 - qc + 15) : 31u) * 4u; }
    }
    const unsigned tb_addr = (unsigned)(uintptr_t)(shm + L_RPB);
#define ATT_KRD(KOFF) do { const ALAS unsigned char* ka_ = shm + L_K + (KOFF) + hi * 1024 + r32 * 16; \
        _Pragma("unroll") for (int d0 = 0; d0 < ND; ++d0) { kf[2 * d0] = *(const ALAS bf16x8*)(ka_ + d0 * 2048); kf[2 * d0 + 1] = *(const ALAS bf16x8*)(ka_ + d0 * 2048 + 512); } } while (0)
#define ATT_QK2(P0, P1, d0) do { if ((d0) == 0) { P0 = __builtin_amdgcn_mfma_f32_32x32x16_bf16(kf[0], qr[0], negm, 0, 0, 0); P1 = __builtin_amdgcn_mfma_f32_32x32x16_bf16(kf[1], qr[0], negm, 0, 0, 0); } \
            else { P0 = __builtin_amdgcn_mfma_f32_32x32x16_bf16(kf[2 * (d0)], qr[d0], P0, 0, 0, 0); P1 = __builtin_amdgcn_mfma_f32_32x32x16_bf16(kf[2 * (d0) + 1], qr[d0], P1, 0, 0, 0); } } while (0)
#define ATT_QKM(P0, P1) do { _Pragma("unroll") for (int d0 = 0; d0 < ND; ++d0) ATT_QK2(P0, P1, d0); } while (0)
#define ATT_VRD(VOFF) do { const ALAS unsigned char* va_ = shm + L_V + (VOFF) + ((lane >> 4) & 1) * 32 + (lane & 3) * 8 + (4 * hi + ((lane & 15) >> 2)) * 64; \
        _Pragma("unroll") for (int kg = 0; kg < 4; ++kg) _Pragma("unroll") for (int dh = 0; dh < 2; ++dh) if (NKG(kg)) { \
            vf[(kg * 2 + dh) * 2] = vtr(va_ + dh * 4096 + kg * 1024); vf[(kg * 2 + dh) * 2 + 1] = vtr(va_ + dh * 4096 + kg * 1024 + 512); } } while (0)
#define ATT_VWAIT() do {} while (0)
#define ATT_VF(kg, dh) ((bf16x8){vf[((kg) * 2 + (dh)) * 2][0], vf[((kg) * 2 + (dh)) * 2][1], vf[((kg) * 2 + (dh)) * 2][2], vf[((kg) * 2 + (dh)) * 2][3], vf[((kg) * 2 + (dh)) * 2 + 1][0], vf[((kg) * 2 + (dh)) * 2 + 1][1], vf[((kg) * 2 + (dh)) * 2 + 1][2], vf[((kg) * 2 + (dh)) * 2 + 1][3]})
#define ATT_ACTIVE(t) ((MODE == 0) || ((t) >= rs && (t) <= rs + 7))
    const unsigned kaddr0 = (unsigned)(uintptr_t)(shm + L_K) + hi * 1024 + r32 * 16;
    const unsigned vaddr0 = (unsigned)(uintptr_t)(shm + L_V) + ((lane >> 4) & 1) * 32 + (lane & 3) * 8 + (4 * hi + ((lane & 15) >> 2)) * 64;
    bf16x8 kf[2 * ND]; s16x4 vf[16];
    f32x16 p0 = f32x16{}, p1 = f32x16{};
    u32x4 pw[4] = {};
#define ATT_KEEP_PV() do { asm volatile("" :: "v"(pw[0]), "v"(pw[1]), "v"(pw[2]), "v"(pw[3])); \
        asm volatile("" :: "v"(vf[0]), "v"(vf[1]), "v"(vf[2]), "v"(vf[3]), "v"(vf[4]), "v"(vf[5]), "v"(vf[6]), "v"(vf[7]), "v"(vf[8]), "v"(vf[9]), "v"(vf[10]), "v"(vf[11]), "v"(vf[12]), "v"(vf[13]), "v"(vf[14]), "v"(vf[15])); } while (0)
#define ATT_KEEP_K() do { if constexpr (ND == 4) asm volatile("" :: "v"(kf[0]), "v"(kf[1]), "v"(kf[2]), "v"(kf[3]), "v"(kf[4]), "v"(kf[5]), "v"(kf[6]), "v"(kf[7])); \
        else asm volatile("" :: "v"(kf[0]), "v"(kf[1]), "v"(kf[2]), "v"(kf[3]), "v"(kf[4]), "v"(kf[5]), "v"(kf[6]), "v"(kf[7]), "v"(kf[8 % (2 * ND)]), "v"(kf[9 % (2 * ND)]), "v"(kf[10 % (2 * ND)]), "v"(kf[11 % (2 * ND)])); } while (0)
    ATT_WAITBAR();
    static_assert(MODE == 1, "this unit is the neighbourhood one: step j of a wave = its j-th window row");
    int islot = 5;
    for (int j = 0; j < 8; ++j) {
        const int t = rs + j;
        const int rel = t - tlo; const int buf = rel >= 6 ? rel - 6 : rel;
        const bool issued = tlo + j + 5 <= thi;
        if (issued) { ATT_ISSUE_K(tlo + j + 5, islot * KSLOT); ATT_ISSUE_V(tlo + j + 5, islot * VSLOT); }
        islot = (islot == 5) ? 0 : islot + 1;
        const bool act = true;
        if (act) { ATT_KRD(buf * KSLOT); ATT_QKM(p0, p1); if (MODE == 0) ATT_VRD(buf * VSLOT); }
        __builtin_amdgcn_sched_barrier(0);
        if (act) {
            if (MODE == 1) {
                float bb[32];
                const ALAS unsigned char* rb = shm + L_RPB + (t - wrow + 7) * 128;
#pragma unroll
                for (int e = 0; e < 16; ++e) { bb[e] = N0(e) ? *(const ALAS float*)(rb + co[e]) : 0.f; bb[16 + e] = N1(e) ? *(const ALAS float*)(rb + co[16 + e]) : 0.f; }
#pragma unroll
                for (int e = 0; e < 16; ++e) { if (N0(e)) p0[e] += bb[e]; if (N1(e)) p1[e] += bb[16 + e]; }
                ATT_VRD(buf * VSLOT);
            }
            float rm0 = -INFINITY, rm1 = -INFINITY;
#pragma unroll
            for (int r = 0; r < 16; r += 2) { if (N0(r)) rm0 = fmaxf(fmaxf(rm0, p0[r]), p0[r + 1]); if (N1(r)) rm1 = fmaxf(fmaxf(rm1, p1[r]), p1[r + 1]); }
            float rm = fmaxf(rm0, rm1);
            rm = xhalf_max(rm);
            if (first || __any(rm > THR)) {
                const float dl = first ? rm : fmaxf(rm, 0.f);
                mhat += dl;
#pragma unroll
                for (int r = 0; r < 16; ++r) { if (N0(r)) p0[r] -= dl; if (N1(r)) p1[r] -= dl; negm[r] = -mhat; }
                if (!first) { const float f = exp2f(-dl); l_reg *= f; if (hi == 0) wsf[r32] = f;
#pragma unroll
                    for (int r = 0; r < 16; ++r) { const float fr_ = wsf[crow(r, hi)]; o[0][r] *= fr_; o[1][r] *= fr_; } }
                first = false;
            }
            float sa0 = 0.f, sa1 = 0.f, sa2 = 0.f, sa3 = 0.f;
#pragma unroll
            for (int r = 0; r < 16; r += 4) { if (N0(r)) { p0[r] = __builtin_amdgcn_exp2f(p0[r]); p0[r + 1] = __builtin_amdgcn_exp2f(p0[r + 1]); p0[r + 2] = __builtin_amdgcn_exp2f(p0[r + 2]); p0[r + 3] = __builtin_amdgcn_exp2f(p0[r + 3]);
                sa0 += p0[r]; sa1 += p0[r + 1]; sa2 += p0[r + 2]; sa3 += p0[r + 3]; } else { p0[r] = 0.f; p0[r + 1] = 0.f; p0[r + 2] = 0.f; p0[r + 3] = 0.f; } }
#pragma unroll
            for (int j = 0; j < 4; ++j) { pw[0][j] = cvtpk_s(p0[2 * j], p0[2 * j + 1]); pw[1][j] = cvtpk_s(p0[8 + 2 * j], p0[8 + 2 * j + 1]); }
            ATT_VWAIT();
#pragma unroll
            for (int kg = 0; kg < 2; ++kg)
#pragma unroll
                for (int dh = 0; dh < 2; ++dh) if (NKG(kg)) o[dh] = __builtin_amdgcn_mfma_f32_32x32x16_bf16(__builtin_bit_cast(bf16x8, pw[kg]), ATT_VF(kg, dh), o[dh], 0, 0, 0);
            __builtin_amdgcn_sched_barrier(0);
#pragma unroll
            for (int r = 0; r < 16; r += 4) { if (N1(r)) { p1[r] = __builtin_amdgcn_exp2f(p1[r]); p1[r + 1] = __builtin_amdgcn_exp2f(p1[r + 1]); p1[r + 2] = __builtin_amdgcn_exp2f(p1[r + 2]); p1[r + 3] = __builtin_amdgcn_exp2f(p1[r + 3]);
                sa0 += p1[r]; sa1 += p1[r + 1]; sa2 += p1[r + 2]; sa3 += p1[r + 3]; } else { p1[r] = 0.f; p1[r + 1] = 0.f; p1[r + 2] = 0.f; p1[r + 3] = 0.f; } }
            l_reg += (sa0 + sa1) + (sa2 + sa3);
#pragma unroll
            for (int j = 0; j < 4; ++j) { pw[2][j] = cvtpk_s(p1[2 * j], p1[2 * j + 1]); pw[3][j] = cvtpk_s(p1[8 + 2 * j], p1[8 + 2 * j + 1]); }
#pragma unroll
            for (int kg = 2; kg < 4; ++kg)
#pragma unroll
                for (int dh = 0; dh < 2; ++dh) if (NKG(kg)) o[dh] = __builtin_amdgcn_mfma_f32_32x32x16_bf16(__builtin_bit_cast(bf16x8, pw[kg]), ATT_VF(kg, dh), o[dh], 0, 0, 0);
        }
        if (issued) asm volatile("s_waitcnt vmcnt(2) lgkmcnt(0)\n\ts_barrier" ::: "memory");
        else ATT_WAITBAR();
    }
#undef ATT_KEEP_PV
#undef ATT_KEEP_K
#undef ATT_KRD
#undef ATT_QK2
#undef ATT_QKM
#undef ATT_VRD
#undef ATT_VWAIT
#undef ATT_VF
#undef ATT_QK
#undef ATT_ACTIVE
#undef N0
#undef N1
#undef NKG
    if (has_next) {
        const bf16_t* nk0 = nx.K0 + (nx.rowbase + lane) * (long)nx.k0p + wid * 8;
        const bf16_t* nk1 = nx.K1 + (nx.rowbase + lane) * (long)nx.k1p + (wid & 3) * 8;
        const bf16_t* nv = nx.V + (nx.rowbase + 16 * (wid & 3) + (lane >> 2)) * (long)nx.vp + (wid >> 2) * 32 + (lane & 3) * 8;
#pragma unroll
        for (int i = 0; i < 5; ++i) if (nx.tlo + i <= nx.thi) {
            dma16(nk0 + (long)(nx.tlo + i) * 64 * nx.k0p, shm + L_K + i * KSLOT + wid * 1024);
            if (nx.dqk == 96) dma16(nk1 + (long)(nx.tlo + i) * 64 * nx.k1p, shm + L_K + i * KSLOT + (8 + (wid & 3)) * 1024);
            dma16(nv + (long)(nx.tlo + i) * 64 * nx.vp, shm + L_V + i * VSLOT + wid * 1024); }
    }
    l_reg = xhalf_sum(l_reg);
    if (hi == 0) wsf[32 + r32] = l_reg;
    float rli[16];
#pragma unroll
    for (int r = 0; r < 16; ++r) rli[r] = 1.0f / wsf[32 + crow(r, hi)];
    bf16_t* Ow = d.O + (rowbase + q0 + wid * 32) * (long)d.op;
    { ALAS bf16_t* stg = (ALAS bf16_t*)(shm + L_OST) + wid * 2048;
#pragma unroll
      for (int r = 0; r < 16; ++r) { const int orow = crow(r, hi);
#pragma unroll
          for (int dh = 0; dh < 2; ++dh) stg[orow * 64 + dh * 32 + r32] = (bf16_t)(cvtpk_s(o[dh][r] * rli[r], 0.f) & 0xffffu); }
      asm volatile("s_waitcnt lgkmcnt(0)" ::: "memory");
#pragma unroll
      for (int i = 0; i < 4; ++i) { const int row = i * 8 + (lane >> 3), ch = lane & 7; const u32x4 v = *(const ALAS u32x4*)(stg + row * 64 + ch * 8); *(u32x4*)(Ow + (long)row * d.op + ch * 8) = v; } }
    asm volatile("s_waitcnt lgkmcnt(0)\n\ts_barrier" ::: "memory");
#undef ATT_ISSUE_K
#undef ATT_ISSUE_V
#undef ATT_WAITBAR
}
}

namespace attn_ex {
using bf16=__hip_bfloat16;
using bf16x8=__attribute__((ext_vector_type(8)))short;
using s16x4=__attribute__((ext_vector_type(4)))short;
using f32x16=__attribute__((ext_vector_type(16)))float;
using u32x4=__attribute__((ext_vector_type(4)))unsigned;
constexpr int SEQ=8192,D=64;
constexpr int NW=8,QBLK=32,QB=QBLK*NW,KVBLK=64,NQB=SEQ/QB;
constexpr int ATTN_UNIT_ROWS=QB;
__device__ __forceinline__ int crow(int r,int hi){return (r&3)+8*(r>>2)+4*hi;}
#define SBAR() __builtin_amdgcn_sched_barrier(0)
__device__ __forceinline__ void cmask(f32x16&p0,f32x16&p1,int jb,int qrel,int hi){
  const float NEG=-INFINITY; int kb=64*jb+4*hi;
  #pragma unroll
  for(int r=0;r<16;++r){int kv=kb+(r&3)+8*(r>>2); if(kv>qrel)p0[r]=NEG; if(kv+32>qrel)p1[r]=NEG;}
}

constexpr int NSLOT=3, SLOTB=8192;
constexpr int LDS_K=0, LDS_V=NSLOT*SLOTB, LDS_WS=2*NSLOT*SLOTB, LDS_OST=LDS_WS+NW*64*4, LDS_BYTES=LDS_OST+NW*4096;
constexpr float C2=0.125f*1.4426950408889634f;
__device__ __forceinline__ void glds16(const void*gsrc,unsigned lds_dst){unsigned keep;
  asm volatile("s_mov_b32 %0, m0\n\ts_mov_b32 m0, %2\n\ts_nop 0\n\tglobal_load_lds_dwordx4 %1, off\n\ts_mov_b32 m0, %0":"=&s"(keep):"v"(gsrc),"s"(lds_dst):"memory");}
__device__ __forceinline__ float max3f(float a,float b,float c){float r;asm("v_max3_f32 %0, %1, %2, %3":"=v"(r):"v"(a),"v"(b),"v"(c));return r;}
__device__ __forceinline__ float max2f(float a,float b){float r;asm("v_max_f32_e32 %0, %1, %2":"=v"(r):"v"(a),"v"(b));return r;}
__device__ __forceinline__ float fadd_s(float a,float b){float r;asm("v_add_f32_e32 %0, %1, %2":"=v"(r):"v"(a),"v"(b));return r;}
__device__ __forceinline__ float fsub_s(float a,float b){float r;asm("v_sub_f32_e32 %0, %1, %2":"=v"(r):"v"(a),"v"(b));return r;}
typedef float f32x2_t __attribute__((ext_vector_type(2))); typedef __bf16 bf16x2_t __attribute__((ext_vector_type(2)));
__device__ __forceinline__ unsigned cvtpk_s(float lo,float hi){f32x2_t v={lo,hi};bf16x2_t b=__builtin_convertvector(v,bf16x2_t);return __builtin_bit_cast(unsigned,b);}
#define WAIT_BAR(N) asm volatile("s_waitcnt vmcnt(" #N ") lgkmcnt(0)\n\ts_barrier":::"memory")

__device__ __forceinline__ void qkt(f32x16&p0,f32x16&p1,const char*Kslot,const bf16x8*qr,const f32x16&negm,int r32,int hi){
  const char*kb=Kslot+hi*1024+r32*16;
  #pragma unroll
  for(int d0=0;d0<4;++d0){
    const bf16x8 b0=*reinterpret_cast<const bf16x8*>(kb+d0*2048);
    const bf16x8 b1=*reinterpret_cast<const bf16x8*>(kb+d0*2048+512);
    if(d0==0){p0=__builtin_amdgcn_mfma_f32_32x32x16_bf16(b0,qr[0],negm,0,0,0);p1=__builtin_amdgcn_mfma_f32_32x32x16_bf16(b1,qr[0],negm,0,0,0);}
    else{p0=__builtin_amdgcn_mfma_f32_32x32x16_bf16(b0,qr[d0],p0,0,0,0);p1=__builtin_amdgcn_mfma_f32_32x32x16_bf16(b1,qr[d0],p1,0,0,0);}}
}
typedef __attribute__((address_space(3))) const char* lds_cptr;
typedef short v4i16_t __attribute__((ext_vector_type(4)));
__device__ __forceinline__ void kload8(bf16x8*kf,lds_cptr kp){
  kf[0]=*(const __attribute__((address_space(3))) bf16x8*)(kp);      kf[1]=*(const __attribute__((address_space(3))) bf16x8*)(kp+512);
  kf[2]=*(const __attribute__((address_space(3))) bf16x8*)(kp+2048); kf[3]=*(const __attribute__((address_space(3))) bf16x8*)(kp+2560);
  kf[4]=*(const __attribute__((address_space(3))) bf16x8*)(kp+4096); kf[5]=*(const __attribute__((address_space(3))) bf16x8*)(kp+4608);
  kf[6]=*(const __attribute__((address_space(3))) bf16x8*)(kp+6144); kf[7]=*(const __attribute__((address_space(3))) bf16x8*)(kp+6656);
}
__device__ __forceinline__ void kload2(bf16x8*kf,lds_cptr kp,int j){ kf[2*j]=*(const __attribute__((address_space(3))) bf16x8*)(kp+j*2048); kf[2*j+1]=*(const __attribute__((address_space(3))) bf16x8*)(kp+j*2048+512); }
__device__ __forceinline__ s16x4 vtr(lds_cptr p){ return __builtin_bit_cast(s16x4,__builtin_amdgcn_ds_read_tr16_b64_v4i16((__attribute__((address_space(3))) v4i16_t*)p)); }
__device__ __forceinline__ float rowmax(const f32x16&p0,const f32x16&p1){
  float a=max3f(p0[0],p0[1],p1[0]),b=max3f(p0[2],p0[3],p1[1]);a=max3f(a,p1[2],p1[3]);
  #pragma unroll
  for(int r=4;r<16;r+=4){a=max3f(a,p0[r],p0[r+1]);b=max3f(b,p0[r+2],p0[r+3]);a=max3f(a,p1[r],p1[r+1]);b=max3f(b,p1[r+2],p1[r+3]);}
  const float m=max2f(a,b);
  auto rr=__builtin_amdgcn_permlane32_swap(__float_as_uint(m),__float_as_uint(m),false,false);
  return max2f(__uint_as_float(rr[0]),__uint_as_float(rr[1]));
}
__device__ __forceinline__ void pv(f32x16*o,int vb,bf16x8 pa0,bf16x8 pa1,bf16x8 pa2,bf16x8 pa3){
  #pragma unroll
  for(int d0=0;d0<2;++d0){s16x4 lo[4],hi[4];
    #pragma unroll
    for(int ks=0;ks<4;++ks){
      asm volatile("ds_read_b64_tr_b16 %0,%1 offset:%c2":"=&v"(lo[ks]):"v"(vb),"i"(d0*4096+ks*1024):"memory");
      asm volatile("ds_read_b64_tr_b16 %0,%1 offset:%c2":"=&v"(hi[ks]):"v"(vb),"i"(d0*4096+ks*1024+512):"memory");}
    asm volatile("s_waitcnt lgkmcnt(0)":::"memory");SBAR();
    #define PK(k) (bf16x8){lo[k][0],lo[k][1],lo[k][2],lo[k][3],hi[k][0],hi[k][1],hi[k][2],hi[k][3]}
    o[d0]=__builtin_amdgcn_mfma_f32_32x32x16_bf16(pa0,PK(0),o[d0],0,0,0);
    o[d0]=__builtin_amdgcn_mfma_f32_32x32x16_bf16(pa1,PK(1),o[d0],0,0,0);
    o[d0]=__builtin_amdgcn_mfma_f32_32x32x16_bf16(pa2,PK(2),o[d0],0,0,0);
    o[d0]=__builtin_amdgcn_mfma_f32_32x32x16_bf16(pa3,PK(3),o[d0],0,0,0);
    #undef PK
  }
}

#ifndef ATTN_STORE16
#define ATTN_STORE16(p,v) (*(u32x4*)(p)=(v))
#endif
template<int THRL,int QP,int KP,int VP,int OP> __device__ __forceinline__ void attn_unit(const bf16*Qb,const bf16*__restrict__ Kh,const bf16*__restrict__ Vh,bf16*Ob,char*shm){
  const int tid=threadIdx.x,lane=tid&63,r32=lane&31,hi=lane>>5; const int wid=__builtin_amdgcn_readfirstlane(tid>>6);
  const bf16*Qw=Qb+(long)(wid*QBLK)*QP;
  const unsigned lds0=(unsigned)(uintptr_t)shm;
  float*wsf=(float*)(shm+LDS_WS)+wid*64;
  const bf16*ksrc=Kh+(long)lane*KP+wid*8;
  const bf16*vsrc=Vh+(long)(16*(wid&3)+(lane>>2))*VP+(wid>>2)*32+(lane&3)*8;
  const unsigned kdst=lds0+LDS_K+wid*1024, vdst=lds0+LDS_V+wid*1024;
  #define DMA_K(t,slot) glds16(ksrc+(long)(t)*KVBLK*KP,(unsigned)__builtin_amdgcn_readfirstlane(kdst+(slot)))
  #define DMA_V(t,slot) glds16(vsrc+(long)(t)*KVBLK*VP,(unsigned)__builtin_amdgcn_readfirstlane(vdst+(slot)))
  const int vb0=(int)(lds0+LDS_V)+((lane>>4)&1)*32+(lane&3)*8+(4*hi+((lane&15)>>2))*64;
  const char*Kbase=shm+LDS_K; bf16x8 kf[8];
  const lds_cptr shm3=(lds_cptr)shm; const lds_cptr kp0=shm3+LDS_K+hi*1024+r32*16; const lds_cptr vp0=shm3+LDS_V+((lane>>4)&1)*32+(lane&3)*8+(4*hi+((lane&15)>>2))*64;
  constexpr int NT=SEQ/KVBLK;
  DMA_K(0,0);DMA_V(0,0);DMA_K(1,SLOTB);
  bf16x8 qr[4];
  #pragma unroll
  for(int d0=0;d0<4;++d0)qr[d0]=*reinterpret_cast<const bf16x8*>(&Qw[(long)r32*QP+d0*16+hi*8]);
  float mhat=0.f,l_reg=0.f;f32x16 o[2];o[0]=f32x16{};o[1]=f32x16{};f32x16 negm=f32x16{};asm volatile("":"+v"(negm));
  #define CMASK(P0,P1,t) do{}while(0)
  bool resc=false;
  #define START(P0,P1) do{ const float rm=rowmax(P0,P1); resc=false; \
    { const float dl=rm; mhat=fadd_s(mhat,dl); \
      _Pragma("unroll") for(int r=0;r<16;++r){P0[r]=fsub_s(P0[r],dl);P1[r]=fsub_s(P1[r],dl);} \
      _Pragma("unroll") for(int r=0;r<16;++r)negm[r]=-mhat; asm volatile("":"+v"(negm)); } \
    _Pragma("unroll") for(int r=0;r<16;++r)P0[r]=__builtin_amdgcn_exp2f(P0[r]); }while(0)
  #define RESC() do{ if(resc){ asm volatile("s_waitcnt lgkmcnt(0)":::"memory"); \
      _Pragma("unroll") for(int d_=0;d_<2;++d_) _Pragma("unroll") for(int r=0;r<16;++r)o[d_][r]*=wsf[crow(r,hi)]; } }while(0)
  f32x16 pA0,pA1,pB0,pB1;
  int sl_prev=0,sl_cur=0,sl_next=SLOTB;
  #define ROT() do{sl_prev=sl_cur;sl_cur=sl_next;sl_next=(sl_next==(NSLOT-1)*SLOTB)?0:sl_next+SLOTB;}while(0)
  DMA_K(2,2*SLOTB);
  WAIT_BAR(3);
  qkt(pA0,pA1,Kbase,qr,negm,r32,hi);asm volatile("s_nop 15\n\ts_nop 7":"+v"(pA0),"+v"(pA1));CMASK(pA0,pA1,0);
  START(pA0,pA1);
  _Pragma("unroll") for(int r=0;r<16;++r)pA1[r]=__builtin_amdgcn_exp2f(pA1[r]);
  WAIT_BAR(0);
  DMA_K(3,0);DMA_V(1,SLOTB);
  ROT();
  kload8(kf,kp0+sl_cur);
  WAIT_BAR(2);
  s16x4 vlo[8],vhi[8]; u32x4 pw0,pw1,pw2,pw3;
  #define PKW(P,B) cvtpk_s(P[B],P[B+1])
  #define PAF(k) __builtin_bit_cast(bf16x8,pw##k)
  #define VFR(i) (bf16x8){vlo[i][0],vlo[i][1],vlo[i][2],vlo[i][3],vhi[i][0],vhi[i][1],vhi[i][2],vhi[i][3]}
  #define PIN(x) asm volatile("":"+v"(x))
  #define MX3(a,b,c) __builtin_fmaxf(__builtin_fmaxf((a),(b)),(c))
  #define GAPA(MF,A0,A1,A2,A3,W0,W1,PW) do{ MF; sacc+=A0; sacc+=A1; sacc+=A2; sacc+=A3; PIN(sacc); W0; W1; PIN(PW); SBAR(); }while(0)
  #define EX(v) __builtin_amdgcn_exp2f(v)
  #define GAPB(MF,X,B) do{ MF; X[B]=EX(X[B]); X[B+1]=EX(X[B+1]); X[B+2]=EX(X[B+2]); X[B+3]=EX(X[B+3]); PIN(X); SBAR(); }while(0)
  #define VRD(i) do{ vlo[i]=vtr(vp_+(((i)>>2)*4096+((i)&3)*1024)); vhi[i]=vtr(vp_+(((i)>>2)*4096+((i)&3)*1024+512)); }while(0)
  #define KRD(G,j) do{ if(G){ kload2(kf,kp0+sl_next,j); SBAR(); } }while(0)
  #define STEP(C0,C1,P0,P1,t,GK,GV,GL) do{ SBAR(); \
    const lds_cptr vp_=vp0+sl_prev; \
    VRD(0); SBAR(); float sacc=(P0[0]+P0[1]); \
    GAPA(C0=__builtin_amdgcn_mfma_f32_32x32x16_bf16(kf[0],qr[0],negm,0,0,0), P0[2],P0[3],P0[4],P0[5],     pw0[0]=PKW(P0,0), pw0[1]=PKW(P0,2), pw0); \
    VRD(4); SBAR(); GAPA(C1=__builtin_amdgcn_mfma_f32_32x32x16_bf16(kf[1],qr[0],negm,0,0,0), P0[6],P0[7],P0[8],P0[9],     pw0[2]=PKW(P0,4), pw0[3]=PKW(P0,6), pw0); \
    VRD(1); SBAR(); GAPA(C0=__builtin_amdgcn_mfma_f32_32x32x16_bf16(kf[2],qr[1],C0,0,0,0),   P0[10],P0[11],P0[12],P0[13], pw1[0]=PKW(P0,8), pw1[1]=PKW(P0,10), pw1); \
    VRD(5); SBAR(); GAPA(C1=__builtin_amdgcn_mfma_f32_32x32x16_bf16(kf[3],qr[1],C1,0,0,0),   P0[14],P0[15],P1[0],P1[1],   pw1[2]=PKW(P0,12),pw1[3]=PKW(P0,14), pw1); \
    VRD(2); SBAR(); GAPA(C0=__builtin_amdgcn_mfma_f32_32x32x16_bf16(kf[4],qr[2],C0,0,0,0),   P1[2],P1[3],P1[4],P1[5],     pw2[0]=PKW(P1,0), pw2[1]=PKW(P1,2), pw2); \
    VRD(6); SBAR(); GAPA(C1=__builtin_amdgcn_mfma_f32_32x32x16_bf16(kf[5],qr[2],C1,0,0,0),   P1[6],P1[7],P1[8],P1[9],     pw2[2]=PKW(P1,4), pw2[3]=PKW(P1,6), pw2); \
    VRD(3); SBAR(); GAPA(C0=__builtin_amdgcn_mfma_f32_32x32x16_bf16(kf[6],qr[3],C0,0,0,0),   P1[10],P1[11],P1[12],P1[13], pw3[0]=PKW(P1,8), pw3[1]=PKW(P1,10), pw3); \
    VRD(7); SBAR(); GAPA(C1=__builtin_amdgcn_mfma_f32_32x32x16_bf16(kf[7],qr[3],C1,0,0,0),   P1[14],P1[15],0.f,0.f,       pw3[2]=PKW(P1,12),pw3[3]=PKW(P1,14), pw3); \
    l_reg+=sacc; \
    if(GK){DMA_K((t)+3,sl_cur);} if(GV){DMA_V((t)+1,sl_next);} \
    CMASK(C0,C1,t); \
    { float a=MX3(C0[0],C0[1],C1[0]),b=MX3(C0[2],C0[3],C1[1]); a=MX3(a,C1[2],C1[3]); \
      _Pragma("unroll") for(int r=4;r<16;r+=4){a=MX3(a,C0[r],C0[r+1]);b=MX3(b,C0[r+2],C0[r+3]);a=MX3(a,C1[r],C1[r+1]);b=MX3(b,C1[r+2],C1[r+3]);} \
      float rm=__builtin_fmaxf(a,b); { auto rr=__builtin_amdgcn_permlane32_swap(__float_as_uint(rm),__float_as_uint(rm),false,false); rm=__builtin_fmaxf(__uint_as_float(rr[0]),__uint_as_float(rr[1])); } \
      resc=false; \
      if(__builtin_expect(__any(rm>(float)THRL),0)){ const float dl=__builtin_fmaxf(rm,0.f); mhat+=dl; \
        _Pragma("unroll") for(int r=0;r<16;++r){C0[r]-=dl;C1[r]-=dl;} \
        _Pragma("unroll") for(int r=0;r<16;++r)negm[r]=-mhat; asm volatile("":"+v"(negm)); \
        const float f=__builtin_amdgcn_exp2f(-dl); l_reg*=f; if(hi==0)wsf[r32]=f; resc=true; } } \
    SBAR(); \
    GAPB(o[0]=__builtin_amdgcn_mfma_f32_32x32x16_bf16(PAF(0),VFR(0),o[0],0,0,0), C0,0); \
    GAPB(o[1]=__builtin_amdgcn_mfma_f32_32x32x16_bf16(PAF(0),VFR(4),o[1],0,0,0), C0,4); \
    KRD(GL,0); GAPB(o[0]=__builtin_amdgcn_mfma_f32_32x32x16_bf16(PAF(1),VFR(1),o[0],0,0,0), C0,8); \
    KRD(GL,1); GAPB(o[1]=__builtin_amdgcn_mfma_f32_32x32x16_bf16(PAF(1),VFR(5),o[1],0,0,0), C0,12); \
    KRD(GL,2); GAPB(o[0]=__builtin_amdgcn_mfma_f32_32x32x16_bf16(PAF(2),VFR(2),o[0],0,0,0), C1,0); \
    KRD(GL,3); GAPB(o[1]=__builtin_amdgcn_mfma_f32_32x32x16_bf16(PAF(2),VFR(6),o[1],0,0,0), C1,4); \
    GAPB(o[0]=__builtin_amdgcn_mfma_f32_32x32x16_bf16(PAF(3),VFR(3),o[0],0,0,0), C1,8); \
    GAPB(o[1]=__builtin_amdgcn_mfma_f32_32x32x16_bf16(PAF(3),VFR(7),o[1],0,0,0), C1,12); \
    }while(0)
  int t=1;
  #undef CMASK
  #define CMASK(P0,P1,t) do{}while(0)
  for(;t+5<NT;t+=2){
    STEP(pB0,pB1,pA0,pA1,t,true,true,true);     WAIT_BAR(2); RESC(); ROT();
    STEP(pA0,pA1,pB0,pB1,t+1,true,true,true);   WAIT_BAR(2); RESC(); ROT();
  }
  #undef CMASK
  #define CMASK(P0,P1,t) do{}while(0)
  #define ENDW(tt) do{ if((tt)+3<NT){WAIT_BAR(2);} else if((tt)+2<NT){WAIT_BAR(1);} else {WAIT_BAR(0);} }while(0)
  for(;t+1<NT;t+=2){
    STEP(pB0,pB1,pA0,pA1,t,(t+3<NT),(t+1<NT),(t+1<NT));       ENDW(t);   RESC(); ROT();
    STEP(pA0,pA1,pB0,pB1,t+1,(t+4<NT),(t+2<NT),(t+2<NT));     ENDW(t+1); RESC(); ROT();
  }
  STEP(pB0,pB1,pA0,pA1,NT-1,false,false,false); RESC();
  { float sacc=pB0[0]+pB0[1]; _Pragma("unroll") for(int r=2;r<16;++r)sacc+=pB0[r]; _Pragma("unroll") for(int r=0;r<16;++r)sacc+=pB1[r]; l_reg+=sacc;
    pw0=(u32x4){PKW(pB0,0),PKW(pB0,2),PKW(pB0,4),PKW(pB0,6)};pw1=(u32x4){PKW(pB0,8),PKW(pB0,10),PKW(pB0,12),PKW(pB0,14)};pw2=(u32x4){PKW(pB1,0),PKW(pB1,2),PKW(pB1,4),PKW(pB1,6)};pw3=(u32x4){PKW(pB1,8),PKW(pB1,10),PKW(pB1,12),PKW(pB1,14)};
    SBAR(); pv(o,vb0+sl_cur,PAF(0),PAF(1),PAF(2),PAF(3)); }
  #undef PKW
  #undef PAF
  #undef VFR
  #undef PIN
  #undef MX3
  #undef GAPA
  #undef GAPB
  #undef EX
  #undef VRD
  #undef KRD
  #undef STEP
  #undef ENDW
  {auto rr=__builtin_amdgcn_permlane32_swap(__float_as_uint(l_reg),__float_as_uint(l_reg),false,false);l_reg=__uint_as_float(rr[0])+__uint_as_float(rr[1]);}
  if(hi==0)wsf[32+r32]=l_reg;asm volatile("s_waitcnt lgkmcnt(0)":::"memory");
  float rli[16];
  #pragma unroll
  for(int r=0;r<16;++r)rli[r]=__builtin_amdgcn_rcpf(wsf[32+crow(r,hi)]);
  bf16*Ow=Ob+(long)(wid*QBLK)*OP;
  { bf16*stg=(bf16*)(shm+LDS_OST)+wid*2048;
    #pragma unroll
    for(int r=0;r<16;++r){const int orow=crow(r,hi);
      #pragma unroll
      for(int d0=0;d0<2;++d0)stg[orow*64+d0*32+r32]=__float2bfloat16(o[d0][r]*rli[r]);}
    asm volatile("s_waitcnt lgkmcnt(0)":::"memory");
    #pragma unroll
    for(int i=0;i<4;++i){const int row=i*8+(lane>>3),ch=lane&7; const u32x4 v=*(const u32x4*)(stg+row*64+ch*8); ATTN_STORE16(Ow+(long)row*OP+ch*8,v);} }
  asm volatile("s_waitcnt lgkmcnt(0)\n\ts_barrier":::"memory");
  #undef DMA_K
  #undef DMA_V
  #undef CMASK
  #undef START
  #undef RESC
  #undef ROT
}
constexpr int ATTN_LDS_BYTES=LDS_BYTES;
#undef SBAR
#undef WAIT_BAR
}

namespace attn_ex96 {
using bf16=__hip_bfloat16;
using bf16x8=__attribute__((ext_vector_type(8)))short;
using s16x4=__attribute__((ext_vector_type(4)))short;
using f32x16=__attribute__((ext_vector_type(16)))float;
using u32x4=__attribute__((ext_vector_type(4)))unsigned;
constexpr int SEQ=8192,D=64;
constexpr int NW=8,QBLK=32,QB=QBLK*NW,KVBLK=64,NQB=SEQ/QB;
constexpr int ATTN_UNIT_ROWS=QB;
__device__ __forceinline__ int crow(int r,int hi){return (r&3)+8*(r>>2)+4*hi;}
#define SBAR() __builtin_amdgcn_sched_barrier(0)
__device__ __forceinline__ void cmask(f32x16&p0,f32x16&p1,int jb,int qrel,int hi){
  const float NEG=-INFINITY; int kb=64*jb+4*hi;
  #pragma unroll
  for(int r=0;r<16;++r){int kv=kb+(r&3)+8*(r>>2); if(kv>qrel)p0[r]=NEG; if(kv+32>qrel)p1[r]=NEG;}
}

constexpr int NSLOT=3, SLOTB=12288;
constexpr int LDS_K=0, LDS_V=NSLOT*SLOTB, LDS_WS=2*NSLOT*SLOTB, LDS_OST=LDS_WS+NW*64*4, LDS_BYTES=LDS_OST+NW*4096;
constexpr float C2=0.125f*1.4426950408889634f;
__device__ __forceinline__ void glds16(const void*gsrc,unsigned lds_dst){unsigned keep;
  asm volatile("s_mov_b32 %0, m0\n\ts_mov_b32 m0, %2\n\ts_nop 0\n\tglobal_load_lds_dwordx4 %1, off\n\ts_mov_b32 m0, %0":"=&s"(keep):"v"(gsrc),"s"(lds_dst):"memory");}
__device__ __forceinline__ float max3f(float a,float b,float c){float r;asm("v_max3_f32 %0, %1, %2, %3":"=v"(r):"v"(a),"v"(b),"v"(c));return r;}
__device__ __forceinline__ float max2f(float a,float b){float r;asm("v_max_f32_e32 %0, %1, %2":"=v"(r):"v"(a),"v"(b));return r;}
__device__ __forceinline__ float fadd_s(float a,float b){float r;asm("v_add_f32_e32 %0, %1, %2":"=v"(r):"v"(a),"v"(b));return r;}
__device__ __forceinline__ float fsub_s(float a,float b){float r;asm("v_sub_f32_e32 %0, %1, %2":"=v"(r):"v"(a),"v"(b));return r;}
typedef float f32x2_t __attribute__((ext_vector_type(2))); typedef __bf16 bf16x2_t __attribute__((ext_vector_type(2)));
__device__ __forceinline__ unsigned cvtpk_s(float lo,float hi){f32x2_t v={lo,hi};bf16x2_t b=__builtin_convertvector(v,bf16x2_t);return __builtin_bit_cast(unsigned,b);}
#define WAIT_BAR(N) asm volatile("s_waitcnt vmcnt(" #N ") lgkmcnt(0)\n\ts_barrier":::"memory")

__device__ __forceinline__ void qkt(f32x16&p0,f32x16&p1,const char*Kslot,const bf16x8*qr,int r32,int hi){ const f32x16 zero=f32x16{};
  const char*kb=Kslot+hi*1024+r32*16;
  #pragma unroll
  for(int d0=0;d0<6;++d0){
    const bf16x8 b0=*reinterpret_cast<const bf16x8*>(kb+d0*2048);
    const bf16x8 b1=*reinterpret_cast<const bf16x8*>(kb+d0*2048+512);
    if(d0==0){p0=__builtin_amdgcn_mfma_f32_32x32x16_bf16(b0,qr[0],zero,0,0,0);p1=__builtin_amdgcn_mfma_f32_32x32x16_bf16(b1,qr[0],zero,0,0,0);}
    else{p0=__builtin_amdgcn_mfma_f32_32x32x16_bf16(b0,qr[d0],p0,0,0,0);p1=__builtin_amdgcn_mfma_f32_32x32x16_bf16(b1,qr[d0],p1,0,0,0);}}
}
typedef __attribute__((address_space(3))) const char* lds_cptr;
typedef short v4i16_t __attribute__((ext_vector_type(4)));
__device__ __forceinline__ void kload8(bf16x8*kf,lds_cptr kp){
  kf[0]=*(const __attribute__((address_space(3))) bf16x8*)(kp);      kf[1]=*(const __attribute__((address_space(3))) bf16x8*)(kp+512);
  kf[2]=*(const __attribute__((address_space(3))) bf16x8*)(kp+2048); kf[3]=*(const __attribute__((address_space(3))) bf16x8*)(kp+2560);
  kf[4]=*(const __attribute__((address_space(3))) bf16x8*)(kp+4096); kf[5]=*(const __attribute__((address_space(3))) bf16x8*)(kp+4608);
  kf[6]=*(const __attribute__((address_space(3))) bf16x8*)(kp+6144); kf[7]=*(const __attribute__((address_space(3))) bf16x8*)(kp+6656);
}
__device__ __forceinline__ void kload2(bf16x8*kf,lds_cptr kp,int j){ kf[2*j]=*(const __attribute__((address_space(3))) bf16x8*)(kp+j*2048); kf[2*j+1]=*(const __attribute__((address_space(3))) bf16x8*)(kp+j*2048+512); }
__device__ __forceinline__ s16x4 vtr(lds_cptr p){ return __builtin_bit_cast(s16x4,__builtin_amdgcn_ds_read_tr16_b64_v4i16((__attribute__((address_space(3))) v4i16_t*)p)); }
__device__ __forceinline__ float rowmax(const f32x16&p0,const f32x16&p1){
  float a=max3f(p0[0],p0[1],p1[0]),b=max3f(p0[2],p0[3],p1[1]);a=max3f(a,p1[2],p1[3]);
  #pragma unroll
  for(int r=4;r<16;r+=4){a=max3f(a,p0[r],p0[r+1]);b=max3f(b,p0[r+2],p0[r+3]);a=max3f(a,p1[r],p1[r+1]);b=max3f(b,p1[r+2],p1[r+3]);}
  const float m=max2f(a,b);
  auto rr=__builtin_amdgcn_permlane32_swap(__float_as_uint(m),__float_as_uint(m),false,false);
  return max2f(__uint_as_float(rr[0]),__uint_as_float(rr[1]));
}
__device__ __forceinline__ void pv(f32x16*o,int vb,bf16x8 pa0,bf16x8 pa1,bf16x8 pa2,bf16x8 pa3){
  #pragma unroll
  for(int d0=0;d0<2;++d0){s16x4 lo[4],hi[4];
    #pragma unroll
    for(int ks=0;ks<4;++ks){
      asm volatile("ds_read_b64_tr_b16 %0,%1 offset:%c2":"=&v"(lo[ks]):"v"(vb),"i"(d0*4096+ks*1024):"memory");
      asm volatile("ds_read_b64_tr_b16 %0,%1 offset:%c2":"=&v"(hi[ks]):"v"(vb),"i"(d0*4096+ks*1024+512):"memory");}
    asm volatile("s_waitcnt lgkmcnt(0)":::"memory");SBAR();
    #define PK(k) (bf16x8){lo[k][0],lo[k][1],lo[k][2],lo[k][3],hi[k][0],hi[k][1],hi[k][2],hi[k][3]}
    o[d0]=__builtin_amdgcn_mfma_f32_32x32x16_bf16(pa0,PK(0),o[d0],0,0,0);
    o[d0]=__builtin_amdgcn_mfma_f32_32x32x16_bf16(pa1,PK(1),o[d0],0,0,0);
    o[d0]=__builtin_amdgcn_mfma_f32_32x32x16_bf16(pa2,PK(2),o[d0],0,0,0);
    o[d0]=__builtin_amdgcn_mfma_f32_32x32x16_bf16(pa3,PK(3),o[d0],0,0,0);
    #undef PK
  }
}

#ifndef ATTN_STORE16
#define ATTN_STORE16(p,v) (*(u32x4*)(p)=(v))
#endif
template<int THRL,int QP,int KP,int VP,int OP> __device__ __forceinline__ void attn_unit(const bf16*Qb,const bf16*Qr,const bf16*__restrict__ Kh,const bf16*__restrict__ Kr,const bf16*__restrict__ Vh,bf16*Ob,int tq0,char*shm){
  const int tid=threadIdx.x,lane=tid&63,r32=lane&31,hi=lane>>5; const int wid=__builtin_amdgcn_readfirstlane(tid>>6);
  const bf16*Qw=Qb+(long)(wid*QBLK)*QP;
  const unsigned lds0=(unsigned)(uintptr_t)shm;
  float*wsf=(float*)(shm+LDS_WS)+wid*64;
  const bf16*ksrc=Kh+(long)lane*KP+wid*8; const bf16*rsrc=Kr+(long)lane*32+(wid&3)*8;
  const bf16*vsrc=Vh+(long)(16*(wid&3)+(lane>>2))*VP+(wid>>2)*32+(lane&3)*8;
  const unsigned kdst=lds0+LDS_K+wid*1024, vdst=lds0+LDS_V+wid*1024;
  #define DMA_KN(t,slot) glds16(ksrc+(long)(t)*KVBLK*KP,(unsigned)__builtin_amdgcn_readfirstlane(kdst+(slot)))
  #define DMA_R(t,slot) glds16(rsrc+(long)(t)*KVBLK*32,(unsigned)__builtin_amdgcn_readfirstlane(lds0+LDS_K+(8+(wid&3))*1024+(slot)))
  #define DMA_K(t,slot) do{ DMA_KN(t,slot); DMA_R(t,slot); }while(0)
  #define DMA_V(t,slot) glds16(vsrc+(long)(t)*KVBLK*VP,(unsigned)__builtin_amdgcn_readfirstlane(vdst+(slot)))
  const int vb0=(int)(lds0+LDS_V)+((lane>>4)&1)*32+(lane&3)*8+(4*hi+((lane&15)>>2))*64;
  const char*Kbase=shm+LDS_K; bf16x8 kf[8];
  const lds_cptr shm3=(lds_cptr)shm; const lds_cptr kp0=shm3+LDS_K+hi*1024+r32*16; const lds_cptr vp0=shm3+LDS_V+((lane>>4)&1)*32+(lane&3)*8+(4*hi+((lane&15)>>2))*64;
  constexpr int NT=SEQ/KVBLK;
  DMA_K(0,0);DMA_V(0,0);DMA_K(1,SLOTB);
  bf16x8 qr[6];
  #pragma unroll
  for(int d0=0;d0<4;++d0)qr[d0]=*reinterpret_cast<const bf16x8*>(&Qw[(long)r32*QP+d0*16+hi*8]);
  { const int tq=tq0+wid*QBLK+r32; const bf16*qp=Qr+(long)(wid*QBLK+r32)*QP+hi*8;
    #pragma unroll
    for(int dd=0;dd<2;++dd){ const bf16x8 raw=*reinterpret_cast<const bf16x8*>(qp+dd*16); const u32x4 w=__builtin_bit_cast(u32x4,raw); u32x4 pwx;
      #pragma unroll
      for(int j=0;j<4;++j)pwx[j]=(unsigned)__shfl_xor((int)w[j],32);
      const bf16x8 par=__builtin_bit_cast(bf16x8,pwx); const float pos=(dd==0)?(float)(tq>>6):(float)(tq&63); float ov[8];
      #pragma unroll
      for(int e=0;e<8;++e){ const float inv=exp2f(-(float)e*(13.287712379549449f/8.0f)); float s,c; att::sincos_acc(pos*inv,s,c);
        const float x=att::bf2f(raw[e]),y=att::bf2f(par[e]); ov[e]=hi==0?x*c-y*s:x*c+y*s; }
      u32x4 o4; o4.x=cvtpk_s(ov[0],ov[1]); o4.y=cvtpk_s(ov[2],ov[3]); o4.z=cvtpk_s(ov[4],ov[5]); o4.w=cvtpk_s(ov[6],ov[7]); qr[4+dd]=__builtin_bit_cast(bf16x8,o4); } }
  float mhat=0.f,l_reg=0.f;f32x16 o[2];o[0]=f32x16{};o[1]=f32x16{};const f32x16 zero=f32x16{};
  #define CMASK(P0,P1,t) do{}while(0)
  bool resc=false;
  #define START(P0,P1) do{ const float rm=rowmax(P0,P1); resc=false; \
    { const float dl=rm; mhat=fadd_s(mhat,dl); \
      _Pragma("unroll") for(int r=0;r<16;++r){P0[r]=fsub_s(P0[r],dl);P1[r]=fsub_s(P1[r],dl);} \
      } \
    _Pragma("unroll") for(int r=0;r<16;++r)P0[r]=__builtin_amdgcn_exp2f(P0[r]); }while(0)
  #define RESC() do{ if(resc){ asm volatile("s_waitcnt lgkmcnt(0)":::"memory"); \
      _Pragma("unroll") for(int d_=0;d_<2;++d_) _Pragma("unroll") for(int r=0;r<16;++r)o[d_][r]*=wsf[crow(r,hi)]; } }while(0)
  f32x16 pA0,pA1,pB0,pB1;
  int sl_prev=0,sl_cur=0,sl_next=SLOTB;
  #define ROT() do{sl_prev=sl_cur;sl_cur=sl_next;sl_next=(sl_next==(NSLOT-1)*SLOTB)?0:sl_next+SLOTB;}while(0)
  DMA_K(2,2*SLOTB);
  WAIT_BAR(3);
  qkt(pA0,pA1,Kbase,qr,r32,hi);asm volatile("s_nop 15\n\ts_nop 7":"+v"(pA0),"+v"(pA1));CMASK(pA0,pA1,0);
  START(pA0,pA1);
  _Pragma("unroll") for(int r=0;r<16;++r)pA1[r]=__builtin_amdgcn_exp2f(pA1[r]);
  WAIT_BAR(0);
  DMA_KN(3,0);DMA_V(1,SLOTB);
  ROT();
  kload8(kf,kp0+sl_cur);
  WAIT_BAR(2);
  s16x4 vlo[8],vhi[8]; u32x4 pw0,pw1,pw2,pw3;
  #define PKW(P,B) cvtpk_s(P[B],P[B+1])
  #define PAF(k) __builtin_bit_cast(bf16x8,pw##k)
  #define VFR(i) (bf16x8){vlo[i][0],vlo[i][1],vlo[i][2],vlo[i][3],vhi[i][0],vhi[i][1],vhi[i][2],vhi[i][3]}
  #define PIN(x) asm volatile("":"+v"(x))
  #define MX3(a,b,c) __builtin_fmaxf(__builtin_fmaxf((a),(b)),(c))
  #define GAPA(MF,A0,A1,A2,A3,W0,W1,PW) do{ MF; sacc+=A0; sacc+=A1; sacc+=A2; sacc+=A3; PIN(sacc); W0; W1; PIN(PW); SBAR(); }while(0)
  #define EX(v) __builtin_amdgcn_exp2f(v)
  #define GAPB(MF,X,B) do{ MF; X[B]=EX(X[B]); X[B+1]=EX(X[B+1]); X[B+2]=EX(X[B+2]); X[B+3]=EX(X[B+3]); PIN(X); SBAR(); }while(0)
  #define VRD(i) do{ vlo[i]=vtr(vp_+(((i)>>2)*4096+((i)&3)*1024)); vhi[i]=vtr(vp_+(((i)>>2)*4096+((i)&3)*1024+512)); }while(0)
  #define KRD(G,j) do{ if(G){ kload2(kf,kp0+sl_next,j); SBAR(); } }while(0)
  #define STEP(C0,C1,P0,P1,t,GK,GV,GL) do{ SBAR(); \
    const lds_cptr vp_=vp0+sl_prev; \
    VRD(0); SBAR(); float sacc=(P0[0]+P0[1]); \
    GAPA(C0=__builtin_amdgcn_mfma_f32_32x32x16_bf16(kf[0],qr[0],zero,0,0,0), P0[2],P0[3],P0[4],P0[5],     pw0[0]=PKW(P0,0), pw0[1]=PKW(P0,2), pw0); \
    VRD(4); SBAR(); GAPA(C1=__builtin_amdgcn_mfma_f32_32x32x16_bf16(kf[1],qr[0],zero,0,0,0), P0[6],P0[7],P0[8],P0[9],     pw0[2]=PKW(P0,4), pw0[3]=PKW(P0,6), pw0); \
    VRD(1); SBAR(); GAPA(C0=__builtin_amdgcn_mfma_f32_32x32x16_bf16(kf[2],qr[1],C0,0,0,0),   P0[10],P0[11],P0[12],P0[13], pw1[0]=PKW(P0,8), pw1[1]=PKW(P0,10), pw1); \
    VRD(5); SBAR(); GAPA(C1=__builtin_amdgcn_mfma_f32_32x32x16_bf16(kf[3],qr[1],C1,0,0,0),   P0[14],P0[15],P1[0],P1[1],   pw1[2]=PKW(P0,12),pw1[3]=PKW(P0,14), pw1); \
    VRD(2); SBAR(); GAPA(C0=__builtin_amdgcn_mfma_f32_32x32x16_bf16(kf[4],qr[2],C0,0,0,0),   P1[2],P1[3],P1[4],P1[5],     pw2[0]=PKW(P1,0), pw2[1]=PKW(P1,2), pw2); \
    VRD(6); SBAR(); GAPA(C1=__builtin_amdgcn_mfma_f32_32x32x16_bf16(kf[5],qr[2],C1,0,0,0),   P1[6],P1[7],P1[8],P1[9],     pw2[2]=PKW(P1,4), pw2[3]=PKW(P1,6), pw2); \
    VRD(3); SBAR(); GAPA(C0=__builtin_amdgcn_mfma_f32_32x32x16_bf16(kf[6],qr[3],C0,0,0,0),   P1[10],P1[11],P1[12],P1[13], pw3[0]=PKW(P1,8), pw3[1]=PKW(P1,10), pw3); \
    VRD(7); SBAR(); GAPA(C1=__builtin_amdgcn_mfma_f32_32x32x16_bf16(kf[7],qr[3],C1,0,0,0),   P1[14],P1[15],0.f,0.f,       pw3[2]=PKW(P1,12),pw3[3]=PKW(P1,14), pw3); \
    l_reg+=sacc; \
    { const lds_cptr rp_=kp0+sl_cur+8192; \
      const bf16x8 r0_=*(const __attribute__((address_space(3))) bf16x8*)(rp_), r1_=*(const __attribute__((address_space(3))) bf16x8*)(rp_+512), r2_=*(const __attribute__((address_space(3))) bf16x8*)(rp_+2048), r3_=*(const __attribute__((address_space(3))) bf16x8*)(rp_+2560); \
      C0=__builtin_amdgcn_mfma_f32_32x32x16_bf16(r0_,qr[4],C0,0,0,0); C1=__builtin_amdgcn_mfma_f32_32x32x16_bf16(r1_,qr[4],C1,0,0,0); \
      C0=__builtin_amdgcn_mfma_f32_32x32x16_bf16(r2_,qr[5],C0,0,0,0); C1=__builtin_amdgcn_mfma_f32_32x32x16_bf16(r3_,qr[5],C1,0,0,0); \
      _Pragma("unroll") for(int r=0;r<16;++r){C0[r]-=mhat;C1[r]-=mhat;} } \
    SBAR(); \
    if(GK){DMA_KN((t)+3,sl_cur);} if(GV){DMA_V((t)+1,sl_next);} \
    CMASK(C0,C1,t); \
    { float a=MX3(C0[0],C0[1],C1[0]),b=MX3(C0[2],C0[3],C1[1]); a=MX3(a,C1[2],C1[3]); \
      _Pragma("unroll") for(int r=4;r<16;r+=4){a=MX3(a,C0[r],C0[r+1]);b=MX3(b,C0[r+2],C0[r+3]);a=MX3(a,C1[r],C1[r+1]);b=MX3(b,C1[r+2],C1[r+3]);} \
      float rm=__builtin_fmaxf(a,b); { auto rr=__builtin_amdgcn_permlane32_swap(__float_as_uint(rm),__float_as_uint(rm),false,false); rm=__builtin_fmaxf(__uint_as_float(rr[0]),__uint_as_float(rr[1])); } \
      resc=false; \
      if(__builtin_expect(__any(rm>(float)THRL),0)){ const float dl=__builtin_fmaxf(rm,0.f); mhat+=dl; \
        _Pragma("unroll") for(int r=0;r<16;++r){C0[r]-=dl;C1[r]-=dl;} \
        const float f=__builtin_amdgcn_exp2f(-dl); l_reg*=f; if(hi==0)wsf[r32]=f; resc=true; } } \
    SBAR(); \
    GAPB(o[0]=__builtin_amdgcn_mfma_f32_32x32x16_bf16(PAF(0),VFR(0),o[0],0,0,0), C0,0); \
    GAPB(o[1]=__builtin_amdgcn_mfma_f32_32x32x16_bf16(PAF(0),VFR(4),o[1],0,0,0), C0,4); \
    KRD(GL,0); GAPB(o[0]=__builtin_amdgcn_mfma_f32_32x32x16_bf16(PAF(1),VFR(1),o[0],0,0,0), C0,8); \
    KRD(GL,1); GAPB(o[1]=__builtin_amdgcn_mfma_f32_32x32x16_bf16(PAF(1),VFR(5),o[1],0,0,0), C0,12); \
    KRD(GL,2); GAPB(o[0]=__builtin_amdgcn_mfma_f32_32x32x16_bf16(PAF(2),VFR(2),o[0],0,0,0), C1,0); \
    KRD(GL,3); GAPB(o[1]=__builtin_amdgcn_mfma_f32_32x32x16_bf16(PAF(2),VFR(6),o[1],0,0,0), C1,4); \
    GAPB(o[0]=__builtin_amdgcn_mfma_f32_32x32x16_bf16(PAF(3),VFR(3),o[0],0,0,0), C1,8); \
    GAPB(o[1]=__builtin_amdgcn_mfma_f32_32x32x16_bf16(PAF(3),VFR(7),o[1],0,0,0), C1,12); \
    }while(0)
  int t=1;
  #undef CMASK
  #define CMASK(P0,P1,t) do{}while(0)
  for(;t+5<NT;t+=2){
    DMA_R(t+2,sl_prev); STEP(pB0,pB1,pA0,pA1,t,true,true,true);     WAIT_BAR(3); RESC(); ROT();
    DMA_R(t+3,sl_prev); STEP(pA0,pA1,pB0,pB1,t+1,true,true,true);   WAIT_BAR(3); RESC(); ROT();
  }
  #undef CMASK
  #define CMASK(P0,P1,t) do{}while(0)
  #define ENDW(tt) do{ if((tt)+3<NT){WAIT_BAR(3);} else if((tt)+2<NT){WAIT_BAR(1);} else {WAIT_BAR(0);} }while(0)
  for(;t+1<NT;t+=2){
    if(t+2<NT){DMA_R(t+2,sl_prev);} STEP(pB0,pB1,pA0,pA1,t,(t+3<NT),(t+1<NT),(t+1<NT));       ENDW(t);   RESC(); ROT();
    if(t+3<NT){DMA_R(t+3,sl_prev);} STEP(pA0,pA1,pB0,pB1,t+1,(t+4<NT),(t+2<NT),(t+2<NT));     ENDW(t+1); RESC(); ROT();
  }
  STEP(pB0,pB1,pA0,pA1,NT-1,false,false,false); RESC();
  { float sacc=pB0[0]+pB0[1]; _Pragma("unroll") for(int r=2;r<16;++r)sacc+=pB0[r]; _Pragma("unroll") for(int r=0;r<16;++r)sacc+=pB1[r]; l_reg+=sacc;
    pw0=(u32x4){PKW(pB0,0),PKW(pB0,2),PKW(pB0,4),PKW(pB0,6)};pw1=(u32x4){PKW(pB0,8),PKW(pB0,10),PKW(pB0,12),PKW(pB0,14)};pw2=(u32x4){PKW(pB1,0),PKW(pB1,2),PKW(pB1,4),PKW(pB1,6)};pw3=(u32x4){PKW(pB1,8),PKW(pB1,10),PKW(pB1,12),PKW(pB1,14)};
    SBAR(); pv(o,vb0+sl_cur,PAF(0),PAF(1),PAF(2),PAF(3)); }
  #undef PKW
  #undef PAF
  #undef VFR
  #undef PIN
  #undef MX3
  #undef GAPA
  #undef GAPB
  #undef EX
  #undef VRD
  #undef KRD
  #undef STEP
  #undef ENDW
  {auto rr=__builtin_amdgcn_permlane32_swap(__float_as_uint(l_reg),__float_as_uint(l_reg),false,false);l_reg=__uint_as_float(rr[0])+__uint_as_float(rr[1]);}
  if(hi==0)wsf[32+r32]=l_reg;asm volatile("s_waitcnt lgkmcnt(0)":::"memory");
  float rli[16];
  #pragma unroll
  for(int r=0;r<16;++r)rli[r]=__builtin_amdgcn_rcpf(wsf[32+crow(r,hi)]);
  bf16*Ow=Ob+(long)(wid*QBLK)*OP;
  { bf16*stg=(bf16*)(shm+LDS_OST)+wid*2048;
    #pragma unroll
    for(int r=0;r<16;++r){const int orow=crow(r,hi);
      #pragma unroll
      for(int d0=0;d0<2;++d0)stg[orow*64+d0*32+r32]=__float2bfloat16(o[d0][r]*rli[r]);}
    asm volatile("s_waitcnt lgkmcnt(0)":::"memory");
    #pragma unroll
    for(int i=0;i<4;++i){const int row=i*8+(lane>>3),ch=lane&7; const u32x4 v=*(const u32x4*)(stg+row*64+ch*8); ATTN_STORE16(Ow+(long)row*OP+ch*8,v);} }
  asm volatile("s_waitcnt lgkmcnt(0)\n\ts_barrier":::"memory");
  #undef DMA_K
  #undef DMA_KN
  #undef DMA_R
  #undef DMA_V
  #undef CMASK
  #undef START
  #undef RESC
  #undef ROT
}
constexpr int ATTN_LDS_BYTES=LDS_BYTES;
#undef SBAR
#undef WAIT_BAR
}

constexpr int NWAVES = 8;
constexpr int M = 32768, D = 1024, SEQ = 8192, NB = 4, FF = 4096, NIN = 1440, NINP = 1536;
constexpr size_t MiB = 1u << 20;
constexpr size_t WS_PART = 2 * MiB;
constexpr size_t WS_WIN = 18 * MiB, WS_WUQ = 21 * MiB, WS_WUKV = 22 * MiB, WS_WO0 = 23 * MiB, WS_WUP0 = 25 * MiB, WS_WDN0 = 33 * MiB;
constexpr size_t WS_WQKV = 41 * MiB, WS_WO1 = 47 * MiB, WS_WUP1 = 49 * MiB, WS_WDN1 = 57 * MiB;
constexpr size_t WS_HB = 66 * MiB;
constexpr size_t WS_U = 130 * MiB;
constexpr size_t WS_Z = 130 * MiB, WS_MIX = 130 * MiB, WS_QA = 226 * MiB, WS_KA = 258 * MiB, WS_VA = 266 * MiB, WS_CQ = 274 * MiB, WS_CKV = 298 * MiB, WS_KR = 314 * MiB, WS_QB = 316 * MiB, WS_KVB = 386 * MiB;
constexpr size_t WS_QKV = 130 * MiB, WS_O1 = 322 * MiB;
constexpr size_t WS_END = 450 * MiB;
constexpr int LDS_BYTES = 143360;
static_assert(att::L_END <= 139264, "attention LDS");

#define LAS __attribute__((address_space(3)))
typedef unsigned short bf16;
typedef unsigned v4u __attribute__((ext_vector_type(4)));
typedef float f32x4 __attribute__((ext_vector_type(4)));
#define LDS_WAIT() asm volatile("s_waitcnt lgkmcnt(0)" ::: "memory")

__device__ __forceinline__ float wave_sum(float v) {
#pragma unroll
    for (int o = 1; o < 64; o <<= 1) v += __shfl_xor(v, o);
    return v;
}
__device__ __forceinline__ unsigned pk2(float lo, float hi) { return pg8::cvt_pk_bf16(lo, hi); }
__device__ __forceinline__ void transpose_item(const float* W, const float* gain, int K, int N, bf16* WT, LAS float* scr, int item, int lane, bool headperm = false) {
    const int nblk = N / 32, kb = item / nblk, nb = item % nblk, k0 = 64 * kb, n0 = 32 * nb;
#pragma unroll 8
    for (int i = 0; i < 32; ++i) { const int kk = 2 * i + (lane >> 5); const float g = gain ? gain[k0 + kk] : 1.f; scr[kk * 33 + (lane & 31)] = W[(size_t)(k0 + kk) * N + n0 + (lane & 31)] * g; }
    LDS_WAIT(); asm volatile("" ::: "memory");
    const int c = lane & 7;
#pragma unroll
    for (int j = 0; j < 4; ++j) { const int n = (lane >> 3) + 8 * j; const LAS float* s = scr + (8 * c) * 33 + n;
        v4u o; o.x = pk2(s[0 * 33], s[1 * 33]); o.y = pk2(s[2 * 33], s[3 * 33]); o.z = pk2(s[4 * 33], s[5 * 33]); o.w = pk2(s[6 * 33], s[7 * 33]);
        int nn = n0 + n; if (headperm && nn < 768) { const int d = nn & 63, hh = (nn >> 6) & 3; nn = (nn & ~255) + 128 * (d >> 5) + 32 * hh + (d & 31); }
        *(v4u*)(WT + (size_t)nn * K + k0 + 8 * c) = o; }
    LDS_WAIT(); asm volatile("" ::: "memory");
}

#define XB_TMO      128
#define XB_XCNT(j)  (256  + 64 * (j))
#define XB_XSUB(j)  (1280 + 64 * (j))
#define XB_XGEN(j)  (2304 + 64 * (j))
#define XB_TOP      3328
#define XB_TOPGEN   3392
#define XCD_BAR_WORDS 3456
#define XB_SPIN_CAP (1u << 22)

__device__ __forceinline__ unsigned xb_ld(unsigned* p)              { return __hip_atomic_load(p, __ATOMIC_RELAXED, __HIP_MEMORY_SCOPE_AGENT); }
__device__ __forceinline__ unsigned xb_add(unsigned* p, unsigned v) { return __hip_atomic_fetch_add(p, v, __ATOMIC_RELAXED, __HIP_MEMORY_SCOPE_AGENT); }
__device__ __forceinline__ unsigned xb_xcc_id() { return (unsigned)__builtin_amdgcn_s_getreg((3 << 11) | 20) & 0xFu; }
#define XB_SPIN(cond, bar) do { unsigned _sp = 0; while (cond) { __builtin_amdgcn_s_sleep(1); \
    if ((++_sp & 255u) == 0u) { if (xb_ld(&(bar)[XB_TMO])) break; if (_sp > XB_SPIN_CAP) { atomicAdd(&(bar)[XB_TMO], 1u); break; } } } } while (0)

struct XcdBarrier {
    unsigned* bar; unsigned x;
    volatile LAS unsigned* st;
};

__device__ __forceinline__ XcdBarrier xcd_barrier_post(unsigned* bar, volatile LAS unsigned* st) {
    XcdBarrier b; b.bar = bar; b.x = xb_xcc_id(); b.st = st;
    if (threadIdx.x == 0) (void)xb_add(&bar[XB_XCNT(b.x)], 1u);
    return b;
}
__device__ __forceinline__ void xcd_barrier_complete(unsigned* bar, unsigned x, unsigned& nloc, unsigned& nx) {
    const unsigned G = gridDim.x * gridDim.y * gridDim.z;
    unsigned sum, cnt, mine, sp = 0u;
    for (;;) {
        sum = 0u; cnt = 0u; mine = 0u;
#pragma unroll
        for (unsigned j = 0; j < 16; ++j) { const unsigned c = xb_ld(&bar[XB_XCNT(j)]); sum += c; cnt += (c > 0u) ? 1u : 0u; mine = (j == x) ? c : mine; }
        if (sum == G) break;
        __builtin_amdgcn_s_sleep(1);
        if ((++sp & 255u) == 0u) { if (xb_ld(&bar[XB_TMO])) break; if (sp > XB_SPIN_CAP) { atomicAdd(&bar[XB_TMO], 1u); break; } }
    }
    nloc = mine > 0u ? mine : 1u; nx = cnt > 0u ? cnt : 1u;
}

__device__ __forceinline__ void xcd_barrier(const XcdBarrier& b) {
    asm volatile("s_waitcnt vmcnt(0)" ::: "memory");
    __syncthreads();
    if (threadIdx.x == 0) {
        unsigned* bar = b.bar;
        __builtin_amdgcn_s_waitcnt(0);
        unsigned nloc = b.st[0], nx = b.st[1];
        if (nloc == 0u) { xcd_barrier_complete(bar, b.x, nloc, nx); b.st[0] = nloc; b.st[1] = nx; }
        const unsigned old = xb_add(&bar[XB_XSUB(b.x)], 1u);
        const unsigned gen = old / nloc;
        if (old + 1u == (gen + 1u) * nloc) {
            __builtin_amdgcn_fence(__ATOMIC_RELEASE, "agent");
            asm volatile("s_waitcnt vmcnt(0)" ::: "memory");
            const unsigned og = xb_add(&bar[XB_TOP], 1u);
            const unsigned tg = og / nx;
            if (og + 1u == (tg + 1u) * nx) xb_add(&bar[XB_TOPGEN], 1u);
            else XB_SPIN(xb_ld(&bar[XB_TOPGEN]) == tg, bar);
            __builtin_amdgcn_fence(__ATOMIC_ACQUIRE, "agent");
            xb_add(&bar[XB_XGEN(b.x)], 1u);
            asm volatile("s_waitcnt vmcnt(0)" ::: "memory");
        } else {
            XB_SPIN(xb_ld(&bar[XB_XGEN(b.x)]) == gen, bar);
            __builtin_amdgcn_fence(__ATOMIC_ACQUIRE, "agent");
            asm volatile("s_waitcnt vmcnt(0)" ::: "memory");
        }
    }
    __syncthreads();
}

struct Args { const float* in[17]; float* out; unsigned char* ws; int ph_lo, ph_hi; };

__device__ __forceinline__ void ld8(const bf16* p, float (&v)[8]) { const v4u w = *(const v4u*)p;
#pragma unroll
    for (int j = 0; j < 4; ++j) { v[2 * j] = __uint_as_float(w[j] << 16); v[2 * j + 1] = __uint_as_float(w[j] & 0xffff0000u); } }
__device__ __forceinline__ void up8(const v4u w, float (&v)[8]) {
#pragma unroll
    for (int j = 0; j < 4; ++j) { v[2 * j] = __uint_as_float(w[j] << 16); v[2 * j + 1] = __uint_as_float(w[j] & 0xffff0000u); } }
__device__ __forceinline__ void st8(bf16* p, const float (&v)[8]) { v4u o; o.x = pk2(v[0], v[1]); o.y = pk2(v[2], v[3]); o.z = pk2(v[4], v[5]); o.w = pk2(v[6], v[7]); *(v4u*)p = o; }

__device__ __forceinline__ void head_norm_rope(float (&v)[8], const float* gain, int j, int prow, int pcol, float scale, const float* tc, const float* ts) {
    float ss = 0.f;
#pragma unroll
    for (int e = 0; e < 8; ++e) ss += v[e] * v[e];
    ss += __shfl_xor(ss, 1); ss += __shfl_xor(ss, 2); ss += __shfl_xor(ss, 4);
    const float rstd = 1.0f / sqrtf(ss * (1.0f / 64.0f) + pg8::NORM_EPS);
    const int pos = (j < 4) ? prow : pcol; const int o16 = pos * 16 + (j & 1) * 8;
    const f32x4 c0 = *(const f32x4*)(tc + o16), c1 = *(const f32x4*)(tc + o16 + 4), s0 = *(const f32x4*)(ts + o16), s1 = *(const f32x4*)(ts + o16 + 4);
    const f32x4 g0 = *(const f32x4*)(gain + j * 8), g1 = *(const f32x4*)(gain + j * 8 + 4);
#pragma unroll
    for (int e = 0; e < 8; ++e) {
        const float g = e < 4 ? g0[e & 3] : g1[e & 3], c = e < 4 ? c0[e & 3] : c1[e & 3], s = e < 4 ? s0[e & 3] : s1[e & 3];
        const float y = v[e] * rstd * g; const float py = __shfl_xor(y, 2);
        v[e] = (((j & 2) == 0) ? y * c - py * s : y * c + py * s) * scale;
    }
}

__global__ void __launch_bounds__(NWAVES * 64, 2) fwd_kernel(Args args) {
    extern __shared__ __attribute__((aligned(16))) unsigned char lds[];
    cg::grid_group grid = cg::this_grid();
    LAS unsigned char* L = (LAS unsigned char*)lds;
    const int tid = threadIdx.x, lane = tid & 63, wave = __builtin_amdgcn_readfirstlane(tid >> 6);
    const int G = gridDim.x; const int bx = blockIdx.x;
    const int vcu = (G % 8 == 0) ? (bx % 8) * (G / 8) + bx / 8 : bx;
    const int gw = vcu * NWAVES + wave, NGW = G * NWAVES;
    unsigned char* ws = args.ws;
    const float* x = args.in[0]; float* out = args.out;
    float* PART = (float*)(ws + WS_PART);
#define PARTN(k) (PART + (size_t)(k) * M * 16)
    bf16 *HB = (bf16*)(ws + WS_HB), *U = (bf16*)(ws + WS_U), *Z = (bf16*)(ws + WS_Z), *MIX = (bf16*)(ws + WS_MIX);
    bf16 *QA = (bf16*)(ws + WS_QA), *KA = (bf16*)(ws + WS_KA), *VA = (bf16*)(ws + WS_VA), *CQ = (bf16*)(ws + WS_CQ), *CKV = (bf16*)(ws + WS_CKV), *KR = (bf16*)(ws + WS_KR);
    bf16 *QB = (bf16*)(ws + WS_QB), *KVB = (bf16*)(ws + WS_KVB), *QKV = (bf16*)(ws + WS_QKV), *O1 = (bf16*)(ws + WS_O1);
    bf16 *WIN = (bf16*)(ws + WS_WIN), *WUQ = (bf16*)(ws + WS_WUQ), *WUKV = (bf16*)(ws + WS_WUKV), *WO0 = (bf16*)(ws + WS_WO0), *WUP0 = (bf16*)(ws + WS_WUP0), *WDN0 = (bf16*)(ws + WS_WDN0);
    bf16 *WQKV = (bf16*)(ws + WS_WQKV), *WO1 = (bf16*)(ws + WS_WO1), *WUP1 = (bf16*)(ws + WS_WUP1), *WDN1 = (bf16*)(ws + WS_WDN1);
    const int lo = args.ph_lo, hi = args.ph_hi;
    float* TAC = (float*)(ws + MiB); float* TAS = TAC + 2048; float* TBC = TAS + 2048; float* TBS = TBC + 1024;
    volatile LAS unsigned* MISC = (volatile LAS unsigned*)(L + 139264);
    if (tid < 2) MISC[tid] = 0u;
    __syncthreads();
    unsigned* BARW = (unsigned*)(ws + 8192);
    XcdBarrier xbar; xbar.bar = BARW; xbar.x = 0; xbar.st = MISC;
#ifndef PROBE_PHASE
#define PROBE_PHASE -1
#endif
#define IN(k) (lo <= (k) && (k) < hi)
#define REPS(k) ((PROBE_PHASE == (k)) ? 2 : 1)
#define SEAM(k) do { if (IN(k) && IN((k) + 1)) { if ((k) == 0) { grid.sync(); xbar = xcd_barrier_post(BARW, MISC); } else xcd_barrier(xbar); } } while (0)
    constexpr float C2A = 0.125f * att::LOG2E;
    constexpr float C2B = 0.10206207261596577f * att::LOG2E;

    if (IN(0)) {
        if (bx == 0) for (int i = tid; i < XCD_BAR_WORDS; i += NWAVES * 64) BARW[i] = 0u;
        LAS float* scr = (LAS float*)(L + wave * 16384);
        constexpr int I0 = 16 * 45, I1 = 6 * 24, I2 = 4 * 32, I3 = 16 * 32, I4 = 16 * 128, I5 = 64 * 32, I6 = 16 * 96, I7 = 16 * 32, I8 = I4, I9 = I5;
        constexpr int NITEMS = I0 + I1 + I2 + I3 + I4 + I5 + I6 + I7 + I8 + I9;
        for (int it = gw; it < NITEMS; it += NGW) {
            int r = it;
            if (r < I0) { transpose_item(args.in[2], args.in[1], D, NIN, WIN, scr, r, lane, true); continue; } r -= I0;
            if (r < I1) { transpose_item(args.in[6], args.in[5], 384, 768, WUQ, scr, r, lane); continue; } r -= I1;
            if (r < I2) { transpose_item(args.in[8], args.in[7], 256, 1024, WUKV, scr, r, lane); continue; } r -= I2;
            if (r < I3) { transpose_item(args.in[9], nullptr, D, D, WO0, scr, r, lane); continue; } r -= I3;
            if (r < I4) { transpose_item(args.in[14], args.in[13], D, FF, WUP0, scr, r, lane); continue; } r -= I4;
            if (r < I5) { transpose_item(args.in[15], nullptr, FF, D, WDN0, scr, r, lane); continue; } r -= I5;
            if (r < I6) { transpose_item(args.in[10], args.in[1] + D, D, 3 * D, WQKV, scr, r, lane); continue; } r -= I6;
            if (r < I7) { transpose_item(args.in[12], nullptr, D, D, WO1, scr, r, lane); continue; } r -= I7;
            if (r < I8) { transpose_item(args.in[14] + (size_t)D * FF, args.in[13] + D, D, FF, WUP1, scr, r, lane); continue; } r -= I8;
            transpose_item(args.in[15] + (size_t)FF * D, nullptr, FF, D, WDN1, scr, r, lane);
        }
        for (int i = bx * 512 + tid; i < 128 * 16; i += G * 512) { const int pos = i >> 4, f = i & 15; float s, c; att::sincos_acc((float)pos * exp2f(-(float)f * (13.287712379549449f / 16.0f)), s, c); TAC[i] = c; TAS[i] = s; }
        for (int i = bx * 512 + tid; i < 128 * 8; i += G * 512) { const int pos = i >> 3, f = i & 7; float s, c; att::sincos_acc((float)pos * exp2f(-(float)f * (13.287712379549449f / 8.0f)), s, c); TBC[i] = c; TBS[i] = s; }
        { v4u* p = (v4u*)(WIN + (size_t)NIN * D); const int n16 = (NINP - NIN) * D * 2 / 16; for (int i = bx * 512 + tid; i < n16; i += G * 512) p[i] = (v4u){0u, 0u, 0u, 0u}; }
        for (int m = gw; m < M; m += NGW) {
            const f32x4* xr = (const f32x4*)(x + (size_t)m * D) + lane; f32x4 v[4]; float s = 0.f;
#pragma unroll
            for (int j = 0; j < 4; ++j) { v[j] = xr[64 * j]; s += (v[j].x * v[j].x + v[j].y * v[j].y) + (v[j].z * v[j].z + v[j].w * v[j].w); }
            s = wave_sum(s);
            unsigned long long* o8 = (unsigned long long*)(HB + (size_t)m * D) + lane;
#pragma unroll
            for (int j = 0; j < 4; ++j) o8[64 * j] = (unsigned long long)pk2(v[j].x, v[j].y) | ((unsigned long long)pk2(v[j].z, v[j].w) << 32);
            if (lane < 16) PARTN(0)[(size_t)m * 16 + lane] = (lane == 0) ? s : 0.f;
        }
    }
    SEAM(0);
    if (IN(1)) {
        pg8::Gemm g{HB, WIN, M, NINP, D}; pg8::StaticOrder S; S.init(M, NINP, G, bx); S.rep = REPS(1);
        pg8::EpiIn E{PARTN(0), QA, KA, VA, CQ, CKV, KR, PARTN(5), PARTN(6), args.in[3], args.in[4], TAC, TAS, TBC, TBS, C2A};
        pg8::gemm_phase<pg8::EpiIn, pg8::StaticOrder, true, true>(L, g, S, E);
    }
    SEAM(1);
    if (IN(3)) {
        { pg8::Gemm g{CQ, WUQ, M, 768, 384}; pg8::StaticOrder S; S.init(M, 768, G, bx);
          pg8::EpiScale<0> E{QB, 768, PARTN(5), 1.0f / 384.0f, 3, C2B};
          pg8::gemm_phase<pg8::EpiScale<0>, pg8::StaticOrder, true, true>(L, g, S, E); }
        { pg8::Gemm g{CKV, WUKV, M, 1024, 256}; pg8::StaticOrder S; S.init(M, 1024, G, bx);
          pg8::EpiScale<0> E{KVB, 1024, PARTN(6), 1.0f / 256.0f, 0, 1.f};
          pg8::gemm_phase<pg8::EpiScale<0>, pg8::StaticOrder, true, true>(L, g, S, E); }
    }
    SEAM(3);
    if (IN(4)) {
        for (int uu = vcu; uu < 2048 * REPS(4); uu += G) { const int u = uu & 2047;
            const int pair = u >> 5, qb = u & 31; const int typ = (pair >> 3) & 1; const int idx = (pair >> 4) * 8 + (pair & 7); const int b = idx >> 3, h = idx & 7;
            const long rowbase = (long)b * SEQ;
            const bool has_next = (uu + G) < 2048 * REPS(4); const int un = (uu + G) & 2047; const int pairn = un >> 5; const int typn = (pairn >> 3) & 1; const int idxn = (pairn >> 4) * 8 + (pairn & 7); const int bn = idxn >> 3, hn = idxn & 7;
            att::Next nx;
            if (typn == 0) nx = att::Next{KA + (hn >> 2) * 64, KR, VA + (hn >> 2) * 64, 128, 32, 128, (long)bn * SEQ, 0, SEQ / 64 - 1, 64};
            else nx = att::Next{KVB + hn * 128, KR, KVB + hn * 128 + 64, 1024, 32, 1024, (long)bn * SEQ, 0, SEQ / 64 - 1, 96};
            if (typ == 0) { att::Desc d{QA + h * 64, nullptr, KA + (h >> 2) * 64, nullptr, VA + (h >> 2) * 64, MIX + h * 64, 512, 0, 128, 0, 128, 1024};
                (void)d; attn_ex::attn_unit<8, 512, 128, 128, 1024>((const attn_ex::bf16*)(QA + (size_t)(rowbase + qb * 256) * 512 + h * 64), (const attn_ex::bf16*)(KA + (size_t)rowbase * 128 + (h >> 2) * 64),
                    (const attn_ex::bf16*)(VA + (size_t)rowbase * 128 + (h >> 2) * 64), (attn_ex::bf16*)(MIX + (size_t)(rowbase + qb * 256) * 1024 + h * 64), (char*)lds); }
            else { att::Desc d{QB + h * 96, QB + h * 96 + 64, KVB + h * 128, KR, KVB + h * 128 + 64, MIX + 512 + h * 64, 768, 768, 1024, 32, 1024, 1024};
                (void)d; attn_ex96::attn_unit<8, 768, 1024, 1024, 1024>((const attn_ex96::bf16*)(QB + (size_t)(rowbase + qb * 256) * 768 + h * 96), (const attn_ex96::bf16*)(QB + (size_t)(rowbase + qb * 256) * 768 + h * 96 + 64),
                    (const attn_ex96::bf16*)(KVB + (size_t)rowbase * 1024 + h * 128), (const attn_ex96::bf16*)(KR + (size_t)rowbase * 32), (const attn_ex96::bf16*)(KVB + (size_t)rowbase * 1024 + h * 128 + 64),
                    (attn_ex96::bf16*)(MIX + (size_t)(rowbase + qb * 256) * 1024 + 512 + h * 64), qb * 256, (char*)lds); }
        }
    }
    SEAM(4);
    if (IN(5)) {
        pg8::Gemm g{MIX, WO0, M, D, D}; pg8::StaticOrder S; S.init(M, D, G, bx); S.rep = REPS(5);
        pg8::EpiRes E{x, out, HB, PARTN(1), D};
        pg8::gemm_phase<pg8::EpiRes, pg8::StaticOrder, true, true>(L, g, S, E);
    }
    SEAM(5);
    if (IN(6)) {
        pg8::Gemm g{HB, WUP0, M, FF, D}; pg8::StaticOrder S; S.init(M, FF, G, bx); S.rep = REPS(6);
        pg8::EpiScale<1> E{U, FF, PARTN(1), 1.0f / D, 0, 1.f};
        pg8::gemm_phase<pg8::EpiScale<1>, pg8::StaticOrder, true, true>(L, g, S, E);
    }
    SEAM(6);
    if (IN(7)) {
        pg8::Gemm g{U, WDN0, M, D, FF}; pg8::StaticOrder S; S.init(M, D, G, bx);
        pg8::EpiRes E{out, out, HB, PARTN(2), D};
        pg8::gemm_phase<pg8::EpiRes, pg8::StaticOrder, true, true>(L, g, S, E);
    }
    SEAM(7);
    if (IN(8)) {
        pg8::Gemm g{HB, WQKV, M, 3 * D, D}; pg8::StaticOrder S; S.init(M, 3 * D, G, bx); S.rep = REPS(8);
        pg8::EpiScale<0> E{QKV, 3 * D, PARTN(2), 1.0f / D, 4, C2A, M};
        pg8::gemm_phase<pg8::EpiScale<0>, pg8::StaticOrder, true, true>(L, g, S, E);
    }
    SEAM(8);
    if (IN(9)) {
        for (int uu = vcu; uu < 2048 * REPS(9); uu += G) { const int u = uu & 2047;
            const int pair = u >> 5, qb = u & 31; const int b = pair >> 4, h = pair & 15;
            const int R0 = qb * 4; const int tlo = min(max(R0 - 4, 0), 120), thi = min(max(R0 + 3 - 4, 0), 120) + 7;
            att::Desc d{QKV + (size_t)h * M * 64, nullptr, QKV + (size_t)(16 + h) * M * 64, nullptr, QKV + (size_t)(32 + h) * M * 64, O1 + h * 64, 64, 0, 64, 0, 64, D};
            const bool has_next = (uu + G) < 2048 * REPS(9); const int un = (uu + G) & 2047; const int pairn = un >> 5, qbn = un & 31; const int bn = pairn >> 4, hn = pairn & 15;
            const int R0n = qbn * 4; const int tlon = min(max(R0n - 4, 0), 120), thin = min(max(R0n + 3 - 4, 0), 120) + 7;
            const att::Next nx{QKV + (size_t)(16 + hn) * M * 64, KR, QKV + (size_t)(32 + hn) * M * 64, 64, 32, 64, (long)bn * SEQ, tlon, thin, 64};
            if (wave & 1) att::unit<64, 1, 1>(d, (long)b * SEQ, qb * 256, tlo, thi, args.in[11] + h * 465, L, uu != vcu, has_next, nx);
            else att::unit<64, 1, 0>(d, (long)b * SEQ, qb * 256, tlo, thi, args.in[11] + h * 465, L, uu != vcu, has_next, nx);
        }
    }
    SEAM(9);
    if (IN(10)) {
        pg8::Gemm g{O1, WO1, M, D, D}; pg8::StaticOrder S; S.init(M, D, G, bx);
        pg8::EpiRes E{out, out, HB, PARTN(3), D};
        pg8::gemm_phase<pg8::EpiRes, pg8::StaticOrder, true, true>(L, g, S, E);
    }
    SEAM(10);
    if (IN(11)) {
        pg8::Gemm g{HB, WUP1, M, FF, D}; pg8::StaticOrder S; S.init(M, FF, G, bx);
        pg8::EpiScale<1> E{U, FF, PARTN(3), 1.0f / D, 0, 1.f};
        pg8::gemm_phase<pg8::EpiScale<1>, pg8::StaticOrder, true, true>(L, g, S, E);
    }
    SEAM(11);
    if (IN(12)) {
        pg8::Gemm g{U, WDN1, M, D, FF}; pg8::StaticOrder S; S.init(M, D, G, bx);
        pg8::EpiRes E{out, out, nullptr, PARTN(4), D};
        pg8::gemm_phase<pg8::EpiRes, pg8::StaticOrder, true, true>(L, g, S, E);
    }
    SEAM(12);
    if (IN(13)) {
        const float* gf = args.in[16];
        for (int m = gw; m < M; m += NGW) {
            f32x4* xr = (f32x4*)(out + (size_t)m * D) + lane; const f32x4* pp = (const f32x4*)(PARTN(4) + (size_t)m * 16);
            const f32x4 a = pp[0], b = pp[1], c = pp[2], d4 = pp[3];
            const float s = ((a[0] + a[1]) + (a[2] + a[3])) + ((b[0] + b[1]) + (b[2] + b[3])) + ((c[0] + c[1]) + (c[2] + c[3])) + ((d4[0] + d4[1]) + (d4[2] + d4[3]));
            const float rstd = 1.0f / sqrtf(s * (1.0f / D) + pg8::NORM_EPS);
#pragma unroll
            for (int j = 0; j < 4; ++j) { const f32x4 v = xr[64 * j]; const f32x4 gg = ((const f32x4*)gf)[lane + 64 * j]; xr[64 * j] = v * rstd * gg; }
        }
    }
#undef IN
#undef SEAM
}

#ifndef MK_PER_PHASE
#define MK_PER_PHASE 0
#endif
extern "C" void kernel_launch(void* const* d_in, const int* in_sizes, int n_in, void* d_out, int out_size, void* d_ws, size_t ws_size, hipStream_t stream) {
    static int grid = 0;
    if (grid == 0) {
        if (n_in != 17 || in_sizes[0] != M * D || out_size != M * D || ws_size < WS_END) { fprintf(stderr, "kernel_launch: unexpected shapes / workspace (n_in %d, in0 %d, out %d, ws %zu)\n", n_in, n_in > 0 ? in_sizes[0] : -1, out_size, ws_size); grid = -1; return; }
        int dev = 0, cus = 0, per_cu = 0;
        if (hipGetDevice(&dev) != hipSuccess || hipDeviceGetAttribute(&cus, hipDeviceAttributeMultiprocessorCount, dev) != hipSuccess) { grid = -1; return; }
        if (hipFuncSetAttribute((const void*)fwd_kernel, hipFuncAttributeMaxDynamicSharedMemorySize, LDS_BYTES) != hipSuccess) { fprintf(stderr, "kernel_launch: hipFuncSetAttribute failed\n"); grid = -1; return; }
        if (hipOccupancyMaxActiveBlocksPerMultiprocessor(&per_cu, (const void*)fwd_kernel, NWAVES * 64, LDS_BYTES) != hipSuccess || per_cu < 1) { fprintf(stderr, "kernel_launch: occupancy query says %d\n", per_cu); per_cu = 1; }
        (void)hipGetLastError();
        grid = cus * per_cu;
        fprintf(stderr, "kernel_launch: grid %d (cus %d x %d)\n", grid, cus, per_cu);
    }
    if (grid < 0) return;
    Args a{};
    for (int i = 0; i < 17; ++i) a.in[i] = (const float*)d_in[i];
    a.out = (float*)d_out; a.ws = (unsigned char*)d_ws;
#if MK_PER_PHASE
    for (int p = 0; p < 14; ++p) { a.ph_lo = p; a.ph_hi = p + 1; hipLaunchKernelGGL(fwd_kernel, dim3(grid), dim3(NWAVES * 64), LDS_BYTES, stream, a); }
#else
    a.ph_lo = 0; a.ph_hi = 14;
    void* kargs[] = {&a};
    hipError_t e = hipLaunchCooperativeKernel((const void*)fwd_kernel, dim3(grid), dim3(NWAVES * 64), kargs, LDS_BYTES, stream);
    if (e != hipSuccess) fprintf(stderr, "cooperative launch failed: %s (grid %d)\n", hipGetErrorString(e), grid);
#endif
}
```

```cpp
#include <hip/hip_runtime.h>
#include <hip/hip_cooperative_groups.h>
#include <hip/hip_bf16.h>
#include <cstdio>
#include <cstdint>
#include <cmath>
namespace cg = cooperative_groups;
namespace pg8 {
#define PG8_LAS __attribute__((address_space(3)))
typedef unsigned short bf16_t;
typedef short bf16x8 __attribute__((ext_vector_type(8)));
typedef float f32x4 __attribute__((ext_vector_type(4)));
typedef unsigned u32x4 __attribute__((ext_vector_type(4)));
constexpr int BM = 256, BK = 64, HALF = 128, HTB = HALF * BK * 2  , STAGE_BYTES = 8 * HTB, NXCD = 8, WGM = 8;

__host__ __device__ __forceinline__ int lds_byte(int r, int c) { const int st = (r >> 4) * 2 + (c >> 5), rr = r & 15, cc = c & 31, ob = rr * 64 + cc * 2; return st * 1024 + (ob ^ (((ob >> 9) & 1) << 5)); }
__host__ __device__ __forceinline__ void stage_rc(int b, int& R, int& C) { const int st = b / 1024, sb = b % 1024, swz = sb ^ (((sb >> 9) & 1) << 5); R = (st >> 1) * 16 + swz / 64; C = (st & 1) * 32 + (swz % 64) / 2; }
__host__ __device__ __forceinline__ int perm32(int rho) { const int n = rho >> 4, i = rho & 15; return 8 * (i >> 2) + 4 * n + (i & 3); }

struct Unit { int pm, pn; };
struct Gemm { const bf16_t* A; const bf16_t* Bt; int M, N, K; };

struct StaticOrder {
    int nM, nN, nwg, G, c, rep = 1;
    __host__ __device__ void init(int M, int N, int G_, int c_) { nM = M / BM; nN = N / BM; nwg = nM * nN; G = G_; c = c_; }
    __host__ __device__ bool next(int i, Unit& u) const {
        const long L = (long)i * G + c; if (L >= (long)nwg * rep) return false;
        int wgid = (int)(L % nwg); { const int q = nwg / NXCD, r = nwg % NXCD, xcd = wgid % NXCD, off = wgid / NXCD; wgid = (xcd < r ? xcd * (q + 1) : r * (q + 1) + (xcd - r) * q) + off; }
        const int nig = WGM * nN, gid = wgid / nig, fm = gid * WGM, gsz = (nM - fm) < WGM ? (nM - fm) : WGM;
        u.pm = fm + ((wgid % nig) % gsz); u.pn = (wgid % nig) / gsz; return true;
    }
    __device__ __forceinline__ void a_ready(const Unit&) const {}
    __device__ __forceinline__ void done(const Unit&) const {}
};
__device__ __forceinline__ unsigned cvt_pk_bf16(float lo, float hi) { unsigned r; asm volatile("v_cvt_pk_bf16_f32 %0, %1, %2" : "=v"(r) : "v"(lo), "v"(hi)); return r; }
constexpr float NORM_EPS = 1e-6f;
template <int ACT> struct EpiScale {
    static constexpr bool PERM = true, AFTER_DRAIN = false;
    bf16_t* O; int ldc; const float* part; float inv_dim; int nq_tiles; float qscale; int hm = 0;
    __device__ __forceinline__ void operator()(const f32x4 (&acc)[2][2][4][2], const Unit& u, int wr, int wc, int fr, int fq) const {
        const int row0 = u.pm * BM + wr * 64 + fr; const int col0 = u.pn * BM + wc * 32 + 8 * fq;
        const float sc = (u.pn < nq_tiles) ? qscale : 1.f;
#pragma unroll
        for (int ai = 0; ai < 2; ++ai)
#pragma unroll
            for (int m = 0; m < 4; ++m) { const int row = row0 + ai * HALF + m * 16; float rs = 1.f;
                if (part) { const f32x4 a = *(const f32x4*)(part + (size_t)row * 16 + 4 * fq);
                    float s = (a[0] + a[1]) + (a[2] + a[3]); s += __shfl_xor(s, 16); s += __shfl_xor(s, 32);
                    rs = 1.0f / sqrtf(s * inv_dim + NORM_EPS); }
                if (ACT == 0) rs *= sc;
                bf16_t* rowp = hm ? O + ((size_t)(col0 >> 6) * hm + row) * 64 + (col0 & 63) : O + (size_t)row * ldc + col0;
#pragma unroll
                for (int bj = 0; bj < 2; ++bj) { f32x4 v0 = acc[ai][bj][m][0] * rs, v1 = acc[ai][bj][m][1] * rs;
                    if (ACT == 1) {
#pragma unroll
                        for (int e = 0; e < 4; ++e) { float a = fmaxf(v0[e], 0.f), b = fmaxf(v1[e], 0.f); v0[e] = a * a; v1[e] = b * b; } }
                    u32x4 w; w.x = cvt_pk_bf16(v0[0], v0[1]); w.y = cvt_pk_bf16(v0[2], v0[3]); w.z = cvt_pk_bf16(v1[0], v1[1]); w.w = cvt_pk_bf16(v1[2], v1[3]);
                    *(u32x4*)(rowp + (hm ? (size_t)bj * 2 * hm * 64 : (size_t)(bj * HALF))) = w; } }
    }
};
struct EpiIn {
    static constexpr bool PERM = true, AFTER_DRAIN = false;
    const float* part0; bf16_t *QA, *KA, *VA, *CQ, *CKV, *KR; float *pcq, *pckv; const float *gq, *gk, *tac, *tas, *tbc, *tbs; float qscale;
    __device__ __forceinline__ void st16(bf16_t* p, const f32x4 a, const f32x4 b) const { u32x4 w; w.x = cvt_pk_bf16(a[0], a[1]); w.y = cvt_pk_bf16(a[2], a[3]); w.z = cvt_pk_bf16(b[0], b[1]); w.w = cvt_pk_bf16(b[2], b[3]); *(u32x4*)p = w; }
    __device__ __forceinline__ float sq8(const f32x4 a, const f32x4 b) const { return (a[0] * a[0] + a[1] * a[1]) + (a[2] * a[2] + a[3] * a[3]) + (b[0] * b[0] + b[1] * b[1]) + (b[2] * b[2] + b[3] * b[3]); }
    __device__ __forceinline__ void operator()(const f32x4 (&acc)[2][2][4][2], const Unit& u, int wr, int wc, int fr, int fq) const {
        const int row0 = u.pm * BM + wr * 64 + fr; const int pn = u.pn;
#pragma unroll
        for (int ai = 0; ai < 2; ++ai)
#pragma unroll
            for (int m = 0; m < 4; ++m) { const int row = row0 + ai * HALF + m * 16;
                const float rsx = 1.0f / sqrtf(part0[(size_t)row * 16] * (1.0f / 1024.0f) + NORM_EPS);
                const int t = row & 8191; const int prow = t >> 6, pcol = t & 63;
                f32x4 z[2][2];
#pragma unroll
                for (int bj = 0; bj < 2; ++bj)
#pragma unroll
                    for (int n = 0; n < 2; ++n) z[bj][n] = acc[ai][bj][m][n] * rsx;
                if (pn <= 2) {
                    if (pn == 2 && wc >= 2) {
#pragma unroll
                        for (int bj = 0; bj < 2; ++bj) st16(VA + (size_t)row * 128 + (wc - 2) * 64 + 32 * bj + 8 * fq, z[bj][0], z[bj][1]);
                    } else {
                        float ss = sq8(z[0][0], z[0][1]) + sq8(z[1][0], z[1][1]);
                        ss += __shfl_xor(ss, 16); ss += __shfl_xor(ss, 32);
                        const float hr = 1.0f / sqrtf(ss * (1.0f / 64.0f) + NORM_EPS);
                        const float* gain = (pn == 2) ? gk : gq; const float sc = (pn == 2) ? 1.f : qscale;
                        bf16_t* dst = (pn == 2) ? KA + (size_t)row * 128 + wc * 64 : QA + (size_t)row * 512 + (4 * pn + wc) * 64;
#pragma unroll
                        for (int bj = 0; bj < 2; ++bj) { const int pos = bj ? pcol : prow; f32x4 o2[2];
#pragma unroll
                            for (int n = 0; n < 2; ++n) { const int ti = pos * 16 + 8 * (fq & 1) + 4 * n;
                                const f32x4 c4 = *(const f32x4*)(tac + ti), s4 = *(const f32x4*)(tas + ti), g4 = *(const f32x4*)(gain + 32 * bj + 8 * fq + 4 * n);
#pragma unroll
                                for (int e = 0; e < 4; ++e) { const float y = z[bj][n][e] * hr * g4[e]; const float py = __shfl_xor(y, 32);
                                    o2[n][e] = (((fq & 2) == 0) ? y * c4[e] - py * s4[e] : y * c4[e] + py * s4[e]) * sc; } }
                            st16(dst + 32 * bj + 8 * fq, o2[0], o2[1]); }
                    }
                } else if (pn == 3) {
#pragma unroll
                    for (int bj = 0; bj < 2; ++bj) st16(CQ + (size_t)row * 384 + 128 * bj + 32 * wc + 8 * fq, z[bj][0], z[bj][1]);
                    float ss = sq8(z[0][0], z[0][1]) + sq8(z[1][0], z[1][1]); ss += __shfl_xor(ss, 16); ss += __shfl_xor(ss, 32);
                    if (fq == 0) { pcq[(size_t)row * 16 + wc] = ss; pcq[(size_t)row * 16 + 8 + wc] = 0.f; }
                } else if (pn == 4) {
                    st16(CQ + (size_t)row * 384 + 256 + 32 * wc + 8 * fq, z[0][0], z[0][1]);
                    st16(CKV + (size_t)row * 256 + 32 * wc + 8 * fq, z[1][0], z[1][1]);
                    float s0 = sq8(z[0][0], z[0][1]), s1 = sq8(z[1][0], z[1][1]); s0 += __shfl_xor(s0, 16); s0 += __shfl_xor(s0, 32); s1 += __shfl_xor(s1, 16); s1 += __shfl_xor(s1, 32);
                    if (fq == 0) { pcq[(size_t)row * 16 + 4 + wc] = s0; pcq[(size_t)row * 16 + 12 + wc] = 0.f; pckv[(size_t)row * 16 + wc] = s1; }
                } else {
                    st16(CKV + (size_t)row * 256 + 128 + 32 * wc + 8 * fq, z[0][0], z[0][1]);
                    float s0 = sq8(z[0][0], z[0][1]); s0 += __shfl_xor(s0, 16); s0 += __shfl_xor(s0, 32);
                    if (fq == 0) { pckv[(size_t)row * 16 + 4 + wc] = s0; pckv[(size_t)row * 16 + 8 + wc] = 0.f; pckv[(size_t)row * 16 + 12 + wc] = 0.f; }
                    if (wc == 0) {
                        const int pos = (fq < 2) ? prow : pcol; f32x4 o2[2];
#pragma unroll
                        for (int n = 0; n < 2; ++n) { const f32x4 c4 = *(const f32x4*)(tbc + pos * 8 + 4 * n), s4 = *(const f32x4*)(tbs + pos * 8 + 4 * n);
#pragma unroll
                            for (int e = 0; e < 4; ++e) { const float y = z[1][n][e]; const float py = __shfl_xor(y, 16);
                                o2[n][e] = ((fq & 1) == 0) ? y * c4[e] - py * s4[e] : y * c4[e] + py * s4[e]; } }
                        st16(KR + (size_t)row * 32 + 8 * fq, o2[0], o2[1]);
                    }
                }
            }
    }
};

struct EpiRes {
    static constexpr bool PERM = true, AFTER_DRAIN = false;
    const float* base; float* out; bf16_t* ob; float* part; int ldc;
    __device__ __forceinline__ void operator()(const f32x4 (&acc)[2][2][4][2], const Unit& u, int wr, int wc, int fr, int fq) const {
        const int row0 = u.pm * BM + wr * 64 + fr; const int col0 = u.pn * BM + wc * 32 + 8 * fq;
#pragma unroll
        for (int ai = 0; ai < 2; ++ai)
#pragma unroll
            for (int m = 0; m < 4; ++m) { const int row = row0 + ai * HALF + m * 16; const size_t off = (size_t)row * ldc + col0; float ss = 0.f;
#pragma unroll
                for (int bj = 0; bj < 2; ++bj) { const f32x4 b0 = *(const f32x4*)(base + off + bj * HALF), b1 = *(const f32x4*)(base + off + bj * HALF + 4);
                    const f32x4 v0 = acc[ai][bj][m][0] + b0, v1 = acc[ai][bj][m][1] + b1;
                    *(f32x4*)(out + off + bj * HALF) = v0; *(f32x4*)(out + off + bj * HALF + 4) = v1;
                    u32x4 w; w.x = cvt_pk_bf16(v0[0], v0[1]); w.y = cvt_pk_bf16(v0[2], v0[3]); w.z = cvt_pk_bf16(v1[0], v1[1]); w.w = cvt_pk_bf16(v1[2], v1[3]);
                    if (ob) *(u32x4*)(ob + off + bj * HALF) = w;
                    ss += (v0[0] * v0[0] + v0[1] * v0[1]) + (v0[2] * v0[2] + v0[3] * v0[3]) + (v1[0] * v1[0] + v1[1] * v1[1]) + (v1[2] * v1[2] + v1[3] * v1[3]); }
                ss += __shfl_xor(ss, 16); ss += __shfl_xor(ss, 32);
                if (fq == 0) part[(size_t)row * 16 + u.pn * 4 + wc] = ss; }
    }
};

template <class Epi, class Sched, bool ALIGN_EPI = false, bool SP2 = false>
__device__ __forceinline__ void gemm_phase(PG8_LAS unsigned char* lds, const Gemm g, const Sched& S, const Epi& E) {
    const int tid = threadIdx.x, wid = __builtin_amdgcn_readfirstlane(tid >> 6), lane = tid & 63, wr = wid >> 2, wc = wid & 3, fr = lane & 15, fq = lane >> 4;
    const int K = g.K, nt = K / BK;
    unsigned voffA[2], voffB[2];
#pragma unroll
    for (int i = 0; i < 2; ++i) { int R, C; stage_rc(tid * 16 + i * 8192, R, C); const int Rb = Epi::PERM ? ((R & ~31) + perm32(R & 31)) : R;
        voffA[i] = (unsigned)(R * K + C) * 2u; voffB[i] = (unsigned)(Rb * K + C) * 2u; }
    const size_t kstep = (size_t)(BK * 2);
    const size_t hstep = (size_t)HALF * K * 2;
    const size_t tstep = 2 * hstep;
    const unsigned ldsw = (unsigned)wid * 1024u;
    const int aoff = lds_byte(wr * 64 + fr, fq * 8), boff = lds_byte(wc * 32 + fr, fq * 8);
#define PG8_SA(b, h) (((b) * 2 + (h)) * HTB)
#define PG8_SB(b, h) ((4 + (b) * 2 + (h)) * HTB)
#define PG8_STAGE(bufoff, gbase, voff) do { _Pragma("unroll") for (int _i = 0; _i < 2; ++_i) \
        __builtin_amdgcn_global_load_lds((const unsigned*)((const char*)(gbase) + (voff)[_i]), (PG8_LAS unsigned*)(lds + (bufoff) + ldsw + _i * 8192), 16, 0, 0); } while (0)
#define PG8_LDA(dst, b, h) do { _Pragma("unroll") for (int m = 0; m < 4; ++m) _Pragma("unroll") for (int k = 0; k < 2; ++k) dst[m][k] = *(const PG8_LAS bf16x8*)(lds + PG8_SA(b, h) + aoff + m * 2048 + k * 1024); } while (0)
#define PG8_LDB(dst, b, h) do { _Pragma("unroll") for (int n = 0; n < 2; ++n) _Pragma("unroll") for (int k = 0; k < 2; ++k) dst[n][k] = *(const PG8_LAS bf16x8*)(lds + PG8_SB(b, h) + boff + n * 2048 + k * 1024); } while (0)
#define PG8_MMA(ai, bj, At, Bt) do { __builtin_amdgcn_s_setprio(1); _Pragma("unroll") for (int m = 0; m < 4; ++m) _Pragma("unroll") for (int n = 0; n < 2; ++n) _Pragma("unroll") for (int k = 0; k < 2; ++k) \
        acc[ai][bj][m][n] = __builtin_amdgcn_mfma_f32_16x16x32_bf16(Bt[n][k], At[m][k], acc[ai][bj][m][n], 0, 0, 0); __builtin_amdgcn_s_setprio(0); } while (0)
#define PG8_WAIT_V(n) asm volatile("s_waitcnt vmcnt(" #n ")" ::: "memory")
#define PG8_WAIT_L(n) asm volatile("s_waitcnt lgkmcnt(" #n ")" ::: "memory")
#define PG8_BAR __builtin_amdgcn_s_barrier()
#define PG8_SCHED __builtin_amdgcn_sched_barrier(0)
    Unit cur, nxt; int ui = 0;
    if (!S.next(0, cur)) return;
    f32x4 acc[2][2][4][2];
#pragma unroll
    for (int a = 0; a < 2; ++a)
#pragma unroll
        for (int b = 0; b < 2; ++b)
#pragma unroll
            for (int m = 0; m < 4; ++m)
#pragma unroll
                for (int n = 0; n < 2; ++n) acc[a][b][m][n] = (f32x4){0.f, 0.f, 0.f, 0.f};
    bf16x8 At[4][2], B0[2][2], B1[2][2];
    const char* cA = (const char*)g.A + (size_t)cur.pm * tstep; const char* cB = (const char*)g.Bt + (size_t)cur.pn * tstep;
    S.a_ready(cur);
    if constexpr (SP2) {
        PG8_STAGE(PG8_SB(0, 0), cB, voffB); PG8_STAGE(PG8_SB(0, 1), cB + hstep, voffB); PG8_STAGE(PG8_SA(0, 0), cA, voffA); PG8_STAGE(PG8_SA(0, 1), cA + hstep, voffA);
        if (wr == 1) PG8_BAR;
        PG8_WAIT_V(2); PG8_BAR;
        PG8_STAGE(PG8_SB(1, 0), cB + kstep, voffB); PG8_STAGE(PG8_SA(1, 0), cA + kstep, voffA); PG8_STAGE(PG8_SB(1, 1), cB + hstep + kstep, voffB);
        PG8_WAIT_V(6); PG8_BAR;
    } else {
        PG8_STAGE(PG8_SB(0, 0), cB, voffB); PG8_STAGE(PG8_SA(0, 0), cA, voffA); PG8_STAGE(PG8_SB(0, 1), cB + hstep, voffB); PG8_STAGE(PG8_SA(0, 1), cA + hstep, voffA);
        if (wr == 1) PG8_BAR;
        PG8_WAIT_V(4); PG8_BAR;
        PG8_STAGE(PG8_SB(1, 0), cB + kstep, voffB); PG8_STAGE(PG8_SA(1, 0), cA + kstep, voffA); PG8_STAGE(PG8_SB(1, 1), cB + hstep + kstep, voffB);
        PG8_WAIT_V(6); PG8_BAR;
    }
    for (;;) {
        const bool has_next = S.next(ui + 1, nxt);
        const char* nA = has_next ? (const char*)g.A + (size_t)nxt.pm * tstep : cA; const char* nB = has_next ? (const char*)g.Bt + (size_t)nxt.pn * tstep : cB;
        for (int t = 0; t < nt; t += 2) {
            const bool last = (t == nt - 2);
            const char* a1 = cA + (size_t)(t + 1) * kstep;
            const char* a2 = last ? nA : cA + (size_t)(t + 2) * kstep; const char* b2 = last ? nB : cB + (size_t)(t + 2) * kstep;
            const char* a3 = a2 + kstep; const char* b3 = b2 + kstep;
            if (last && has_next) S.a_ready(nxt);
            if constexpr (SP2) {
            PG8_LDB(B0, 0, 0); PG8_LDB(B1, 0, 1); PG8_SCHED; PG8_LDA(At, 0, 0); PG8_STAGE(PG8_SA(1, 1), a1 + hstep, voffA);
            PG8_WAIT_V(8); PG8_WAIT_L(0); PG8_BAR; PG8_MMA(0, 0, At, B0); PG8_MMA(0, 1, At, B1); PG8_BAR; PG8_SCHED;
            PG8_LDA(At, 0, 1); PG8_STAGE(PG8_SB(0, 0), b2, voffB); PG8_STAGE(PG8_SB(0, 1), b2 + hstep, voffB); PG8_STAGE(PG8_SA(0, 0), a2, voffA);
            PG8_WAIT_V(8); PG8_WAIT_L(0); PG8_BAR; PG8_MMA(1, 0, At, B0); PG8_MMA(1, 1, At, B1); PG8_BAR; PG8_SCHED;
            PG8_LDB(B0, 1, 0); PG8_LDB(B1, 1, 1); PG8_SCHED; PG8_LDA(At, 1, 0); PG8_STAGE(PG8_SA(0, 1), a2 + hstep, voffA);
            PG8_WAIT_V(8); PG8_WAIT_L(0); PG8_BAR; PG8_MMA(0, 0, At, B0); PG8_MMA(0, 1, At, B1); PG8_BAR; PG8_SCHED;
            PG8_LDA(At, 1, 1); PG8_STAGE(PG8_SB(1, 0), b3, voffB); PG8_STAGE(PG8_SB(1, 1), b3 + hstep, voffB); PG8_STAGE(PG8_SA(1, 0), a3, voffA);
            PG8_WAIT_V(8); PG8_WAIT_L(0); PG8_BAR; PG8_MMA(1, 0, At, B0); PG8_MMA(1, 1, At, B1); PG8_BAR; PG8_SCHED;
            } else {
            PG8_LDB(B0, 0, 0); PG8_SCHED; PG8_LDA(At, 0, 0); PG8_STAGE(PG8_SA(1, 1), a1 + hstep, voffA);
            PG8_WAIT_L(8); PG8_BAR; PG8_WAIT_L(0); PG8_MMA(0, 0, At, B0); PG8_BAR; PG8_SCHED;
            PG8_LDB(B1, 0, 1); PG8_STAGE(PG8_SB(0, 0), b2, voffB);
            PG8_BAR; PG8_WAIT_L(0); PG8_MMA(0, 1, At, B1); PG8_BAR;
            PG8_LDA(At, 0, 1); PG8_STAGE(PG8_SA(0, 0), a2, voffA);
            PG8_BAR; PG8_WAIT_L(0); PG8_MMA(1, 0, At, B0); PG8_BAR; PG8_SCHED;
            PG8_STAGE(PG8_SB(0, 1), b2 + hstep, voffB);
            PG8_WAIT_V(6); PG8_BAR; PG8_MMA(1, 1, At, B1); PG8_BAR;
            PG8_LDB(B0, 1, 0); PG8_SCHED; PG8_LDA(At, 1, 0); PG8_STAGE(PG8_SA(0, 1), a2 + hstep, voffA);
            PG8_WAIT_L(8); PG8_BAR; PG8_WAIT_L(0); PG8_MMA(0, 0, At, B0); PG8_BAR; PG8_SCHED;
            PG8_LDB(B1, 1, 1); PG8_STAGE(PG8_SB(1, 0), b3, voffB);
            PG8_BAR; PG8_WAIT_L(0); PG8_MMA(0, 1, At, B1); PG8_BAR;
            PG8_LDA(At, 1, 1); PG8_STAGE(PG8_SA(1, 0), a3, voffA);
            PG8_BAR; PG8_WAIT_L(0); PG8_MMA(1, 0, At, B0); PG8_BAR; PG8_SCHED;
            PG8_STAGE(PG8_SB(1, 1), b3 + hstep, voffB);
            PG8_WAIT_V(6); PG8_BAR; PG8_MMA(1, 1, At, B1); PG8_BAR;
            }
        }
        if constexpr (ALIGN_EPI) { if (wr == 0) PG8_BAR; }
        if constexpr (!Epi::AFTER_DRAIN) { E(acc, cur, wr, wc, fr, fq); S.done(cur); }
        if (!has_next) break;
#pragma unroll
        for (int a = 0; a < 2; ++a)
#pragma unroll
            for (int b = 0; b < 2; ++b)
#pragma unroll
                for (int m = 0; m < 4; ++m)
#pragma unroll
                    for (int n = 0; n < 2; ++n) acc[a][b][m][n] = (f32x4){0.f, 0.f, 0.f, 0.f};
        cur = nxt; cA = nA; cB = nB; ++ui;
        if constexpr (ALIGN_EPI) { if (wr == 1) PG8_BAR; }
    }
    PG8_WAIT_V(0);
    if constexpr (!ALIGN_EPI) { if (wr == 0) PG8_BAR; }
    PG8_BAR;
    if constexpr (Epi::AFTER_DRAIN) { E.fused(acc, cur, wr, wc, fr, fq, lds, wid, lane); S.done(cur); }
#undef PG8_SA
#undef PG8_SB
#undef PG8_STAGE
#undef PG8_LDA
#undef PG8_LDB
#undef PG8_MMA
#undef PG8_WAIT_V
#undef PG8_WAIT_L
#undef PG8_BAR
#undef PG8_SCHED
}
}
namespace att {
using bf16x8 = __attribute__((ext_vector_type(8))) short;
using s16x4 = __attribute__((ext_vector_type(4))) short;
using f32x16 = __attribute__((ext_vector_type(16))) float;
using u32x4 = __attribute__((ext_vector_type(4))) unsigned;
typedef unsigned short bf16_t;
#define ALAS __attribute__((address_space(3)))
constexpr int KSLOT = 8192, VSLOT = 8192;
constexpr int NSLOT = 6;
constexpr int L_K = 0, L_V = NSLOT * KSLOT, L_WS = L_V + NSLOT * VSLOT, L_RPB = L_WS + 8 * 64 * 4, L_OST = L_RPB + 2048, L_END = L_OST + 8 * 4096;
constexpr float THR = 8.f;
constexpr float LOG2E = 1.4426950408889634f;
struct Desc { const bf16_t *Q0, *Q1, *K0, *K1, *V; bf16_t* O; int q0p, q1p, k0p, k1p, vp, op; };
struct Next { const bf16_t *K0, *K1, *V; int k0p, k1p, vp; long rowbase; int tlo, thi, dqk; };

__device__ __forceinline__ int crow(int r, int hi) { return (r & 3) + 8 * (r >> 2) + 4 * hi; }
typedef float f32x2_t __attribute__((ext_vector_type(2))); typedef __bf16 bf16x2_t __attribute__((ext_vector_type(2)));
__device__ __forceinline__ unsigned cvtpk_s(float lo, float hi) { f32x2_t v = {lo, hi}; bf16x2_t b = __builtin_convertvector(v, bf16x2_t); return __builtin_bit_cast(unsigned, b); }
__device__ __forceinline__ float bf2f(short s) { return __uint_as_float(((unsigned)(unsigned short)s) << 16); }
typedef short v4i16_t __attribute__((ext_vector_type(4)));
__device__ __forceinline__ s16x4 vtr(const ALAS unsigned char* p) { return __builtin_bit_cast(s16x4, __builtin_amdgcn_ds_read_tr16_b64_v4i16((ALAS v4i16_t*)p)); }
__device__ __forceinline__ void dma16(const void* g, ALAS unsigned char* l) { unsigned keep; const unsigned dst = (unsigned)__builtin_amdgcn_readfirstlane((int)(unsigned)(uintptr_t)l);
    asm volatile("s_mov_b32 %0, m0\n\ts_mov_b32 m0, %2\n\ts_nop 0\n\tglobal_load_lds_dwordx4 %1, off\n\ts_mov_b32 m0, %0" : "=&s"(keep) : "v"(g), "s"(dst) : "memory"); }
__device__ __forceinline__ float xhalf_max(float m) { auto rr = __builtin_amdgcn_permlane32_swap(__float_as_uint(m), __float_as_uint(m), false, false); return fmaxf(__uint_as_float(rr[0]), __uint_as_float(rr[1])); }
__device__ __forceinline__ float xhalf_sum(float m) { auto rr = __builtin_amdgcn_permlane32_swap(__float_as_uint(m), __float_as_uint(m), false, false); return __uint_as_float(rr[0]) + __uint_as_float(rr[1]); }
__device__ __forceinline__ void sincos_acc(float x, float& s, float& c) {
    const float k = rintf(x * 0.6366197723675814f);
    float r = fmaf(-k, 1.5707962513e+00f, x); r = fmaf(-k, 7.5497894159e-08f, r); r = fmaf(-k, 5.3903029534e-15f, r);
    const int q = ((int)k) & 3; const float r2 = r * r;
    const float sp = r + r * r2 * (-1.6666654611e-1f + r2 * (8.3321608736e-3f + r2 * (-1.9515295891e-4f)));
    const float cp = 1.f + r2 * (-0.5f + r2 * (4.166664568298827e-2f + r2 * (-1.388731625493765e-3f + r2 * 2.443315711809948e-5f)));
    const float s0 = (q & 1) ? cp : sp, c0 = (q & 1) ? sp : cp;
    s = (q & 2) ? -s0 : s0; c = ((q + 1) & 2) ? -c0 : c0;
}

template <int DQK, int MODE, int HALF = -1>
__device__ __forceinline__ void unit(const Desc& d, long rowbase, int q0, int tlo, int thi, const float* rpb_h, ALAS unsigned char* shm, bool pre, bool has_next, const Next& nx) {
    constexpr int ND = DQK / 16;
#define N0(r) ((HALF != 1) || (r) >= 12)
#define N1(r) ((HALF != 0) || (r) < 4)
#define NKG(kg) ((kg) == 0 ? (HALF != 1) : (kg) == 3 ? (HALF != 0) : true)
    const int tid = threadIdx.x, lane = tid & 63, r32 = lane & 31, hi = lane >> 5;
    const int wid = __builtin_amdgcn_readfirstlane(tid >> 6);
    ALAS float* wsf = (ALAS float*)(shm + L_WS) + wid * 64;
    ALAS float* rpbs = (ALAS float*)(shm + L_RPB);
    const bf16_t* ksrc0 = d.K0 + (rowbase + lane) * (long)d.k0p + wid * 8;
    const bf16_t* ksrc1 = d.K1 + (rowbase + lane) * (long)d.k1p + (wid & 3) * 8;
    const bf16_t* vsrc = d.V + (rowbase + 16 * (wid & 3) + (lane >> 2)) * (long)d.vp + (wid >> 2) * 32 + (lane & 3) * 8;
#define ATT_ISSUE_K(t, koff) do { \
        dma16(ksrc0 + (long)(t) * 64 * d.k0p, shm + L_K + (koff) + wid * 1024); \
        if (DQK == 96) { dma16(ksrc1 + (long)(t) * 64 * d.k1p, shm + L_K + (koff) + (8 + (wid & 3)) * 1024); } } while (0)
#define ATT_ISSUE_V(t, voff) dma16(vsrc + (long)(t) * 64 * d.vp, shm + L_V + (voff) + wid * 1024)
#define ATT_WAITBAR() asm volatile("s_waitcnt vmcnt(0) lgkmcnt(0)\n\ts_barrier" ::: "memory")
    if (!pre) {
    ATT_ISSUE_K(tlo, 0); ATT_ISSUE_V(tlo, 0);
#pragma unroll
    for (int i = 1; i < 5; ++i) if (tlo + i <= thi) { ATT_ISSUE_K(tlo + i, i * KSLOT); ATT_ISSUE_V(tlo + i, i * VSLOT); }
    }
    const int tq = q0 + wid * 32 + r32;
    if (MODE == 1) { for (int i = tid; i < 15 * 32; i += 512) { const int dr = i >> 5, j = i & 31; rpbs[i] = (j < 31) ? rpb_h[dr * 31 + j] * LOG2E : -INFINITY; } }
    bf16x8 qr[ND];
    { const bf16_t* qp = d.Q0 + (rowbase + tq) * (long)d.q0p + hi * 8;
#pragma unroll
      for (int d0 = 0; d0 < 4; ++d0) qr[d0] = *(const bf16x8*)(qp + d0 * 16); }
    if constexpr (DQK == 96) {
        const bf16_t* qp = d.Q1 + (rowbase + tq) * (long)d.q1p + hi * 8;
#pragma unroll
        for (int dd = 0; dd < 2; ++dd) {
            const bf16x8 raw = *(const bf16x8*)(qp + dd * 16); const u32x4 w = __builtin_bit_cast(u32x4, raw); u32x4 pw;
#pragma unroll
            for (int j = 0; j < 4; ++j) pw[j] = (unsigned)__shfl_xor((int)w[j], 32);
            const bf16x8 par = __builtin_bit_cast(bf16x8, pw);
            const float pos = (dd == 0) ? (float)(tq >> 6) : (float)(tq & 63);
            float ov[8];
#pragma unroll
            for (int e = 0; e < 8; ++e) { const float inv = exp2f(-(float)e * (13.287712379549449f / 8.0f)); float s, c; sincos_acc(pos * inv, s, c);
                const float x = bf2f(raw[e]), y = bf2f(par[e]); ov[e] = hi == 0 ? x * c - y * s : x * c + y * s; }
            u32x4 o4; o4.x = cvtpk_s(ov[0], ov[1]); o4.y = cvtpk_s(ov[2], ov[3]); o4.z = cvtpk_s(ov[4], ov[5]); o4.w = cvtpk_s(ov[6], ov[7]);
            qr[4 + dd] = __builtin_bit_cast(bf16x8, o4);
        }
    }
    float mhat = 0.f, l_reg = 0.f; f32x16 o[2]; o[0] = f32x16{}; o[1] = f32x16{}; f32x16 negm = f32x16{};
    bool first = true;
    const int qrow = tq >> 6, qc = tq & 63;
    const int wrow = __builtin_amdgcn_readfirstlane(qrow);
    const int rs = min(max(wrow - 4, 0), 120);
    const int cs = min(max(qc - 8, 0), 48);
    unsigned co[32];
    if (MODE == 1) {
#pragma unroll
        for (int r = 0; r < 16; ++r) { const int kc = crow(r, hi), kc1 = kc + 32;
            co[r] = (((unsigned)(kc - cs) < 16u) ? (unsigned)(kc - qc + 15) : 31u) * 4u; co[16 + r] = (((unsigned)(kc1 - cs) < 16u) ? (unsigned)(kc1 - qc + 15) : 31u) * 4u; }
    }
    const unsigned tb_addr = (unsigned)(uintptr_t)(shm + L_RPB);
#define ATT_KRD(KOFF) do { const ALAS unsigned char* ka_ = shm + L_K + (KOFF) + hi * 1024 + r32 * 16; \
        _Pragma("unroll") for (int d0 = 0; d0 < ND; ++d0) { kf[2 * d0] = *(const ALAS bf16x8*)(ka_ + d0 * 2048); kf[2 * d0 + 1] = *(const ALAS bf16x8*)(ka_ + d0 * 2048 + 512); } } while (0)
#define ATT_QK2(P0, P1, d0) do { if ((d0) == 0) { P0 = __builtin_amdgcn_mfma_f32_32x32x16_bf16(kf[0], qr[0], negm, 0, 0, 0); P1 = __builtin_amdgcn_mfma_f32_32x32x16_bf16(kf[1], qr[0], negm, 0, 0, 0); } \
            else { P0 = __builtin_amdgcn_mfma_f32_32x32x16_bf16(kf[2 * (d0)], qr[d0], P0, 0, 0, 0); P1 = __builtin_amdgcn_mfma_f32_32x32x16_bf16(kf[2 * (d0) + 1], qr[d0], P1, 0, 0, 0); } } while (0)
#define ATT_QKM(P0, P1) do { _Pragma("unroll") for (int d0 = 0; d0 < ND; ++d0) ATT_QK2(P0, P1, d0); } while (0)
#define ATT_VRD(VOFF) do { const ALAS unsigned char* va_ = shm + L_V + (VOFF) + ((lane >> 4) & 1) * 32 + (lane & 3) * 8 + (4 * hi + ((lane & 15) >> 2)) * 64; \
        _Pragma("unroll") for (int kg = 0; kg < 4; ++kg) _Pragma("unroll") for (int dh = 0; dh < 2; ++dh) if (NKG(kg)) { \
            vf[(kg * 2 + dh) * 2] = vtr(va_ + dh * 4096 + kg * 1024); vf[(kg * 2 + dh) * 2 + 1] = vtr(va_ + dh * 4096 + kg * 1024 + 512); } } while (0)
#define ATT_VWAIT() do {} while (0)
#define ATT_VF(kg, dh) ((bf16x8){vf[((kg) * 2 + (dh)) * 2][0], vf[((kg) * 2 + (dh)) * 2][1], vf[((kg) * 2 + (dh)) * 2][2], vf[((kg) * 2 + (dh)) * 2][3], vf[((kg) * 2 + (dh)) * 2 + 1][0], vf[((kg) * 2 + (dh)) * 2 + 1][1], vf[((kg) * 2 + (dh)) * 2 + 1][2], vf[((kg) * 2 + (dh)) * 2 + 1][3]})
#define ATT_ACTIVE(t) ((MODE == 0) || ((t) >= rs && (t) <= rs + 7))
    const unsigned kaddr0 = (unsigned)(uintptr_t)(shm + L_K) + hi * 1024 + r32 * 16;
    const unsigned vaddr0 = (unsigned)(uintptr_t)(shm + L_V) + ((lane >> 4) & 1) * 32 + (lane & 3) * 8 + (4 * hi + ((lane & 15) >> 2)) * 64;
    bf16x8 kf[2 * ND]; s16x4 vf[16];
    f32x16 p0 = f32x16{}, p1 = f32x16{};
    u32x4 pw[4] = {};
#define ATT_KEEP_PV() do { asm volatile("" :: "v"(pw[0]), "v"(pw[1]), "v"(pw[2]), "v"(pw[3])); \
        asm volatile("" :: "v"(vf[0]), "v"(vf[1]), "v"(vf[2]), "v"(vf[3]), "v"(vf[4]), "v"(vf[5]), "v"(vf[6]), "v"(vf[7]), "v"(vf[8]), "v"(vf[9]), "v"(vf[10]), "v"(vf[11]), "v"(vf[12]), "v"(vf[13]), "v"(vf[14]), "v"(vf[15])); } while (0)
#define ATT_KEEP_K() do { if constexpr (ND == 4) asm volatile("" :: "v"(kf[0]), "v"(kf[1]), "v"(kf[2]), "v"(kf[3]), "v"(kf[4]), "v"(kf[5]), "v"(kf[6]), "v"(kf[7])); \
        else asm volatile("" :: "v"(kf[0]), "v"(kf[1]), "v"(kf[2]), "v"(kf[3]), "v"(kf[4]), "v"(kf[5]), "v"(kf[6]), "v"(kf[7]), "v"(kf[8 % (2 * ND)]), "v"(kf[9 % (2 * ND)]), "v"(kf[10 % (2 * ND)]), "v"(kf[11 % (2 * ND)])); } while (0)
    ATT_WAITBAR();
    static_assert(MODE == 1, "this unit is the neighbourhood one: step j of a wave = its j-th window row");
    int islot = 5;
    for (int j = 0; j < 8; ++j) {
        const int t = rs + j;
        const int rel = t - tlo; const int buf = rel >= 6 ? rel - 6 : rel;
        const bool issued = tlo + j + 5 <= thi;
        if (issued) { ATT_ISSUE_K(tlo + j + 5, islot * KSLOT); ATT_ISSUE_V(tlo + j + 5, islot * VSLOT); }
        islot = (islot == 5) ? 0 : islot + 1;
        const bool act = true;
        if (act) { ATT_KRD(buf * KSLOT); ATT_QKM(p0, p1); if (MODE == 0) ATT_VRD(buf * VSLOT); }
        __builtin_amdgcn_sched_barrier(0);
        if (act) {
            if (MODE == 1) {
                float bb[32];
                const ALAS unsigned char* rb = shm + L_RPB + (t - wrow + 7) * 128;
#pragma unroll
                for (int e = 0; e < 16; ++e) { bb[e] = N0(e) ? *(const ALAS float*)(rb + co[e]) : 0.f; bb[16 + e] = N1(e) ? *(const ALAS float*)(rb + co[16 + e]) : 0.f; }
#pragma unroll
                for (int e = 0; e < 16; ++e) { if (N0(e)) p0[e] += bb[e]; if (N1(e)) p1[e] += bb[16 + e]; }
                ATT_VRD(buf * VSLOT);
            }
            float rm0 = -INFINITY, rm1 = -INFINITY;
#pragma unroll
            for (int r = 0; r < 16; r += 2) { if (N0(r)) rm0 = fmaxf(fmaxf(rm0, p0[r]), p0[r + 1]); if (N1(r)) rm1 = fmaxf(fmaxf(rm1, p1[r]), p1[r + 1]); }
            float rm = fmaxf(rm0, rm1);
            rm = xhalf_max(rm);
            if (first || __any(rm > THR)) {
                const float dl = first ? rm : fmaxf(rm, 0.f);
                mhat += dl;
#pragma unroll
                for (int r = 0; r < 16; ++r) { if (N0(r)) p0[r] -= dl; if (N1(r)) p1[r] -= dl; negm[r] = -mhat; }
                if (!first) { const float f = exp2f(-dl); l_reg *= f; if (hi == 0) wsf[r32] = f;
#pragma unroll
                    for (int r = 0; r < 16; ++r) { const float fr_ = wsf[crow(r, hi)]; o[0][r] *= fr_; o[1][r] *= fr_; } }
                first = false;
            }
            float sa0 = 0.f, sa1 = 0.f, sa2 = 0.f, sa3 = 0.f;
#pragma unroll
            for (int r = 0; r < 16; r += 4) { if (N0(r)) { p0[r] = __builtin_amdgcn_exp2f(p0[r]); p0[r + 1] = __builtin_amdgcn_exp2f(p0[r + 1]); p0[r + 2] = __builtin_amdgcn_exp2f(p0[r + 2]); p0[r + 3] = __builtin_amdgcn_exp2f(p0[r + 3]);
                sa0 += p0[r]; sa1 += p0[r + 1]; sa2 += p0[r + 2]; sa3 += p0[r + 3]; } else { p0[r] = 0.f; p0[r + 1] = 0.f; p0[r + 2] = 0.f; p0[r + 3] = 0.f; } }
#pragma unroll
            for (int j = 0; j < 4; ++j) { pw[0][j] = cvtpk_s(p0[2 * j], p0[2 * j + 1]); pw[1][j] = cvtpk_s(p0[8 + 2 * j], p0[8 + 2 * j + 1]); }
            ATT_VWAIT();
#pragma unroll
            for (int kg = 0; kg < 2; ++kg)
#pragma unroll
                for (int dh = 0; dh < 2; ++dh) if (NKG(kg)) o[dh] = __builtin_amdgcn_mfma_f32_32x32x16_bf16(__builtin_bit_cast(bf16x8, pw[kg]), ATT_VF(kg, dh), o[dh], 0, 0, 0);
            __builtin_amdgcn_sched_barrier(0);
#pragma unroll
            for (int r = 0; r < 16; r += 4) { if (N1(r)) { p1[r] = __builtin_amdgcn_exp2f(p1[r]); p1[r + 1] = __builtin_amdgcn_exp2f(p1[r + 1]); p1[r + 2] = __builtin_amdgcn_exp2f(p1[r + 2]); p1[r + 3] = __builtin_amdgcn_exp2f(p1[r + 3]);
                sa0 += p1[r]; sa1 += p1[r + 1]; sa2 += p1[r + 2]; sa3 += p1[r + 3]; } else { p1[r] = 0.f; p1[r + 1] = 0.f; p1[r + 2] = 0.f; p1[r + 3] = 0.f; } }
            l_reg += (sa0 + sa1) + (sa2 + sa3);
#pragma unroll
            for (int j = 0; j < 4; ++j) { pw[2][j] = cvtpk_s(p1[2 * j], p1[2 * j + 1]); pw[3][j] = cvtpk_s(p1[8 + 2 * j], p1[8 + 2 * j + 1]); }
#pragma unroll
            for (int kg = 2; kg < 4; ++kg)
#pragma unroll
                for (int dh = 0; dh < 2; ++dh) if (NKG(kg)) o[dh] = __builtin_amdgcn_mfma_f32_32x32x16_bf16(__builtin_bit_cast(bf16x8, pw[kg]), ATT_VF(kg, dh), o[dh], 0, 0, 0);
        }
        if (issued) asm volatile("s_waitcnt vmcnt(2) lgkmcnt(0)\n\ts_barrier" ::: "memory");
        else ATT_WAITBAR();
    }
#undef ATT_KEEP_PV
#undef ATT_KEEP_K
#undef ATT_KRD
#undef ATT_QK2
#undef ATT_QKM
#undef ATT_VRD
#undef ATT_VWAIT
#undef ATT_VF
#undef ATT_QK
#undef ATT_ACTIVE
#undef N0
#undef N1
#undef NKG
    if (has_next) {
        const bf16_t* nk0 = nx.K0 + (nx.rowbase + lane) * (long)nx.k0p + wid * 8;
        const bf16_t* nk1 = nx.K1 + (nx.rowbase + lane) * (long)nx.k1p + (wid & 3) * 8;
        const bf16_t* nv = nx.V + (nx.rowbase + 16 * (wid & 3) + (lane >> 2)) * (long)nx.vp + (wid >> 2) * 32 + (lane & 3) * 8;
#pragma unroll
        for (int i = 0; i < 5; ++i) if (nx.tlo + i <= nx.thi) {
            dma16(nk0 + (long)(nx.tlo + i) * 64 * nx.k0p, shm + L_K + i * KSLOT + wid * 1024);
            if (nx.dqk == 96) dma16(nk1 + (long)(nx.tlo + i) * 64 * nx.k1p, shm + L_K + i * KSLOT + (8 + (wid & 3)) * 1024);
            dma16(nv + (long)(nx.tlo + i) * 64 * nx.vp, shm + L_V + i * VSLOT + wid * 1024); }
    }
    l_reg = xhalf_sum(l_reg);
    if (hi == 0) wsf[32 + r32] = l_reg;
    float rli[16];
#pragma unroll
    for (int r = 0; r < 16; ++r) rli[r] = 1.0f / wsf[32 + crow(r, hi)];
    bf16_t* Ow = d.O + (rowbase + q0 + wid * 32) * (long)d.op;
    { ALAS bf16_t* stg = (ALAS bf16_t*)(shm + L_OST) + wid * 2048;
#pragma unroll
      for (int r = 0; r < 16; ++r) { const int orow = crow(r, hi);
#pragma unroll
          for (int dh = 0; dh < 2; ++dh) stg[orow * 64 + dh * 32 + r32] = (bf16_t)(cvtpk_s(o[dh][r] * rli[r], 0.f) & 0xffffu); }
      asm volatile("s_waitcnt lgkmcnt(0)" ::: "memory");
#pragma unroll
      for (int i = 0; i < 4; ++i) { const int row = i * 8 + (lane >> 3), ch = lane & 7; const u32x4 v = *(const ALAS u32x4*)(stg + row * 64 + ch * 8); *(u32x4*)(Ow + (long)row * d.op + ch * 8) = v; } }
    asm volatile("s_waitcnt lgkmcnt(0)\n\ts_barrier" ::: "memory");
#undef ATT_ISSUE_K
#undef ATT_ISSUE_V
#undef ATT_WAITBAR
}
}

namespace attn_ex {
using bf16=__hip_bfloat16;
using bf16x8=__attribute__((ext_vector_type(8)))short;
using s16x4=__attribute__((ext_vector_type(4)))short;
using f32x16=__attribute__((ext_vector_type(16)))float;
using u32x4=__attribute__((ext_vector_type(4)))unsigned;
constexpr int SEQ=8192,D=64;
constexpr int NW=8,QBLK=32,QB=QBLK*NW,KVBLK=64,NQB=SEQ/QB;
constexpr int ATTN_UNIT_ROWS=QB;
__device__ __forceinline__ int crow(int r,int hi){return (r&3)+8*(r>>2)+4*hi;}
#define SBAR() __builtin_amdgcn_sched_barrier(0)
__device__ __forceinline__ void cmask(f32x16&p0,f32x16&p1,int jb,int qrel,int hi){
  const float NEG=-INFINITY; int kb=64*jb+4*hi;
  #pragma unroll
  for(int r=0;r<16;++r){int kv=kb+(r&3)+8*(r>>2); if(kv>qrel)p0[r]=NEG; if(kv+32>qrel)p1[r]=NEG;}
}

constexpr int NSLOT=3, SLOTB=8192;
constexpr int LDS_K=0, LDS_V=NSLOT*SLOTB, LDS_WS=2*NSLOT*SLOTB, LDS_OST=LDS_WS+NW*64*4, LDS_BYTES=LDS_OST+NW*4096;
constexpr float C2=0.125f*1.4426950408889634f;
__device__ __forceinline__ void glds16(const void*gsrc,unsigned lds_dst){unsigned keep;
  asm volatile("s_mov_b32 %0, m0\n\ts_mov_b32 m0, %2\n\ts_nop 0\n\tglobal_load_lds_dwordx4 %1, off\n\ts_mov_b32 m0, %0":"=&s"(keep):"v"(gsrc),"s"(lds_dst):"memory");}
__device__ __forceinline__ float max3f(float a,float b,float c){float r;asm("v_max3_f32 %0, %1, %2, %3":"=v"(r):"v"(a),"v"(b),"v"(c));return r;}
__device__ __forceinline__ float max2f(float a,float b){float r;asm("v_max_f32_e32 %0, %1, %2":"=v"(r):"v"(a),"v"(b));return r;}
__device__ __forceinline__ float fadd_s(float a,float b){float r;asm("v_add_f32_e32 %0, %1, %2":"=v"(r):"v"(a),"v"(b));return r;}
__device__ __forceinline__ float fsub_s(float a,float b){float r;asm("v_sub_f32_e32 %0, %1, %2":"=v"(r):"v"(a),"v"(b));return r;}
typedef float f32x2_t __attribute__((ext_vector_type(2))); typedef __bf16 bf16x2_t __attribute__((ext_vector_type(2)));
__device__ __forceinline__ unsigned cvtpk_s(float lo,float hi){f32x2_t v={lo,hi};bf16x2_t b=__builtin_convertvector(v,bf16x2_t);return __builtin_bit_cast(unsigned,b);}
#define WAIT_BAR(N) asm volatile("s_waitcnt vmcnt(" #N ") lgkmcnt(0)\n\ts_barrier":::"memory")

__device__ __forceinline__ void qkt(f32x16&p0,f32x16&p1,const char*Kslot,const bf16x8*qr,const f32x16&negm,int r32,int hi){
  const char*kb=Kslot+hi*1024+r32*16;
  #pragma unroll
  for(int d0=0;d0<4;++d0){
    const bf16x8 b0=*reinterpret_cast<const bf16x8*>(kb+d0*2048);
    const bf16x8 b1=*reinterpret_cast<const bf16x8*>(kb+d0*2048+512);
    if(d0==0){p0=__builtin_amdgcn_mfma_f32_32x32x16_bf16(b0,qr[0],negm,0,0,0);p1=__builtin_amdgcn_mfma_f32_32x32x16_bf16(b1,qr[0],negm,0,0,0);}
    else{p0=__builtin_amdgcn_mfma_f32_32x32x16_bf16(b0,qr[d0],p0,0,0,0);p1=__builtin_amdgcn_mfma_f32_32x32x16_bf16(b1,qr[d0],p1,0,0,0);}}
}
typedef __attribute__((address_space(3))) const char* lds_cptr;
typedef short v4i16_t __attribute__((ext_vector_type(4)));
__device__ __forceinline__ void kload8(bf16x8*kf,lds_cptr kp){
  kf[0]=*(const __attribute__((address_space(3))) bf16x8*)(kp);      kf[1]=*(const __attribute__((address_space(3))) bf16x8*)(kp+512);
  kf[2]=*(const __attribute__((address_space(3))) bf16x8*)(kp+2048); kf[3]=*(const __attribute__((address_space(3))) bf16x8*)(kp+2560);
  kf[4]=*(const __attribute__((address_space(3))) bf16x8*)(kp+4096); kf[5]=*(const __attribute__((address_space(3))) bf16x8*)(kp+4608);
  kf[6]=*(const __attribute__((address_space(3))) bf16x8*)(kp+6144); kf[7]=*(const __attribute__((address_space(3))) bf16x8*)(kp+6656);
}
__device__ __forceinline__ void kload2(bf16x8*kf,lds_cptr kp,int j){ kf[2*j]=*(const __attribute__((address_space(3))) bf16x8*)(kp+j*2048); kf[2*j+1]=*(const __attribute__((address_space(3))) bf16x8*)(kp+j*2048+512); }
__device__ __forceinline__ s16x4 vtr(lds_cptr p){ return __builtin_bit_cast(s16x4,__builtin_amdgcn_ds_read_tr16_b64_v4i16((__attribute__((address_space(3))) v4i16_t*)p)); }
__device__ __forceinline__ float rowmax(const f32x16&p0,const f32x16&p1){
  float a=max3f(p0[0],p0[1],p1[0]),b=max3f(p0[2],p0[3],p1[1]);a=max3f(a,p1[2],p1[3]);
  #pragma unroll
  for(int r=4;r<16;r+=4){a=max3f(a,p0[r],p0[r+1]);b=max3f(b,p0[r+2],p0[r+3]);a=max3f(a,p1[r],p1[r+1]);b=max3f(b,p1[r+2],p1[r+3]);}
  const float m=max2f(a,b);
  auto rr=__builtin_amdgcn_permlane32_swap(__float_as_uint(m),__float_as_uint(m),false,false);
  return max2f(__uint_as_float(rr[0]),__uint_as_float(rr[1]));
}
__device__ __forceinline__ void pv(f32x16*o,int vb,bf16x8 pa0,bf16x8 pa1,bf16x8 pa2,bf16x8 pa3){
  #pragma unroll
  for(int d0=0;d0<2;++d0){s16x4 lo[4],hi[4];
    #pragma unroll
    for(int ks=0;ks<4;++ks){
      asm volatile("ds_read_b64_tr_b16 %0,%1 offset:%c2":"=&v"(lo[ks]):"v"(vb),"i"(d0*4096+ks*1024):"memory");
      asm volatile("ds_read_b64_tr_b16 %0,%1 offset:%c2":"=&v"(hi[ks]):"v"(vb),"i"(d0*4096+ks*1024+512):"memory");}
    asm volatile("s_waitcnt lgkmcnt(0)":::"memory");SBAR();
    #define PK(k) (bf16x8){lo[k][0],lo[k][1],lo[k][2],lo[k][3],hi[k][0],hi[k][1],hi[k][2],hi[k][3]}
    o[d0]=__builtin_amdgcn_mfma_f32_32x32x16_bf16(pa0,PK(0),o[d0],0,0,0);
    o[d0]=__builtin_amdgcn_mfma_f32_32x32x16_bf16(pa1,PK(1),o[d0],0,0,0);
    o[d0]=__builtin_amdgcn_mfma_f32_32x32x16_bf16(pa2,PK(2),o[d0],0,0,0);
    o[d0]=__builtin_amdgcn_mfma_f32_32x32x16_bf16(pa3,PK(3),o[d0],0,0,0);
    #undef PK
  }
}

#ifndef ATTN_STORE16
#define ATTN_STORE16(p,v) (*(u32x4*)(p)=(v))
#endif
template<int THRL,int QP,int KP,int VP,int OP> __device__ __forceinline__ void attn_unit(const bf16*Qb,const bf16*__restrict__ Kh,const bf16*__restrict__ Vh,bf16*Ob,char*shm){
  const int tid=threadIdx.x,lane=tid&63,r32=lane&31,hi=lane>>5; const int wid=__builtin_amdgcn_readfirstlane(tid>>6);
  const bf16*Qw=Qb+(long)(wid*QBLK)*QP;
  const unsigned lds0=(unsigned)(uintptr_t)shm;
  float*wsf=(float*)(shm+LDS_WS)+wid*64;
  const bf16*ksrc=Kh+(long)lane*KP+wid*8;
  const bf16*vsrc=Vh+(long)(16*(wid&3)+(lane>>2))*VP+(wid>>2)*32+(lane&3)*8;
  const unsigned kdst=lds0+LDS_K+wid*1024, vdst=lds0+LDS_V+wid*1024;
  #define DMA_K(t,slot) glds16(ksrc+(long)(t)*KVBLK*KP,(unsigned)__builtin_amdgcn_readfirstlane(kdst+(slot)))
  #define DMA_V(t,slot) glds16(vsrc+(long)(t)*KVBLK*VP,(unsigned)__builtin_amdgcn_readfirstlane(vdst+(slot)))
  const int vb0=(int)(lds0+LDS_V)+((lane>>4)&1)*32+(lane&3)*8+(4*hi+((lane&15)>>2))*64;
  const char*Kbase=shm+LDS_K; bf16x8 kf[8];
  const lds_cptr shm3=(lds_cptr)shm; const lds_cptr kp0=shm3+LDS_K+hi*1024+r32*16; const lds_cptr vp0=shm3+LDS_V+((lane>>4)&1)*32+(lane&3)*8+(4*hi+((lane&15)>>2))*64;
  constexpr int NT=SEQ/KVBLK;
  DMA_K(0,0);DMA_V(0,0);DMA_K(1,SLOTB);
  bf16x8 qr[4];
  #pragma unroll
  for(int d0=0;d0<4;++d0)qr[d0]=*reinterpret_cast<const bf16x8*>(&Qw[(long)r32*QP+d0*16+hi*8]);
  float mhat=0.f,l_reg=0.f;f32x16 o[2];o[0]=f32x16{};o[1]=f32x16{};f32x16 negm=f32x16{};asm volatile("":"+v"(negm));
  #define CMASK(P0,P1,t) do{}while(0)
  bool resc=false;
  #define START(P0,P1) do{ const float rm=rowmax(P0,P1); resc=false; \
    { const float dl=rm; mhat=fadd_s(mhat,dl); \
      _Pragma("unroll") for(int r=0;r<16;++r){P0[r]=fsub_s(P0[r],dl);P1[r]=fsub_s(P1[r],dl);} \
      _Pragma("unroll") for(int r=0;r<16;++r)negm[r]=-mhat; asm volatile("":"+v"(negm)); } \
    _Pragma("unroll") for(int r=0;r<16;++r)P0[r]=__builtin_amdgcn_exp2f(P0[r]); }while(0)
  #define RESC() do{ if(resc){ asm volatile("s_waitcnt lgkmcnt(0)":::"memory"); \
      _Pragma("unroll") for(int d_=0;d_<2;++d_) _Pragma("unroll") for(int r=0;r<16;++r)o[d_][r]*=wsf[crow(r,hi)]; } }while(0)
  f32x16 pA0,pA1,pB0,pB1;
  int sl_prev=0,sl_cur=0,sl_next=SLOTB;
  #define ROT() do{sl_prev=sl_cur;sl_cur=sl_next;sl_next=(sl_next==(NSLOT-1)*SLOTB)?0:sl_next+SLOTB;}while(0)
  DMA_K(2,2*SLOTB);
  WAIT_BAR(3);
  qkt(pA0,pA1,Kbase,qr,negm,r32,hi);asm volatile("s_nop 15\n\ts_nop 7":"+v"(pA0),"+v"(pA1));CMASK(pA0,pA1,0);
  START(pA0,pA1);
  _Pragma("unroll") for(int r=0;r<16;++r)pA1[r]=__builtin_amdgcn_exp2f(pA1[r]);
  WAIT_BAR(0);
  DMA_K(3,0);DMA_V(1,SLOTB);
  ROT();
  kload8(kf,kp0+sl_cur);
  WAIT_BAR(2);
  s16x4 vlo[8],vhi[8]; u32x4 pw0,pw1,pw2,pw3;
  #define PKW(P,B) cvtpk_s(P[B],P[B+1])
  #define PAF(k) __builtin_bit_cast(bf16x8,pw##k)
  #define VFR(i) (bf16x8){vlo[i][0],vlo[i][1],vlo[i][2],vlo[i][3],vhi[i][0],vhi[i][1],vhi[i][2],vhi[i][3]}
  #define PIN(x) asm volatile("":"+v"(x))
  #define MX3(a,b,c) __builtin_fmaxf(__builtin_fmaxf((a),(b)),(c))
  #define GAPA(MF,A0,A1,A2,A3,W0,W1,PW) do{ MF; sacc+=A0; sacc+=A1; sacc+=A2; sacc+=A3; PIN(sacc); W0; W1; PIN(PW); SBAR(); }while(0)
  #define EX(v) __builtin_amdgcn_exp2f(v)
  #define GAPB(MF,X,B) do{ MF; X[B]=EX(X[B]); X[B+1]=EX(X[B+1]); X[B+2]=EX(X[B+2]); X[B+3]=EX(X[B+3]); PIN(X); SBAR(); }while(0)
  #define VRD(i) do{ vlo[i]=vtr(vp_+(((i)>>2)*4096+((i)&3)*1024)); vhi[i]=vtr(vp_+(((i)>>2)*4096+((i)&3)*1024+512)); }while(0)
  #define KRD(G,j) do{ if(G){ kload2(kf,kp0+sl_next,j); SBAR(); } }while(0)
  #define STEP(C0,C1,P0,P1,t,GK,GV,GL) do{ SBAR(); \
    const lds_cptr vp_=vp0+sl_prev; \
    VRD(0); SBAR(); float sacc=(P0[0]+P0[1]); \
    GAPA(C0=__builtin_amdgcn_mfma_f32_32x32x16_bf16(kf[0],qr[0],negm,0,0,0), P0[2],P0[3],P0[4],P0[5],     pw0[0]=PKW(P0,0), pw0[1]=PKW(P0,2), pw0); \
    VRD(4); SBAR(); GAPA(C1=__builtin_amdgcn_mfma_f32_32x32x16_bf16(kf[1],qr[0],negm,0,0,0), P0[6],P0[7],P0[8],P0[9],     pw0[2]=PKW(P0,4), pw0[3]=PKW(P0,6), pw0); \
    VRD(1); SBAR(); GAPA(C0=__builtin_amdgcn_mfma_f32_32x32x16_bf16(kf[2],qr[1],C0,0,0,0),   P0[10],P0[11],P0[12],P0[13], pw1[0]=PKW(P0,8), pw1[1]=PKW(P0,10), pw1); \
    VRD(5); SBAR(); GAPA(C1=__builtin_amdgcn_mfma_f32_32x32x16_bf16(kf[3],qr[1],C1,0,0,0),   P0[14],P0[15],P1[0],P1[1],   pw1[2]=PKW(P0,12),pw1[3]=PKW(P0,14), pw1); \
    VRD(2); SBAR(); GAPA(C0=__builtin_amdgcn_mfma_f32_32x32x16_bf16(kf[4],qr[2],C0,0,0,0),   P1[2],P1[3],P1[4],P1[5],     pw2[0]=PKW(P1,0), pw2[1]=PKW(P1,2), pw2); \
    VRD(6); SBAR(); GAPA(C1=__builtin_amdgcn_mfma_f32_32x32x16_bf16(kf[5],qr[2],C1,0,0,0),   P1[6],P1[7],P1[8],P1[9],     pw2[2]=PKW(P1,4), pw2[3]=PKW(P1,6), pw2); \
    VRD(3); SBAR(); GAPA(C0=__builtin_amdgcn_mfma_f32_32x32x16_bf16(kf[6],qr[3],C0,0,0,0),   P1[10],P1[11],P1[12],P1[13], pw3[0]=PKW(P1,8), pw3[1]=PKW(P1,10), pw3); \
    VRD(7); SBAR(); GAPA(C1=__builtin_amdgcn_mfma_f32_32x32x16_bf16(kf[7],qr[3],C1,0,0,0),   P1[14],P1[15],0.f,0.f,       pw3[2]=PKW(P1,12),pw3[3]=PKW(P1,14), pw3); \
    l_reg+=sacc; \
    if(GK){DMA_K((t)+3,sl_cur);} if(GV){DMA_V((t)+1,sl_next);} \
    CMASK(C0,C1,t); \
    { float a=MX3(C0[0],C0[1],C1[0]),b=MX3(C0[2],C0[3],C1[1]); a=MX3(a,C1[2],C1[3]); \
      _Pragma("unroll") for(int r=4;r<16;r+=4){a=MX3(a,C0[r],C0[r+1]);b=MX3(b,C0[r+2],C0[r+3]);a=MX3(a,C1[r],C1[r+1]);b=MX3(b,C1[r+2],C1[r+3]);} \
      float rm=__builtin_fmaxf(a,b); { auto rr=__builtin_amdgcn_permlane32_swap(__float_as_uint(rm),__float_as_uint(rm),false,false); rm=__builtin_fmaxf(__uint_as_float(rr[0]),__uint_as_float(rr[1])); } \
      resc=false; \
      if(__builtin_expect(__any(rm>(float)THRL),0)){ const float dl=__builtin_fmaxf(rm,0.f); mhat+=dl; \
        _Pragma("unroll") for(int r=0;r<16;++r){C0[r]-=dl;C1[r]-=dl;} \
        _Pragma("unroll") for(int r=0;r<16;++r)negm[r]=-mhat; asm volatile("":"+v"(negm)); \
        const float f=__builtin_amdgcn_exp2f(-dl); l_reg*=f; if(hi==0)wsf[r32]=f; resc=true; } } \
    SBAR(); \
    GAPB(o[0]=__builtin_amdgcn_mfma_f32_32x32x16_bf16(PAF(0),VFR(0),o[0],0,0,0), C0,0); \
    GAPB(o[1]=__builtin_amdgcn_mfma_f32_32x32x16_bf16(PAF(0),VFR(4),o[1],0,0,0), C0,4); \
    KRD(GL,0); GAPB(o[0]=__builtin_amdgcn_mfma_f32_32x32x16_bf16(PAF(1),VFR(1),o[0],0,0,0), C0,8); \
    KRD(GL,1); GAPB(o[1]=__builtin_amdgcn_mfma_f32_32x32x16_bf16(PAF(1),VFR(5),o[1],0,0,0), C0,12); \
    KRD(GL,2); GAPB(o[0]=__builtin_amdgcn_mfma_f32_32x32x16_bf16(PAF(2),VFR(2),o[0],0,0,0), C1,0); \
    KRD(GL,3); GAPB(o[1]=__builtin_amdgcn_mfma_f32_32x32x16_bf16(PAF(2),VFR(6),o[1],0,0,0), C1,4); \
    GAPB(o[0]=__builtin_amdgcn_mfma_f32_32x32x16_bf16(PAF(3),VFR(3),o[0],0,0,0), C1,8); \
    GAPB(o[1]=__builtin_amdgcn_mfma_f32_32x32x16_bf16(PAF(3),VFR(7),o[1],0,0,0), C1,12); \
    }while(0)
  int t=1;
  #undef CMASK
  #define CMASK(P0,P1,t) do{}while(0)
  for(;t+5<NT;t+=2){
    STEP(pB0,pB1,pA0,pA1,t,true,true,true);     WAIT_BAR(2); RESC(); ROT();
    STEP(pA0,pA1,pB0,pB1,t+1,true,true,true);   WAIT_BAR(2); RESC(); ROT();
  }
  #undef CMASK
  #define CMASK(P0,P1,t) do{}while(0)
  #define ENDW(tt) do{ if((tt)+3<NT){WAIT_BAR(2);} else if((tt)+2<NT){WAIT_BAR(1);} else {WAIT_BAR(0);} }while(0)
  for(;t+1<NT;t+=2){
    STEP(pB0,pB1,pA0,pA1,t,(t+3<NT),(t+1<NT),(t+1<NT));       ENDW(t);   RESC(); ROT();
    STEP(pA0,pA1,pB0,pB1,t+1,(t+4<NT),(t+2<NT),(t+2<NT));     ENDW(t+1); RESC(); ROT();
  }
  STEP(pB0,pB1,pA0,pA1,NT-1,false,false,false); RESC();
  { float sacc=pB0[0]+pB0[1]; _Pragma("unroll") for(int r=2;r<16;++r)sacc+=pB0[r]; _Pragma("unroll") for(int r=0;r<16;++r)sacc+=pB1[r]; l_reg+=sacc;
    pw0=(u32x4){PKW(pB0,0),PKW(pB0,2),PKW(pB0,4),PKW(pB0,6)};pw1=(u32x4){PKW(pB0,8),PKW(pB0,10),PKW(pB0,12),PKW(pB0,14)};pw2=(u32x4){PKW(pB1,0),PKW(pB1,2),PKW(pB1,4),PKW(pB1,6)};pw3=(u32x4){PKW(pB1,8),PKW(pB1,10),PKW(pB1,12),PKW(pB1,14)};
    SBAR(); pv(o,vb0+sl_cur,PAF(0),PAF(1),PAF(2),PAF(3)); }
  #undef PKW
  #undef PAF
  #undef VFR
  #undef PIN
  #undef MX3
  #undef GAPA
  #undef GAPB
  #undef EX
  #undef VRD
  #undef KRD
  #undef STEP
  #undef ENDW
  {auto rr=__builtin_amdgcn_permlane32_swap(__float_as_uint(l_reg),__float_as_uint(l_reg),false,false);l_reg=__uint_as_float(rr[0])+__uint_as_float(rr[1]);}
  if(hi==0)wsf[32+r32]=l_reg;asm volatile("s_waitcnt lgkmcnt(0)":::"memory");
  float rli[16];
  #pragma unroll
  for(int r=0;r<16;++r)rli[r]=__builtin_amdgcn_rcpf(wsf[32+crow(r,hi)]);
  bf16*Ow=Ob+(long)(wid*QBLK)*OP;
  { bf16*stg=(bf16*)(shm+LDS_OST)+wid*2048;
    #pragma unroll
    for(int r=0;r<16;++r){const int orow=crow(r,hi);
      #pragma unroll
      for(int d0=0;d0<2;++d0)stg[orow*64+d0*32+r32]=__float2bfloat16(o[d0][r]*rli[r]);}
    asm volatile("s_waitcnt lgkmcnt(0)":::"memory");
    #pragma unroll
    for(int i=0;i<4;++i){const int row=i*8+(lane>>3),ch=lane&7; const u32x4 v=*(const u32x4*)(stg+row*64+ch*8); ATTN_STORE16(Ow+(long)row*OP+ch*8,v);} }
  asm volatile("s_waitcnt lgkmcnt(0)\n\ts_barrier":::"memory");
  #undef DMA_K
  #undef DMA_V
  #undef CMASK
  #undef START
  #undef RESC
  #undef ROT
}
constexpr int ATTN_LDS_BYTES=LDS_BYTES;
#undef SBAR
#undef WAIT_BAR
}

namespace attn_ex96 {
using bf16=__hip_bfloat16;
using bf16x8=__attribute__((ext_vector_type(8)))short;
using s16x4=__attribute__((ext_vector_type(4)))short;
using f32x16=__attribute__((ext_vector_type(16)))float;
using u32x4=__attribute__((ext_vector_type(4)))unsigned;
constexpr int SEQ=8192,D=64;
constexpr int NW=8,QBLK=32,QB=QBLK*NW,KVBLK=64,NQB=SEQ/QB;
constexpr int ATTN_UNIT_ROWS=QB;
__device__ __forceinline__ int crow(int r,int hi){return (r&3)+8*(r>>2)+4*hi;}
#define SBAR() __builtin_amdgcn_sched_barrier(0)
__device__ __forceinline__ void cmask(f32x16&p0,f32x16&p1,int jb,int qrel,int hi){
  const float NEG=-INFINITY; int kb=64*jb+4*hi;
  #pragma unroll
  for(int r=0;r<16;++r){int kv=kb+(r&3)+8*(r>>2); if(kv>qrel)p0[r]=NEG; if(kv+32>qrel)p1[r]=NEG;}
}

constexpr int NSLOT=3, SLOTB=12288;
constexpr int LDS_K=0, LDS_V=NSLOT*SLOTB, LDS_WS=2*NSLOT*SLOTB, LDS_OST=LDS_WS+NW*64*4, LDS_BYTES=LDS_OST+NW*4096;
constexpr float C2=0.125f*1.4426950408889634f;
__device__ __forceinline__ void glds16(const void*gsrc,unsigned lds_dst){unsigned keep;
  asm volatile("s_mov_b32 %0, m0\n\ts_mov_b32 m0, %2\n\ts_nop 0\n\tglobal_load_lds_dwordx4 %1, off\n\ts_mov_b32 m0, %0":"=&s"(keep):"v"(gsrc),"s"(lds_dst):"memory");}
__device__ __forceinline__ float max3f(float a,float b,float c){float r;asm("v_max3_f32 %0, %1, %2, %3":"=v"(r):"v"(a),"v"(b),"v"(c));return r;}
__device__ __forceinline__ float max2f(float a,float b){float r;asm("v_max_f32_e32 %0, %1, %2":"=v"(r):"v"(a),"v"(b));return r;}
__device__ __forceinline__ float fadd_s(float a,float b){float r;asm("v_add_f32_e32 %0, %1, %2":"=v"(r):"v"(a),"v"(b));return r;}
__device__ __forceinline__ float fsub_s(float a,float b){float r;asm("v_sub_f32_e32 %0, %1, %2":"=v"(r):"v"(a),"v"(b));return r;}
typedef float f32x2_t __attribute__((ext_vector_type(2))); typedef __bf16 bf16x2_t __attribute__((ext_vector_type(2)));
__device__ __forceinline__ unsigned cvtpk_s(float lo,float hi){f32x2_t v={lo,hi};bf16x2_t b=__builtin_convertvector(v,bf16x2_t);return __builtin_bit_cast(unsigned,b);}
#define WAIT_BAR(N) asm volatile("s_waitcnt vmcnt(" #N ") lgkmcnt(0)\n\ts_barrier":::"memory")

__device__ __forceinline__ void qkt(f32x16&p0,f32x16&p1,const char*Kslot,const bf16x8*qr,int r32,int hi){ const f32x16 zero=f32x16{};
  const char*kb=Kslot+hi*1024+r32*16;
  #pragma unroll
  for(int d0=0;d0<6;++d0){
    const bf16x8 b0=*reinterpret_cast<const bf16x8*>(kb+d0*2048);
    const bf16x8 b1=*reinterpret_cast<const bf16x8*>(kb+d0*2048+512);
    if(d0==0){p0=__builtin_amdgcn_mfma_f32_32x32x16_bf16(b0,qr[0],zero,0,0,0);p1=__builtin_amdgcn_mfma_f32_32x32x16_bf16(b1,qr[0],zero,0,0,0);}
    else{p0=__builtin_amdgcn_mfma_f32_32x32x16_bf16(b0,qr[d0],p0,0,0,0);p1=__builtin_amdgcn_mfma_f32_32x32x16_bf16(b1,qr[d0],p1,0,0,0);}}
}
typedef __attribute__((address_space(3))) const char* lds_cptr;
typedef short v4i16_t __attribute__((ext_vector_type(4)));
__device__ __forceinline__ void kload8(bf16x8*kf,lds_cptr kp){
  kf[0]=*(const __attribute__((address_space(3))) bf16x8*)(kp);      kf[1]=*(const __attribute__((address_space(3))) bf16x8*)(kp+512);
  kf[2]=*(const __attribute__((address_space(3))) bf16x8*)(kp+2048); kf[3]=*(const __attribute__((address_space(3))) bf16x8*)(kp+2560);
  kf[4]=*(const __attribute__((address_space(3))) bf16x8*)(kp+4096); kf[5]=*(const __attribute__((address_space(3))) bf16x8*)(kp+4608);
  kf[6]=*(const __attribute__((address_space(3))) bf16x8*)(kp+6144); kf[7]=*(const __attribute__((address_space(3))) bf16x8*)(kp+6656);
}
__device__ __forceinline__ void kload2(bf16x8*kf,lds_cptr kp,int j){ kf[2*j]=*(const __attribute__((address_space(3))) bf16x8*)(kp+j*2048); kf[2*j+1]=*(const __attribute__((address_space(3))) bf16x8*)(kp+j*2048+512); }
__device__ __forceinline__ s16x4 vtr(lds_cptr p){ return __builtin_bit_cast(s16x4,__builtin_amdgcn_ds_read_tr16_b64_v4i16((__attribute__((address_space(3))) v4i16_t*)p)); }
__device__ __forceinline__ float rowmax(const f32x16&p0,const f32x16&p1){
  float a=max3f(p0[0],p0[1],p1[0]),b=max3f(p0[2],p0[3],p1[1]);a=max3f(a,p1[2],p1[3]);
  #pragma unroll
  for(int r=4;r<16;r+=4){a=max3f(a,p0[r],p0[r+1]);b=max3f(b,p0[r+2],p0[r+3]);a=max3f(a,p1[r],p1[r+1]);b=max3f(b,p1[r+2],p1[r+3]);}
  const float m=max2f(a,b);
  auto rr=__builtin_amdgcn_permlane32_swap(__float_as_uint(m),__float_as_uint(m),false,false);
  return max2f(__uint_as_float(rr[0]),__uint_as_float(rr[1]));
}
__device__ __forceinline__ void pv(f32x16*o,int vb,bf16x8 pa0,bf16x8 pa1,bf16x8 pa2,bf16x8 pa3){
  #pragma unroll
  for(int d0=0;d0<2;++d0){s16x4 lo[4],hi[4];
    #pragma unroll
    for(int ks=0;ks<4;++ks){
      asm volatile("ds_read_b64_tr_b16 %0,%1 offset:%c2":"=&v"(lo[ks]):"v"(vb),"i"(d0*4096+ks*1024):"memory");
      asm volatile("ds_read_b64_tr_b16 %0,%1 offset:%c2":"=&v"(hi[ks]):"v"(vb),"i"(d0*4096+ks*1024+512):"memory");}
    asm volatile("s_waitcnt lgkmcnt(0)":::"memory");SBAR();
    #define PK(k) (bf16x8){lo[k][0],lo[k][1],lo[k][2],lo[k][3],hi[k][0],hi[k][1],hi[k][2],hi[k][3]}
    o[d0]=__builtin_amdgcn_mfma_f32_32x32x16_bf16(pa0,PK(0),o[d0],0,0,0);
    o[d0]=__builtin_amdgcn_mfma_f32_32x32x16_bf16(pa1,PK(1),o[d0],0,0,0);
    o[d0]=__builtin_amdgcn_mfma_f32_32x32x16_bf16(pa2,PK(2),o[d0],0,0,0);
    o[d0]=__builtin_amdgcn_mfma_f32_32x32x16_bf16(pa3,PK(3),o[d0],0,0,0);
    #undef PK
  }
}

#ifndef ATTN_STORE16
#define ATTN_STORE16(p,v) (*(u32x4*)(p)=(v))
#endif
template<int THRL,int QP,int KP,int VP,int OP> __device__ __forceinline__ void attn_unit(const bf16*Qb,const bf16*Qr,const bf16*__restrict__ Kh,const bf16*__restrict__ Kr,const bf16*__restrict__ Vh,bf16*Ob,int tq0,char*shm){
  const int tid=threadIdx.x,lane=tid&63,r32=lane&31,hi=lane>>5; const int wid=__builtin_amdgcn_readfirstlane(tid>>6);
  const bf16*Qw=Qb+(long)(wid*QBLK)*QP;
  const unsigned lds0=(unsigned)(uintptr_t)shm;
  float*wsf=(float*)(shm+LDS_WS)+wid*64;
  const bf16*ksrc=Kh+(long)lane*KP+wid*8; const bf16*rsrc=Kr+(long)lane*32+(wid&3)*8;
  const bf16*vsrc=Vh+(long)(16*(wid&3)+(lane>>2))*VP+(wid>>2)*32+(lane&3)*8;
  const unsigned kdst=lds0+LDS_K+wid*1024, vdst=lds0+LDS_V+wid*1024;
  #define DMA_KN(t,slot) glds16(ksrc+(long)(t)*KVBLK*KP,(unsigned)__builtin_amdgcn_readfirstlane(kdst+(slot)))
  #define DMA_R(t,slot) glds16(rsrc+(long)(t)*KVBLK*32,(unsigned)__builtin_amdgcn_readfirstlane(lds0+LDS_K+(8+(wid&3))*1024+(slot)))
  #define DMA_K(t,slot) do{ DMA_KN(t,slot); DMA_R(t,slot); }while(0)
  #define DMA_V(t,slot) glds16(vsrc+(long)(t)*KVBLK*VP,(unsigned)__builtin_amdgcn_readfirstlane(vdst+(slot)))
  const int vb0=(int)(lds0+LDS_V)+((lane>>4)&1)*32+(lane&3)*8+(4*hi+((lane&15)>>2))*64;
  const char*Kbase=shm+LDS_K; bf16x8 kf[8];
  const lds_cptr shm3=(lds_cptr)shm; const lds_cptr kp0=shm3+LDS_K+hi*1024+r32*16; const lds_cptr vp0=shm3+LDS_V+((lane>>4)&1)*32+(lane&3)*8+(4*hi+((lane&15)>>2))*64;
  constexpr int NT=SEQ/KVBLK;
  DMA_K(0,0);DMA_V(0,0);DMA_K(1,SLOTB);
  bf16x8 qr[6];
  #pragma unroll
  for(int d0=0;d0<4;++d0)qr[d0]=*reinterpret_cast<const bf16x8*>(&Qw[(long)r32*QP+d0*16+hi*8]);
  { const int tq=tq0+wid*QBLK+r32; const bf16*qp=Qr+(long)(wid*QBLK+r32)*QP+hi*8;
    #pragma unroll
    for(int dd=0;dd<2;++dd){ const bf16x8 raw=*reinterpret_cast<const bf16x8*>(qp+dd*16); const u32x4 w=__builtin_bit_cast(u32x4,raw); u32x4 pwx;
      #pragma unroll
      for(int j=0;j<4;++j)pwx[j]=(unsigned)__shfl_xor((int)w[j],32);
      const bf16x8 par=__builtin_bit_cast(bf16x8,pwx); const float pos=(dd==0)?(float)(tq>>6):(float)(tq&63); float ov[8];
      #pragma unroll
      for(int e=0;e<8;++e){ const float inv=exp2f(-(float)e*(13.287712379549449f/8.0f)); float s,c; att::sincos_acc(pos*inv,s,c);
        const float x=att::bf2f(raw[e]),y=att::bf2f(par[e]); ov[e]=hi==0?x*c-y*s:x*c+y*s; }
      u32x4 o4; o4.x=cvtpk_s(ov[0],ov[1]); o4.y=cvtpk_s(ov[2],ov[3]); o4.z=cvtpk_s(ov[4],ov[5]); o4.w=cvtpk_s(ov[6],ov[7]); qr[4+dd]=__builtin_bit_cast(bf16x8,o4); } }
  float mhat=0.f,l_reg=0.f;f32x16 o[2];o[0]=f32x16{};o[1]=f32x16{};const f32x16 zero=f32x16{};
  #define CMASK(P0,P1,t) do{}while(0)
  bool resc=false;
  #define START(P0,P1) do{ const float rm=rowmax(P0,P1); resc=false; \
    { const float dl=rm; mhat=fadd_s(mhat,dl); \
      _Pragma("unroll") for(int r=0;r<16;++r){P0[r]=fsub_s(P0[r],dl);P1[r]=fsub_s(P1[r],dl);} \
      } \
    _Pragma("unroll") for(int r=0;r<16;++r)P0[r]=__builtin_amdgcn_exp2f(P0[r]); }while(0)
  #define RESC() do{ if(resc){ asm volatile("s_waitcnt lgkmcnt(0)":::"memory"); \
      _Pragma("unroll") for(int d_=0;d_<2;++d_) _Pragma("unroll") for(int r=0;r<16;++r)o[d_][r]*=wsf[crow(r,hi)]; } }while(0)
  f32x16 pA0,pA1,pB0,pB1;
  int sl_prev=0,sl_cur=0,sl_next=SLOTB;
  #define ROT() do{sl_prev=sl_cur;sl_cur=sl_next;sl_next=(sl_next==(NSLOT-1)*SLOTB)?0:sl_next+SLOTB;}while(0)
  DMA_K(2,2*SLOTB);
  WAIT_BAR(3);
  qkt(pA0,pA1,Kbase,qr,r32,hi);asm volatile("s_nop 15\n\ts_nop 7":"+v"(pA0),"+v"(pA1));CMASK(pA0,pA1,0);
  START(pA0,pA1);
  _Pragma("unroll") for(int r=0;r<16;++r)pA1[r]=__builtin_amdgcn_exp2f(pA1[r]);
  WAIT_BAR(0);
  DMA_KN(3,0);DMA_V(1,SLOTB);
  ROT();
  kload8(kf,kp0+sl_cur);
  WAIT_BAR(2);
  s16x4 vlo[8],vhi[8]; u32x4 pw0,pw1,pw2,pw3;
  #define PKW(P,B) cvtpk_s(P[B],P[B+1])
  #define PAF(k) __builtin_bit_cast(bf16x8,pw##k)
  #define VFR(i) (bf16x8){vlo[i][0],vlo[i][1],vlo[i][2],vlo[i][3],vhi[i][0],vhi[i][1],vhi[i][2],vhi[i][3]}
  #define PIN(x) asm volatile("":"+v"(x))
  #define MX3(a,b,c) __builtin_fmaxf(__builtin_fmaxf((a),(b)),(c))
  #define GAPA(MF,A0,A1,A2,A3,W0,W1,PW) do{ MF; sacc+=A0; sacc+=A1; sacc+=A2; sacc+=A3; PIN(sacc); W0; W1; PIN(PW); SBAR(); }while(0)
  #define EX(v) __builtin_amdgcn_exp2f(v)
  #define GAPB(MF,X,B) do{ MF; X[B]=EX(X[B]); X[B+1]=EX(X[B+1]); X[B+2]=EX(X[B+2]); X[B+3]=EX(X[B+3]); PIN(X); SBAR(); }while(0)
  #define VRD(i) do{ vlo[i]=vtr(vp_+(((i)>>2)*4096+((i)&3)*1024)); vhi[i]=vtr(vp_+(((i)>>2)*4096+((i)&3)*1024+512)); }while(0)
  #define KRD(G,j) do{ if(G){ kload2(kf,kp0+sl_next,j); SBAR(); } }while(0)
  #define STEP(C0,C1,P0,P1,t,GK,GV,GL) do{ SBAR(); \
    const lds_cptr vp_=vp0+sl_prev; \
    VRD(0); SBAR(); float sacc=(P0[0]+P0[1]); \
    GAPA(C0=__builtin_amdgcn_mfma_f32_32x32x16_bf16(kf[0],qr[0],zero,0,0,0), P0[2],P0[3],P0[4],P0[5],     pw0[0]=PKW(P0,0), pw0[1]=PKW(P0,2), pw0); \
    VRD(4); SBAR(); GAPA(C1=__builtin_amdgcn_mfma_f32_32x32x16_bf16(kf[1],qr[0],zero,0,0,0), P0[6],P0[7],P0[8],P0[9],     pw0[2]=PKW(P0,4), pw0[3]=PKW(P0,6), pw0); \
    VRD(1); SBAR(); GAPA(C0=__builtin_amdgcn_mfma_f32_32x32x16_bf16(kf[2],qr[1],C0,0,0,0),   P0[10],P0[11],P0[12],P0[13], pw1[0]=PKW(P0,8), pw1[1]=PKW(P0,10), pw1); \
    VRD(5); SBAR(); GAPA(C1=__builtin_amdgcn_mfma_f32_32x32x16_bf16(kf[3],qr[1],C1,0,0,0),   P0[14],P0[15],P1[0],P1[1],   pw1[2]=PKW(P0,12),pw1[3]=PKW(P0,14), pw1); \
    VRD(2); SBAR(); GAPA(C0=__builtin_amdgcn_mfma_f32_32x32x16_bf16(kf[4],qr[2],C0,0,0,0),   P1[2],P1[3],P1[4],P1[5],     pw2[0]=PKW(P1,0), pw2[1]=PKW(P1,2), pw2); \
    VRD(6); SBAR(); GAPA(C1=__builtin_amdgcn_mfma_f32_32x32x16_bf16(kf[5],qr[2],C1,0,0,0),   P1[6],P1[7],P1[8],P1[9],     pw2[2]=PKW(P1,4), pw2[3]=PKW(P1,6), pw2); \
    VRD(3); SBAR(); GAPA(C0=__builtin_amdgcn_mfma_f32_32x32x16_bf16(kf[6],qr[3],C0,0,0,0),   P1[10],P1[11],P1[12],P1[13], pw3[0]=PKW(P1,8), pw3[1]=PKW(P1,10), pw3); \
    VRD(7); SBAR(); GAPA(C1=__builtin_amdgcn_mfma_f32_32x32x16_bf16(kf[7],qr[3],C1,0,0,0),   P1[14],P1[15],0.f,0.f,       pw3[2]=PKW(P1,12),pw3[3]=PKW(P1,14), pw3); \
    l_reg+=sacc; \
    { const lds_cptr rp_=kp0+sl_cur+8192; \
      const bf16x8 r0_=*(const __attribute__((address_space(3))) bf16x8*)(rp_), r1_=*(const __attribute__((address_space(3))) bf16x8*)(rp_+512), r2_=*(const __attribute__((address_space(3))) bf16x8*)(rp_+2048), r3_=*(const __attribute__((address_space(3))) bf16x8*)(rp_+2560); \
      C0=__builtin_amdgcn_mfma_f32_32x32x16_bf16(r0_,qr[4],C0,0,0,0); C1=__builtin_amdgcn_mfma_f32_32x32x16_bf16(r1_,qr[4],C1,0,0,0); \
      C0=__builtin_amdgcn_mfma_f32_32x32x16_bf16(r2_,qr[5],C0,0,0,0); C1=__builtin_amdgcn_mfma_f32_32x32x16_bf16(r3_,qr[5],C1,0,0,0); \
      _Pragma("unroll") for(int r=0;r<16;++r){C0[r]-=mhat;C1[r]-=mhat;} } \
    SBAR(); \
    if(GK){DMA_KN((t)+3,sl_cur);} if(GV){DMA_V((t)+1,sl_next);} \
    CMASK(C0,C1,t); \
    { float a=MX3(C0[0],C0[1],C1[0]),b=MX3(C0[2],C0[3],C1[1]); a=MX3(a,C1[2],C1[3]); \
      _Pragma("unroll") for(int r=4;r<16;r+=4){a=MX3(a,C0[r],C0[r+1]);b=MX3(b,C0[r+2],C0[r+3]);a=MX3(a,C1[r],C1[r+1]);b=MX3(b,C1[r+2],C1[r+3]);} \
      float rm=__builtin_fmaxf(a,b); { auto rr=__builtin_amdgcn_permlane32_swap(__float_as_uint(rm),__float_as_uint(rm),false,false); rm=__builtin_fmaxf(__uint_as_float(rr[0]),__uint_as_float(rr[1])); } \
      resc=false; \
      if(__builtin_expect(__any(rm>(float)THRL),0)){ const float dl=__builtin_fmaxf(rm,0.f); mhat+=dl; \
        _Pragma("unroll") for(int r=0;r<16;++r){C0[r]-=dl;C1[r]-=dl;} \
        const float f=__builtin_amdgcn_exp2f(-dl); l_reg*=f; if(hi==0)wsf[r32]=f; resc=true; } } \
    SBAR(); \
    GAPB(o[0]=__builtin_amdgcn_mfma_f32_32x32x16_bf16(PAF(0),VFR(0),o[0],0,0,0), C0,0); \
    GAPB(o[1]=__builtin_amdgcn_mfma_f32_32x32x16_bf16(PAF(0),VFR(4),o[1],0,0,0), C0,4); \
    KRD(GL,0); GAPB(o[0]=__builtin_amdgcn_mfma_f32_32x32x16_bf16(PAF(1),VFR(1),o[0],0,0,0), C0,8); \
    KRD(GL,1); GAPB(o[1]=__builtin_amdgcn_mfma_f32_32x32x16_bf16(PAF(1),VFR(5),o[1],0,0,0), C0,12); \
    KRD(GL,2); GAPB(o[0]=__builtin_amdgcn_mfma_f32_32x32x16_bf16(PAF(2),VFR(2),o[0],0,0,0), C1,0); \
    KRD(GL,3); GAPB(o[1]=__builtin_amdgcn_mfma_f32_32x32x16_bf16(PAF(2),VFR(6),o[1],0,0,0), C1,4); \
    GAPB(o[0]=__builtin_amdgcn_mfma_f32_32x32x16_bf16(PAF(3),VFR(3),o[0],0,0,0), C1,8); \
    GAPB(o[1]=__builtin_amdgcn_mfma_f32_32x32x16_bf16(PAF(3),VFR(7),o[1],0,0,0), C1,12); \
    }while(0)
  int t=1;
  #undef CMASK
  #define CMASK(P0,P1,t) do{}while(0)
  for(;t+5<NT;t+=2){
    DMA_R(t+2,sl_prev); STEP(pB0,pB1,pA0,pA1,t,true,true,true);     WAIT_BAR(3); RESC(); ROT();
    DMA_R(t+3,sl_prev); STEP(pA0,pA1,pB0,pB1,t+1,true,true,true);   WAIT_BAR(3); RESC(); ROT();
  }
  #undef CMASK
  #define CMASK(P0,P1,t) do{}while(0)
  #define ENDW(tt) do{ if((tt)+3<NT){WAIT_BAR(3);} else if((tt)+2<NT){WAIT_BAR(1);} else {WAIT_BAR(0);} }while(0)
  for(;t+1<NT;t+=2){
    if(t+2<NT){DMA_R(t+2,sl_prev);} STEP(pB0,pB1,pA0,pA1,t,(t+3<NT),(t+1<NT),(t+1<NT));       ENDW(t);   RESC(); ROT();
    if(t+3<NT){DMA_R(t+3,sl_prev);} STEP(pA0,pA1,pB0,pB1,t+1,(t+4<NT),(t+2<NT),(t+2<NT));     ENDW(t+1); RESC(); ROT();
  }
  STEP(pB0,pB1,pA0,pA1,NT-1,false,false,false); RESC();
  { float sacc=pB0[0]+pB0[1]; _Pragma("unroll") for(int r=2;r<16;++r)sacc+=pB0[r]; _Pragma("unroll") for(int r=0;r<16;++r)sacc+=pB1[r]; l_reg+=sacc;
    pw0=(u32x4){PKW(pB0,0),PKW(pB0,2),PKW(pB0,4),PKW(pB0,6)};pw1=(u32x4){PKW(pB0,8),PKW(pB0,10),PKW(pB0,12),PKW(pB0,14)};pw2=(u32x4){PKW(pB1,0),PKW(pB1,2),PKW(pB1,4),PKW(pB1,6)};pw3=(u32x4){PKW(pB1,8),PKW(pB1,10),PKW(pB1,12),PKW(pB1,14)};
    SBAR(); pv(o,vb0+sl_cur,PAF(0),PAF(1),PAF(2),PAF(3)); }
  #undef PKW
  #undef PAF
  #undef VFR
  #undef PIN
  #undef MX3
  #undef GAPA
  #undef GAPB
  #undef EX
  #undef VRD
  #undef KRD
  #undef STEP
  #undef ENDW
  {auto rr=__builtin_amdgcn_permlane32_swap(__float_as_uint(l_reg),__float_as_uint(l_reg),false,false);l_reg=__uint_as_float(rr[0])+__uint_as_float(rr[1]);}
  if(hi==0)wsf[32+r32]=l_reg;asm volatile("s_waitcnt lgkmcnt(0)":::"memory");
  float rli[16];
  #pragma unroll
  for(int r=0;r<16;++r)rli[r]=__builtin_amdgcn_rcpf(wsf[32+crow(r,hi)]);
  bf16*Ow=Ob+(long)(wid*QBLK)*OP;
  { bf16*stg=(bf16*)(shm+LDS_OST)+wid*2048;
    #pragma unroll
    for(int r=0;r<16;++r){const int orow=crow(r,hi);
      #pragma unroll
      for(int d0=0;d0<2;++d0)stg[orow*64+d0*32+r32]=__float2bfloat16(o[d0][r]*rli[r]);}
    asm volatile("s_waitcnt lgkmcnt(0)":::"memory");
    #pragma unroll
    for(int i=0;i<4;++i){const int row=i*8+(lane>>3),ch=lane&7; const u32x4 v=*(const u32x4*)(stg+row*64+ch*8); ATTN_STORE16(Ow+(long)row*OP+ch*8,v);} }
  asm volatile("s_waitcnt lgkmcnt(0)\n\ts_barrier":::"memory");
  #undef DMA_K
  #undef DMA_KN
  #undef DMA_R
  #undef DMA_V
  #undef CMASK
  #undef START
  #undef RESC
  #undef ROT
}
constexpr int ATTN_LDS_BYTES=LDS_BYTES;
#undef SBAR
#undef WAIT_BAR
}

constexpr int NWAVES = 8;
constexpr int M = 32768, D = 1024, SEQ = 8192, NB = 4, FF = 4096, NIN = 1440, NINP = 1536;
constexpr size_t MiB = 1u << 20;
constexpr size_t WS_PART = 2 * MiB;
constexpr size_t WS_WIN = 18 * MiB, WS_WUQ = 21 * MiB, WS_WUKV = 22 * MiB, WS_WO0 = 23 * MiB, WS_WUP0 = 25 * MiB, WS_WDN0 = 33 * MiB;
constexpr size_t WS_WQKV = 41 * MiB, WS_WO1 = 47 * MiB, WS_WUP1 = 49 * MiB, WS_WDN1 = 57 * MiB;
constexpr size_t WS_HB = 66 * MiB;
constexpr size_t WS_U = 130 * MiB;
constexpr size_t WS_Z = 130 * MiB, WS_MIX = 130 * MiB, WS_QA = 226 * MiB, WS_KA = 258 * MiB, WS_VA = 266 * MiB, WS_CQ = 274 * MiB, WS_CKV = 298 * MiB, WS_KR = 314 * MiB, WS_QB = 316 * MiB, WS_KVB = 386 * MiB;
constexpr size_t WS_QKV = 130 * MiB, WS_O1 = 322 * MiB;
constexpr size_t WS_END = 450 * MiB;
constexpr int LDS_BYTES = 143360;
static_assert(att::L_END <= 139264, "attention LDS");

#define LAS __attribute__((address_space(3)))
typedef unsigned short bf16;
typedef unsigned v4u __attribute__((ext_vector_type(4)));
typedef float f32x4 __attribute__((ext_vector_type(4)));
#define LDS_WAIT() asm volatile("s_waitcnt lgkmcnt(0)" ::: "memory")

__device__ __forceinline__ float wave_sum(float v) {
#pragma unroll
    for (int o = 1; o < 64; o <<= 1) v += __shfl_xor(v, o);
    return v;
}
__device__ __forceinline__ unsigned pk2(float lo, float hi) { return pg8::cvt_pk_bf16(lo, hi); }
__device__ __forceinline__ void transpose_item(const float* W, const float* gain, int K, int N, bf16* WT, LAS float* scr, int item, int lane, bool headperm = false) {
    const int nblk = N / 32, kb = item / nblk, nb = item % nblk, k0 = 64 * kb, n0 = 32 * nb;
#pragma unroll 8
    for (int i = 0; i < 32; ++i) { const int kk = 2 * i + (lane >> 5); const float g = gain ? gain[k0 + kk] : 1.f; scr[kk * 33 + (lane & 31)] = W[(size_t)(k0 + kk) * N + n0 + (lane & 31)] * g; }
    LDS_WAIT(); asm volatile("" ::: "memory");
    const int c = lane & 7;
#pragma unroll
    for (int j = 0; j < 4; ++j) { const int n = (lane >> 3) + 8 * j; const LAS float* s = scr + (8 * c) * 33 + n;
        v4u o; o.x = pk2(s[0 * 33], s[1 * 33]); o.y = pk2(s[2 * 33], s[3 * 33]); o.z = pk2(s[4 * 33], s[5 * 33]); o.w = pk2(s[6 * 33], s[7 * 33]);
        int nn = n0 + n; if (headperm && nn < 768) { const int d = nn & 63, hh = (nn >> 6) & 3; nn = (nn & ~255) + 128 * (d >> 5) + 32 * hh + (d & 31); }
        *(v4u*)(WT + (size_t)nn * K + k0 + 8 * c) = o; }
    LDS_WAIT(); asm volatile("" ::: "memory");
}

#define XB_TMO      128
#define XB_XCNT(j)  (256  + 64 * (j))
#define XB_XSUB(j)  (1280 + 64 * (j))
#define XB_XGEN(j)  (2304 + 64 * (j))
#define XB_TOP      3328
#define XB_TOPGEN   3392
#define XCD_BAR_WORDS 3456
#define XB_SPIN_CAP (1u << 22)

__device__ __forceinline__ unsigned xb_ld(unsigned* p)              { return __hip_atomic_load(p, __ATOMIC_RELAXED, __HIP_MEMORY_SCOPE_AGENT); }
__device__ __forceinline__ unsigned xb_add(unsigned* p, unsigned v) { return __hip_atomic_fetch_add(p, v, __ATOMIC_RELAXED, __HIP_MEMORY_SCOPE_AGENT); }
__device__ __forceinline__ unsigned xb_xcc_id() { return (unsigned)__builtin_amdgcn_s_getreg((3 << 11) | 20) & 0xFu; }
#define XB_SPIN(cond, bar) do { unsigned _sp = 0; while (cond) { __builtin_amdgcn_s_sleep(1); \
    if ((++_sp & 255u) == 0u) { if (xb_ld(&(bar)[XB_TMO])) break; if (_sp > XB_SPIN_CAP) { atomicAdd(&(bar)[XB_TMO], 1u); break; } } } } while (0)

struct XcdBarrier {
    unsigned* bar; unsigned x;
    volatile LAS unsigned* st;
};

__device__ __forceinline__ XcdBarrier xcd_barrier_post(unsigned* bar, volatile LAS unsigned* st) {
    XcdBarrier b; b.bar = bar; b.x = xb_xcc_id(); b.st = st;
    if (threadIdx.x == 0) (void)xb_add(&bar[XB_XCNT(b.x)], 1u);
    return b;
}
__device__ __forceinline__ void xcd_barrier_complete(unsigned* bar, unsigned x, unsigned& nloc, unsigned& nx) {
    const unsigned G = gridDim.x * gridDim.y * gridDim.z;
    unsigned sum, cnt, mine, sp = 0u;
    for (;;) {
        sum = 0u; cnt = 0u; mine = 0u;
#pragma unroll
        for (unsigned j = 0; j < 16; ++j) { const unsigned c = xb_ld(&bar[XB_XCNT(j)]); sum += c; cnt += (c > 0u) ? 1u : 0u; mine = (j == x) ? c : mine; }
        if (sum == G) break;
        __builtin_amdgcn_s_sleep(1);
        if ((++sp & 255u) == 0u) { if (xb_ld(&bar[XB_TMO])) break; if (sp > XB_SPIN_CAP) { atomicAdd(&bar[XB_TMO], 1u); break; } }
    }
    nloc = mine > 0u ? mine : 1u; nx = cnt > 0u ? cnt : 1u;
}

__device__ __forceinline__ void xcd_barrier(const XcdBarrier& b) {
    asm volatile("s_waitcnt vmcnt(0)" ::: "memory");
    __syncthreads();
    if (threadIdx.x == 0) {
        unsigned* bar = b.bar;
        __builtin_amdgcn_s_waitcnt(0);
        unsigned nloc = b.st[0], nx = b.st[1];
        if (nloc == 0u) { xcd_barrier_complete(bar, b.x, nloc, nx); b.st[0] = nloc; b.st[1] = nx; }
        const unsigned old = xb_add(&bar[XB_XSUB(b.x)], 1u);
        const unsigned gen = old / nloc;
        if (old + 1u == (gen + 1u) * nloc) {
            __builtin_amdgcn_fence(__ATOMIC_RELEASE, "agent");
            asm volatile("s_waitcnt vmcnt(0)" ::: "memory");
            const unsigned og = xb_add(&bar[XB_TOP], 1u);
            const unsigned tg = og / nx;
            if (og + 1u == (tg + 1u) * nx) xb_add(&bar[XB_TOPGEN], 1u);
            else XB_SPIN(xb_ld(&bar[XB_TOPGEN]) == tg, bar);
            __builtin_amdgcn_fence(__ATOMIC_ACQUIRE, "agent");
            xb_add(&bar[XB_XGEN(b.x)], 1u);
            asm volatile("s_waitcnt vmcnt(0)" ::: "memory");
        } else {
            XB_SPIN(xb_ld(&bar[XB_XGEN(b.x)]) == gen, bar);
            __builtin_amdgcn_fence(__ATOMIC_ACQUIRE, "agent");
            asm volatile("s_waitcnt vmcnt(0)" ::: "memory");
        }
    }
    __syncthreads();
}

struct Args { const float* in[17]; float* out; unsigned char* ws; int ph_lo, ph_hi; };

__device__ __forceinline__ void ld8(const bf16* p, float (&v)[8]) { const v4u w = *(const v4u*)p;
#pragma unroll
    for (int j = 0; j < 4; ++j) { v[2 * j] = __uint_as_float(w[j] << 16); v[2 * j + 1] = __uint_as_float(w[j] & 0xffff0000u); } }
__device__ __forceinline__ void up8(const v4u w, float (&v)[8]) {
#pragma unroll
    for (int j = 0; j < 4; ++j) { v[2 * j] = __uint_as_float(w[j] << 16); v[2 * j + 1] = __uint_as_float(w[j] & 0xffff0000u); } }
__device__ __forceinline__ void st8(bf16* p, const float (&v)[8]) { v4u o; o.x = pk2(v[0], v[1]); o.y = pk2(v[2], v[3]); o.z = pk2(v[4], v[5]); o.w = pk2(v[6], v[7]); *(v4u*)p = o; }

__device__ __forceinline__ void head_norm_rope(float (&v)[8], const float* gain, int j, int prow, int pcol, float scale, const float* tc, const float* ts) {
    float ss = 0.f;
#pragma unroll
    for (int e = 0; e < 8; ++e) ss += v[e] * v[e];
    ss += __shfl_xor(ss, 1); ss += __shfl_xor(ss, 2); ss += __shfl_xor(ss, 4);
    const float rstd = 1.0f / sqrtf(ss * (1.0f / 64.0f) + pg8::NORM_EPS);
    const int pos = (j < 4) ? prow : pcol; const int o16 = pos * 16 + (j & 1) * 8;
    const f32x4 c0 = *(const f32x4*)(tc + o16), c1 = *(const f32x4*)(tc + o16 + 4), s0 = *(const f32x4*)(ts + o16), s1 = *(const f32x4*)(ts + o16 + 4);
    const f32x4 g0 = *(const f32x4*)(gain + j * 8), g1 = *(const f32x4*)(gain + j * 8 + 4);
#pragma unroll
    for (int e = 0; e < 8; ++e) {
        const float g = e < 4 ? g0[e & 3] : g1[e & 3], c = e < 4 ? c0[e & 3] : c1[e & 3], s = e < 4 ? s0[e & 3] : s1[e & 3];
        const float y = v[e] * rstd * g; const float py = __shfl_xor(y, 2);
        v[e] = (((j & 2) == 0) ? y * c - py * s : y * c + py * s) * scale;
    }
}

__global__ void __launch_bounds__(NWAVES * 64, 2) fwd_kernel(Args args) {
    extern __shared__ __attribute__((aligned(16))) unsigned char lds[];
    cg::grid_group grid = cg::this_grid();
    LAS unsigned char* L = (LAS unsigned char*)lds;
    const int tid = threadIdx.x, lane = tid & 63, wave = __builtin_amdgcn_readfirstlane(tid >> 6);
    const int G = gridDim.x; const int bx = blockIdx.x;
    const int vcu = (G % 8 == 0) ? (bx % 8) * (G / 8) + bx / 8 : bx;
    const int gw = vcu * NWAVES + wave, NGW = G * NWAVES;
    unsigned char* ws = args.ws;
    const float* x = args.in[0]; float* out = args.out;
    float* PART = (float*)(ws + WS_PART);
#define PARTN(k) (PART + (size_t)(k) * M * 16)
    bf16 *HB = (bf16*)(ws + WS_HB), *U = (bf16*)(ws + WS_U), *Z = (bf16*)(ws + WS_Z), *MIX = (bf16*)(ws + WS_MIX);
    bf16 *QA = (bf16*)(ws + WS_QA), *KA = (bf16*)(ws + WS_KA), *VA = (bf16*)(ws + WS_VA), *CQ = (bf16*)(ws + WS_CQ), *CKV = (bf16*)(ws + WS_CKV), *KR = (bf16*)(ws + WS_KR);
    bf16 *QB = (bf16*)(ws + WS_QB), *KVB = (bf16*)(ws + WS_KVB), *QKV = (bf16*)(ws + WS_QKV), *O1 = (bf16*)(ws + WS_O1);
    bf16 *WIN = (bf16*)(ws + WS_WIN), *WUQ = (bf16*)(ws + WS_WUQ), *WUKV = (bf16*)(ws + WS_WUKV), *WO0 = (bf16*)(ws + WS_WO0), *WUP0 = (bf16*)(ws + WS_WUP0), *WDN0 = (bf16*)(ws + WS_WDN0);
    bf16 *WQKV = (bf16*)(ws + WS_WQKV), *WO1 = (bf16*)(ws + WS_WO1), *WUP1 = (bf16*)(ws + WS_WUP1), *WDN1 = (bf16*)(ws + WS_WDN1);
    const int lo = args.ph_lo, hi = args.ph_hi;
    float* TAC = (float*)(ws + MiB); float* TAS = TAC + 2048; float* TBC = TAS + 2048; float* TBS = TBC + 1024;
    volatile LAS unsigned* MISC = (volatile LAS unsigned*)(L + 139264);
    if (tid < 2) MISC[tid] = 0u;
    __syncthreads();
    unsigned* BARW = (unsigned*)(ws + 8192);
    XcdBarrier xbar; xbar.bar = BARW; xbar.x = 0; xbar.st = MISC;
#ifndef PROBE_PHASE
#define PROBE_PHASE -1
#endif
#define IN(k) (lo <= (k) && (k) < hi)
#define REPS(k) ((PROBE_PHASE == (k)) ? 2 : 1)
#define SEAM(k) do { if (IN(k) && IN((k) + 1)) { if ((k) == 0) { grid.sync(); xbar = xcd_barrier_post(BARW, MISC); } else xcd_barrier(xbar); } } while (0)
    constexpr float C2A = 0.125f * att::LOG2E;
    constexpr float C2B = 0.10206207261596577f * att::LOG2E;

    if (IN(0)) {
        if (bx == 0) for (int i = tid; i < XCD_BAR_WORDS; i += NWAVES * 64) BARW[i] = 0u;
        LAS float* scr = (LAS float*)(L + wave * 16384);
        constexpr int I0 = 16 * 45, I1 = 6 * 24, I2 = 4 * 32, I3 = 16 * 32, I4 = 16 * 128, I5 = 64 * 32, I6 = 16 * 96, I7 = 16 * 32, I8 = I4, I9 = I5;
        constexpr int NITEMS = I0 + I1 + I2 + I3 + I4 + I5 + I6 + I7 + I8 + I9;
        for (int it = gw; it < NITEMS; it += NGW) {
            int r = it;
            if (r < I0) { transpose_item(args.in[2], args.in[1], D, NIN, WIN, scr, r, lane, true); continue; } r -= I0;
            if (r < I1) { transpose_item(args.in[6], args.in[5], 384, 768, WUQ, scr, r, lane); continue; } r -= I1;
            if (r < I2) { transpose_item(args.in[8], args.in[7], 256, 1024, WUKV, scr, r, lane); continue; } r -= I2;
            if (r < I3) { transpose_item(args.in[9], nullptr, D, D, WO0, scr, r, lane); continue; } r -= I3;
            if (r < I4) { transpose_item(args.in[14], args.in[13], D, FF, WUP0, scr, r, lane); continue; } r -= I4;
            if (r < I5) { transpose_item(args.in[15], nullptr, FF, D, WDN0, scr, r, lane); continue; } r -= I5;
            if (r < I6) { transpose_item(args.in[10], args.in[1] + D, D, 3 * D, WQKV, scr, r, lane); continue; } r -= I6;
            if (r < I7) { transpose_item(args.in[12], nullptr, D, D, WO1, scr, r, lane); continue; } r -= I7;
            if (r < I8) { transpose_item(args.in[14] + (size_t)D * FF, args.in[13] + D, D, FF, WUP1, scr, r, lane); continue; } r -= I8;
            transpose_item(args.in[15] + (size_t)FF * D, nullptr, FF, D, WDN1, scr, r, lane);
        }
        for (int i = bx * 512 + tid; i < 128 * 16; i += G * 512) { const int pos = i >> 4, f = i & 15; float s, c; att::sincos_acc((float)pos * exp2f(-(float)f * (13.287712379549449f / 16.0f)), s, c); TAC[i] = c; TAS[i] = s; }
        for (int i = bx * 512 + tid; i < 128 * 8; i += G * 512) { const int pos = i >> 3, f = i & 7; float s, c; att::sincos_acc((float)pos * exp2f(-(float)f * (13.287712379549449f / 8.0f)), s, c); TBC[i] = c; TBS[i] = s; }
        { v4u* p = (v4u*)(WIN + (size_t)NIN * D); const int n16 = (NINP - NIN) * D * 2 / 16; for (int i = bx * 512 + tid; i < n16; i += G * 512) p[i] = (v4u){0u, 0u, 0u, 0u}; }
        for (int m = gw; m < M; m += NGW) {
            const f32x4* xr = (const f32x4*)(x + (size_t)m * D) + lane; f32x4 v[4]; float s = 0.f;
#pragma unroll
            for (int j = 0; j < 4; ++j) { v[j] = xr[64 * j]; s += (v[j].x * v[j].x + v[j].y * v[j].y) + (v[j].z * v[j].z + v[j].w * v[j].w); }
            s = wave_sum(s);
            unsigned long long* o8 = (unsigned long long*)(HB + (size_t)m * D) + lane;
#pragma unroll
            for (int j = 0; j < 4; ++j) o8[64 * j] = (unsigned long long)pk2(v[j].x, v[j].y) | ((unsigned long long)pk2(v[j].z, v[j].w) << 32);
            if (lane < 16) PARTN(0)[(size_t)m * 16 + lane] = (lane == 0) ? s : 0.f;
        }
    }
    SEAM(0);
    if (IN(1)) {
        pg8::Gemm g{HB, WIN, M, NINP, D}; pg8::StaticOrder S; S.init(M, NINP, G, bx); S.rep = REPS(1);
        pg8::EpiIn E{PARTN(0), QA, KA, VA, CQ, CKV, KR, PARTN(5), PARTN(6), args.in[3], args.in[4], TAC, TAS, TBC, TBS, C2A};
        pg8::gemm_phase<pg8::EpiIn, pg8::StaticOrder, true, true>(L, g, S, E);
    }
    SEAM(1);
    if (IN(3)) {
        { pg8::Gemm g{CQ, WUQ, M, 768, 384}; pg8::StaticOrder S; S.init(M, 768, G, bx);
          pg8::EpiScale<0> E{QB, 768, PARTN(5), 1.0f / 384.0f, 3, C2B};
          pg8::gemm_phase<pg8::EpiScale<0>, pg8::StaticOrder, true, true>(L, g, S, E); }
        { pg8::Gemm g{CKV, WUKV, M, 1024, 256}; pg8::StaticOrder S; S.init(M, 1024, G, bx);
          pg8::EpiScale<0> E{KVB, 1024, PARTN(6), 1.0f / 256.0f, 0, 1.f};
          pg8::gemm_phase<pg8::EpiScale<0>, pg8::StaticOrder, true, true>(L, g, S, E); }
    }
    SEAM(3);
    if (IN(4)) {
        for (int uu = vcu; uu < 2048 * REPS(4); uu += G) { const int u = uu & 2047;
            const int pair = u >> 5, qb = u & 31; const int typ = (pair >> 3) & 1; const int idx = (pair >> 4) * 8 + (pair & 7); const int b = idx >> 3, h = idx & 7;
            const long rowbase = (long)b * SEQ;
            const bool has_next = (uu + G) < 2048 * REPS(4); const int un = (uu + G) & 2047; const int pairn = un >> 5; const int typn = (pairn >> 3) & 1; const int idxn = (pairn >> 4) * 8 + (pairn & 7); const int bn = idxn >> 3, hn = idxn & 7;
            att::Next nx;
            if (typn == 0) nx = att::Next{KA + (hn >> 2) * 64, KR, VA + (hn >> 2) * 64, 128, 32, 128, (long)bn * SEQ, 0, SEQ / 64 - 1, 64};
            else nx = att::Next{KVB + hn * 128, KR, KVB + hn * 128 + 64, 1024, 32, 1024, (long)bn * SEQ, 0, SEQ / 64 - 1, 96};
            if (typ == 0) { att::Desc d{QA + h * 64, nullptr, KA + (h >> 2) * 64, nullptr, VA + (h >> 2) * 64, MIX + h * 64, 512, 0, 128, 0, 128, 1024};
                (void)d; attn_ex::attn_unit<8, 512, 128, 128, 1024>((const attn_ex::bf16*)(QA + (size_t)(rowbase + qb * 256) * 512 + h * 64), (const attn_ex::bf16*)(KA + (size_t)rowbase * 128 + (h >> 2) * 64),
                    (const attn_ex::bf16*)(VA + (size_t)rowbase * 128 + (h >> 2) * 64), (attn_ex::bf16*)(MIX + (size_t)(rowbase + qb * 256) * 1024 + h * 64), (char*)lds); }
            else { att::Desc d{QB + h * 96, QB + h * 96 + 64, KVB + h * 128, KR, KVB + h * 128 + 64, MIX + 512 + h * 64, 768, 768, 1024, 32, 1024, 1024};
                (void)d; attn_ex96::attn_unit<8, 768, 1024, 1024, 1024>((const attn_ex96::bf16*)(QB + (size_t)(rowbase + qb * 256) * 768 + h * 96), (const attn_ex96::bf16*)(QB + (size_t)(rowbase + qb * 256) * 768 + h * 96 + 64),
                    (const attn_ex96::bf16*)(KVB + (size_t)rowbase * 1024 + h * 128), (const attn_ex96::bf16*)(KR + (size_t)rowbase * 32), (const attn_ex96::bf16*)(KVB + (size_t)rowbase * 1024 + h * 128 + 64),
                    (attn_ex96::bf16*)(MIX + (size_t)(rowbase + qb * 256) * 1024 + 512 + h * 64), qb * 256, (char*)lds); }
        }
    }
    SEAM(4);
    if (IN(5)) {
        pg8::Gemm g{MIX, WO0, M, D, D}; pg8::StaticOrder S; S.init(M, D, G, bx); S.rep = REPS(5);
        pg8::EpiRes E{x, out, HB, PARTN(1), D};
        pg8::gemm_phase<pg8::EpiRes, pg8::StaticOrder, true, true>(L, g, S, E);
    }
    SEAM(5);
    if (IN(6)) {
        pg8::Gemm g{HB, WUP0, M, FF, D}; pg8::StaticOrder S; S.init(M, FF, G, bx); S.rep = REPS(6);
        pg8::EpiScale<1> E{U, FF, PARTN(1), 1.0f / D, 0, 1.f};
        pg8::gemm_phase<pg8::EpiScale<1>, pg8::StaticOrder, true, true>(L, g, S, E);
    }
    SEAM(6);
    if (IN(7)) {
        pg8::Gemm g{U, WDN0, M, D, FF}; pg8::StaticOrder S; S.init(M, D, G, bx);
        pg8::EpiRes E{out, out, HB, PARTN(2), D};
        pg8::gemm_phase<pg8::EpiRes, pg8::StaticOrder, true, true>(L, g, S, E);
    }
    SEAM(7);
    if (IN(8)) {
        pg8::Gemm g{HB, WQKV, M, 3 * D, D}; pg8::StaticOrder S; S.init(M, 3 * D, G, bx); S.rep = REPS(8);
        pg8::EpiScale<0> E{QKV, 3 * D, PARTN(2), 1.0f / D, 4, C2A, M};
        pg8::gemm_phase<pg8::EpiScale<0>, pg8::StaticOrder, true, true>(L, g, S, E);
    }
    SEAM(8);
    if (IN(9)) {
        for (int uu = vcu; uu < 2048 * REPS(9); uu += G) { const int u = uu & 2047;
            const int pair = u >> 5, qb = u & 31; const int b = pair >> 4, h = pair & 15;
            const int R0 = qb * 4; const int tlo = min(max(R0 - 4, 0), 120), thi = min(max(R0 + 3 - 4, 0), 120) + 7;
            att::Desc d{QKV + (size_t)h * M * 64, nullptr, QKV + (size_t)(16 + h) * M * 64, nullptr, QKV + (size_t)(32 + h) * M * 64, O1 + h * 64, 64, 0, 64, 0, 64, D};
            const bool has_next = (uu + G) < 2048 * REPS(9); const int un = (uu + G) & 2047; const int pairn = un >> 5, qbn = un & 31; const int bn = pairn >> 4, hn = pairn & 15;
            const int R0n = qbn * 4; const int tlon = min(max(R0n - 4, 0), 120), thin = min(max(R0n + 3 - 4, 0), 120) + 7;
            const att::Next nx{QKV + (size_t)(16 + hn) * M * 64, KR, QKV + (size_t)(32 + hn) * M * 64, 64, 32, 64, (long)bn * SEQ, tlon, thin, 64};
            if (wave & 1) att::unit<64, 1, 1>(d, (long)b * SEQ, qb * 256, tlo, thi, args.in[11] + h * 465, L, uu != vcu, has_next, nx);
            else att::unit<64, 1, 0>(d, (long)b * SEQ, qb * 256, tlo, thi, args.in[11] + h * 465, L, uu != vcu, has_next, nx);
        }
    }
    SEAM(9);
    if (IN(10)) {
        pg8::Gemm g{O1, WO1, M, D, D}; pg8::StaticOrder S; S.init(M, D, G, bx);
        pg8::EpiRes E{out, out, HB, PARTN(3), D};
        pg8::gemm_phase<pg8::EpiRes, pg8::StaticOrder, true, true>(L, g, S, E);
    }
    SEAM(10);
    if (IN(11)) {
        pg8::Gemm g{HB, WUP1, M, FF, D}; pg8::StaticOrder S; S.init(M, FF, G, bx);
        pg8::EpiScale<1> E{U, FF, PARTN(3), 1.0f / D, 0, 1.f};
        pg8::gemm_phase<pg8::EpiScale<1>, pg8::StaticOrder, true, true>(L, g, S, E);
    }
    SEAM(11);
    if (IN(12)) {
        pg8::Gemm g{U, WDN1, M, D, FF}; pg8::StaticOrder S; S.init(M, D, G, bx);
        pg8::EpiRes E{out, out, nullptr, PARTN(4), D};
        pg8::gemm_phase<pg8::EpiRes, pg8::StaticOrder, true, true>(L, g, S, E);
    }
    SEAM(12);
    if (IN(13)) {
        const float* gf = args.in[16];
        for (int m = gw; m < M; m += NGW) {
            f32x4* xr = (f32x4*)(out + (size_t)m * D) + lane; const f32x4* pp = (const f32x4*)(PARTN(4) + (size_t)m * 16);
            const f32x4 a = pp[0], b = pp[1], c = pp[2], d4 = pp[3];
            const float s = ((a[0] + a[1]) + (a[2] + a[3])) + ((b[0] + b[1]) + (b[2] + b[3])) + ((c[0] + c[1]) + (c[2] + c[3])) + ((d4[0] + d4[1]) + (d4[2] + d4[3]));
            const float rstd = 1.0f / sqrtf(s * (1.0f / D) + pg8::NORM_EPS);
#pragma unroll
            for (int j = 0; j < 4; ++j) { const f32x4 v = xr[64 * j]; const f32x4 gg = ((const f32x4*)gf)[lane + 64 * j]; xr[64 * j] = v * rstd * gg; }
        }
    }
#undef IN
#undef SEAM
}

#ifndef MK_PER_PHASE
#define MK_PER_PHASE 0
#endif
extern "C" void kernel_launch(void* const* d_in, const int* in_sizes, int n_in, void* d_out, int out_size, void* d_ws, size_t ws_size, hipStream_t stream) {
    static int grid = 0;
    if (grid == 0) {
        if (n_in != 17 || in_sizes[0] != M * D || out_size != M * D || ws_size < WS_END) { fprintf(stderr, "kernel_launch: unexpected shapes / workspace (n_in %d, in0 %d, out %d, ws %zu)\n", n_in, n_in > 0 ? in_sizes[0] : -1, out_size, ws_size); grid = -1; return; }
        int dev = 0, cus = 0, per_cu = 0;
        if (hipGetDevice(&dev) != hipSuccess || hipDeviceGetAttribute(&cus, hipDeviceAttributeMultiprocessorCount, dev) != hipSuccess) { grid = -1; return; }
        if (hipFuncSetAttribute((const void*)fwd_kernel, hipFuncAttributeMaxDynamicSharedMemorySize, LDS_BYTES) != hipSuccess) { fprintf(stderr, "kernel_launch: hipFuncSetAttribute failed\n"); grid = -1; return; }
        if (hipOccupancyMaxActiveBlocksPerMultiprocessor(&per_cu, (const void*)fwd_kernel, NWAVES * 64, LDS_BYTES) != hipSuccess || per_cu < 1) { fprintf(stderr, "kernel_launch: occupancy query says %d\n", per_cu); per_cu = 1; }
        (void)hipGetLastError();
        grid = cus * per_cu;
        fprintf(stderr, "kernel_launch: grid %d (cus %d x %d)\n", grid, cus, per_cu);
    }
    if (grid < 0) return;
    Args a{};
    for (int i = 0; i < 17; ++i) a.in[i] = (const float*)d_in[i];
    a.out = (float*)d_out; a.ws = (unsigned char*)d_ws;
#if MK_PER_PHASE
    for (int p = 0; p < 14; ++p) { a.ph_lo = p; a.ph_hi = p + 1; hipLaunchKernelGGL(fwd_kernel, dim3(grid), dim3(NWAVES * 64), LDS_BYTES, stream, a); }
#else
    a.ph_lo = 0; a.ph_hi = 14;
    void* kargs[] = {&a};
    hipError_t e = hipLaunchCooperativeKernel((const void*)fwd_kernel, dim3(grid), dim3(NWAVES * 64), kargs, LDS_BYTES, stream);
    if (e != hipSuccess) fprintf(stderr, "cooperative launch failed: %s (grid %d)\n", hipGetErrorString(e), grid);
#endif
}
```

```cpp
#include <hip/hip_runtime.h>
#include <hip/hip_cooperative_groups.h>
#include <hip/hip_bf16.h>
#include <cstdio>
#include <cstdint>
#include <cmath>
namespace cg = cooperative_groups;
namespace pg8 {
#define PG8_LAS __attribute__((address_space(3)))
typedef unsigned short bf16_t;
typedef short bf16x8 __attribute__((ext_vector_type(8)));
typedef float f32x4 __attribute__((ext_vector_type(4)));
typedef unsigned u32x4 __attribute__((ext_vector_type(4)));
constexpr int BM = 256, BK = 64, HALF = 128, HTB = HALF * BK * 2  , STAGE_BYTES = 8 * HTB, NXCD = 8, WGM = 8;

__host__ __device__ __forceinline__ int lds_byte(int r, int c) { const int st = (r >> 4) * 2 + (c >> 5), rr = r & 15, cc = c & 31, ob = rr * 64 + cc * 2; return st * 1024 + (ob ^ (((ob >> 9) & 1) << 5)); }
__host__ __device__ __forceinline__ void stage_rc(int b, int& R, int& C) { const int st = b / 1024, sb = b % 1024, swz = sb ^ (((sb >> 9) & 1) << 5); R = (st >> 1) * 16 + swz / 64; C = (st & 1) * 32 + (swz % 64) / 2; }
__host__ __device__ __forceinline__ int perm32(int rho) { const int n = rho >> 4, i = rho & 15; return 8 * (i >> 2) + 4 * n + (i & 3); }

struct Unit { int pm, pn; };
struct Gemm { const bf16_t* A; const bf16_t* Bt; int M, N, K; };

struct StaticOrder {
    int nM, nN, nwg, G, c, rep = 1;
    __host__ __device__ void init(int M, int N, int G_, int c_) { nM = M / BM; nN = N / BM; nwg = nM * nN; G = G_; c = c_; }
    __host__ __device__ bool next(int i, Unit& u) const {
        const long L = (long)i * G + c; if (L >= (long)nwg * rep) return false;
        int wgid = (int)(L % nwg); { const int q = nwg / NXCD, r = nwg % NXCD, xcd = wgid % NXCD, off = wgid / NXCD; wgid = (xcd < r ? xcd * (q + 1) : r * (q + 1) + (xcd - r) * q) + off; }
        const int nig = WGM * nN, gid = wgid / nig, fm = gid * WGM, gsz = (nM - fm) < WGM ? (nM - fm) : WGM;
        u.pm = fm + ((wgid % nig) % gsz); u.pn = (wgid % nig) / gsz; return true;
    }
    __device__ __forceinline__ void a_ready(const Unit&) const {}
    __device__ __forceinline__ void done(const Unit&) const {}
};
__device__ __forceinline__ unsigned cvt_pk_bf16(float lo, float hi) { unsigned r; asm volatile("v_cvt_pk_bf16_f32 %0, %1, %2" : "=v"(r) : "v"(lo), "v"(hi)); return r; }
constexpr float NORM_EPS = 1e-6f;
template <int ACT> struct EpiScale {
    static constexpr bool PERM = true, AFTER_DRAIN = false;
    bf16_t* O; int ldc; const float* part; float inv_dim; int nq_tiles; float qscale; int hm = 0;
    __device__ __forceinline__ void operator()(const f32x4 (&acc)[2][2][4][2], const Unit& u, int wr, int wc, int fr, int fq) const {
        const int row0 = u.pm * BM + wr * 64 + fr; const int col0 = u.pn * BM + wc * 32 + 8 * fq;
        const float sc = (u.pn < nq_tiles) ? qscale : 1.f;
#pragma unroll
        for (int ai = 0; ai < 2; ++ai)
#pragma unroll
            for (int m = 0; m < 4; ++m) { const int row = row0 + ai * HALF + m * 16; float rs = 1.f;
                if (part) { const f32x4 a = *(const f32x4*)(part + (size_t)row * 16 + 4 * fq);
                    float s = (a[0] + a[1]) + (a[2] + a[3]); s += __shfl_xor(s, 16); s += __shfl_xor(s, 32);
                    rs = 1.0f / sqrtf(s * inv_dim + NORM_EPS); }
                if (ACT == 0) rs *= sc;
                bf16_t* rowp = hm ? O + ((size_t)(col0 >> 6) * hm + row) * 64 + (col0 & 63) : O + (size_t)row * ldc + col0;
#pragma unroll
                for (int bj = 0; bj < 2; ++bj) { f32x4 v0 = acc[ai][bj][m][0] * rs, v1 = acc[ai][bj][m][1] * rs;
                    if (ACT == 1) {
#pragma unroll
                        for (int e = 0; e < 4; ++e) { float a = fmaxf(v0[e], 0.f), b = fmaxf(v1[e], 0.f); v0[e] = a * a; v1[e] = b * b; } }
                    u32x4 w; w.x = cvt_pk_bf16(v0[0], v0[1]); w.y = cvt_pk_bf16(v0[2], v0[3]); w.z = cvt_pk_bf16(v1[0], v1[1]); w.w = cvt_pk_bf16(v1[2], v1[3]);
                    *(u32x4*)(rowp + (hm ? (size_t)bj * 2 * hm * 64 : (size_t)(bj * HALF))) = w; } }
    }
};
struct EpiIn {
    static constexpr bool PERM = true, AFTER_DRAIN = false;
    const float* part0; bf16_t *QA, *KA, *VA, *CQ, *CKV, *KR; float *pcq, *pckv; const float *gq, *gk, *tac, *tas, *tbc, *tbs; float qscale;
    __device__ __forceinline__ void st16(bf16_t* p, const f32x4 a, const f32x4 b) const { u32x4 w; w.x = cvt_pk_bf16(a[0], a[1]); w.y = cvt_pk_bf16(a[2], a[3]); w.z = cvt_pk_bf16(b[0], b[1]); w.w = cvt_pk_bf16(b[2], b[3]); *(u32x4*)p = w; }
    __device__ __forceinline__ float sq8(const f32x4 a, const f32x4 b) const { return (a[0] * a[0] + a[1] * a[1]) + (a[2] * a[2] + a[3] * a[3]) + (b[0] * b[0] + b[1] * b[1]) + (b[2] * b[2] + b[3] * b[3]); }
    __device__ __forceinline__ void operator()(const f32x4 (&acc)[2][2][4][2], const Unit& u, int wr, int wc, int fr, int fq) const {
        const int row0 = u.pm * BM + wr * 64 + fr; const int pn = u.pn;
#pragma unroll
        for (int ai = 0; ai < 2; ++ai)
#pragma unroll
            for (int m = 0; m < 4; ++m) { const int row = row0 + ai * HALF + m * 16;
                const float rsx = 1.0f / sqrtf(part0[(size_t)row * 16] * (1.0f / 1024.0f) + NORM_EPS);
                const int t = row & 8191; const int prow = t >> 6, pcol = t & 63;
                f32x4 z[2][2];
#pragma unroll
                for (int bj = 0; bj < 2; ++bj)
#pragma unroll
                    for (int n = 0; n < 2; ++n) z[bj][n] = acc[ai][bj][m][n] * rsx;
                if (pn <= 2) {
                    if (pn == 2 && wc >= 2) {
#pragma unroll
                        for (int bj = 0; bj < 2; ++bj) st16(VA + (size_t)row * 128 + (wc - 2) * 64 + 32 * bj + 8 * fq, z[bj][0], z[bj][1]);
                    } else {
                        float ss = sq8(z[0][0], z[0][1]) + sq8(z[1][0], z[1][1]);
                        ss += __shfl_xor(ss, 16); ss += __shfl_xor(ss, 32);
                        const float hr = 1.0f / sqrtf(ss * (1.0f / 64.0f) + NORM_EPS);
                        const float* gain = (pn == 2) ? gk : gq; const float sc = (pn == 2) ? 1.f : qscale;
                        bf16_t* dst = (pn == 2) ? KA + (size_t)row * 128 + wc * 64 : QA + (size_t)row * 512 + (4 * pn + wc) * 64;
#pragma unroll
                        for (int bj = 0; bj < 2; ++bj) { const int pos = bj ? pcol : prow; f32x4 o2[2];
#pragma unroll
                            for (int n = 0; n < 2; ++n) { const int ti = pos * 16 + 8 * (fq & 1) + 4 * n;
                                const f32x4 c4 = *(const f32x4*)(tac + ti), s4 = *(const f32x4*)(tas + ti), g4 = *(const f32x4*)(gain + 32 * bj + 8 * fq + 4 * n);
#pragma unroll
                                for (int e = 0; e < 4; ++e) { const float y = z[bj][n][e] * hr * g4[e]; const float py = __shfl_xor(y, 32);
                                    o2[n][e] = (((fq & 2) == 0) ? y * c4[e] - py * s4[e] : y * c4[e] + py * s4[e]) * sc; } }
                            st16(dst + 32 * bj + 8 * fq, o2[0], o2[1]); }
                    }
                } else if (pn == 3) {
#pragma unroll
                    for (int bj = 0; bj < 2; ++bj) st16(CQ + (size_t)row * 384 + 128 * bj + 32 * wc + 8 * fq, z[bj][0], z[bj][1]);
                    float ss = sq8(z[0][0], z[0][1]) + sq8(z[1][0], z[1][1]); ss += __shfl_xor(ss, 16); ss += __shfl_xor(ss, 32);
                    if (fq == 0) { pcq[(size_t)row * 16 + wc] = ss; pcq[(size_t)row * 16 + 8 + wc] = 0.f; }
                } else if (pn == 4) {
                    st16(CQ + (size_t)row * 384 + 256 + 32 * wc + 8 * fq, z[0][0], z[0][1]);
                    st16(CKV + (size_t)row * 256 + 32 * wc + 8 * fq, z[1][0], z[1][1]);
                    float s0 = sq8(z[0][0], z[0][1]), s1 = sq8(z[1][0], z[1][1]); s0 += __shfl_xor(s0, 16); s0 += __shfl_xor(s0, 32); s1 += __shfl_xor(s1, 16); s1 += __shfl_xor(s1, 32);
                    if (fq == 0) { pcq[(size_t)row * 16 + 4 + wc] = s0; pcq[(size_t)row * 16 + 12 + wc] = 0.f; pckv[(size_t)row * 16 + wc] = s1; }
                } else {
                    st16(CKV + (size_t)row * 256 + 128 + 32 * wc + 8 * fq, z[0][0], z[0][1]);
                    float s0 = sq8(z[0][0], z[0][1]); s0 += __shfl_xor(s0, 16); s0 += __shfl_xor(s0, 32);
                    if (fq == 0) { pckv[(size_t)row * 16 + 4 + wc] = s0; pckv[(size_t)row * 16 + 8 + wc] = 0.f; pckv[(size_t)row * 16 + 12 + wc] = 0.f; }
                    if (wc == 0) {
                        const int pos = (fq < 2) ? prow : pcol; f32x4 o2[2];
#pragma unroll
                        for (int n = 0; n < 2; ++n) { const f32x4 c4 = *(const f32x4*)(tbc + pos * 8 + 4 * n), s4 = *(const f32x4*)(tbs + pos * 8 + 4 * n);
#pragma unroll
                            for (int e = 0; e < 4; ++e) { const float y = z[1][n][e]; const float py = __shfl_xor(y, 16);
                                o2[n][e] = ((fq & 1) == 0) ? y * c4[e] - py * s4[e] : y * c4[e] + py * s4[e]; } }
                        st16(KR + (size_t)row * 32 + 8 * fq, o2[0], o2[1]);
                    }
                }
            }
    }
};

struct EpiRes {
    static constexpr bool PERM = true, AFTER_DRAIN = false;
    const float* base; float* out; bf16_t* ob; float* part; int ldc; const bf16_t* bb = nullptr;
    __device__ __forceinline__ void operator()(const f32x4 (&acc)[2][2][4][2], const Unit& u, int wr, int wc, int fr, int fq) const {
        const int row0 = u.pm * BM + wr * 64 + fr; const int col0 = u.pn * BM + wc * 32 + 8 * fq;
#pragma unroll
        for (int ai = 0; ai < 2; ++ai)
#pragma unroll
            for (int m = 0; m < 4; ++m) { const int row = row0 + ai * HALF + m * 16; const size_t off = (size_t)row * ldc + col0; float ss = 0.f;
#pragma unroll
                for (int bj = 0; bj < 2; ++bj) { f32x4 b0, b1;
                    if (bb) { const u32x4 q = *(const u32x4*)(bb + off + bj * HALF); b0 = (f32x4){__uint_as_float(q.x << 16), __uint_as_float(q.x & 0xffff0000u), __uint_as_float(q.y << 16), __uint_as_float(q.y & 0xffff0000u)};
                        b1 = (f32x4){__uint_as_float(q.z << 16), __uint_as_float(q.z & 0xffff0000u), __uint_as_float(q.w << 16), __uint_as_float(q.w & 0xffff0000u)}; }
                    else { b0 = *(const f32x4*)(base + off + bj * HALF); b1 = *(const f32x4*)(base + off + bj * HALF + 4); }
                    const f32x4 v0 = acc[ai][bj][m][0] + b0, v1 = acc[ai][bj][m][1] + b1;
                    if (out) { *(f32x4*)(out + off + bj * HALF) = v0; *(f32x4*)(out + off + bj * HALF + 4) = v1; }
                    u32x4 w; w.x = cvt_pk_bf16(v0[0], v0[1]); w.y = cvt_pk_bf16(v0[2], v0[3]); w.z = cvt_pk_bf16(v1[0], v1[1]); w.w = cvt_pk_bf16(v1[2], v1[3]);
                    if (ob) *(u32x4*)(ob + off + bj * HALF) = w;
                    ss += (v0[0] * v0[0] + v0[1] * v0[1]) + (v0[2] * v0[2] + v0[3] * v0[3]) + (v1[0] * v1[0] + v1[1] * v1[1]) + (v1[2] * v1[2] + v1[3] * v1[3]); }
                ss += __shfl_xor(ss, 16); ss += __shfl_xor(ss, 32);
                if (fq == 0) part[(size_t)row * 16 + u.pn * 4 + wc] = ss; }
    }
};

template <class Epi, class Sched, bool ALIGN_EPI = false, bool SP2 = false>
__device__ __forceinline__ void gemm_phase(PG8_LAS unsigned char* lds, const Gemm g, const Sched& S, const Epi& E) {
    const int tid = threadIdx.x, wid = __builtin_amdgcn_readfirstlane(tid >> 6), lane = tid & 63, wr = wid >> 2, wc = wid & 3, fr = lane & 15, fq = lane >> 4;
    const int K = g.K, nt = K / BK;
    unsigned voffA[2], voffB[2];
#pragma unroll
    for (int i = 0; i < 2; ++i) { int R, C; stage_rc(tid * 16 + i * 8192, R, C); const int Rb = Epi::PERM ? ((R & ~31) + perm32(R & 31)) : R;
        voffA[i] = (unsigned)(R * K + C) * 2u; voffB[i] = (unsigned)(Rb * K + C) * 2u; }
    const size_t kstep = (size_t)(BK * 2);
    const size_t hstep = (size_t)HALF * K * 2;
    const size_t tstep = 2 * hstep;
    const unsigned ldsw = (unsigned)wid * 1024u;
    const int aoff = lds_byte(wr * 64 + fr, fq * 8), boff = lds_byte(wc * 32 + fr, fq * 8);
#define PG8_SA(b, h) (((b) * 2 + (h)) * HTB)
#define PG8_SB(b, h) ((4 + (b) * 2 + (h)) * HTB)
#define PG8_STAGE(bufoff, gbase, voff) do { _Pragma("unroll") for (int _i = 0; _i < 2; ++_i) \
        __builtin_amdgcn_global_load_lds((const unsigned*)((const char*)(gbase) + (voff)[_i]), (PG8_LAS unsigned*)(lds + (bufoff) + ldsw + _i * 8192), 16, 0, 0); } while (0)
#define PG8_LDA(dst, b, h) do { _Pragma("unroll") for (int m = 0; m < 4; ++m) _Pragma("unroll") for (int k = 0; k < 2; ++k) dst[m][k] = *(const PG8_LAS bf16x8*)(lds + PG8_SA(b, h) + aoff + m * 2048 + k * 1024); } while (0)
#define PG8_LDB(dst, b, h) do { _Pragma("unroll") for (int n = 0; n < 2; ++n) _Pragma("unroll") for (int k = 0; k < 2; ++k) dst[n][k] = *(const PG8_LAS bf16x8*)(lds + PG8_SB(b, h) + boff + n * 2048 + k * 1024); } while (0)
#define PG8_MMA(ai, bj, At, Bt) do { __builtin_amdgcn_s_setprio(1); _Pragma("unroll") for (int m = 0; m < 4; ++m) _Pragma("unroll") for (int n = 0; n < 2; ++n) _Pragma("unroll") for (int k = 0; k < 2; ++k) \
        acc[ai][bj][m][n] = __builtin_amdgcn_mfma_f32_16x16x32_bf16(Bt[n][k], At[m][k], acc[ai][bj][m][n], 0, 0, 0); __builtin_amdgcn_s_setprio(0); } while (0)
#define PG8_WAIT_V(n) asm volatile("s_waitcnt vmcnt(" #n ")" ::: "memory")
#define PG8_WAIT_L(n) asm volatile("s_waitcnt lgkmcnt(" #n ")" ::: "memory")
#define PG8_BAR __builtin_amdgcn_s_barrier()
#define PG8_SCHED __builtin_amdgcn_sched_barrier(0)
    Unit cur, nxt; int ui = 0;
    if (!S.next(0, cur)) return;
    f32x4 acc[2][2][4][2];
#pragma unroll
    for (int a = 0; a < 2; ++a)
#pragma unroll
        for (int b = 0; b < 2; ++b)
#pragma unroll
            for (int m = 0; m < 4; ++m)
#pragma unroll
                for (int n = 0; n < 2; ++n) acc[a][b][m][n] = (f32x4){0.f, 0.f, 0.f, 0.f};
    bf16x8 At[4][2], B0[2][2], B1[2][2];
    const char* cA = (const char*)g.A + (size_t)cur.pm * tstep; const char* cB = (const char*)g.Bt + (size_t)cur.pn * tstep;
    S.a_ready(cur);
    if constexpr (SP2) {
        PG8_STAGE(PG8_SB(0, 0), cB, voffB); PG8_STAGE(PG8_SB(0, 1), cB + hstep, voffB); PG8_STAGE(PG8_SA(0, 0), cA, voffA); PG8_STAGE(PG8_SA(0, 1), cA + hstep, voffA);
        if (wr == 1) PG8_BAR;
        PG8_WAIT_V(2); PG8_BAR;
        PG8_STAGE(PG8_SB(1, 0), cB + kstep, voffB); PG8_STAGE(PG8_SA(1, 0), cA + kstep, voffA); PG8_STAGE(PG8_SB(1, 1), cB + hstep + kstep, voffB);
        PG8_WAIT_V(6); PG8_BAR;
    } else {
        PG8_STAGE(PG8_SB(0, 0), cB, voffB); PG8_STAGE(PG8_SA(0, 0), cA, voffA); PG8_STAGE(PG8_SB(0, 1), cB + hstep, voffB); PG8_STAGE(PG8_SA(0, 1), cA + hstep, voffA);
        if (wr == 1) PG8_BAR;
        PG8_WAIT_V(4); PG8_BAR;
        PG8_STAGE(PG8_SB(1, 0), cB + kstep, voffB); PG8_STAGE(PG8_SA(1, 0), cA + kstep, voffA); PG8_STAGE(PG8_SB(1, 1), cB + hstep + kstep, voffB);
        PG8_WAIT_V(6); PG8_BAR;
    }
    for (;;) {
        const bool has_next = S.next(ui + 1, nxt);
        const char* nA = has_next ? (const char*)g.A + (size_t)nxt.pm * tstep : cA; const char* nB = has_next ? (const char*)g.Bt + (size_t)nxt.pn * tstep : cB;
        for (int t = 0; t < nt; t += 2) {
            const bool last = (t == nt - 2);
            const char* a1 = cA + (size_t)(t + 1) * kstep;
            const char* a2 = last ? nA : cA + (size_t)(t + 2) * kstep; const char* b2 = last ? nB : cB + (size_t)(t + 2) * kstep;
            const char* a3 = a2 + kstep; const char* b3 = b2 + kstep;
            if (last && has_next) S.a_ready(nxt);
            if constexpr (SP2) {
            PG8_LDB(B0, 0, 0); PG8_LDB(B1, 0, 1); PG8_SCHED; PG8_LDA(At, 0, 0); PG8_STAGE(PG8_SA(1, 1), a1 + hstep, voffA);
            PG8_WAIT_V(8); PG8_WAIT_L(0); PG8_BAR; PG8_MMA(0, 0, At, B0); PG8_MMA(0, 1, At, B1); PG8_BAR; PG8_SCHED;
            PG8_LDA(At, 0, 1); PG8_STAGE(PG8_SB(0, 0), b2, voffB); PG8_STAGE(PG8_SB(0, 1), b2 + hstep, voffB); PG8_STAGE(PG8_SA(0, 0), a2, voffA);
            PG8_WAIT_V(8); PG8_WAIT_L(0); PG8_BAR; PG8_MMA(1, 0, At, B0); PG8_MMA(1, 1, At, B1); PG8_BAR; PG8_SCHED;
            PG8_LDB(B0, 1, 0); PG8_LDB(B1, 1, 1); PG8_SCHED; PG8_LDA(At, 1, 0); PG8_STAGE(PG8_SA(0, 1), a2 + hstep, voffA);
            PG8_WAIT_V(8); PG8_WAIT_L(0); PG8_BAR; PG8_MMA(0, 0, At, B0); PG8_MMA(0, 1, At, B1); PG8_BAR; PG8_SCHED;
            PG8_LDA(At, 1, 1); PG8_STAGE(PG8_SB(1, 0), b3, voffB); PG8_STAGE(PG8_SB(1, 1), b3 + hstep, voffB); PG8_STAGE(PG8_SA(1, 0), a3, voffA);
            PG8_WAIT_V(8); PG8_WAIT_L(0); PG8_BAR; PG8_MMA(1, 0, At, B0); PG8_MMA(1, 1, At, B1); PG8_BAR; PG8_SCHED;
            } else {
            PG8_LDB(B0, 0, 0); PG8_SCHED; PG8_LDA(At, 0, 0); PG8_STAGE(PG8_SA(1, 1), a1 + hstep, voffA);
            PG8_WAIT_L(8); PG8_BAR; PG8_WAIT_L(0); PG8_MMA(0, 0, At, B0); PG8_BAR; PG8_SCHED;
            PG8_LDB(B1, 0, 1); PG8_STAGE(PG8_SB(0, 0), b2, voffB);
            PG8_BAR; PG8_WAIT_L(0); PG8_MMA(0, 1, At, B1); PG8_BAR;
            PG8_LDA(At, 0, 1); PG8_STAGE(PG8_SA(0, 0), a2, voffA);
            PG8_BAR; PG8_WAIT_L(0); PG8_MMA(1, 0, At, B0); PG8_BAR; PG8_SCHED;
            PG8_STAGE(PG8_SB(0, 1), b2 + hstep, voffB);
            PG8_WAIT_V(6); PG8_BAR; PG8_MMA(1, 1, At, B1); PG8_BAR;
            PG8_LDB(B0, 1, 0); PG8_SCHED; PG8_LDA(At, 1, 0); PG8_STAGE(PG8_SA(0, 1), a2 + hstep, voffA);
            PG8_WAIT_L(8); PG8_BAR; PG8_WAIT_L(0); PG8_MMA(0, 0, At, B0); PG8_BAR; PG8_SCHED;
            PG8_LDB(B1, 1, 1); PG8_STAGE(PG8_SB(1, 0), b3, voffB);
            PG8_BAR; PG8_WAIT_L(0); PG8_MMA(0, 1, At, B1); PG8_BAR;
            PG8_LDA(At, 1, 1); PG8_STAGE(PG8_SA(1, 0), a3, voffA);
            PG8_BAR; PG8_WAIT_L(0); PG8_MMA(1, 0, At, B0); PG8_BAR; PG8_SCHED;
            PG8_STAGE(PG8_SB(1, 1), b3 + hstep, voffB);
            PG8_WAIT_V(6); PG8_BAR; PG8_MMA(1, 1, At, B1); PG8_BAR;
            }
        }
        if constexpr (ALIGN_EPI) { if (wr == 0) PG8_BAR; }
        if constexpr (!Epi::AFTER_DRAIN) { E(acc, cur, wr, wc, fr, fq); S.done(cur); }
        if (!has_next) break;
#pragma unroll
        for (int a = 0; a < 2; ++a)
#pragma unroll
            for (int b = 0; b < 2; ++b)
#pragma unroll
                for (int m = 0; m < 4; ++m)
#pragma unroll
                    for (int n = 0; n < 2; ++n) acc[a][b][m][n] = (f32x4){0.f, 0.f, 0.f, 0.f};
        cur = nxt; cA = nA; cB = nB; ++ui;
        if constexpr (ALIGN_EPI) { if (wr == 1) PG8_BAR; }
    }
    PG8_WAIT_V(0);
    if constexpr (!ALIGN_EPI) { if (wr == 0) PG8_BAR; }
    PG8_BAR;
    if constexpr (Epi::AFTER_DRAIN) { E.fused(acc, cur, wr, wc, fr, fq, lds, wid, lane); S.done(cur); }
#undef PG8_SA
#undef PG8_SB
#undef PG8_STAGE
#undef PG8_LDA
#undef PG8_LDB
#undef PG8_MMA
#undef PG8_WAIT_V
#undef PG8_WAIT_L
#undef PG8_BAR
#undef PG8_SCHED
}
}
namespace att {
using bf16x8 = __attribute__((ext_vector_type(8))) short;
using s16x4 = __attribute__((ext_vector_type(4))) short;
using f32x16 = __attribute__((ext_vector_type(16))) float;
using u32x4 = __attribute__((ext_vector_type(4))) unsigned;
typedef unsigned short bf16_t;
#define ALAS __attribute__((address_space(3)))
constexpr int KSLOT = 8192, VSLOT = 8192;
constexpr int NSLOT = 6;
constexpr int L_K = 0, L_V = NSLOT * KSLOT, L_WS = L_V + NSLOT * VSLOT, L_RPB = L_WS + 8 * 64 * 4, L_OST = L_RPB + 2048, L_END = L_OST + 8 * 4096;
constexpr float THR = 8.f;
constexpr float LOG2E = 1.4426950408889634f;
struct Desc { const bf16_t *Q0, *Q1, *K0, *K1, *V; bf16_t* O; int q0p, q1p, k0p, k1p, vp, op; };
struct Next { const bf16_t *K0, *K1, *V; int k0p, k1p, vp; long rowbase; int tlo, thi, dqk; };

__device__ __forceinline__ int crow(int r, int hi) { return (r & 3) + 8 * (r >> 2) + 4 * hi; }
typedef float f32x2_t __attribute__((ext_vector_type(2))); typedef __bf16 bf16x2_t __attribute__((ext_vector_type(2)));
__device__ __forceinline__ unsigned cvtpk_s(float lo, float hi) { f32x2_t v = {lo, hi}; bf16x2_t b = __builtin_convertvector(v, bf16x2_t); return __builtin_bit_cast(unsigned, b); }
__device__ __forceinline__ float bf2f(short s) { return __uint_as_float(((unsigned)(unsigned short)s) << 16); }
typedef short v4i16_t __attribute__((ext_vector_type(4)));
__device__ __forceinline__ s16x4 vtr(const ALAS unsigned char* p) { return __builtin_bit_cast(s16x4, __builtin_amdgcn_ds_read_tr16_b64_v4i16((ALAS v4i16_t*)p)); }
__device__ __forceinline__ void dma16(const void* g, ALAS unsigned char* l) { unsigned keep; const unsigned dst = (unsigned)__builtin_amdgcn_readfirstlane((int)(unsigned)(uintptr_t)l);
    asm volatile("s_mov_b32 %0, m0\n\ts_mov_b32 m0, %2\n\ts_nop 0\n\tglobal_load_lds_dwordx4 %1, off\n\ts_mov_b32 m0, %0" : "=&s"(keep) : "v"(g), "s"(dst) : "memory"); }
__device__ __forceinline__ float xhalf_max(float m) { auto rr = __builtin_amdgcn_permlane32_swap(__float_as_uint(m), __float_as_uint(m), false, false); return fmaxf(__uint_as_float(rr[0]), __uint_as_float(rr[1])); }
__device__ __forceinline__ float xhalf_sum(float m) { auto rr = __builtin_amdgcn_permlane32_swap(__float_as_uint(m), __float_as_uint(m), false, false); return __uint_as_float(rr[0]) + __uint_as_float(rr[1]); }
__device__ __forceinline__ void sincos_acc(float x, float& s, float& c) {
    const float k = rintf(x * 0.6366197723675814f);
    float r = fmaf(-k, 1.5707962513e+00f, x); r = fmaf(-k, 7.5497894159e-08f, r); r = fmaf(-k, 5.3903029534e-15f, r);
    const int q = ((int)k) & 3; const float r2 = r * r;
    const float sp = r + r * r2 * (-1.6666654611e-1f + r2 * (8.3321608736e-3f + r2 * (-1.9515295891e-4f)));
    const float cp = 1.f + r2 * (-0.5f + r2 * (4.166664568298827e-2f + r2 * (-1.388731625493765e-3f + r2 * 2.443315711809948e-5f)));
    const float s0 = (q & 1) ? cp : sp, c0 = (q & 1) ? sp : cp;
    s = (q & 2) ? -s0 : s0; c = ((q + 1) & 2) ? -c0 : c0;
}

template <int DQK, int MODE, int HALF = -1>
__device__ __forceinline__ void unit(const Desc& d, long rowbase, int q0, int tlo, int thi, const float* rpb_h, ALAS unsigned char* shm, bool pre, bool has_next, const Next& nx) {
    constexpr int ND = DQK / 16;
#define N0(r) ((HALF != 1) || (r) >= 12)
#define N1(r) ((HALF != 0) || (r) < 4)
#define NKG(kg) ((kg) == 0 ? (HALF != 1) : (kg) == 3 ? (HALF != 0) : true)
    const int tid = threadIdx.x, lane = tid & 63, r32 = lane & 31, hi = lane >> 5;
    const int wid = __builtin_amdgcn_readfirstlane(tid >> 6);
    ALAS float* wsf = (ALAS float*)(shm + L_WS) + wid * 64;
    ALAS float* rpbs = (ALAS float*)(shm + L_RPB);
    const bf16_t* ksrc0 = d.K0 + (rowbase + lane) * (long)d.k0p + wid * 8;
    const bf16_t* ksrc1 = d.K1 + (rowbase + lane) * (long)d.k1p + (wid & 3) * 8;
    const bf16_t* vsrc = d.V + (rowbase + 16 * (wid & 3) + (lane >> 2)) * (long)d.vp + (wid >> 2) * 32 + (lane & 3) * 8;
#define ATT_ISSUE_K(t, koff) do { \
        dma16(ksrc0 + (long)(t) * 64 * d.k0p, shm + L_K + (koff) + wid * 1024); \
        if (DQK == 96) { dma16(ksrc1 + (long)(t) * 64 * d.k1p, shm + L_K + (koff) + (8 + (wid & 3)) * 1024); } } while (0)
#define ATT_ISSUE_V(t, voff) dma16(vsrc + (long)(t) * 64 * d.vp, shm + L_V + (voff) + wid * 1024)
#define ATT_WAITBAR() asm volatile("s_waitcnt vmcnt(0) lgkmcnt(0)\n\ts_barrier" ::: "memory")
    if (!pre) {
    ATT_ISSUE_K(tlo, 0); ATT_ISSUE_V(tlo, 0);
#pragma unroll
    for (int i = 1; i < 5; ++i) if (tlo + i <= thi) { ATT_ISSUE_K(tlo + i, i * KSLOT); ATT_ISSUE_V(tlo + i, i * VSLOT); }
    }
    const int tq = q0 + wid * 32 + r32;
    if (MODE == 1) { for (int i = tid; i < 15 * 32; i += 512) { const int dr = i >> 5, j = i & 31; rpbs[i] = (j < 31) ? rpb_h[dr * 31 + j] * LOG2E : -INFINITY; } }
    bf16x8 qr[ND];
    { const bf16_t* qp = d.Q0 + (rowbase + tq) * (long)d.q0p + hi * 8;
#pragma unroll
      for (int d0 = 0; d0 < 4; ++d0) qr[d0] = *(const bf16x8*)(qp + d0 * 16); }
    if constexpr (DQK == 96) {
        const bf16_t* qp = d.Q1 + (rowbase + tq) * (long)d.q1p + hi * 8;
#pragma unroll
        for (int dd = 0; dd < 2; ++dd) {
            const bf16x8 raw = *(const bf16x8*)(qp + dd * 16); const u32x4 w = __builtin_bit_cast(u32x4, raw); u32x4 pw;
#pragma unroll
            for (int j = 0; j < 4; ++j) pw[j] = (unsigned)__shfl_xor((int)w[j], 32);
            const bf16x8 par = __builtin_bit_cast(bf16x8, pw);
            const float pos = (dd == 0) ? (float)(tq >> 6) : (float)(tq & 63);
            float ov[8];
#pragma unroll
            for (int e = 0; e < 8; ++e) { const float inv = exp2f(-(float)e * (13.287712379549449f / 8.0f)); float s, c; sincos_acc(pos * inv, s, c);
                const float x = bf2f(raw[e]), y = bf2f(par[e]); ov[e] = hi == 0 ? x * c - y * s : x * c + y * s; }
            u32x4 o4; o4.x = cvtpk_s(ov[0], ov[1]); o4.y = cvtpk_s(ov[2], ov[3]); o4.z = cvtpk_s(ov[4], ov[5]); o4.w = cvtpk_s(ov[6], ov[7]);
            qr[4 + dd] = __builtin_bit_cast(bf16x8, o4);
        }
    }
    float mhat = 0.f, l_reg = 0.f; f32x16 o[2]; o[0] = f32x16{}; o[1] = f32x16{}; f32x16 negm = f32x16{};
    bool first = true;
    const int qrow = tq >> 6, qc = tq & 63;
    const int wrow = __builtin_amdgcn_readfirstlane(qrow);
    const int rs = min(max(wrow - 4, 0), 120);
    const int cs = min(max(qc - 8, 0), 48);
    unsigned co[32];
    if (MODE == 1) {
#pragma unroll
        for (int r = 0; r < 16; ++r) { const int kc = crow(r, hi), kc1 = kc + 32;
            co[r] = (((unsigned)(kc - cs) < 16u) ? (unsigned)(kc - qc + 15) : 31u) * 4u; co[16 + r] = (((unsigned)(kc1 - cs) < 16u) ? (unsigned)(kc1 - qc + 15) : 31u) * 4u; }
    }
    const unsigned tb_addr = (unsigned)(uintptr_t)(shm + L_RPB);
#define ATT_KRD(KOFF) do { const ALAS unsigned char* ka_ = shm + L_K + (KOFF) + hi * 1024 + r32 * 16; \
        _Pragma("unroll") for (int d0 = 0; d0 < ND; ++d0) { kf[2 * d0] = *(const ALAS bf16x8*)(ka_ + d0 * 2048); kf[2 * d0 + 1] = *(const ALAS bf16x8*)(ka_ + d0 * 2048 + 512); } } while (0)
#define ATT_QK2(P0, P1, d0) do { if ((d0) == 0) { P0 = __builtin_amdgcn_mfma_f32_32x32x16_bf16(kf[0], qr[0], negm, 0, 0, 0); P1 = __builtin_amdgcn_mfma_f32_32x32x16_bf16(kf[1], qr[0], negm, 0, 0, 0); } \
            else { P0 = __builtin_amdgcn_mfma_f32_32x32x16_bf16(kf[2 * (d0)], qr[d0], P0, 0, 0, 0); P1 = __builtin_amdgcn_mfma_f32_32x32x16_bf16(kf[2 * (d0) + 1], qr[d0], P1, 0, 0, 0); } } while (0)
#define ATT_QKM(P0, P1) do { _Pragma("unroll") for (int d0 = 0; d0 < ND; ++d0) ATT_QK2(P0, P1, d0); } while (0)
#define ATT_VRD(VOFF) do { const ALAS unsigned char* va_ = shm + L_V + (VOFF) + ((lane >> 4) & 1) * 32 + (lane & 3) * 8 + (4 * hi + ((lane & 15) >> 2)) * 64; \
        _Pragma("unroll") for (int kg = 0; kg < 4; ++kg) _Pragma("unroll") for (int dh = 0; dh < 2; ++dh) if (NKG(kg)) { \
            vf[(kg * 2 + dh) * 2] = vtr(va_ + dh * 4096 + kg * 1024); vf[(kg * 2 + dh) * 2 + 1] = vtr(va_ + dh * 4096 + kg * 1024 + 512); } } while (0)
#define ATT_VWAIT() do {} while (0)
#define ATT_VF(kg, dh) ((bf16x8){vf[((kg) * 2 + (dh)) * 2][0], vf[((kg) * 2 + (dh)) * 2][1], vf[((kg) * 2 + (dh)) * 2][2], vf[((kg) * 2 + (dh)) * 2][3], vf[((kg) * 2 + (dh)) * 2 + 1][0], vf[((kg) * 2 + (dh)) * 2 + 1][1], vf[((kg) * 2 + (dh)) * 2 + 1][2], vf[((kg) * 2 + (dh)) * 2 + 1][3]})
#define ATT_ACTIVE(t) ((MODE == 0) || ((t) >= rs && (t) <= rs + 7))
    const unsigned kaddr0 = (unsigned)(uintptr_t)(shm + L_K) + hi * 1024 + r32 * 16;
    const unsigned vaddr0 = (unsigned)(uintptr_t)(shm + L_V) + ((lane >> 4) & 1) * 32 + (lane & 3) * 8 + (4 * hi + ((lane & 15) >> 2)) * 64;
    bf16x8 kf[2 * ND]; s16x4 vf[16];
    f32x16 p0 = f32x16{}, p1 = f32x16{};
    u32x4 pw[4] = {};
#define ATT_KEEP_PV() do { asm volatile("" :: "v"(pw[0]), "v"(pw[1]), "v"(pw[2]), "v"(pw[3])); \
        asm volatile("" :: "v"(vf[0]), "v"(vf[1]), "v"(vf[2]), "v"(vf[3]), "v"(vf[4]), "v"(vf[5]), "v"(vf[6]), "v"(vf[7]), "v"(vf[8]), "v"(vf[9]), "v"(vf[10]), "v"(vf[11]), "v"(vf[12]), "v"(vf[13]), "v"(vf[14]), "v"(vf[15])); } while (0)
#define ATT_KEEP_K() do { if constexpr (ND == 4) asm volatile("" :: "v"(kf[0]), "v"(kf[1]), "v"(kf[2]), "v"(kf[3]), "v"(kf[4]), "v"(kf[5]), "v"(kf[6]), "v"(kf[7])); \
        else asm volatile("" :: "v"(kf[0]), "v"(kf[1]), "v"(kf[2]), "v"(kf[3]), "v"(kf[4]), "v"(kf[5]), "v"(kf[6]), "v"(kf[7]), "v"(kf[8 % (2 * ND)]), "v"(kf[9 % (2 * ND)]), "v"(kf[10 % (2 * ND)]), "v"(kf[11 % (2 * ND)])); } while (0)
    ATT_WAITBAR();
    static_assert(MODE == 1, "this unit is the neighbourhood one: step j of a wave = its j-th window row");
    int islot = 5;
    for (int j = 0; j < 8; ++j) {
        const int t = rs + j;
        const int rel = t - tlo; const int buf = rel >= 6 ? rel - 6 : rel;
        const bool issued = tlo + j + 5 <= thi;
        if (issued) { ATT_ISSUE_K(tlo + j + 5, islot * KSLOT); ATT_ISSUE_V(tlo + j + 5, islot * VSLOT); }
        islot = (islot == 5) ? 0 : islot + 1;
        const bool act = true;
        if (act) { ATT_KRD(buf * KSLOT); ATT_QKM(p0, p1); if (MODE == 0) ATT_VRD(buf * VSLOT); }
        __builtin_amdgcn_sched_barrier(0);
        if (act) {
            if (MODE == 1) {
                float bb[32];
                const ALAS unsigned char* rb = shm + L_RPB + (t - wrow + 7) * 128;
#pragma unroll
                for (int e = 0; e < 16; ++e) { bb[e] = N0(e) ? *(const ALAS float*)(rb + co[e]) : 0.f; bb[16 + e] = N1(e) ? *(const ALAS float*)(rb + co[16 + e]) : 0.f; }
#pragma unroll
                for (int e = 0; e < 16; ++e) { if (N0(e)) p0[e] += bb[e]; if (N1(e)) p1[e] += bb[16 + e]; }
                ATT_VRD(buf * VSLOT);
            }
            float rm0 = -INFINITY, rm1 = -INFINITY;
#pragma unroll
            for (int r = 0; r < 16; r += 2) { if (N0(r)) rm0 = fmaxf(fmaxf(rm0, p0[r]), p0[r + 1]); if (N1(r)) rm1 = fmaxf(fmaxf(rm1, p1[r]), p1[r + 1]); }
            float rm = fmaxf(rm0, rm1);
            rm = xhalf_max(rm);
            if (first || __any(rm > THR)) {
                const float dl = first ? rm : fmaxf(rm, 0.f);
                mhat += dl;
#pragma unroll
                for (int r = 0; r < 16; ++r) { if (N0(r)) p0[r] -= dl; if (N1(r)) p1[r] -= dl; negm[r] = -mhat; }
                if (!first) { const float f = exp2f(-dl); l_reg *= f; if (hi == 0) wsf[r32] = f;
#pragma unroll
                    for (int r = 0; r < 16; ++r) { const float fr_ = wsf[crow(r, hi)]; o[0][r] *= fr_; o[1][r] *= fr_; } }
                first = false;
            }
            float sa0 = 0.f, sa1 = 0.f, sa2 = 0.f, sa3 = 0.f;
#pragma unroll
            for (int r = 0; r < 16; r += 4) { if (N0(r)) { p0[r] = __builtin_amdgcn_exp2f(p0[r]); p0[r + 1] = __builtin_amdgcn_exp2f(p0[r + 1]); p0[r + 2] = __builtin_amdgcn_exp2f(p0[r + 2]); p0[r + 3] = __builtin_amdgcn_exp2f(p0[r + 3]);
                sa0 += p0[r]; sa1 += p0[r + 1]; sa2 += p0[r + 2]; sa3 += p0[r + 3]; } else { p0[r] = 0.f; p0[r + 1] = 0.f; p0[r + 2] = 0.f; p0[r + 3] = 0.f; } }
#pragma unroll
            for (int j = 0; j < 4; ++j) { pw[0][j] = cvtpk_s(p0[2 * j], p0[2 * j + 1]); pw[1][j] = cvtpk_s(p0[8 + 2 * j], p0[8 + 2 * j + 1]); }
            ATT_VWAIT();
#pragma unroll
            for (int kg = 0; kg < 2; ++kg)
#pragma unroll
                for (int dh = 0; dh < 2; ++dh) if (NKG(kg)) o[dh] = __builtin_amdgcn_mfma_f32_32x32x16_bf16(__builtin_bit_cast(bf16x8, pw[kg]), ATT_VF(kg, dh), o[dh], 0, 0, 0);
            __builtin_amdgcn_sched_barrier(0);
#pragma unroll
            for (int r = 0; r < 16; r += 4) { if (N1(r)) { p1[r] = __builtin_amdgcn_exp2f(p1[r]); p1[r + 1] = __builtin_amdgcn_exp2f(p1[r + 1]); p1[r + 2] = __builtin_amdgcn_exp2f(p1[r + 2]); p1[r + 3] = __builtin_amdgcn_exp2f(p1[r + 3]);
                sa0 += p1[r]; sa1 += p1[r + 1]; sa2 += p1[r + 2]; sa3 += p1[r + 3]; } else { p1[r] = 0.f; p1[r + 1] = 0.f; p1[r + 2] = 0.f; p1[r + 3] = 0.f; } }
            l_reg += (sa0 + sa1) + (sa2 + sa3);
#pragma unroll
            for (int j = 0; j < 4; ++j) { pw[2][j] = cvtpk_s(p1[2 * j], p1[2 * j + 1]); pw[3][j] = cvtpk_s(p1[8 + 2 * j], p1[8 + 2 * j + 1]); }
#pragma unroll
            for (int kg = 2; kg < 4; ++kg)
#pragma unroll
                for (int dh = 0; dh < 2; ++dh) if (NKG(kg)) o[dh] = __builtin_amdgcn_mfma_f32_32x32x16_bf16(__builtin_bit_cast(bf16x8, pw[kg]), ATT_VF(kg, dh), o[dh], 0, 0, 0);
        }
        if (issued) asm volatile("s_waitcnt vmcnt(2) lgkmcnt(0)\n\ts_barrier" ::: "memory");
        else ATT_WAITBAR();
    }
#undef ATT_KEEP_PV
#undef ATT_KEEP_K
#undef ATT_KRD
#undef ATT_QK2
#undef ATT_QKM
#undef ATT_VRD
#undef ATT_VWAIT
#undef ATT_VF
#undef ATT_QK
#undef ATT_ACTIVE
#undef N0
#undef N1
#undef NKG
    if (has_next) {
        const bf16_t* nk0 = nx.K0 + (nx.rowbase + lane) * (long)nx.k0p + wid * 8;
        const bf16_t* nk1 = nx.K1 + (nx.rowbase + lane) * (long)nx.k1p + (wid & 3) * 8;
        const bf16_t* nv = nx.V + (nx.rowbase + 16 * (wid & 3) + (lane >> 2)) * (long)nx.vp + (wid >> 2) * 32 + (lane & 3) * 8;
#pragma unroll
        for (int i = 0; i < 5; ++i) if (nx.tlo + i <= nx.thi) {
            dma16(nk0 + (long)(nx.tlo + i) * 64 * nx.k0p, shm + L_K + i * KSLOT + wid * 1024);
            if (nx.dqk == 96) dma16(nk1 + (long)(nx.tlo + i) * 64 * nx.k1p, shm + L_K + i * KSLOT + (8 + (wid & 3)) * 1024);
            dma16(nv + (long)(nx.tlo + i) * 64 * nx.vp, shm + L_V + i * VSLOT + wid * 1024); }
    }
    l_reg = xhalf_sum(l_reg);
    if (hi == 0) wsf[32 + r32] = l_reg;
    float rli[16];
#pragma unroll
    for (int r = 0; r < 16; ++r) rli[r] = 1.0f / wsf[32 + crow(r, hi)];
    bf16_t* Ow = d.O + (rowbase + q0 + wid * 32) * (long)d.op;
    { ALAS bf16_t* stg = (ALAS bf16_t*)(shm + L_OST) + wid * 2048;
#pragma unroll
      for (int r = 0; r < 16; ++r) { const int orow = crow(r, hi);
#pragma unroll
          for (int dh = 0; dh < 2; ++dh) stg[orow * 64 + dh * 32 + r32] = (bf16_t)(cvtpk_s(o[dh][r] * rli[r], 0.f) & 0xffffu); }
      asm volatile("s_waitcnt lgkmcnt(0)" ::: "memory");
#pragma unroll
      for (int i = 0; i < 4; ++i) { const int row = i * 8 + (lane >> 3), ch = lane & 7; const u32x4 v = *(const ALAS u32x4*)(stg + row * 64 + ch * 8); *(u32x4*)(Ow + (long)row * d.op + ch * 8) = v; } }
    asm volatile("s_waitcnt lgkmcnt(0)\n\ts_barrier" ::: "memory");
#undef ATT_ISSUE_K
#undef ATT_ISSUE_V
#undef ATT_WAITBAR
}
}

namespace attn_ex {
using bf16=__hip_bfloat16;
using bf16x8=__attribute__((ext_vector_type(8)))short;
using s16x4=__attribute__((ext_vector_type(4)))short;
using f32x16=__attribute__((ext_vector_type(16)))float;
using u32x4=__attribute__((ext_vector_type(4)))unsigned;
constexpr int SEQ=8192,D=64;
constexpr int NW=8,QBLK=32,QB=QBLK*NW,KVBLK=64,NQB=SEQ/QB;
constexpr int ATTN_UNIT_ROWS=QB;
__device__ __forceinline__ int crow(int r,int hi){return (r&3)+8*(r>>2)+4*hi;}
#define SBAR() __builtin_amdgcn_sched_barrier(0)
__device__ __forceinline__ void cmask(f32x16&p0,f32x16&p1,int jb,int qrel,int hi){
  const float NEG=-INFINITY; int kb=64*jb+4*hi;
  #pragma unroll
  for(int r=0;r<16;++r){int kv=kb+(r&3)+8*(r>>2); if(kv>qrel)p0[r]=NEG; if(kv+32>qrel)p1[r]=NEG;}
}

constexpr int NSLOT=3, SLOTB=8192;
constexpr int LDS_K=0, LDS_V=NSLOT*SLOTB, LDS_WS=2*NSLOT*SLOTB, LDS_OST=LDS_WS+NW*64*4, LDS_BYTES=LDS_OST+NW*4096;
constexpr float C2=0.125f*1.4426950408889634f;
__device__ __forceinline__ void glds16(const void*gsrc,unsigned lds_dst){unsigned keep;
  asm volatile("s_mov_b32 %0, m0\n\ts_mov_b32 m0, %2\n\ts_nop 0\n\tglobal_load_lds_dwordx4 %1, off\n\ts_mov_b32 m0, %0":"=&s"(keep):"v"(gsrc),"s"(lds_dst):"memory");}
__device__ __forceinline__ float max3f(float a,float b,float c){float r;asm("v_max3_f32 %0, %1, %2, %3":"=v"(r):"v"(a),"v"(b),"v"(c));return r;}
__device__ __forceinline__ float max2f(float a,float b){float r;asm("v_max_f32_e32 %0, %1, %2":"=v"(r):"v"(a),"v"(b));return r;}
__device__ __forceinline__ float fadd_s(float a,float b){float r;asm("v_add_f32_e32 %0, %1, %2":"=v"(r):"v"(a),"v"(b));return r;}
__device__ __forceinline__ float fsub_s(float a,float b){float r;asm("v_sub_f32_e32 %0, %1, %2":"=v"(r):"v"(a),"v"(b));return r;}
typedef float f32x2_t __attribute__((ext_vector_type(2))); typedef __bf16 bf16x2_t __attribute__((ext_vector_type(2)));
__device__ __forceinline__ unsigned cvtpk_s(float lo,float hi){f32x2_t v={lo,hi};bf16x2_t b=__builtin_convertvector(v,bf16x2_t);return __builtin_bit_cast(unsigned,b);}
#define WAIT_BAR(N) asm volatile("s_waitcnt vmcnt(" #N ") lgkmcnt(0)\n\ts_barrier":::"memory")

__device__ __forceinline__ void qkt(f32x16&p0,f32x16&p1,const char*Kslot,const bf16x8*qr,const f32x16&negm,int r32,int hi){
  const char*kb=Kslot+hi*1024+r32*16;
  #pragma unroll
  for(int d0=0;d0<4;++d0){
    const bf16x8 b0=*reinterpret_cast<const bf16x8*>(kb+d0*2048);
    const bf16x8 b1=*reinterpret_cast<const bf16x8*>(kb+d0*2048+512);
    if(d0==0){p0=__builtin_amdgcn_mfma_f32_32x32x16_bf16(b0,qr[0],negm,0,0,0);p1=__builtin_amdgcn_mfma_f32_32x32x16_bf16(b1,qr[0],negm,0,0,0);}
    else{p0=__builtin_amdgcn_mfma_f32_32x32x16_bf16(b0,qr[d0],p0,0,0,0);p1=__builtin_amdgcn_mfma_f32_32x32x16_bf16(b1,qr[d0],p1,0,0,0);}}
}
typedef __attribute__((address_space(3))) const char* lds_cptr;
typedef short v4i16_t __attribute__((ext_vector_type(4)));
__device__ __forceinline__ void kload8(bf16x8*kf,lds_cptr kp){
  kf[0]=*(const __attribute__((address_space(3))) bf16x8*)(kp);      kf[1]=*(const __attribute__((address_space(3))) bf16x8*)(kp+512);
  kf[2]=*(const __attribute__((address_space(3))) bf16x8*)(kp+2048); kf[3]=*(const __attribute__((address_space(3))) bf16x8*)(kp+2560);
  kf[4]=*(const __attribute__((address_space(3))) bf16x8*)(kp+4096); kf[5]=*(const __attribute__((address_space(3))) bf16x8*)(kp+4608);
  kf[6]=*(const __attribute__((address_space(3))) bf16x8*)(kp+6144); kf[7]=*(const __attribute__((address_space(3))) bf16x8*)(kp+6656);
}
__device__ __forceinline__ void kload2(bf16x8*kf,lds_cptr kp,int j){ kf[2*j]=*(const __attribute__((address_space(3))) bf16x8*)(kp+j*2048); kf[2*j+1]=*(const __attribute__((address_space(3))) bf16x8*)(kp+j*2048+512); }
__device__ __forceinline__ s16x4 vtr(lds_cptr p){ return __builtin_bit_cast(s16x4,__builtin_amdgcn_ds_read_tr16_b64_v4i16((__attribute__((address_space(3))) v4i16_t*)p)); }
__device__ __forceinline__ float rowmax(const f32x16&p0,const f32x16&p1){
  float a=max3f(p0[0],p0[1],p1[0]),b=max3f(p0[2],p0[3],p1[1]);a=max3f(a,p1[2],p1[3]);
  #pragma unroll
  for(int r=4;r<16;r+=4){a=max3f(a,p0[r],p0[r+1]);b=max3f(b,p0[r+2],p0[r+3]);a=max3f(a,p1[r],p1[r+1]);b=max3f(b,p1[r+2],p1[r+3]);}
  const float m=max2f(a,b);
  auto rr=__builtin_amdgcn_permlane32_swap(__float_as_uint(m),__float_as_uint(m),false,false);
  return max2f(__uint_as_float(rr[0]),__uint_as_float(rr[1]));
}
__device__ __forceinline__ void pv(f32x16*o,int vb,bf16x8 pa0,bf16x8 pa1,bf16x8 pa2,bf16x8 pa3){
  #pragma unroll
  for(int d0=0;d0<2;++d0){s16x4 lo[4],hi[4];
    #pragma unroll
    for(int ks=0;ks<4;++ks){
      asm volatile("ds_read_b64_tr_b16 %0,%1 offset:%c2":"=&v"(lo[ks]):"v"(vb),"i"(d0*4096+ks*1024):"memory");
      asm volatile("ds_read_b64_tr_b16 %0,%1 offset:%c2":"=&v"(hi[ks]):"v"(vb),"i"(d0*4096+ks*1024+512):"memory");}
    asm volatile("s_waitcnt lgkmcnt(0)":::"memory");SBAR();
    #define PK(k) (bf16x8){lo[k][0],lo[k][1],lo[k][2],lo[k][3],hi[k][0],hi[k][1],hi[k][2],hi[k][3]}
    o[d0]=__builtin_amdgcn_mfma_f32_32x32x16_bf16(pa0,PK(0),o[d0],0,0,0);
    o[d0]=__builtin_amdgcn_mfma_f32_32x32x16_bf16(pa1,PK(1),o[d0],0,0,0);
    o[d0]=__builtin_amdgcn_mfma_f32_32x32x16_bf16(pa2,PK(2),o[d0],0,0,0);
    o[d0]=__builtin_amdgcn_mfma_f32_32x32x16_bf16(pa3,PK(3),o[d0],0,0,0);
    #undef PK
  }
}

#ifndef ATTN_STORE16
#define ATTN_STORE16(p,v) (*(u32x4*)(p)=(v))
#endif
template<int THRL,int QP,int KP,int VP,int OP> __device__ __forceinline__ void attn_unit(const bf16*Qb,const bf16*__restrict__ Kh,const bf16*__restrict__ Vh,bf16*Ob,char*shm){
  const int tid=threadIdx.x,lane=tid&63,r32=lane&31,hi=lane>>5; const int wid=__builtin_amdgcn_readfirstlane(tid>>6);
  const bf16*Qw=Qb+(long)(wid*QBLK)*QP;
  const unsigned lds0=(unsigned)(uintptr_t)shm;
  float*wsf=(float*)(shm+LDS_WS)+wid*64;
  const bf16*ksrc=Kh+(long)lane*KP+wid*8;
  const bf16*vsrc=Vh+(long)(16*(wid&3)+(lane>>2))*VP+(wid>>2)*32+(lane&3)*8;
  const unsigned kdst=lds0+LDS_K+wid*1024, vdst=lds0+LDS_V+wid*1024;
  #define DMA_K(t,slot) glds16(ksrc+(long)(t)*KVBLK*KP,(unsigned)__builtin_amdgcn_readfirstlane(kdst+(slot)))
  #define DMA_V(t,slot) glds16(vsrc+(long)(t)*KVBLK*VP,(unsigned)__builtin_amdgcn_readfirstlane(vdst+(slot)))
  const int vb0=(int)(lds0+LDS_V)+((lane>>4)&1)*32+(lane&3)*8+(4*hi+((lane&15)>>2))*64;
  const char*Kbase=shm+LDS_K; bf16x8 kf[8];
  const lds_cptr shm3=(lds_cptr)shm; const lds_cptr kp0=shm3+LDS_K+hi*1024+r32*16; const lds_cptr vp0=shm3+LDS_V+((lane>>4)&1)*32+(lane&3)*8+(4*hi+((lane&15)>>2))*64;
  constexpr int NT=SEQ/KVBLK;
  DMA_K(0,0);DMA_V(0,0);DMA_K(1,SLOTB);
  bf16x8 qr[4];
  #pragma unroll
  for(int d0=0;d0<4;++d0)qr[d0]=*reinterpret_cast<const bf16x8*>(&Qw[(long)r32*QP+d0*16+hi*8]);
  float mhat=0.f,l_reg=0.f;f32x16 o[2];o[0]=f32x16{};o[1]=f32x16{};f32x16 negm=f32x16{};asm volatile("":"+v"(negm));
  #define CMASK(P0,P1,t) do{}while(0)
  bool resc=false;
  #define START(P0,P1) do{ const float rm=rowmax(P0,P1); resc=false; \
    { const float dl=rm; mhat=fadd_s(mhat,dl); \
      _Pragma("unroll") for(int r=0;r<16;++r){P0[r]=fsub_s(P0[r],dl);P1[r]=fsub_s(P1[r],dl);} \
      _Pragma("unroll") for(int r=0;r<16;++r)negm[r]=-mhat; asm volatile("":"+v"(negm)); } \
    _Pragma("unroll") for(int r=0;r<16;++r)P0[r]=__builtin_amdgcn_exp2f(P0[r]); }while(0)
  #define RESC() do{ if(resc){ asm volatile("s_waitcnt lgkmcnt(0)":::"memory"); \
      _Pragma("unroll") for(int d_=0;d_<2;++d_) _Pragma("unroll") for(int r=0;r<16;++r)o[d_][r]*=wsf[crow(r,hi)]; } }while(0)
  f32x16 pA0,pA1,pB0,pB1;
  int sl_prev=0,sl_cur=0,sl_next=SLOTB;
  #define ROT() do{sl_prev=sl_cur;sl_cur=sl_next;sl_next=(sl_next==(NSLOT-1)*SLOTB)?0:sl_next+SLOTB;}while(0)
  DMA_K(2,2*SLOTB);
  WAIT_BAR(3);
  qkt(pA0,pA1,Kbase,qr,negm,r32,hi);asm volatile("s_nop 15\n\ts_nop 7":"+v"(pA0),"+v"(pA1));CMASK(pA0,pA1,0);
  START(pA0,pA1);
  _Pragma("unroll") for(int r=0;r<16;++r)pA1[r]=__builtin_amdgcn_exp2f(pA1[r]);
  WAIT_BAR(0);
  DMA_K(3,0);DMA_V(1,SLOTB);
  ROT();
  kload8(kf,kp0+sl_cur);
  WAIT_BAR(2);
  s16x4 vlo[8],vhi[8]; u32x4 pw0,pw1,pw2,pw3;
  #define PKW(P,B) cvtpk_s(P[B],P[B+1])
  #define PAF(k) __builtin_bit_cast(bf16x8,pw##k)
  #define VFR(i) (bf16x8){vlo[i][0],vlo[i][1],vlo[i][2],vlo[i][3],vhi[i][0],vhi[i][1],vhi[i][2],vhi[i][3]}
  #define PIN(x) asm volatile("":"+v"(x))
  #define MX3(a,b,c) __builtin_fmaxf(__builtin_fmaxf((a),(b)),(c))
  #define GAPA(MF,A0,A1,A2,A3,W0,W1,PW) do{ MF; sacc+=A0; sacc+=A1; sacc+=A2; sacc+=A3; PIN(sacc); W0; W1; PIN(PW); SBAR(); }while(0)
  #define EX(v) __builtin_amdgcn_exp2f(v)
  #define GAPB(MF,X,B) do{ MF; X[B]=EX(X[B]); X[B+1]=EX(X[B+1]); X[B+2]=EX(X[B+2]); X[B+3]=EX(X[B+3]); PIN(X); SBAR(); }while(0)
  #define VRD(i) do{ vlo[i]=vtr(vp_+(((i)>>2)*4096+((i)&3)*1024)); vhi[i]=vtr(vp_+(((i)>>2)*4096+((i)&3)*1024+512)); }while(0)
  #define KRD(G,j) do{ if(G){ kload2(kf,kp0+sl_next,j); SBAR(); } }while(0)
  #define STEP(C0,C1,P0,P1,t,GK,GV,GL) do{ SBAR(); \
    const lds_cptr vp_=vp0+sl_prev; \
    VRD(0); SBAR(); float sacc=(P0[0]+P0[1]); \
    GAPA(C0=__builtin_amdgcn_mfma_f32_32x32x16_bf16(kf[0],qr[0],negm,0,0,0), P0[2],P0[3],P0[4],P0[5],     pw0[0]=PKW(P0,0), pw0[1]=PKW(P0,2), pw0); \
    VRD(4); SBAR(); GAPA(C1=__builtin_amdgcn_mfma_f32_32x32x16_bf16(kf[1],qr[0],negm,0,0,0), P0[6],P0[7],P0[8],P0[9],     pw0[2]=PKW(P0,4), pw0[3]=PKW(P0,6), pw0); \
    VRD(1); SBAR(); GAPA(C0=__builtin_amdgcn_mfma_f32_32x32x16_bf16(kf[2],qr[1],C0,0,0,0),   P0[10],P0[11],P0[12],P0[13], pw1[0]=PKW(P0,8), pw1[1]=PKW(P0,10), pw1); \
    VRD(5); SBAR(); GAPA(C1=__builtin_amdgcn_mfma_f32_32x32x16_bf16(kf[3],qr[1],C1,0,0,0),   P0[14],P0[15],P1[0],P1[1],   pw1[2]=PKW(P0,12),pw1[3]=PKW(P0,14), pw1); \
    VRD(2); SBAR(); GAPA(C0=__builtin_amdgcn_mfma_f32_32x32x16_bf16(kf[4],qr[2],C0,0,0,0),   P1[2],P1[3],P1[4],P1[5],     pw2[0]=PKW(P1,0), pw2[1]=PKW(P1,2), pw2); \
    VRD(6); SBAR(); GAPA(C1=__builtin_amdgcn_mfma_f32_32x32x16_bf16(kf[5],qr[2],C1,0,0,0),   P1[6],P1[7],P1[8],P1[9],     pw2[2]=PKW(P1,4), pw2[3]=PKW(P1,6), pw2); \
    VRD(3); SBAR(); GAPA(C0=__builtin_amdgcn_mfma_f32_32x32x16_bf16(kf[6],qr[3],C0,0,0,0),   P1[10],P1[11],P1[12],P1[13], pw3[0]=PKW(P1,8), pw3[1]=PKW(P1,10), pw3); \
    VRD(7); SBAR(); GAPA(C1=__builtin_amdgcn_mfma_f32_32x32x16_bf16(kf[7],qr[3],C1,0,0,0),   P1[14],P1[15],0.f,0.f,       pw3[2]=PKW(P1,12),pw3[3]=PKW(P1,14), pw3); \
    l_reg+=sacc; \
    if(GK){DMA_K((t)+3,sl_cur);} if(GV){DMA_V((t)+1,sl_next);} \
    CMASK(C0,C1,t); \
    { float a=MX3(C0[0],C0[1],C1[0]),b=MX3(C0[2],C0[3],C1[1]); a=MX3(a,C1[2],C1[3]); \
      _Pragma("unroll") for(int r=4;r<16;r+=4){a=MX3(a,C0[r],C0[r+1]);b=MX3(b,C0[r+2],C0[r+3]);a=MX3(a,C1[r],C1[r+1]);b=MX3(b,C1[r+2],C1[r+3]);} \
      float rm=__builtin_fmaxf(a,b); { auto rr=__builtin_amdgcn_permlane32_swap(__float_as_uint(rm),__float_as_uint(rm),false,false); rm=__builtin_fmaxf(__uint_as_float(rr[0]),__uint_as_float(rr[1])); } \
      resc=false; \
      if(__builtin_expect(__any(rm>(float)THRL),0)){ const float dl=__builtin_fmaxf(rm,0.f); mhat+=dl; \
        _Pragma("unroll") for(int r=0;r<16;++r){C0[r]-=dl;C1[r]-=dl;} \
        _Pragma("unroll") for(int r=0;r<16;++r)negm[r]=-mhat; asm volatile("":"+v"(negm)); \
        const float f=__builtin_amdgcn_exp2f(-dl); l_reg*=f; if(hi==0)wsf[r32]=f; resc=true; } } \
    SBAR(); \
    GAPB(o[0]=__builtin_amdgcn_mfma_f32_32x32x16_bf16(PAF(0),VFR(0),o[0],0,0,0), C0,0); \
    GAPB(o[1]=__builtin_amdgcn_mfma_f32_32x32x16_bf16(PAF(0),VFR(4),o[1],0,0,0), C0,4); \
    KRD(GL,0); GAPB(o[0]=__builtin_amdgcn_mfma_f32_32x32x16_bf16(PAF(1),VFR(1),o[0],0,0,0), C0,8); \
    KRD(GL,1); GAPB(o[1]=__builtin_amdgcn_mfma_f32_32x32x16_bf16(PAF(1),VFR(5),o[1],0,0,0), C0,12); \
    KRD(GL,2); GAPB(o[0]=__builtin_amdgcn_mfma_f32_32x32x16_bf16(PAF(2),VFR(2),o[0],0,0,0), C1,0); \
    KRD(GL,3); GAPB(o[1]=__builtin_amdgcn_mfma_f32_32x32x16_bf16(PAF(2),VFR(6),o[1],0,0,0), C1,4); \
    GAPB(o[0]=__builtin_amdgcn_mfma_f32_32x32x16_bf16(PAF(3),VFR(3),o[0],0,0,0), C1,8); \
    GAPB(o[1]=__builtin_amdgcn_mfma_f32_32x32x16_bf16(PAF(3),VFR(7),o[1],0,0,0), C1,12); \
    }while(0)
  int t=1;
  #undef CMASK
  #define CMASK(P0,P1,t) do{}while(0)
  for(;t+5<NT;t+=2){
    STEP(pB0,pB1,pA0,pA1,t,true,true,true);     WAIT_BAR(2); RESC(); ROT();
    STEP(pA0,pA1,pB0,pB1,t+1,true,true,true);   WAIT_BAR(2); RESC(); ROT();
  }
  #undef CMASK
  #define CMASK(P0,P1,t) do{}while(0)
  #define ENDW(tt) do{ if((tt)+3<NT){WAIT_BAR(2);} else if((tt)+2<NT){WAIT_BAR(1);} else {WAIT_BAR(0);} }while(0)
  for(;t+1<NT;t+=2){
    STEP(pB0,pB1,pA0,pA1,t,(t+3<NT),(t+1<NT),(t+1<NT));       ENDW(t);   RESC(); ROT();
    STEP(pA0,pA1,pB0,pB1,t+1,(t+4<NT),(t+2<NT),(t+2<NT));     ENDW(t+1); RESC(); ROT();
  }
  STEP(pB0,pB1,pA0,pA1,NT-1,false,false,false); RESC();
  { float sacc=pB0[0]+pB0[1]; _Pragma("unroll") for(int r=2;r<16;++r)sacc+=pB0[r]; _Pragma("unroll") for(int r=0;r<16;++r)sacc+=pB1[r]; l_reg+=sacc;
    pw0=(u32x4){PKW(pB0,0),PKW(pB0,2),PKW(pB0,4),PKW(pB0,6)};pw1=(u32x4){PKW(pB0,8),PKW(pB0,10),PKW(pB0,12),PKW(pB0,14)};pw2=(u32x4){PKW(pB1,0),PKW(pB1,2),PKW(pB1,4),PKW(pB1,6)};pw3=(u32x4){PKW(pB1,8),PKW(pB1,10),PKW(pB1,12),PKW(pB1,14)};
    SBAR(); pv(o,vb0+sl_cur,PAF(0),PAF(1),PAF(2),PAF(3)); }
  #undef PKW
  #undef PAF
  #undef VFR
  #undef PIN
  #undef MX3
  #undef GAPA
  #undef GAPB
  #undef EX
  #undef VRD
  #undef KRD
  #undef STEP
  #undef ENDW
  {auto rr=__builtin_amdgcn_permlane32_swap(__float_as_uint(l_reg),__float_as_uint(l_reg),false,false);l_reg=__uint_as_float(rr[0])+__uint_as_float(rr[1]);}
  if(hi==0)wsf[32+r32]=l_reg;asm volatile("s_waitcnt lgkmcnt(0)":::"memory");
  float rli[16];
  #pragma unroll
  for(int r=0;r<16;++r)rli[r]=__builtin_amdgcn_rcpf(wsf[32+crow(r,hi)]);
  bf16*Ow=Ob+(long)(wid*QBLK)*OP;
  { bf16*stg=(bf16*)(shm+LDS_OST)+wid*2048;
    #pragma unroll
    for(int r=0;r<16;++r){const int orow=crow(r,hi);
      #pragma unroll
      for(int d0=0;d0<2;++d0)stg[orow*64+d0*32+r32]=__float2bfloat16(o[d0][r]*rli[r]);}
    asm volatile("s_waitcnt lgkmcnt(0)":::"memory");
    #pragma unroll
    for(int i=0;i<4;++i){const int row=i*8+(lane>>3),ch=lane&7; const u32x4 v=*(const u32x4*)(stg+row*64+ch*8); ATTN_STORE16(Ow+(long)row*OP+ch*8,v);} }
  asm volatile("s_waitcnt lgkmcnt(0)\n\ts_barrier":::"memory");
  #undef DMA_K
  #undef DMA_V
  #undef CMASK
  #undef START
  #undef RESC
  #undef ROT
}
constexpr int ATTN_LDS_BYTES=LDS_BYTES;
#undef SBAR
#undef WAIT_BAR
}

namespace attn_ex96 {
using bf16=__hip_bfloat16;
using bf16x8=__attribute__((ext_vector_type(8)))short;
using s16x4=__attribute__((ext_vector_type(4)))short;
using f32x16=__attribute__((ext_vector_type(16)))float;
using u32x4=__attribute__((ext_vector_type(4)))unsigned;
constexpr int SEQ=8192,D=64;
constexpr int NW=8,QBLK=32,QB=QBLK*NW,KVBLK=64,NQB=SEQ/QB;
constexpr int ATTN_UNIT_ROWS=QB;
__device__ __forceinline__ int crow(int r,int hi){return (r&3)+8*(r>>2)+4*hi;}
#define SBAR() __builtin_amdgcn_sched_barrier(0)
__device__ __forceinline__ void cmask(f32x16&p0,f32x16&p1,int jb,int qrel,int hi){
  const float NEG=-INFINITY; int kb=64*jb+4*hi;
  #pragma unroll
  for(int r=0;r<16;++r){int kv=kb+(r&3)+8*(r>>2); if(kv>qrel)p0[r]=NEG; if(kv+32>qrel)p1[r]=NEG;}
}

constexpr int NSLOT=3, SLOTB=12288;
constexpr int LDS_K=0, LDS_V=NSLOT*SLOTB, LDS_WS=2*NSLOT*SLOTB, LDS_OST=LDS_WS+NW*64*4, LDS_BYTES=LDS_OST+NW*4096;
constexpr float C2=0.125f*1.4426950408889634f;
__device__ __forceinline__ void glds16(const void*gsrc,unsigned lds_dst){unsigned keep;
  asm volatile("s_mov_b32 %0, m0\n\ts_mov_b32 m0, %2\n\ts_nop 0\n\tglobal_load_lds_dwordx4 %1, off\n\ts_mov_b32 m0, %0":"=&s"(keep):"v"(gsrc),"s"(lds_dst):"memory");}
__device__ __forceinline__ float max3f(float a,float b,float c){float r;asm("v_max3_f32 %0, %1, %2, %3":"=v"(r):"v"(a),"v"(b),"v"(c));return r;}
__device__ __forceinline__ float max2f(float a,float b){float r;asm("v_max_f32_e32 %0, %1, %2":"=v"(r):"v"(a),"v"(b));return r;}
__device__ __forceinline__ float fadd_s(float a,float b){float r;asm("v_add_f32_e32 %0, %1, %2":"=v"(r):"v"(a),"v"(b));return r;}
__device__ __forceinline__ float fsub_s(float a,float b){float r;asm("v_sub_f32_e32 %0, %1, %2":"=v"(r):"v"(a),"v"(b));return r;}
typedef float f32x2_t __attribute__((ext_vector_type(2))); typedef __bf16 bf16x2_t __attribute__((ext_vector_type(2)));
__device__ __forceinline__ unsigned cvtpk_s(float lo,float hi){f32x2_t v={lo,hi};bf16x2_t b=__builtin_convertvector(v,bf16x2_t);return __builtin_bit_cast(unsigned,b);}
#define WAIT_BAR(N) asm volatile("s_waitcnt vmcnt(" #N ") lgkmcnt(0)\n\ts_barrier":::"memory")

__device__ __forceinline__ void qkt(f32x16&p0,f32x16&p1,const char*Kslot,const bf16x8*qr,int r32,int hi){ const f32x16 zero=f32x16{};
  const char*kb=Kslot+hi*1024+r32*16;
  #pragma unroll
  for(int d0=0;d0<6;++d0){
    const bf16x8 b0=*reinterpret_cast<const bf16x8*>(kb+d0*2048);
    const bf16x8 b1=*reinterpret_cast<const bf16x8*>(kb+d0*2048+512);
    if(d0==0){p0=__builtin_amdgcn_mfma_f32_32x32x16_bf16(b0,qr[0],zero,0,0,0);p1=__builtin_amdgcn_mfma_f32_32x32x16_bf16(b1,qr[0],zero,0,0,0);}
    else{p0=__builtin_amdgcn_mfma_f32_32x32x16_bf16(b0,qr[d0],p0,0,0,0);p1=__builtin_amdgcn_mfma_f32_32x32x16_bf16(b1,qr[d0],p1,0,0,0);}}
}
typedef __attribute__((address_space(3))) const char* lds_cptr;
typedef short v4i16_t __attribute__((ext_vector_type(4)));
__device__ __forceinline__ void kload8(bf16x8*kf,lds_cptr kp){
  kf[0]=*(const __attribute__((address_space(3))) bf16x8*)(kp);      kf[1]=*(const __attribute__((address_space(3))) bf16x8*)(kp+512);
  kf[2]=*(const __attribute__((address_space(3))) bf16x8*)(kp+2048); kf[3]=*(const __attribute__((address_space(3))) bf16x8*)(kp+2560);
  kf[4]=*(const __attribute__((address_space(3))) bf16x8*)(kp+4096); kf[5]=*(const __attribute__((address_space(3))) bf16x8*)(kp+4608);
  kf[6]=*(const __attribute__((address_space(3))) bf16x8*)(kp+6144); kf[7]=*(const __attribute__((address_space(3))) bf16x8*)(kp+6656);
}
__device__ __forceinline__ void kload2(bf16x8*kf,lds_cptr kp,int j){ kf[2*j]=*(const __attribute__((address_space(3))) bf16x8*)(kp+j*2048); kf[2*j+1]=*(const __attribute__((address_space(3))) bf16x8*)(kp+j*2048+512); }
__device__ __forceinline__ s16x4 vtr(lds_cptr p){ return __builtin_bit_cast(s16x4,__builtin_amdgcn_ds_read_tr16_b64_v4i16((__attribute__((address_space(3))) v4i16_t*)p)); }
__device__ __forceinline__ float rowmax(const f32x16&p0,const f32x16&p1){
  float a=max3f(p0[0],p0[1],p1[0]),b=max3f(p0[2],p0[3],p1[1]);a=max3f(a,p1[2],p1[3]);
  #pragma unroll
  for(int r=4;r<16;r+=4){a=max3f(a,p0[r],p0[r+1]);b=max3f(b,p0[r+2],p0[r+3]);a=max3f(a,p1[r],p1[r+1]);b=max3f(b,p1[r+2],p1[r+3]);}
  const float m=max2f(a,b);
  auto rr=__builtin_amdgcn_permlane32_swap(__float_as_uint(m),__float_as_uint(m),false,false);
  return max2f(__uint_as_float(rr[0]),__uint_as_float(rr[1]));
}
__device__ __forceinline__ void pv(f32x16*o,int vb,bf16x8 pa0,bf16x8 pa1,bf16x8 pa2,bf16x8 pa3){
  #pragma unroll
  for(int d0=0;d0<2;++d0){s16x4 lo[4],hi[4];
    #pragma unroll
    for(int ks=0;ks<4;++ks){
      asm volatile("ds_read_b64_tr_b16 %0,%1 offset:%c2":"=&v"(lo[ks]):"v"(vb),"i"(d0*4096+ks*1024):"memory");
      asm volatile("ds_read_b64_tr_b16 %0,%1 offset:%c2":"=&v"(hi[ks]):"v"(vb),"i"(d0*4096+ks*1024+512):"memory");}
    asm volatile("s_waitcnt lgkmcnt(0)":::"memory");SBAR();
    #define PK(k) (bf16x8){lo[k][0],lo[k][1],lo[k][2],lo[k][3],hi[k][0],hi[k][1],hi[k][2],hi[k][3]}
    o[d0]=__builtin_amdgcn_mfma_f32_32x32x16_bf16(pa0,PK(0),o[d0],0,0,0);
    o[d0]=__builtin_amdgcn_mfma_f32_32x32x16_bf16(pa1,PK(1),o[d0],0,0,0);
    o[d0]=__builtin_amdgcn_mfma_f32_32x32x16_bf16(pa2,PK(2),o[d0],0,0,0);
    o[d0]=__builtin_amdgcn_mfma_f32_32x32x16_bf16(pa3,PK(3),o[d0],0,0,0);
    #undef PK
  }
}

#ifndef ATTN_STORE16
#define ATTN_STORE16(p,v) (*(u32x4*)(p)=(v))
#endif
template<int THRL,int QP,int KP,int VP,int OP> __device__ __forceinline__ void attn_unit(const bf16*Qb,const bf16*Qr,const bf16*__restrict__ Kh,const bf16*__restrict__ Kr,const bf16*__restrict__ Vh,bf16*Ob,int tq0,char*shm){
  const int tid=threadIdx.x,lane=tid&63,r32=lane&31,hi=lane>>5; const int wid=__builtin_amdgcn_readfirstlane(tid>>6);
  const bf16*Qw=Qb+(long)(wid*QBLK)*QP;
  const unsigned lds0=(unsigned)(uintptr_t)shm;
  float*wsf=(float*)(shm+LDS_WS)+wid*64;
  const bf16*ksrc=Kh+(long)lane*KP+wid*8; const bf16*rsrc=Kr+(long)lane*32+(wid&3)*8;
  const bf16*vsrc=Vh+(long)(16*(wid&3)+(lane>>2))*VP+(wid>>2)*32+(lane&3)*8;
  const unsigned kdst=lds0+LDS_K+wid*1024, vdst=lds0+LDS_V+wid*1024;
  #define DMA_KN(t,slot) glds16(ksrc+(long)(t)*KVBLK*KP,(unsigned)__builtin_amdgcn_readfirstlane(kdst+(slot)))
  #define DMA_R(t,slot) glds16(rsrc+(long)(t)*KVBLK*32,(unsigned)__builtin_amdgcn_readfirstlane(lds0+LDS_K+(8+(wid&3))*1024+(slot)))
  #define DMA_K(t,slot) do{ DMA_KN(t,slot); DMA_R(t,slot); }while(0)
  #define DMA_V(t,slot) glds16(vsrc+(long)(t)*KVBLK*VP,(unsigned)__builtin_amdgcn_readfirstlane(vdst+(slot)))
  const int vb0=(int)(lds0+LDS_V)+((lane>>4)&1)*32+(lane&3)*8+(4*hi+((lane&15)>>2))*64;
  const char*Kbase=shm+LDS_K; bf16x8 kf[8];
  const lds_cptr shm3=(lds_cptr)shm; const lds_cptr kp0=shm3+LDS_K+hi*1024+r32*16; const lds_cptr vp0=shm3+LDS_V+((lane>>4)&1)*32+(lane&3)*8+(4*hi+((lane&15)>>2))*64;
  constexpr int NT=SEQ/KVBLK;
  DMA_K(0,0);DMA_V(0,0);DMA_K(1,SLOTB);
  bf16x8 qr[6];
  #pragma unroll
  for(int d0=0;d0<4;++d0)qr[d0]=*reinterpret_cast<const bf16x8*>(&Qw[(long)r32*QP+d0*16+hi*8]);
  { const int tq=tq0+wid*QBLK+r32; const bf16*qp=Qr+(long)(wid*QBLK+r32)*QP+hi*8;
    #pragma unroll
    for(int dd=0;dd<2;++dd){ const bf16x8 raw=*reinterpret_cast<const bf16x8*>(qp+dd*16); const u32x4 w=__builtin_bit_cast(u32x4,raw); u32x4 pwx;
      #pragma unroll
      for(int j=0;j<4;++j)pwx[j]=(unsigned)__shfl_xor((int)w[j],32);
      const bf16x8 par=__builtin_bit_cast(bf16x8,pwx); const float pos=(dd==0)?(float)(tq>>6):(float)(tq&63); float ov[8];
      #pragma unroll
      for(int e=0;e<8;++e){ const float inv=exp2f(-(float)e*(13.287712379549449f/8.0f)); float s,c; att::sincos_acc(pos*inv,s,c);
        const float x=att::bf2f(raw[e]),y=att::bf2f(par[e]); ov[e]=hi==0?x*c-y*s:x*c+y*s; }
      u32x4 o4; o4.x=cvtpk_s(ov[0],ov[1]); o4.y=cvtpk_s(ov[2],ov[3]); o4.z=cvtpk_s(ov[4],ov[5]); o4.w=cvtpk_s(ov[6],ov[7]); qr[4+dd]=__builtin_bit_cast(bf16x8,o4); } }
  float mhat=0.f,l_reg=0.f;f32x16 o[2];o[0]=f32x16{};o[1]=f32x16{};const f32x16 zero=f32x16{};
  #define CMASK(P0,P1,t) do{}while(0)
  bool resc=false;
  #define START(P0,P1) do{ const float rm=rowmax(P0,P1); resc=false; \
    { const float dl=rm; mhat=fadd_s(mhat,dl); \
      _Pragma("unroll") for(int r=0;r<16;++r){P0[r]=fsub_s(P0[r],dl);P1[r]=fsub_s(P1[r],dl);} \
      } \
    _Pragma("unroll") for(int r=0;r<16;++r)P0[r]=__builtin_amdgcn_exp2f(P0[r]); }while(0)
  #define RESC() do{ if(resc){ asm volatile("s_waitcnt lgkmcnt(0)":::"memory"); \
      _Pragma("unroll") for(int d_=0;d_<2;++d_) _Pragma("unroll") for(int r=0;r<16;++r)o[d_][r]*=wsf[crow(r,hi)]; } }while(0)
  f32x16 pA0,pA1,pB0,pB1;
  int sl_prev=0,sl_cur=0,sl_next=SLOTB;
  #define ROT() do{sl_prev=sl_cur;sl_cur=sl_next;sl_next=(sl_next==(NSLOT-1)*SLOTB)?0:sl_next+SLOTB;}while(0)
  DMA_K(2,2*SLOTB);
  WAIT_BAR(3);
  qkt(pA0,pA1,Kbase,qr,r32,hi);asm volatile("s_nop 15\n\ts_nop 7":"+v"(pA0),"+v"(pA1));CMASK(pA0,pA1,0);
  START(pA0,pA1);
  _Pragma("unroll") for(int r=0;r<16;++r)pA1[r]=__builtin_amdgcn_exp2f(pA1[r]);
  WAIT_BAR(0);
  DMA_KN(3,0);DMA_V(1,SLOTB);
  ROT();
  kload8(kf,kp0+sl_cur);
  WAIT_BAR(2);
  s16x4 vlo[8],vhi[8]; u32x4 pw0,pw1,pw2,pw3;
  #define PKW(P,B) cvtpk_s(P[B],P[B+1])
  #define PAF(k) __builtin_bit_cast(bf16x8,pw##k)
  #define VFR(i) (bf16x8){vlo[i][0],vlo[i][1],vlo[i][2],vlo[i][3],vhi[i][0],vhi[i][1],vhi[i][2],vhi[i][3]}
  #define PIN(x) asm volatile("":"+v"(x))
  #define MX3(a,b,c) __builtin_fmaxf(__builtin_fmaxf((a),(b)),(c))
  #define GAPA(MF,A0,A1,A2,A3,W0,W1,PW) do{ MF; sacc+=A0; sacc+=A1; sacc+=A2; sacc+=A3; PIN(sacc); W0; W1; PIN(PW); SBAR(); }while(0)
  #define EX(v) __builtin_amdgcn_exp2f(v)
  #define GAPB(MF,X,B) do{ MF; X[B]=EX(X[B]); X[B+1]=EX(X[B+1]); X[B+2]=EX(X[B+2]); X[B+3]=EX(X[B+3]); PIN(X); SBAR(); }while(0)
  #define VRD(i) do{ vlo[i]=vtr(vp_+(((i)>>2)*4096+((i)&3)*1024)); vhi[i]=vtr(vp_+(((i)>>2)*4096+((i)&3)*1024+512)); }while(0)
  #define KRD(G,j) do{ if(G){ kload2(kf,kp0+sl_next,j); SBAR(); } }while(0)
  #define STEP(C0,C1,P0,P1,t,GK,GV,GL) do{ SBAR(); \
    const lds_cptr vp_=vp0+sl_prev; \
    VRD(0); SBAR(); float sacc=(P0[0]+P0[1]); \
    GAPA(C0=__builtin_amdgcn_mfma_f32_32x32x16_bf16(kf[0],qr[0],zero,0,0,0), P0[2],P0[3],P0[4],P0[5],     pw0[0]=PKW(P0,0), pw0[1]=PKW(P0,2), pw0); \
    VRD(4); SBAR(); GAPA(C1=__builtin_amdgcn_mfma_f32_32x32x16_bf16(kf[1],qr[0],zero,0,0,0), P0[6],P0[7],P0[8],P0[9],     pw0[2]=PKW(P0,4), pw0[3]=PKW(P0,6), pw0); \
    VRD(1); SBAR(); GAPA(C0=__builtin_amdgcn_mfma_f32_32x32x16_bf16(kf[2],qr[1],C0,0,0,0),   P0[10],P0[11],P0[12],P0[13], pw1[0]=PKW(P0,8), pw1[1]=PKW(P0,10), pw1); \
    VRD(5); SBAR(); GAPA(C1=__builtin_amdgcn_mfma_f32_32x32x16_bf16(kf[3],qr[1],C1,0,0,0),   P0[14],P0[15],P1[0],P1[1],   pw1[2]=PKW(P0,12),pw1[3]=PKW(P0,14), pw1); \
    VRD(2); SBAR(); GAPA(C0=__builtin_amdgcn_mfma_f32_32x32x16_bf16(kf[4],qr[2],C0,0,0,0),   P1[2],P1[3],P1[4],P1[5],     pw2[0]=PKW(P1,0), pw2[1]=PKW(P1,2), pw2); \
    VRD(6); SBAR(); GAPA(C1=__builtin_amdgcn_mfma_f32_32x32x16_bf16(kf[5],qr[2],C1,0,0,0),   P1[6],P1[7],P1[8],P1[9],     pw2[2]=PKW(P1,4), pw2[3]=PKW(P1,6), pw2); \
    VRD(3); SBAR(); GAPA(C0=__builtin_amdgcn_mfma_f32_32x32x16_bf16(kf[6],qr[3],C0,0,0,0),   P1[10],P1[11],P1[12],P1[13], pw3[0]=PKW(P1,8), pw3[1]=PKW(P1,10), pw3); \
    VRD(7); SBAR(); GAPA(C1=__builtin_amdgcn_mfma_f32_32x32x16_bf16(kf[7],qr[3],C1,0,0,0),   P1[14],P1[15],0.f,0.f,       pw3[2]=PKW(P1,12),pw3[3]=PKW(P1,14), pw3); \
    l_reg+=sacc; \
    { const lds_cptr rp_=kp0+sl_cur+8192; \
      const bf16x8 r0_=*(const __attribute__((address_space(3))) bf16x8*)(rp_), r1_=*(const __attribute__((address_space(3))) bf16x8*)(rp_+512), r2_=*(const __attribute__((address_space(3))) bf16x8*)(rp_+2048), r3_=*(const __attribute__((address_space(3))) bf16x8*)(rp_+2560); \
      C0=__builtin_amdgcn_mfma_f32_32x32x16_bf16(r0_,qr[4],C0,0,0,0); C1=__builtin_amdgcn_mfma_f32_32x32x16_bf16(r1_,qr[4],C1,0,0,0); \
      C0=__builtin_amdgcn_mfma_f32_32x32x16_bf16(r2_,qr[5],C0,0,0,0); C1=__builtin_amdgcn_mfma_f32_32x32x16_bf16(r3_,qr[5],C1,0,0,0); \
      _Pragma("unroll") for(int r=0;r<16;++r){C0[r]-=mhat;C1[r]-=mhat;} } \
    SBAR(); \
    if(GK){DMA_KN((t)+3,sl_cur);} if(GV){DMA_V((t)+1,sl_next);} \
    CMASK(C0,C1,t); \
    { float a=MX3(C0[0],C0[1],C1[0]),b=MX3(C0[2],C0[3],C1[1]); a=MX3(a,C1[2],C1[3]); \
      _Pragma("unroll") for(int r=4;r<16;r+=4){a=MX3(a,C0[r],C0[r+1]);b=MX3(b,C0[r+2],C0[r+3]);a=MX3(a,C1[r],C1[r+1]);b=MX3(b,C1[r+2],C1[r+3]);} \
      float rm=__builtin_fmaxf(a,b); { auto rr=__builtin_amdgcn_permlane32_swap(__float_as_uint(rm),__float_as_uint(rm),false,false); rm=__builtin_fmaxf(__uint_as_float(rr[0]),__uint_as_float(rr[1])); } \
      resc=false; \
      if(__builtin_expect(__any(rm>(float)THRL),0)){ const float dl=__builtin_fmaxf(rm,0.f); mhat+=dl; \
        _Pragma("unroll") for(int r=0;r<16;++r){C0[r]-=dl;C1[r]-=dl;} \
        const float f=__builtin_amdgcn_exp2f(-dl); l_reg*=f; if(hi==0)wsf[r32]=f; resc=true; } } \
    SBAR(); \
    GAPB(o[0]=__builtin_amdgcn_mfma_f32_32x32x16_bf16(PAF(0),VFR(0),o[0],0,0,0), C0,0); \
    GAPB(o[1]=__builtin_amdgcn_mfma_f32_32x32x16_bf16(PAF(0),VFR(4),o[1],0,0,0), C0,4); \
    KRD(GL,0); GAPB(o[0]=__builtin_amdgcn_mfma_f32_32x32x16_bf16(PAF(1),VFR(1),o[0],0,0,0), C0,8); \
    KRD(GL,1); GAPB(o[1]=__builtin_amdgcn_mfma_f32_32x32x16_bf16(PAF(1),VFR(5),o[1],0,0,0), C0,12); \
    KRD(GL,2); GAPB(o[0]=__builtin_amdgcn_mfma_f32_32x32x16_bf16(PAF(2),VFR(2),o[0],0,0,0), C1,0); \
    KRD(GL,3); GAPB(o[1]=__builtin_amdgcn_mfma_f32_32x32x16_bf16(PAF(2),VFR(6),o[1],0,0,0), C1,4); \
    GAPB(o[0]=__builtin_amdgcn_mfma_f32_32x32x16_bf16(PAF(3),VFR(3),o[0],0,0,0), C1,8); \
    GAPB(o[1]=__builtin_amdgcn_mfma_f32_32x32x16_bf16(PAF(3),VFR(7),o[1],0,0,0), C1,12); \
    }while(0)
  int t=1;
  #undef CMASK
  #define CMASK(P0,P1,t) do{}while(0)
  for(;t+5<NT;t+=2){
    DMA_R(t+2,sl_prev); STEP(pB0,pB1,pA0,pA1,t,true,true,true);     WAIT_BAR(3); RESC(); ROT();
    DMA_R(t+3,sl_prev); STEP(pA0,pA1,pB0,pB1,t+1,true,true,true);   WAIT_BAR(3); RESC(); ROT();
  }
  #undef CMASK
  #define CMASK(P0,P1,t) do{}while(0)
  #define ENDW(tt) do{ if((tt)+3<NT){WAIT_BAR(3);} else if((tt)+2<NT){WAIT_BAR(1);} else {WAIT_BAR(0);} }while(0)
  for(;t+1<NT;t+=2){
    if(t+2<NT){DMA_R(t+2,sl_prev);} STEP(pB0,pB1,pA0,pA1,t,(t+3<NT),(t+1<NT),(t+1<NT));       ENDW(t);   RESC(); ROT();
    if(t+3<NT){DMA_R(t+3,sl_prev);} STEP(pA0,pA1,pB0,pB1,t+1,(t+4<NT),(t+2<NT),(t+2<NT));     ENDW(t+1); RESC(); ROT();
  }
  STEP(pB0,pB1,pA0,pA1,NT-1,false,false,false); RESC();
  { float sacc=pB0[0]+pB0[1]; _Pragma("unroll") for(int r=2;r<16;++r)sacc+=pB0[r]; _Pragma("unroll") for(int r=0;r<16;++r)sacc+=pB1[r]; l_reg+=sacc;
    pw0=(u32x4){PKW(pB0,0),PKW(pB0,2),PKW(pB0,4),PKW(pB0,6)};pw1=(u32x4){PKW(pB0,8),PKW(pB0,10),PKW(pB0,12),PKW(pB0,14)};pw2=(u32x4){PKW(pB1,0),PKW(pB1,2),PKW(pB1,4),PKW(pB1,6)};pw3=(u32x4){PKW(pB1,8),PKW(pB1,10),PKW(pB1,12),PKW(pB1,14)};
    SBAR(); pv(o,vb0+sl_cur,PAF(0),PAF(1),PAF(2),PAF(3)); }
  #undef PKW
  #undef PAF
  #undef VFR
  #undef PIN
  #undef MX3
  #undef GAPA
  #undef GAPB
  #undef EX
  #undef VRD
  #undef KRD
  #undef STEP
  #undef ENDW
  {auto rr=__builtin_amdgcn_permlane32_swap(__float_as_uint(l_reg),__float_as_uint(l_reg),false,false);l_reg=__uint_as_float(rr[0])+__uint_as_float(rr[1]);}
  if(hi==0)wsf[32+r32]=l_reg;asm volatile("s_waitcnt lgkmcnt(0)":::"memory");
  float rli[16];
  #pragma unroll
  for(int r=0;r<16;++r)rli[r]=__builtin_amdgcn_rcpf(wsf[32+crow(r,hi)]);
  bf16*Ow=Ob+(long)(wid*QBLK)*OP;
  { bf16*stg=(bf16*)(shm+LDS_OST)+wid*2048;
    #pragma unroll
    for(int r=0;r<16;++r){const int orow=crow(r,hi);
      #pragma unroll
      for(int d0=0;d0<2;++d0)stg[orow*64+d0*32+r32]=__float2bfloat16(o[d0][r]*rli[r]);}
    asm volatile("s_waitcnt lgkmcnt(0)":::"memory");
    #pragma unroll
    for(int i=0;i<4;++i){const int row=i*8+(lane>>3),ch=lane&7; const u32x4 v=*(const u32x4*)(stg+row*64+ch*8); ATTN_STORE16(Ow+(long)row*OP+ch*8,v);} }
  asm volatile("s_waitcnt lgkmcnt(0)\n\ts_barrier":::"memory");
  #undef DMA_K
  #undef DMA_KN
  #undef DMA_R
  #undef DMA_V
  #undef CMASK
  #undef START
  #undef RESC
  #undef ROT
}
constexpr int ATTN_LDS_BYTES=LDS_BYTES;
#undef SBAR
#undef WAIT_BAR
}

constexpr int NWAVES = 8;
constexpr int M = 32768, D = 1024, SEQ = 8192, NB = 4, FF = 4096, NIN = 1440, NINP = 1536;
constexpr size_t MiB = 1u << 20;
constexpr size_t WS_PART = 2 * MiB;
constexpr size_t WS_WIN = 18 * MiB, WS_WUQ = 21 * MiB, WS_WUKV = 22 * MiB, WS_WO0 = 23 * MiB, WS_WUP0 = 25 * MiB, WS_WDN0 = 33 * MiB;
constexpr size_t WS_WQKV = 41 * MiB, WS_WO1 = 47 * MiB, WS_WUP1 = 49 * MiB, WS_WDN1 = 57 * MiB;
constexpr size_t WS_HB = 66 * MiB;
constexpr size_t WS_U = 130 * MiB;
constexpr size_t WS_Z = 130 * MiB, WS_MIX = 130 * MiB, WS_QA = 226 * MiB, WS_KA = 258 * MiB, WS_VA = 266 * MiB, WS_CQ = 274 * MiB, WS_CKV = 298 * MiB, WS_KR = 314 * MiB, WS_QB = 316 * MiB, WS_KVB = 386 * MiB;
constexpr size_t WS_QKV = 130 * MiB, WS_O1 = 322 * MiB;
constexpr size_t WS_END = 450 * MiB;
constexpr int LDS_BYTES = 143360;
static_assert(att::L_END <= 139264, "attention LDS");

#define LAS __attribute__((address_space(3)))
typedef unsigned short bf16;
typedef unsigned v4u __attribute__((ext_vector_type(4)));
typedef float f32x4 __attribute__((ext_vector_type(4)));
#define LDS_WAIT() asm volatile("s_waitcnt lgkmcnt(0)" ::: "memory")

__device__ __forceinline__ float wave_sum(float v) {
#pragma unroll
    for (int o = 1; o < 64; o <<= 1) v += __shfl_xor(v, o);
    return v;
}
__device__ __forceinline__ unsigned pk2(float lo, float hi) { return pg8::cvt_pk_bf16(lo, hi); }
__device__ __forceinline__ void transpose_item(const float* W, const float* gain, int K, int N, bf16* WT, LAS float* scr, int item, int lane, bool headperm = false) {
    const int nblk = N / 32, kb = item / nblk, nb = item % nblk, k0 = 64 * kb, n0 = 32 * nb;
#pragma unroll 8
    for (int i = 0; i < 32; ++i) { const int kk = 2 * i + (lane >> 5); const float g = gain ? gain[k0 + kk] : 1.f; scr[kk * 33 + (lane & 31)] = W[(size_t)(k0 + kk) * N + n0 + (lane & 31)] * g; }
    LDS_WAIT(); asm volatile("" ::: "memory");
    const int c = lane & 7;
#pragma unroll
    for (int j = 0; j < 4; ++j) { const int n = (lane >> 3) + 8 * j; const LAS float* s = scr + (8 * c) * 33 + n;
        v4u o; o.x = pk2(s[0 * 33], s[1 * 33]); o.y = pk2(s[2 * 33], s[3 * 33]); o.z = pk2(s[4 * 33], s[5 * 33]); o.w = pk2(s[6 * 33], s[7 * 33]);
        int nn = n0 + n; if (headperm && nn < 768) { const int d = nn & 63, hh = (nn >> 6) & 3; nn = (nn & ~255) + 128 * (d >> 5) + 32 * hh + (d & 31); }
        *(v4u*)(WT + (size_t)nn * K + k0 + 8 * c) = o; }
    LDS_WAIT(); asm volatile("" ::: "memory");
}

#define XB_TMO      128
#define XB_XCNT(j)  (256  + 64 * (j))
#define XB_XSUB(j)  (1280 + 64 * (j))
#define XB_XGEN(j)  (2304 + 64 * (j))
#define XB_TOP      3328
#define XB_TOPGEN   3392
#define XCD_BAR_WORDS 3456
#define XB_SPIN_CAP (1u << 22)

__device__ __forceinline__ unsigned xb_ld(unsigned* p)              { return __hip_atomic_load(p, __ATOMIC_RELAXED, __HIP_MEMORY_SCOPE_AGENT); }
__device__ __forceinline__ unsigned xb_add(unsigned* p, unsigned v) { return __hip_atomic_fetch_add(p, v, __ATOMIC_RELAXED, __HIP_MEMORY_SCOPE_AGENT); }
__device__ __forceinline__ unsigned xb_xcc_id() { return (unsigned)__builtin_amdgcn_s_getreg((3 << 11) | 20) & 0xFu; }
#define XB_SPIN(cond, bar) do { unsigned _sp = 0; while (cond) { __builtin_amdgcn_s_sleep(1); \
    if ((++_sp & 255u) == 0u) { if (xb_ld(&(bar)[XB_TMO])) break; if (_sp > XB_SPIN_CAP) { atomicAdd(&(bar)[XB_TMO], 1u); break; } } } } while (0)

struct XcdBarrier {
    unsigned* bar; unsigned x;
    volatile LAS unsigned* st;
};

__device__ __forceinline__ XcdBarrier xcd_barrier_post(unsigned* bar, volatile LAS unsigned* st) {
    XcdBarrier b; b.bar = bar; b.x = xb_xcc_id(); b.st = st;
    if (threadIdx.x == 0) (void)xb_add(&bar[XB_XCNT(b.x)], 1u);
    return b;
}
__device__ __forceinline__ void xcd_barrier_complete(unsigned* bar, unsigned x, unsigned& nloc, unsigned& nx) {
    const unsigned G = gridDim.x * gridDim.y * gridDim.z;
    unsigned sum, cnt, mine, sp = 0u;
    for (;;) {
        sum = 0u; cnt = 0u; mine = 0u;
#pragma unroll
        for (unsigned j = 0; j < 16; ++j) { const unsigned c = xb_ld(&bar[XB_XCNT(j)]); sum += c; cnt += (c > 0u) ? 1u : 0u; mine = (j == x) ? c : mine; }
        if (sum == G) break;
        __builtin_amdgcn_s_sleep(1);
        if ((++sp & 255u) == 0u) { if (xb_ld(&bar[XB_TMO])) break; if (sp > XB_SPIN_CAP) { atomicAdd(&bar[XB_TMO], 1u); break; } }
    }
    nloc = mine > 0u ? mine : 1u; nx = cnt > 0u ? cnt : 1u;
}

__device__ __forceinline__ void xcd_barrier(const XcdBarrier& b) {
    asm volatile("s_waitcnt vmcnt(0)" ::: "memory");
    __syncthreads();
    if (threadIdx.x == 0) {
        unsigned* bar = b.bar;
        __builtin_amdgcn_s_waitcnt(0);
        unsigned nloc = b.st[0], nx = b.st[1];
        if (nloc == 0u) { xcd_barrier_complete(bar, b.x, nloc, nx); b.st[0] = nloc; b.st[1] = nx; }
        const unsigned old = xb_add(&bar[XB_XSUB(b.x)], 1u);
        const unsigned gen = old / nloc;
        if (old + 1u == (gen + 1u) * nloc) {
            __builtin_amdgcn_fence(__ATOMIC_RELEASE, "agent");
            asm volatile("s_waitcnt vmcnt(0)" ::: "memory");
            const unsigned og = xb_add(&bar[XB_TOP], 1u);
            const unsigned tg = og / nx;
            if (og + 1u == (tg + 1u) * nx) xb_add(&bar[XB_TOPGEN], 1u);
            else XB_SPIN(xb_ld(&bar[XB_TOPGEN]) == tg, bar);
            __builtin_amdgcn_fence(__ATOMIC_ACQUIRE, "agent");
            xb_add(&bar[XB_XGEN(b.x)], 1u);
            asm volatile("s_waitcnt vmcnt(0)" ::: "memory");
        } else {
            XB_SPIN(xb_ld(&bar[XB_XGEN(b.x)]) == gen, bar);
            __builtin_amdgcn_fence(__ATOMIC_ACQUIRE, "agent");
            asm volatile("s_waitcnt vmcnt(0)" ::: "memory");
        }
    }
    __syncthreads();
}

struct Args { const float* in[17]; float* out; unsigned char* ws; int ph_lo, ph_hi; };

__device__ __forceinline__ void ld8(const bf16* p, float (&v)[8]) { const v4u w = *(const v4u*)p;
#pragma unroll
    for (int j = 0; j < 4; ++j) { v[2 * j] = __uint_as_float(w[j] << 16); v[2 * j + 1] = __uint_as_float(w[j] & 0xffff0000u); } }
__device__ __forceinline__ void up8(const v4u w, float (&v)[8]) {
#pragma unroll
    for (int j = 0; j < 4; ++j) { v[2 * j] = __uint_as_float(w[j] << 16); v[2 * j + 1] = __uint_as_float(w[j] & 0xffff0000u); } }
__device__ __forceinline__ void st8(bf16* p, const float (&v)[8]) { v4u o; o.x = pk2(v[0], v[1]); o.y = pk2(v[2], v[3]); o.z = pk2(v[4], v[5]); o.w = pk2(v[6], v[7]); *(v4u*)p = o; }

__device__ __forceinline__ void head_norm_rope(float (&v)[8], const float* gain, int j, int prow, int pcol, float scale, const float* tc, const float* ts) {
    float ss = 0.f;
#pragma unroll
    for (int e = 0; e < 8; ++e) ss += v[e] * v[e];
    ss += __shfl_xor(ss, 1); ss += __shfl_xor(ss, 2); ss += __shfl_xor(ss, 4);
    const float rstd = 1.0f / sqrtf(ss * (1.0f / 64.0f) + pg8::NORM_EPS);
    const int pos = (j < 4) ? prow : pcol; const int o16 = pos * 16 + (j & 1) * 8;
    const f32x4 c0 = *(const f32x4*)(tc + o16), c1 = *(const f32x4*)(tc + o16 + 4), s0 = *(const f32x4*)(ts + o16), s1 = *(const f32x4*)(ts + o16 + 4);
    const f32x4 g0 = *(const f32x4*)(gain + j * 8), g1 = *(const f32x4*)(gain + j * 8 + 4);
#pragma unroll
    for (int e = 0; e < 8; ++e) {
        const float g = e < 4 ? g0[e & 3] : g1[e & 3], c = e < 4 ? c0[e & 3] : c1[e & 3], s = e < 4 ? s0[e & 3] : s1[e & 3];
        const float y = v[e] * rstd * g; const float py = __shfl_xor(y, 2);
        v[e] = (((j & 2) == 0) ? y * c - py * s : y * c + py * s) * scale;
    }
}

__global__ void __launch_bounds__(NWAVES * 64, 2) fwd_kernel(Args args) {
    extern __shared__ __attribute__((aligned(16))) unsigned char lds[];
    cg::grid_group grid = cg::this_grid();
    LAS unsigned char* L = (LAS unsigned char*)lds;
    const int tid = threadIdx.x, lane = tid & 63, wave = __builtin_amdgcn_readfirstlane(tid >> 6);
    const int G = gridDim.x; const int bx = blockIdx.x;
    const int vcu = (G % 8 == 0) ? (bx % 8) * (G / 8) + bx / 8 : bx;
    const int gw = vcu * NWAVES + wave, NGW = G * NWAVES;
    unsigned char* ws = args.ws;
    const float* x = args.in[0]; float* out = args.out;
    float* PART = (float*)(ws + WS_PART);
#define PARTN(k) (PART + (size_t)(k) * M * 16)
    bf16 *HB = (bf16*)(ws + WS_HB), *U = (bf16*)(ws + WS_U), *Z = (bf16*)(ws + WS_Z), *MIX = (bf16*)(ws + WS_MIX);
    bf16 *QA = (bf16*)(ws + WS_QA), *KA = (bf16*)(ws + WS_KA), *VA = (bf16*)(ws + WS_VA), *CQ = (bf16*)(ws + WS_CQ), *CKV = (bf16*)(ws + WS_CKV), *KR = (bf16*)(ws + WS_KR);
    bf16 *QB = (bf16*)(ws + WS_QB), *KVB = (bf16*)(ws + WS_KVB), *QKV = (bf16*)(ws + WS_QKV), *O1 = (bf16*)(ws + WS_O1);
    bf16 *WIN = (bf16*)(ws + WS_WIN), *WUQ = (bf16*)(ws + WS_WUQ), *WUKV = (bf16*)(ws + WS_WUKV), *WO0 = (bf16*)(ws + WS_WO0), *WUP0 = (bf16*)(ws + WS_WUP0), *WDN0 = (bf16*)(ws + WS_WDN0);
    bf16 *WQKV = (bf16*)(ws + WS_WQKV), *WO1 = (bf16*)(ws + WS_WO1), *WUP1 = (bf16*)(ws + WS_WUP1), *WDN1 = (bf16*)(ws + WS_WDN1);
    const int lo = args.ph_lo, hi = args.ph_hi;
    float* TAC = (float*)(ws + MiB); float* TAS = TAC + 2048; float* TBC = TAS + 2048; float* TBS = TBC + 1024;
    volatile LAS unsigned* MISC = (volatile LAS unsigned*)(L + 139264);
    if (tid < 2) MISC[tid] = 0u;
    __syncthreads();
    unsigned* BARW = (unsigned*)(ws + 8192);
    XcdBarrier xbar; xbar.bar = BARW; xbar.x = 0; xbar.st = MISC;
#ifndef PROBE_PHASE
#define PROBE_PHASE -1
#endif
#define IN(k) (lo <= (k) && (k) < hi)
#define REPS(k) ((PROBE_PHASE == (k)) ? 2 : 1)
#define SEAM(k) do { if (IN(k) && IN((k) + 1)) { if ((k) == 0) { grid.sync(); xbar = xcd_barrier_post(BARW, MISC); } else xcd_barrier(xbar); } } while (0)
    constexpr float C2A = 0.125f * att::LOG2E;
    constexpr float C2B = 0.10206207261596577f * att::LOG2E;

    if (IN(0)) {
        if (bx == 0) for (int i = tid; i < XCD_BAR_WORDS; i += NWAVES * 64) BARW[i] = 0u;
        LAS float* scr = (LAS float*)(L + wave * 16384);
        constexpr int I0 = 16 * 45, I1 = 6 * 24, I2 = 4 * 32, I3 = 16 * 32, I4 = 16 * 128, I5 = 64 * 32, I6 = 16 * 96, I7 = 16 * 32, I8 = I4, I9 = I5;
        constexpr int NITEMS = I0 + I1 + I2 + I3 + I4 + I5 + I6 + I7 + I8 + I9;
        for (int it = gw; it < NITEMS; it += NGW) {
            int r = it;
            if (r < I0) { transpose_item(args.in[2], args.in[1], D, NIN, WIN, scr, r, lane, true); continue; } r -= I0;
            if (r < I1) { transpose_item(args.in[6], args.in[5], 384, 768, WUQ, scr, r, lane); continue; } r -= I1;
            if (r < I2) { transpose_item(args.in[8], args.in[7], 256, 1024, WUKV, scr, r, lane); continue; } r -= I2;
            if (r < I3) { transpose_item(args.in[9], nullptr, D, D, WO0, scr, r, lane); continue; } r -= I3;
            if (r < I4) { transpose_item(args.in[14], args.in[13], D, FF, WUP0, scr, r, lane); continue; } r -= I4;
            if (r < I5) { transpose_item(args.in[15], nullptr, FF, D, WDN0, scr, r, lane); continue; } r -= I5;
            if (r < I6) { transpose_item(args.in[10], args.in[1] + D, D, 3 * D, WQKV, scr, r, lane); continue; } r -= I6;
            if (r < I7) { transpose_item(args.in[12], nullptr, D, D, WO1, scr, r, lane); continue; } r -= I7;
            if (r < I8) { transpose_item(args.in[14] + (size_t)D * FF, args.in[13] + D, D, FF, WUP1, scr, r, lane); continue; } r -= I8;
            transpose_item(args.in[15] + (size_t)FF * D, nullptr, FF, D, WDN1, scr, r, lane);
        }
        for (int i = bx * 512 + tid; i < 128 * 16; i += G * 512) { const int pos = i >> 4, f = i & 15; float s, c; att::sincos_acc((float)pos * exp2f(-(float)f * (13.287712379549449f / 16.0f)), s, c); TAC[i] = c; TAS[i] = s; }
        for (int i = bx * 512 + tid; i < 128 * 8; i += G * 512) { const int pos = i >> 3, f = i & 7; float s, c; att::sincos_acc((float)pos * exp2f(-(float)f * (13.287712379549449f / 8.0f)), s, c); TBC[i] = c; TBS[i] = s; }
        { v4u* p = (v4u*)(WIN + (size_t)NIN * D); const int n16 = (NINP - NIN) * D * 2 / 16; for (int i = bx * 512 + tid; i < n16; i += G * 512) p[i] = (v4u){0u, 0u, 0u, 0u}; }
        for (int m = gw; m < M; m += NGW) {
            const f32x4* xr = (const f32x4*)(x + (size_t)m * D) + lane; f32x4 v[4]; float s = 0.f;
#pragma unroll
            for (int j = 0; j < 4; ++j) { v[j] = xr[64 * j]; s += (v[j].x * v[j].x + v[j].y * v[j].y) + (v[j].z * v[j].z + v[j].w * v[j].w); }
            s = wave_sum(s);
            unsigned long long* o8 = (unsigned long long*)(HB + (size_t)m * D) + lane;
#pragma unroll
            for (int j = 0; j < 4; ++j) o8[64 * j] = (unsigned long long)pk2(v[j].x, v[j].y) | ((unsigned long long)pk2(v[j].z, v[j].w) << 32);
            if (lane < 16) PARTN(0)[(size_t)m * 16 + lane] = (lane == 0) ? s : 0.f;
        }
    }
    SEAM(0);
    if (IN(1)) {
        pg8::Gemm g{HB, WIN, M, NINP, D}; pg8::StaticOrder S; S.init(M, NINP, G, bx); S.rep = REPS(1);
        pg8::EpiIn E{PARTN(0), QA, KA, VA, CQ, CKV, KR, PARTN(5), PARTN(6), args.in[3], args.in[4], TAC, TAS, TBC, TBS, C2A};
        pg8::gemm_phase<pg8::EpiIn, pg8::StaticOrder, true, true>(L, g, S, E);
    }
    SEAM(1);
    if (IN(3)) {
        { pg8::Gemm g{CQ, WUQ, M, 768, 384}; pg8::StaticOrder S; S.init(M, 768, G, bx);
          pg8::EpiScale<0> E{QB, 768, PARTN(5), 1.0f / 384.0f, 3, C2B};
          pg8::gemm_phase<pg8::EpiScale<0>, pg8::StaticOrder, true, true>(L, g, S, E); }
        { pg8::Gemm g{CKV, WUKV, M, 1024, 256}; pg8::StaticOrder S; S.init(M, 1024, G, bx);
          pg8::EpiScale<0> E{KVB, 1024, PARTN(6), 1.0f / 256.0f, 0, 1.f};
          pg8::gemm_phase<pg8::EpiScale<0>, pg8::StaticOrder, true, true>(L, g, S, E); }
    }
    SEAM(3);
    if (IN(4)) {
        for (int uu = vcu; uu < 2048 * REPS(4); uu += G) { const int u = uu & 2047;
            const int pair = u >> 5, qb = u & 31; const int typ = (pair >> 3) & 1; const int idx = (pair >> 4) * 8 + (pair & 7); const int b = idx >> 3, h = idx & 7;
            const long rowbase = (long)b * SEQ;
            const bool has_next = (uu + G) < 2048 * REPS(4); const int un = (uu + G) & 2047; const int pairn = un >> 5; const int typn = (pairn >> 3) & 1; const int idxn = (pairn >> 4) * 8 + (pairn & 7); const int bn = idxn >> 3, hn = idxn & 7;
            att::Next nx;
            if (typn == 0) nx = att::Next{KA + (hn >> 2) * 64, KR, VA + (hn >> 2) * 64, 128, 32, 128, (long)bn * SEQ, 0, SEQ / 64 - 1, 64};
            else nx = att::Next{KVB + hn * 128, KR, KVB + hn * 128 + 64, 1024, 32, 1024, (long)bn * SEQ, 0, SEQ / 64 - 1, 96};
            if (typ == 0) { att::Desc d{QA + h * 64, nullptr, KA + (h >> 2) * 64, nullptr, VA + (h >> 2) * 64, MIX + h * 64, 512, 0, 128, 0, 128, 1024};
                (void)d; attn_ex::attn_unit<8, 512, 128, 128, 1024>((const attn_ex::bf16*)(QA + (size_t)(rowbase + qb * 256) * 512 + h * 64), (const attn_ex::bf16*)(KA + (size_t)rowbase * 128 + (h >> 2) * 64),
                    (const attn_ex::bf16*)(VA + (size_t)rowbase * 128 + (h >> 2) * 64), (attn_ex::bf16*)(MIX + (size_t)(rowbase + qb * 256) * 1024 + h * 64), (char*)lds); }
            else { att::Desc d{QB + h * 96, QB + h * 96 + 64, KVB + h * 128, KR, KVB + h * 128 + 64, MIX + 512 + h * 64, 768, 768, 1024, 32, 1024, 1024};
                (void)d; attn_ex96::attn_unit<8, 768, 1024, 1024, 1024>((const attn_ex96::bf16*)(QB + (size_t)(rowbase + qb * 256) * 768 + h * 96), (const attn_ex96::bf16*)(QB + (size_t)(rowbase + qb * 256) * 768 + h * 96 + 64),
                    (const attn_ex96::bf16*)(KVB + (size_t)rowbase * 1024 + h * 128), (const attn_ex96::bf16*)(KR + (size_t)rowbase * 32), (const attn_ex96::bf16*)(KVB + (size_t)rowbase * 1024 + h * 128 + 64),
                    (attn_ex96::bf16*)(MIX + (size_t)(rowbase + qb * 256) * 1024 + 512 + h * 64), qb * 256, (char*)lds); }
        }
    }
    SEAM(4);
    if (IN(5)) {
        pg8::Gemm g{MIX, WO0, M, D, D}; pg8::StaticOrder S; S.init(M, D, G, bx); S.rep = REPS(5);
        pg8::EpiRes E{x, nullptr, HB, PARTN(1), D};
        pg8::gemm_phase<pg8::EpiRes, pg8::StaticOrder, true, true>(L, g, S, E);
    }
    SEAM(5);
    if (IN(6)) {
        pg8::Gemm g{HB, WUP0, M, FF, D}; pg8::StaticOrder S; S.init(M, FF, G, bx); S.rep = REPS(6);
        pg8::EpiScale<1> E{U, FF, PARTN(1), 1.0f / D, 0, 1.f};
        pg8::gemm_phase<pg8::EpiScale<1>, pg8::StaticOrder, true, true>(L, g, S, E);
    }
    SEAM(6);
    if (IN(7)) {
        pg8::Gemm g{U, WDN0, M, D, FF}; pg8::StaticOrder S; S.init(M, D, G, bx);
        pg8::EpiRes E{nullptr, nullptr, HB, PARTN(2), D, HB};
        pg8::gemm_phase<pg8::EpiRes, pg8::StaticOrder, true, true>(L, g, S, E);
    }
    SEAM(7);
    if (IN(8)) {
        pg8::Gemm g{HB, WQKV, M, 3 * D, D}; pg8::StaticOrder S; S.init(M, 3 * D, G, bx); S.rep = REPS(8);
        pg8::EpiScale<0> E{QKV, 3 * D, PARTN(2), 1.0f / D, 4, C2A, M};
        pg8::gemm_phase<pg8::EpiScale<0>, pg8::StaticOrder, true, true>(L, g, S, E);
    }
    SEAM(8);
    if (IN(9)) {
        for (int uu = vcu; uu < 2048 * REPS(9); uu += G) { const int u = uu & 2047;
            const int pair = u >> 5, qb = u & 31; const int b = pair >> 4, h = pair & 15;
            const int R0 = qb * 4; const int tlo = min(max(R0 - 4, 0), 120), thi = min(max(R0 + 3 - 4, 0), 120) + 7;
            att::Desc d{QKV + (size_t)h * M * 64, nullptr, QKV + (size_t)(16 + h) * M * 64, nullptr, QKV + (size_t)(32 + h) * M * 64, O1 + h * 64, 64, 0, 64, 0, 64, D};
            const bool has_next = (uu + G) < 2048 * REPS(9); const int un = (uu + G) & 2047; const int pairn = un >> 5, qbn = un & 31; const int bn = pairn >> 4, hn = pairn & 15;
            const int R0n = qbn * 4; const int tlon = min(max(R0n - 4, 0), 120), thin = min(max(R0n + 3 - 4, 0), 120) + 7;
            const att::Next nx{QKV + (size_t)(16 + hn) * M * 64, KR, QKV + (size_t)(32 + hn) * M * 64, 64, 32, 64, (long)bn * SEQ, tlon, thin, 64};
            if (wave & 1) att::unit<64, 1, 1>(d, (long)b * SEQ, qb * 256, tlo, thi, args.in[11] + h * 465, L, uu != vcu, has_next, nx);
            else att::unit<64, 1, 0>(d, (long)b * SEQ, qb * 256, tlo, thi, args.in[11] + h * 465, L, uu != vcu, has_next, nx);
        }
    }
    SEAM(9);
    if (IN(10)) {
        pg8::Gemm g{O1, WO1, M, D, D}; pg8::StaticOrder S; S.init(M, D, G, bx);
        pg8::EpiRes E{nullptr, nullptr, HB, PARTN(3), D, HB};
        pg8::gemm_phase<pg8::EpiRes, pg8::StaticOrder, true, true>(L, g, S, E);
    }
    SEAM(10);
    if (IN(11)) {
        pg8::Gemm g{HB, WUP1, M, FF, D}; pg8::StaticOrder S; S.init(M, FF, G, bx);
        pg8::EpiScale<1> E{U, FF, PARTN(3), 1.0f / D, 0, 1.f};
        pg8::gemm_phase<pg8::EpiScale<1>, pg8::StaticOrder, true, true>(L, g, S, E);
    }
    SEAM(11);
    if (IN(12)) {
        pg8::Gemm g{U, WDN1, M, D, FF}; pg8::StaticOrder S; S.init(M, D, G, bx);
        pg8::EpiRes E{nullptr, out, nullptr, PARTN(4), D, HB};
        pg8::gemm_phase<pg8::EpiRes, pg8::StaticOrder, true, true>(L, g, S, E);
    }
    SEAM(12);
    if (IN(13)) {
        const float* gf = args.in[16];
        for (int m = gw; m < M; m += NGW) {
            f32x4* xr = (f32x4*)(out + (size_t)m * D) + lane; const f32x4* pp = (const f32x4*)(PARTN(4) + (size_t)m * 16);
            const f32x4 a = pp[0], b = pp[1], c = pp[2], d4 = pp[3];
            const float s = ((a[0] + a[1]) + (a[2] + a[3])) + ((b[0] + b[1]) + (b[2] + b[3])) + ((c[0] + c[1]) + (c[2] + c[3])) + ((d4[0] + d4[1]) + (d4[2] + d4[3]));
            const float rstd = 1.0f / sqrtf(s * (1.0f / D) + pg8::NORM_EPS);
#pragma unroll
            for (int j = 0; j < 4; ++j) { const f32x4 v = xr[64 * j]; const f32x4 gg = ((const f32x4*)gf)[lane + 64 * j]; xr[64 * j] = v * rstd * gg; }
        }
    }
#undef IN
#undef SEAM
}

#ifndef MK_PER_PHASE
#define MK_PER_PHASE 0
#endif
extern "C" void kernel_launch(void* const* d_in, const int* in_sizes, int n_in, void* d_out, int out_size, void* d_ws, size_t ws_size, hipStream_t stream) {
    static int grid = 0;
    if (grid == 0) {
        if (n_in != 17 || in_sizes[0] != M * D || out_size != M * D || ws_size < WS_END) { fprintf(stderr, "kernel_launch: unexpected shapes / workspace (n_in %d, in0 %d, out %d, ws %zu)\n", n_in, n_in > 0 ? in_sizes[0] : -1, out_size, ws_size); grid = -1; return; }
        int dev = 0, cus = 0, per_cu = 0;
        if (hipGetDevice(&dev) != hipSuccess || hipDeviceGetAttribute(&cus, hipDeviceAttributeMultiprocessorCount, dev) != hipSuccess) { grid = -1; return; }
        if (hipFuncSetAttribute((const void*)fwd_kernel, hipFuncAttributeMaxDynamicSharedMemorySize, LDS_BYTES) != hipSuccess) { fprintf(stderr, "kernel_launch: hipFuncSetAttribute failed\n"); grid = -1; return; }
        if (hipOccupancyMaxActiveBlocksPerMultiprocessor(&per_cu, (const void*)fwd_kernel, NWAVES * 64, LDS_BYTES) != hipSuccess || per_cu < 1) { fprintf(stderr, "kernel_launch: occupancy query says %d\n", per_cu); per_cu = 1; }
        (void)hipGetLastError();
        grid = cus * per_cu;
        fprintf(stderr, "kernel_launch: grid %d (cus %d x %d)\n", grid, cus, per_cu);
    }
    if (grid < 0) return;
    Args a{};
    for (int i = 0; i < 17; ++i) a.in[i] = (const float*)d_in[i];
    a.out = (float*)d_out; a.ws = (unsigned char*)d_ws;
#if MK_PER_PHASE
    for (int p = 0; p < 14; ++p) { a.ph_lo = p; a.ph_hi = p + 1; hipLaunchKernelGGL(fwd_kernel, dim3(grid), dim3(NWAVES * 64), LDS_BYTES, stream, a); }
#else
    a.ph_lo = 0; a.ph_hi = 14;
    void* kargs[] = {&a};
    hipError_t e = hipLaunchCooperativeKernel((const void*)fwd_kernel, dim3(grid), dim3(NWAVES * 64), kargs, LDS_BYTES, stream);
    if (e != hipSuccess) fprintf(stderr, "cooperative launch failed: %s (grid %d)\n", hipGetErrorString(e), grid);
#endif
}
```
